# Optimizing an MI355X kernel written in HIP

```python
import math
import jax, jax.numpy as jnp
from jax import lax
import numpy as np

D_MODEL = 1024
BATCH = 8
SEQ = 4096
DEPTH = 2

CHUNK = 64
Q_BLOCK = 128
HEAD_DIM = 64
FOX_HEADS = 8
SB_HEADS = 8
FOX_WIDTH = FOX_HEADS * HEAD_DIM
SB_WIDTH = SB_HEADS * HEAD_DIM
BRANCH_WIDTH = FOX_WIDTH
N_BRANCHES = 2
IN_WIDTH = 3 * FOX_WIDTH + FOX_HEADS + 3 * SB_WIDTH + N_BRANCHES * D_MODEL
PEER_HEADS = 8
PEER_DK = 128
N_KEYS = 128
N_EXPERTS = N_KEYS * N_KEYS
PEER_TOPK = 16
PEER_BLOCK = 128
EPS = 1e-6

kernel_name = "hybrid_fox_stickbreak_peer_adaln"


def rmsnorm(x, gain):
    x32 = x.astype(jnp.float32)
    y = x32 * lax.rsqrt(jnp.mean(x32 * x32, axis=-1, keepdims=True) + EPS)
    return y.astype(x.dtype) * gain


def modulate(h, shift, scale):
    return h * (1.0 + scale[:, None, :]) + shift[:, None, :]


def split_heads(t, n_heads):
    b, s, _ = t.shape
    return t.reshape(b, s, n_heads, HEAD_DIM).transpose(0, 2, 1, 3)


def merge_heads(t):
    b, h, s, d = t.shape
    return t.transpose(0, 2, 1, 3).reshape(b, s, h * d)


def forgetting_attention(q, k, v, log_f):
    seq = q.shape[2]
    scale = 1.0 / math.sqrt(HEAD_DIM)
    cum_f = lax.cumsum(log_f, axis=2)
    outs = []
    for i in range(seq // Q_BLOCK):
        lo, hi = i * Q_BLOCK, (i + 1) * Q_BLOCK
        qb = q[:, :, lo:hi]
        kp = k[:, :, :hi]
        vp = v[:, :, :hi]
        logits = (jnp.einsum('bhqd,bhkd->bhqk', qb, kp) * scale
                  + cum_f[:, :, lo:hi, None] - cum_f[:, :, None, :hi])
        mask = (lo + jnp.arange(Q_BLOCK))[:, None] >= jnp.arange(hi)[None, :]
        p = jax.nn.softmax(jnp.where(mask, logits, -jnp.inf), axis=-1)
        outs.append(jnp.einsum('bhqk,bhkd->bhqd', p, vp))
    return jnp.concatenate(outs, axis=2)


def stick_breaking_attention(q, k, v):
    seq = q.shape[2]
    scale = 1.0 / math.sqrt(HEAD_DIM)
    outs = []
    for i in range(seq // Q_BLOCK):
        lo, hi = i * Q_BLOCK, (i + 1) * Q_BLOCK
        qb = q[:, :, lo:hi]
        kp = k[:, :, :hi]
        vp = v[:, :, :hi]
        z = jnp.einsum('bhqd,bhkd->bhqk', qb, kp) * scale
        mask = (lo + jnp.arange(Q_BLOCK))[:, None] > jnp.arange(hi)[None, :]
        log_one_minus = jnp.where(mask, jax.nn.log_sigmoid(-z), 0.0)
        suffix = lax.cumsum(log_one_minus, axis=3, reverse=True) - log_one_minus
        weights = jnp.where(mask, jnp.exp(jax.nn.log_sigmoid(z) + suffix), 0.0)
        outs.append(jnp.einsum('bhqk,bhkd->bhqd', weights, vp))
    return jnp.concatenate(outs, axis=2)


def qk_rmsnorm(t, gain):
    t = t * lax.rsqrt(jnp.mean(t * t, axis=-1, keepdims=True) + EPS)
    return t * gain.astype(jnp.float32)


def mixing_sublayer(h, w_in, fox_bf, fox_q_gain, fox_k_gain, w_branch, w_out):
    b, s, _ = h.shape
    proj = h @ w_in
    sizes = [FOX_WIDTH] * 3 + [FOX_HEADS] + [SB_WIDTH] * 3 + [N_BRANCHES * D_MODEL]
    points, acc = [], 0
    for sz in sizes[:-1]:
        acc += sz
        points.append(acc)
    qa, ka, va, fa, qb, kb, vb, gates = jnp.split(proj, points, axis=-1)

    f32 = jnp.float32
    qa = qk_rmsnorm(split_heads(qa, FOX_HEADS).astype(f32), fox_q_gain)
    ka = qk_rmsnorm(split_heads(ka, FOX_HEADS).astype(f32), fox_k_gain)
    va = split_heads(va, FOX_HEADS).astype(f32)
    log_f = jax.nn.log_sigmoid((fa + fox_bf).astype(f32)).transpose(0, 2, 1)
    y_fox = merge_heads(forgetting_attention(qa, ka, va, log_f)).astype(h.dtype)

    qb = split_heads(qb, SB_HEADS).astype(f32)
    kb = split_heads(kb, SB_HEADS).astype(f32)
    vb = split_heads(vb, SB_HEADS).astype(f32)
    y_sb = merge_heads(stick_breaking_attention(qb, kb, vb)).astype(h.dtype)

    branches = jnp.stack([y_fox, y_sb], axis=2)
    branches = jnp.einsum('bsgc,gcd->bsgd', branches, w_branch)
    gate = jax.nn.sigmoid(gates.reshape(b, s, N_BRANCHES, D_MODEL))
    merged = jnp.sum(gate * branches, axis=2)
    return merged @ w_out


def peer_sublayer(h, peer_wq, peer_k1, peer_k2, peer_u, peer_v):
    b, s, d = h.shape
    q = (h @ peer_wq).reshape(b, s, PEER_HEADS, PEER_DK).astype(jnp.float32)
    half = PEER_DK // 2
    s1 = jnp.einsum('bshd,hnd->bshn', q[..., :half], peer_k1.astype(jnp.float32))
    s2 = jnp.einsum('bshd,hnd->bshn', q[..., half:], peer_k2.astype(jnp.float32))
    v1, i1 = lax.top_k(s1, PEER_TOPK)
    v2, i2 = lax.top_k(s2, PEER_TOPK)
    cand = (v1[..., :, None] + v2[..., None, :]).reshape(b, s, PEER_HEADS, PEER_TOPK * PEER_TOPK)
    top_s, j = lax.top_k(cand, PEER_TOPK)
    e1 = jnp.take_along_axis(i1, j // PEER_TOPK, axis=-1)
    e2 = jnp.take_along_axis(i2, j % PEER_TOPK, axis=-1)
    idx = e1 * N_KEYS + e2
    g = jax.nn.softmax(top_s, axis=-1)

    n_blocks = (b * s) // PEER_BLOCK
    xf = h.reshape(n_blocks, PEER_BLOCK, d)
    idx_b = idx.reshape(n_blocks, PEER_BLOCK, PEER_HEADS, PEER_TOPK)
    g_b = g.reshape(n_blocks, PEER_BLOCK, PEER_HEADS, PEER_TOPK)

    def expert_block(args):
        xb, ib, gb = args
        u = jnp.take(peer_u, ib, axis=0)
        act = jax.nn.gelu(jnp.einsum('thkd,td->thk', u, xb), approximate=False)
        v = jnp.take(peer_v, ib, axis=0)
        return jnp.einsum('thk,thkd->td', (gb * act).astype(v.dtype), v)

    y = lax.map(expert_block, (xf, idx_b, g_b))
    return y.reshape(b, s, d)


def setup_inputs(seed: int = 0) -> dict:
    key = jax.random.key(seed)
    ks = jax.random.split(key, 18)
    D = D_MODEL

    def nrm(k, shape, s):
        return jax.random.normal(k, shape, jnp.float32) * s

    return {
        "x": nrm(ks[0], (BATCH, SEQ, D), 1.0),
        "c": nrm(ks[1], (BATCH, D), 1.0),
        "ada_w": nrm(ks[2], (DEPTH, D, 6 * D), 0.5 * D ** -0.5),
        "ada_b": nrm(ks[3], (DEPTH, 6 * D), 0.02),
        "attn_norm": 1.0 + nrm(ks[4], (DEPTH, D), 0.02),
        "ffn_norm": 1.0 + nrm(ks[5], (DEPTH, D), 0.02),
        "w_in": nrm(ks[6], (DEPTH, D, IN_WIDTH), D ** -0.5),
        "fox_bf": jnp.linspace(1.0, 5.0, FOX_HEADS, dtype=jnp.float32)[None, :]
                  + nrm(ks[7], (DEPTH, FOX_HEADS), 0.1),
        "fox_q_gain": 1.0 + nrm(ks[8], (DEPTH, HEAD_DIM), 0.02),
        "fox_k_gain": 1.0 + nrm(ks[9], (DEPTH, HEAD_DIM), 0.02),
        "w_branch": nrm(ks[10], (DEPTH, N_BRANCHES, BRANCH_WIDTH, D), BRANCH_WIDTH ** -0.5),
        "w_out": nrm(ks[11], (DEPTH, D, D), D ** -0.5),
        "peer_wq": nrm(ks[12], (DEPTH, D, PEER_HEADS * PEER_DK), D ** -0.5),
        "peer_k1": nrm(ks[13], (DEPTH, PEER_HEADS, N_KEYS, PEER_DK // 2), (PEER_DK // 2) ** -0.5),
        "peer_k2": nrm(ks[14], (DEPTH, PEER_HEADS, N_KEYS, PEER_DK // 2), (PEER_DK // 2) ** -0.5),
        "peer_u": nrm(ks[15], (DEPTH, N_EXPERTS, D), D ** -0.5),
        "peer_v": nrm(ks[16], (DEPTH, N_EXPERTS, D), 1.0),
    }


def reference(x, c, ada_w, ada_b, attn_norm, ffn_norm, w_in, fox_bf, fox_q_gain,
              fox_k_gain, w_branch, w_out, peer_wq, peer_k1, peer_k2, peer_u, peer_v):
    for l in range(DEPTH):
        mod = jax.nn.silu(c) @ ada_w[l] + ada_b[l]
        sh1, sc1, g1, sh2, sc2, g2 = jnp.split(mod, 6, axis=-1)
        h = modulate(rmsnorm(x, attn_norm[l]), sh1, sc1)
        x = x + g1[:, None, :] * mixing_sublayer(
            h, w_in[l], fox_bf[l], fox_q_gain[l], fox_k_gain[l], w_branch[l], w_out[l])
        h = modulate(rmsnorm(x, ffn_norm[l]), sh2, sc2)
        x = x + g2[:, None, :] * peer_sublayer(
            h, peer_wq[l], peer_k1[l], peer_k2[l], peer_u[l], peer_v[l])
    return x
```

```cpp
#include <hip/hip_runtime.h>
#include <hip/hip_cooperative_groups.h>
#include <hip/hip_bf16.h>
#include <cstdio>
#include <cstdint>
namespace cg = cooperative_groups;

#ifndef MK_MULTI
#define MK_MULTI 0
#endif

constexpr int NB = 8, SEQ = 4096, DM = 1024, NT = NB * SEQ, NH = 8, HD = 64, INW = 5128, NEXP = 16384, NKEYS = 128, TOPK = 16;
constexpr int MODW = 6 * DM;
constexpr float EPS = 1e-6f;
constexpr float LOG2E = 1.4426950408889634f, LN2 = 0.6931471805599453f;
constexpr float C2 = 0.125f * LOG2E;
constexpr int NWAVES = 8, NTHREADS = 512;
constexpr int LDS_BYTES = 147456;

constexpr size_t MiB = 1u << 20;
constexpr size_t WS_CTL = 0;
constexpr size_t WS_MOD = 1 * MiB;
constexpr size_t WS_FA = 2 * MiB;
constexpr size_t WS_FC = 3 * MiB;
constexpr size_t WS_WIN = 4 * MiB;
constexpr size_t WS_WBR = 24 * MiB;
constexpr size_t WS_WOUT = 28 * MiB;
constexpr size_t WS_WQ = 32 * MiB;
constexpr size_t WS_K12 = 36 * MiB;
constexpr size_t WS_UB = 37 * MiB;
constexpr size_t WS_VB = 69 * MiB;
constexpr size_t WS_HB = 101 * MiB;
constexpr size_t WS_QQ = 165 * MiB;
constexpr size_t WS_KK = 229 * MiB;
constexpr size_t WS_VV = 293 * MiB;
constexpr size_t WS_GT = 357 * MiB;
constexpr size_t WS_SSQ = 485 * MiB;
constexpr size_t WS_BQ = 487 * MiB;
constexpr size_t WS_USH = 488 * MiB;
constexpr size_t WS_END = 490 * MiB;

typedef unsigned short bf16_t;
typedef float f32x4 __attribute__((ext_vector_type(4)));
typedef unsigned u32x4 __attribute__((ext_vector_type(4))); typedef unsigned u32x2 __attribute__((ext_vector_type(2)));

struct Prm {
    const float *x, *c, *ada_w, *ada_b, *attn_norm, *ffn_norm, *w_in, *fox_bf, *gq, *gk, *w_branch, *w_out, *wq, *k1, *k2, *pu, *pv;
    float* out; unsigned char* ws; int ph_lo, ph_hi;
};

__device__ __forceinline__ float bf2f(bf16_t v) { return __uint_as_float((unsigned)v << 16); }
__device__ __forceinline__ unsigned f2bf(float f) { unsigned u = __float_as_uint(f); return (u + 0x7fffu + ((u >> 16) & 1u)) >> 16; }
__device__ __forceinline__ unsigned pk2(float lo, float hi) { return f2bf(lo) | (f2bf(hi) << 16); }
__device__ __forceinline__ float wave_sum(float v) {
#pragma unroll
    for (int o = 1; o < 64; o <<= 1) v += __shfl_xor(v, o);
    return v;
}
__device__ __forceinline__ float sigmoidf_(float a) { return 1.0f / (1.0f + __expf(-a)); }
__device__ __forceinline__ float log_sigmoidf_(float a) { return fminf(a, 0.f) - log1pf(expf(-fabsf(a))); }
__device__ __forceinline__ float softplus2(float z2) { return fmaxf(z2, 0.f) + __log2f(1.0f + exp2f(-fabsf(z2))); }

struct Ctx { int tid, lane, wave, gw, ngw; };

__device__ __forceinline__ void ph_mod(const Prm& p, const Ctx& C) {
    float* MOD = (float*)(p.ws + WS_MOD);
    for (int item = C.gw; item < 2 * (MODW / 8); item += C.ngw) {
        const int l = item / (MODW / 8), cb = (item % (MODW / 8)) * 8;
        float acc[8][8];
#pragma unroll
        for (int b = 0; b < 8; ++b)
#pragma unroll
            for (int j = 0; j < 8; ++j) acc[b][j] = 0.f;
        for (int i = 0; i < 16; ++i) {
            const int k = C.lane + 64 * i;
            const float* wp = p.ada_w + ((size_t)l * DM + k) * MODW + cb;
            const f32x4 w0 = *(const f32x4*)wp, w1 = *(const f32x4*)(wp + 4);
            const float w[8] = {w0.x, w0.y, w0.z, w0.w, w1.x, w1.y, w1.z, w1.w};
#pragma unroll
            for (int b = 0; b < 8; ++b) {
                const float cv = p.c[b * DM + k]; const float sv = cv * sigmoidf_(cv);
#pragma unroll
                for (int j = 0; j < 8; ++j) acc[b][j] += sv * w[j];
            }
        }
        float res = 0.f;
#pragma unroll
        for (int b = 0; b < 8; ++b)
#pragma unroll
            for (int j = 0; j < 8; ++j) { const float s = wave_sum(acc[b][j]); if (C.lane == b * 8 + j) res = s; }
        const int b = C.lane >> 3, j = C.lane & 7;
        MOD[((size_t)l * NB + b) * MODW + cb + j] = res + p.ada_b[l * MODW + cb + j];
    }
}

template <bool WITH_FA>
__device__ __forceinline__ void ph_norm(const Prm& p, const Ctx& C, int l, const float* xin, const float* gain, int ch_sh, int ch_sc, unsigned char* lds) {
    const float* MOD = (const float*)(p.ws + WS_MOD) + (size_t)l * NB * MODW;
    bf16_t* HB = (bf16_t*)(p.ws + WS_HB);
    float* FA = (float*)(p.ws + WS_FA);
    f32x4 g4[4];
#pragma unroll
    for (int j = 0; j < 4; ++j) g4[j] = *(const f32x4*)(gain + 4 * C.lane + 256 * j);
    float* wfl = (float*)lds;
    if (WITH_FA) {
        for (int i = C.tid; i < DM * 8; i += NTHREADS) wfl[i] = p.w_in[((size_t)l * DM + (i >> 3)) * INW + 1536 + (i & 7)];
        __syncthreads();
    }
    for (int m0 = C.gw; m0 < NT; m0 += 2 * C.ngw) {
      f32x4 vv[2][4];
#pragma unroll
      for (int rr = 0; rr < 2; ++rr) { const float* xr = xin + (size_t)min(m0 + rr * C.ngw, NT - 1) * DM + 4 * C.lane;
#pragma unroll
        for (int j = 0; j < 4; ++j) vv[rr][j] = *(const f32x4*)(xr + 256 * j); }
#pragma unroll
      for (int rr = 0; rr < 2; ++rr) {
        const int m = m0 + rr * C.ngw; if (m >= NT) break;
        const int b = m / SEQ;
        f32x4 v[4]; float s = 0.f;
#pragma unroll
        for (int j = 0; j < 4; ++j) { v[j] = vv[rr][j]; s += (v[j].x * v[j].x + v[j].y * v[j].y) + (v[j].z * v[j].z + v[j].w * v[j].w); }
        const float r = 1.0f / sqrtf(wave_sum(s) * (1.0f / DM) + EPS);
        const float* shp = MOD + (size_t)b * MODW + ch_sh * DM + 4 * C.lane;
        const float* scp = MOD + (size_t)b * MODW + ch_sc * DM + 4 * C.lane;
        float fa[8];
#pragma unroll
        for (int q = 0; q < 8; ++q) fa[q] = 0.f;
#pragma unroll
        for (int j = 0; j < 4; ++j) {
            const f32x4 sh = *(const f32x4*)(shp + 256 * j), sc = *(const f32x4*)(scp + 256 * j);
            f32x4 h = (v[j] * r) * g4[j] * (sc + 1.0f) + sh;
            unsigned long long o = (unsigned long long)pk2(h.x, h.y) | ((unsigned long long)pk2(h.z, h.w) << 32);
            *(unsigned long long*)(HB + (size_t)m * DM + 4 * C.lane + 256 * j) = o;
            if (WITH_FA) {
                const float hh[4] = {h.x, h.y, h.z, h.w};
#pragma unroll
                for (int e = 0; e < 4; ++e) {
                    const f32x4 wa = *(const f32x4*)(wfl + (4 * C.lane + 256 * j + e) * 8), wb = *(const f32x4*)(wfl + (4 * C.lane + 256 * j + e) * 8 + 4);
                    fa[0] += hh[e] * wa.x; fa[1] += hh[e] * wa.y; fa[2] += hh[e] * wa.z; fa[3] += hh[e] * wa.w;
                    fa[4] += hh[e] * wb.x; fa[5] += hh[e] * wb.y; fa[6] += hh[e] * wb.z; fa[7] += hh[e] * wb.w;
                }
            }
        }
        if (WITH_FA) {
            float res = 0.f;
#pragma unroll
            for (int q = 0; q < 8; ++q) { const float t = wave_sum(fa[q]); if (C.lane == q) res = t; }
            if (C.lane < 8) FA[(size_t)m * 8 + C.lane] = log_sigmoidf_(res + p.fox_bf[l * NH + C.lane]);
        }
      }
    }
    if (WITH_FA) __syncthreads();
}

namespace pg8 {
#define PG8_LAS __attribute__((address_space(3)))
typedef short bf16x8 __attribute__((ext_vector_type(8)));
constexpr int BM = 256, BK = 64, HALF = 128, HTB = HALF * BK * 2  , STAGE_BYTES = 8 * HTB, NXCD = 8, WGM = 8;
__host__ __device__ __forceinline__ int lds_byte(int r, int c) { const int st = (r >> 4) * 2 + (c >> 5), rr = r & 15, cc = c & 31, ob = rr * 64 + cc * 2; return st * 1024 + (ob ^ (((ob >> 9) & 1) << 5)); }
__host__ __device__ __forceinline__ void stage_rc(int b, int& R, int& C) { const int st = b / 1024, sb = b % 1024, swz = sb ^ (((sb >> 9) & 1) << 5); R = (st >> 1) * 16 + swz / 64; C = (st & 1) * 32 + (swz % 64) / 2; }
__host__ __device__ __forceinline__ int perm32(int rho) { const int n = rho >> 4, i = rho & 15; return 8 * (i >> 2) + 4 * n + (i & 3); }

struct Unit { int pm, pn, ka, kb, br; };
struct Gemm { const bf16_t* A; const bf16_t* Bt; int lda, ldb, K; };

struct Order {
    int nM, nN, nwg, G, c, pair;
    __device__ void init(int M, int N, int G_, int c_, int pair_) { nM = M / BM; nN = N / BM; nwg = nM * nN; G = G_; c = c_; pair = pair_; }
    __device__ bool next(int i, Unit& u) const {
        const int ii = pair ? (i >> 1) : i;
        const long L = (long)ii * G + c; if (L >= nwg) return false;
        int wgid = (int)L; { const int q = nwg / NXCD, r = nwg % NXCD, xcd = wgid % NXCD, off = wgid / NXCD; wgid = (xcd < r ? xcd * (q + 1) : r * (q + 1) + (xcd - r) * q) + off; }
        const int nig = WGM * nN, gid = wgid / nig, fm = gid * WGM, gsz = (nM - fm) < WGM ? (nM - fm) : WGM;
        u.pm = fm + ((wgid % nig) % gsz); u.pn = (wgid % nig) / gsz;
        u.br = pair ? (i & 1) : 0; u.ka = u.br * 512; u.kb = u.br * (1024 * 512);
        return true;
    }
    __device__ __forceinline__ void a_ready(const Unit&) const {}
    __device__ __forceinline__ void done(const Unit&) const {}
};

__device__ __forceinline__ unsigned cvt_pk_bf16(float lo, float hi) { unsigned r; asm volatile("v_cvt_pk_bf16_f32 %0, %1, %2" : "=v"(r) : "v"(lo), "v"(hi)); return r; }
__device__ __forceinline__ u32x4 pack8(const f32x4 a, const f32x4 b) { u32x4 w; w.x = cvt_pk_bf16(a[0], a[1]); w.y = cvt_pk_bf16(a[2], a[3]); w.z = cvt_pk_bf16(b[0], b[1]); w.w = cvt_pk_bf16(b[2], b[3]); return w; }
__device__ __forceinline__ void unpack8(const u32x4 w, f32x4& a, f32x4& b) {
    a = (f32x4){__uint_as_float(w.x << 16), __uint_as_float(w.x & 0xffff0000u), __uint_as_float(w.y << 16), __uint_as_float(w.y & 0xffff0000u)};
    b = (f32x4){__uint_as_float(w.z << 16), __uint_as_float(w.z & 0xffff0000u), __uint_as_float(w.w << 16), __uint_as_float(w.w & 0xffff0000u)};
}

struct Epi1 {
    static constexpr bool PERM = true, AFTER_DRAIN = false;
    bf16_t *QQ, *KK, *VV, *GT; const float *gq, *gk;
    __device__ __forceinline__ void operator()(const f32x4 (&acc)[2][2][4][2], const Unit& u, int wr, int wc, int fr, int fq) const {
        const int row0 = u.pm * BM + wr * 64 + fr;
        if (u.pn >= 12) {
            const int col0 = (u.pn - 12) * 256 + wc * 32 + 8 * fq;
#pragma unroll
            for (int ai = 0; ai < 2; ++ai)
#pragma unroll
                for (int m = 0; m < 4; ++m) { bf16_t* rowp = GT + (size_t)(row0 + ai * HALF + m * 16) * 2048 + col0;
#pragma unroll
                    for (int bj = 0; bj < 2; ++bj) { const f32x4 a0 = acc[ai][bj][m][0], a1 = acc[ai][bj][m][1];
                        u32x4 w; w.x = cvt_pk_bf16(sigmoidf_(a0[0]), sigmoidf_(a0[1])); w.y = cvt_pk_bf16(sigmoidf_(a0[2]), sigmoidf_(a0[3]));
                        w.z = cvt_pk_bf16(sigmoidf_(a1[0]), sigmoidf_(a1[1])); w.w = cvt_pk_bf16(sigmoidf_(a1[2]), sigmoidf_(a1[3]));
                        *(u32x4*)(rowp + bj * HALF) = w; } }
        } else {
            const int kind = u.pn >> 1, head = (u.pn & 1) * 4 + wc, k3 = kind % 3;
            bf16_t* base = (k3 == 0 ? QQ : (k3 == 1 ? KK : VV)) + (kind >= 3 ? 512 : 0) + head * 64 + 8 * fq;
            const bool nrm = kind < 2; const float qs = (k3 == 0) ? C2 : 1.0f;
            f32x4 gn[2][2];
#pragma unroll
            for (int bj = 0; bj < 2; ++bj)
#pragma unroll
                for (int n = 0; n < 2; ++n) gn[bj][n] = nrm ? *(const f32x4*)((kind == 0 ? gq : gk) + bj * 32 + 8 * fq + 4 * n) : (f32x4){1.f, 1.f, 1.f, 1.f};
#pragma unroll
            for (int ai = 0; ai < 2; ++ai)
#pragma unroll
                for (int m = 0; m < 4; ++m) {
                    float r = qs;
                    if (nrm) { float ss = 0.f;
#pragma unroll
                        for (int bj = 0; bj < 2; ++bj)
#pragma unroll
                            for (int n = 0; n < 2; ++n) { const f32x4 x = acc[ai][bj][m][n]; ss += (x[0] * x[0] + x[1] * x[1]) + (x[2] * x[2] + x[3] * x[3]); }
                        ss += __shfl_xor(ss, 16); ss += __shfl_xor(ss, 32);
                        r = qs * __builtin_amdgcn_rsqf(ss * (1.0f / 64.0f) + EPS); }
                    bf16_t* rowp = base + (size_t)(row0 + ai * HALF + m * 16) * DM;
#pragma unroll
                    for (int bj = 0; bj < 2; ++bj) *(u32x4*)(rowp + bj * 32) = pack8(acc[ai][bj][m][0] * r * gn[bj][0], acc[ai][bj][m][1] * r * gn[bj][1]);
                }
        }
    }
};
struct EpiGate {
    static constexpr bool PERM = true, AFTER_DRAIN = false;
    const bf16_t* GT; bf16_t* MG;
    __device__ __forceinline__ void operator()(const f32x4 (&acc)[2][2][4][2], const Unit& u, int wr, int wc, int fr, int fq) const {
        const int row0 = u.pm * BM + wr * 64 + fr, col0 = u.pn * BM + wc * 32 + 8 * fq;
#pragma unroll
        for (int ai = 0; ai < 2; ++ai)
#pragma unroll
            for (int m = 0; m < 4; ++m) { const size_t row = (size_t)(row0 + ai * HALF + m * 16);
#pragma unroll
                for (int bj = 0; bj < 2; ++bj) { const int c = col0 + bj * HALF;
                    f32x4 g0, g1; unpack8(*(const u32x4*)(GT + row * 2048 + u.br * 1024 + c), g0, g1);
                    f32x4 v0 = g0 * acc[ai][bj][m][0], v1 = g1 * acc[ai][bj][m][1];
                    if (u.br) { f32x4 o0, o1; unpack8(*(const u32x4*)(MG + row * DM + c), o0, o1); v0 += o0; v1 += o1; }
                    *(u32x4*)(MG + row * DM + c) = pack8(v0, v1); } }
    }
};
struct EpiMerge {
    static constexpr bool PERM = true, AFTER_DRAIN = false, MIDHOOK = true;
    const bf16_t* GT; bf16_t* MG;
    __device__ __forceinline__ void mid(f32x4 (&acc)[2][2][4][2], const Unit& u, int wr, int wc, int fr_, int fq_) const {
        int fr = fr_, fq = fq_; asm volatile("" : "+v"(fr), "+v"(fq));
        const int row0 = u.pm * BM + wr * 64 + fr, col0 = u.pn * BM + wc * 32 + 8 * fq;
#pragma unroll
        for (int ai = 0; ai < 2; ++ai)
#pragma unroll
            for (int mp = 0; mp < 2; ++mp) {
                u32x4 ga[2][2], gb[2][2];
#pragma unroll
                for (int mm = 0; mm < 2; ++mm) { const size_t row = (size_t)(row0 + ai * HALF + (2 * mp + mm) * 16);
#pragma unroll
                    for (int bj = 0; bj < 2; ++bj) { const int c = col0 + bj * HALF; ga[mm][bj] = *(const u32x4*)(GT + row * 2048 + c); gb[mm][bj] = *(const u32x4*)(GT + row * 2048 + 1024 + c); } }
#pragma unroll
                for (int mm = 0; mm < 2; ++mm) { const int m = 2 * mp + mm;
#pragma unroll
                    for (int bj = 0; bj < 2; ++bj) { f32x4 a0, a1, b0, b1; unpack8(ga[mm][bj], a0, a1); unpack8(gb[mm][bj], b0, b1);
#pragma unroll
                        for (int e = 0; e < 4; ++e) { acc[ai][bj][m][0][e] *= a0[e] * __builtin_amdgcn_rcpf(fmaxf(b0[e], 9.094947e-13f)); acc[ai][bj][m][1][e] *= a1[e] * __builtin_amdgcn_rcpf(fmaxf(b1[e], 9.094947e-13f)); } } }
                asm volatile("" ::: "memory"); __builtin_amdgcn_sched_barrier(0); }
    }
    __device__ __forceinline__ void operator()(const f32x4 (&acc)[2][2][4][2], const Unit& u, int wr, int wc, int fr, int fq) const {
        const int row0 = u.pm * BM + wr * 64 + fr, col0 = u.pn * BM + wc * 32 + 8 * fq;
#pragma unroll
        for (int ai = 0; ai < 2; ++ai) {
            u32x4 gb[4][2];
#pragma unroll
            for (int m = 0; m < 4; ++m)
#pragma unroll
                for (int bj = 0; bj < 2; ++bj) gb[m][bj] = *(const u32x4*)(GT + (size_t)(row0 + ai * HALF + m * 16) * 2048 + 1024 + col0 + bj * HALF);
#pragma unroll
            for (int m = 0; m < 4; ++m) { const size_t row = (size_t)(row0 + ai * HALF + m * 16);
#pragma unroll
                for (int bj = 0; bj < 2; ++bj) { const int c = col0 + bj * HALF;
                    f32x4 b0, b1; unpack8(gb[m][bj], b0, b1);
                    f32x4 v0, v1;
#pragma unroll
                    for (int e = 0; e < 4; ++e) { v0[e] = acc[ai][bj][m][0][e] * fmaxf(b0[e], 9.094947e-13f); v1[e] = acc[ai][bj][m][1][e] * fmaxf(b1[e], 9.094947e-13f); }
                    *(u32x4*)(MG + row * DM + c) = pack8(v0, v1); } } }
    }
};
struct EpiOut {
    static constexpr bool PERM = true, AFTER_DRAIN = false;
    const float* xin; float* out; const float* g1;
    const float* gain; bf16_t* XA; float* SSQ;
    __device__ __forceinline__ void operator()(const f32x4 (&acc)[2][2][4][2], const Unit& u, int wr, int wc, int fr, int fq) const {
        const int row0 = u.pm * BM + wr * 64 + fr, col0 = u.pn * BM + wc * 32 + 8 * fq; const int b = (u.pm * BM) / SEQ;
        f32x4 gv[2][2], gs[2][2];
#pragma unroll
        for (int bj = 0; bj < 2; ++bj)
#pragma unroll
            for (int n = 0; n < 2; ++n) { gv[bj][n] = *(const f32x4*)(g1 + (size_t)b * MODW + col0 + bj * HALF + 4 * n);
                gs[bj][n] = *(const f32x4*)(gain + col0 + bj * HALF + 4 * n) * (*(const f32x4*)(g1 + (size_t)b * MODW + 2 * DM + col0 + bj * HALF + 4 * n) + 1.0f); }
#pragma unroll
        for (int ai = 0; ai < 2; ++ai)
#pragma unroll
          for (int mp = 0; mp < 2; ++mp) {
            f32x4 xr[2][2][2];
#pragma unroll
            for (int mm = 0; mm < 2; ++mm)
#pragma unroll
                for (int bj = 0; bj < 2; ++bj)
#pragma unroll
                    for (int n = 0; n < 2; ++n) xr[mm][bj][n] = *(const f32x4*)(xin + (size_t)(row0 + ai * HALF + (2 * mp + mm) * 16) * DM + col0 + bj * HALF + 4 * n);
#pragma unroll
            for (int mm = 0; mm < 2; ++mm) { const int m = 2 * mp + mm; const size_t row = (size_t)(row0 + ai * HALF + m * 16), off = row * DM + col0; float ss = 0.f;
#pragma unroll
                for (int bj = 0; bj < 2; ++bj) { f32x4 x1[2];
#pragma unroll
                    for (int n = 0; n < 2; ++n) { const f32x4 xv = xr[mm][bj][n]; x1[n] = xv + gv[bj][n] * acc[ai][bj][m][n]; *(f32x4*)(out + off + bj * HALF + 4 * n) = x1[n];
                        ss += (x1[n][0] * x1[n][0] + x1[n][1] * x1[n][1]) + (x1[n][2] * x1[n][2] + x1[n][3] * x1[n][3]); }
                    *(u32x4*)(XA + off + bj * HALF) = pack8(x1[0] * gs[bj][0], x1[1] * gs[bj][1]); }
                ss += __shfl_xor(ss, 16); ss += __shfl_xor(ss, 32);
                if (fq == 0) SSQ[row * 16 + u.pn * 4 + wc] = ss; } }
    }
};
struct EpiQ {
    static constexpr bool PERM = true, AFTER_DRAIN = false;
    bf16_t* O; const float* SSQ; const float* bq; float* RT;
    __device__ __forceinline__ void operator()(const f32x4 (&acc)[2][2][4][2], const Unit& u, int wr, int wc, int fr, int fq) const {
        const int row0 = u.pm * BM + wr * 64 + fr, col0 = u.pn * BM + wc * 32 + 8 * fq; const int b = (u.pm * BM) / SEQ;
        f32x4 bv[2][2];
#pragma unroll
        for (int bj = 0; bj < 2; ++bj)
#pragma unroll
            for (int n = 0; n < 2; ++n) bv[bj][n] = *(const f32x4*)(bq + (size_t)b * DM + col0 + bj * HALF + 4 * n);
        float rr[2][4];
#pragma unroll
        for (int ai = 0; ai < 2; ++ai)
#pragma unroll
            for (int m = 0; m < 4; ++m) { const size_t row = (size_t)(row0 + ai * HALF + m * 16);
                const f32x4 sq = *(const f32x4*)(SSQ + row * 16 + 4 * fq);
                float st = (sq[0] + sq[1]) + (sq[2] + sq[3]); st += __shfl_xor(st, 16); st += __shfl_xor(st, 32);
                rr[ai][m] = __builtin_amdgcn_rsqf(st * (1.0f / DM) + EPS); }
#pragma unroll
        for (int ai = 0; ai < 2; ++ai)
#pragma unroll
            for (int m = 0; m < 4; ++m) { const size_t row = (size_t)(row0 + ai * HALF + m * 16); const float r = rr[ai][m];
                bf16_t* rowp = O + row * DM + col0;
                if (u.pn == 0 && wc == 0 && fq == 0) RT[row] = r;
#pragma unroll
                for (int bj = 0; bj < 2; ++bj) *(u32x4*)(rowp + bj * HALF) = pack8(acc[ai][bj][m][0] * r + bv[bj][0], acc[ai][bj][m][1] * r + bv[bj][1]); }
    }
};
struct EpiBf {
    static constexpr bool PERM = true, AFTER_DRAIN = false;
    bf16_t* O; int ldc;
    __device__ __forceinline__ void operator()(const f32x4 (&acc)[2][2][4][2], const Unit& u, int wr, int wc, int fr, int fq) const {
        const int row0 = u.pm * BM + wr * 64 + fr, col0 = u.pn * BM + wc * 32 + 8 * fq;
#pragma unroll
        for (int ai = 0; ai < 2; ++ai)
#pragma unroll
            for (int m = 0; m < 4; ++m) { bf16_t* rowp = O + (size_t)(row0 + ai * HALF + m * 16) * ldc + col0;
#pragma unroll
                for (int bj = 0; bj < 2; ++bj) *(u32x4*)(rowp + bj * HALF) = pack8(acc[ai][bj][m][0], acc[ai][bj][m][1]); }
    }
};

template <class E_, class = void> struct has_midhook { static constexpr bool value = false; };
template <class E_> struct has_midhook<E_, decltype((void)E_::MIDHOOK)> { static constexpr bool value = true; };
template <class Epi, class Sched, bool ALIGN_EPI = false, bool SP2 = false>
__device__ __forceinline__ void gemm_phase(PG8_LAS unsigned char* lds, const Gemm g, const Sched& S, const Epi& E) {
    int tid_ = threadIdx.x; asm volatile("" : "+v"(tid_));
    const int tid = tid_, wid = __builtin_amdgcn_readfirstlane(tid >> 6), lane = tid & 63, wr = wid >> 2, wc = wid & 3, fr = lane & 15, fq = lane >> 4;
    const int K = g.K, nt = K / BK;
    unsigned voffA[2], voffB[2];
#pragma unroll
    for (int i = 0; i < 2; ++i) { int R, C; stage_rc(tid * 16 + i * 8192, R, C); const int Rb = Epi::PERM ? ((R & ~31) + perm32(R & 31)) : R;
        voffA[i] = (unsigned)(R * g.lda + C) * 2u; voffB[i] = (unsigned)(Rb * g.ldb + C) * 2u; }
    const size_t kstep = (size_t)(BK * 2);
    const size_t hsA = (size_t)HALF * g.lda * 2, hsB = (size_t)HALF * g.ldb * 2;
    const size_t tsA = 2 * hsA, tsB = 2 * hsB;
    const unsigned ldsw = (unsigned)wid * 1024u;
    const int aoff = lds_byte(wr * 64 + fr, fq * 8), boff = lds_byte(wc * 32 + fr, fq * 8);
#define PG8_SA(b, h) (((b) * 2 + (h)) * HTB)
#define PG8_SB(b, h) ((4 + (b) * 2 + (h)) * HTB)
#define PG8_STAGE(bufoff, gbase, voff) do { _Pragma("unroll") for (int _i = 0; _i < 2; ++_i) \
        __builtin_amdgcn_global_load_lds((const unsigned*)((const char*)(gbase) + (voff)[_i]), (PG8_LAS unsigned*)(lds + (bufoff) + ldsw + _i * 8192), 16, 0, 0); } while (0)
#define PG8_LDA(dst, b, h) do { _Pragma("unroll") for (int m = 0; m < 4; ++m) _Pragma("unroll") for (int k = 0; k < 2; ++k) dst[m][k] = *(const PG8_LAS bf16x8*)(lds + PG8_SA(b, h) + aoff + m * 2048 + k * 1024); } while (0)
#define PG8_LDB(dst, b, h) do { _Pragma("unroll") for (int n = 0; n < 2; ++n) _Pragma("unroll") for (int k = 0; k < 2; ++k) dst[n][k] = *(const PG8_LAS bf16x8*)(lds + PG8_SB(b, h) + boff + n * 2048 + k * 1024); } while (0)
#define PG8_MMA(ai, bj, At, Bt) do { __builtin_amdgcn_s_setprio(1); _Pragma("unroll") for (int m = 0; m < 4; ++m) _Pragma("unroll") for (int n = 0; n < 2; ++n) _Pragma("unroll") for (int k = 0; k < 2; ++k) \
        acc[ai][bj][m][n] = __builtin_amdgcn_mfma_f32_16x16x32_bf16(Bt[n][k], At[m][k], acc[ai][bj][m][n], 0, 0, 0); __builtin_amdgcn_s_setprio(0); } while (0)
#define PG8_WAIT_V(n) asm volatile("s_waitcnt vmcnt(" #n ")" ::: "memory")
#define PG8_WAIT_L(n) asm volatile("s_waitcnt lgkmcnt(" #n ")" ::: "memory")
#define PG8_BAR __builtin_amdgcn_s_barrier()
#define PG8_SCHED __builtin_amdgcn_sched_barrier(0)
    Unit cur, nxt; int ui = 0;
    if (!S.next(0, cur)) return;
    f32x4 acc[2][2][4][2];
#pragma unroll
    for (int a = 0; a < 2; ++a)
#pragma unroll
        for (int b = 0; b < 2; ++b)
#pragma unroll
            for (int m = 0; m < 4; ++m)
#pragma unroll
                for (int n = 0; n < 2; ++n) acc[a][b][m][n] = (f32x4){0.f, 0.f, 0.f, 0.f};
    bf16x8 At[4][2], B0[2][2], B1[2][2];
    const char* cA = (const char*)g.A + (size_t)cur.pm * tsA + (size_t)cur.ka * 2; const char* cB = (const char*)g.Bt + (size_t)cur.pn * tsB + (size_t)cur.kb * 2;
    S.a_ready(cur);
    if constexpr (SP2) {
        PG8_STAGE(PG8_SB(0, 0), cB, voffB); PG8_STAGE(PG8_SB(0, 1), cB + hsB, voffB); PG8_STAGE(PG8_SA(0, 0), cA, voffA); PG8_STAGE(PG8_SA(0, 1), cA + hsA, voffA);
        if (wr == 1) PG8_BAR;
        PG8_WAIT_V(2); PG8_BAR;
        PG8_STAGE(PG8_SB(1, 0), cB + kstep, voffB); PG8_STAGE(PG8_SA(1, 0), cA + kstep, voffA); PG8_STAGE(PG8_SB(1, 1), cB + hsB + kstep, voffB);
        PG8_WAIT_V(6); PG8_BAR;
    } else {
        PG8_STAGE(PG8_SB(0, 0), cB, voffB); PG8_STAGE(PG8_SA(0, 0), cA, voffA); PG8_STAGE(PG8_SB(0, 1), cB + hsB, voffB); PG8_STAGE(PG8_SA(0, 1), cA + hsA, voffA);
        if (wr == 1) PG8_BAR;
        PG8_WAIT_V(4); PG8_BAR;
        PG8_STAGE(PG8_SB(1, 0), cB + kstep, voffB); PG8_STAGE(PG8_SA(1, 0), cA + kstep, voffA); PG8_STAGE(PG8_SB(1, 1), cB + hsB + kstep, voffB);
        PG8_WAIT_V(6); PG8_BAR;
    }
    for (;;) {
        const bool has_next = S.next(ui + 1, nxt);
        const char* nA = has_next ? (const char*)g.A + (size_t)nxt.pm * tsA + (size_t)nxt.ka * 2 : cA; const char* nB = has_next ? (const char*)g.Bt + (size_t)nxt.pn * tsB + (size_t)nxt.kb * 2 : cB;
        for (int t = 0; t < nt; t += 2) {
            if constexpr (has_midhook<Epi>::value) { if (t == nt / 2) E.mid(acc, cur, wr, wc, fr, fq); }
            const bool last = (t == nt - 2);
            const char* a1 = cA + (size_t)(t + 1) * kstep;
            const char* a2 = last ? nA : cA + (size_t)(t + 2) * kstep; const char* b2 = last ? nB : cB + (size_t)(t + 2) * kstep;
            const char* a3 = a2 + kstep; const char* b3 = b2 + kstep;
            if (last && has_next) S.a_ready(nxt);
            if constexpr (SP2) {
            PG8_LDB(B0, 0, 0); PG8_LDB(B1, 0, 1); PG8_SCHED; PG8_LDA(At, 0, 0); PG8_STAGE(PG8_SA(1, 1), a1 + hsA, voffA);
            PG8_WAIT_V(8); PG8_WAIT_L(0); PG8_BAR; PG8_MMA(0, 0, At, B0); PG8_MMA(0, 1, At, B1); PG8_BAR; PG8_SCHED;
            PG8_LDA(At, 0, 1); PG8_STAGE(PG8_SB(0, 0), b2, voffB); PG8_STAGE(PG8_SB(0, 1), b2 + hsB, voffB); PG8_STAGE(PG8_SA(0, 0), a2, voffA);
            PG8_WAIT_V(8); PG8_WAIT_L(0); PG8_BAR; PG8_MMA(1, 0, At, B0); PG8_MMA(1, 1, At, B1); PG8_BAR; PG8_SCHED;
            PG8_LDB(B0, 1, 0); PG8_LDB(B1, 1, 1); PG8_SCHED; PG8_LDA(At, 1, 0); PG8_STAGE(PG8_SA(0, 1), a2 + hsA, voffA);
            PG8_WAIT_V(8); PG8_WAIT_L(0); PG8_BAR; PG8_MMA(0, 0, At, B0); PG8_MMA(0, 1, At, B1); PG8_BAR; PG8_SCHED;
            PG8_LDA(At, 1, 1); PG8_STAGE(PG8_SB(1, 0), b3, voffB); PG8_STAGE(PG8_SB(1, 1), b3 + hsB, voffB); PG8_STAGE(PG8_SA(1, 0), a3, voffA);
            PG8_WAIT_V(8); PG8_WAIT_L(0); PG8_BAR; PG8_MMA(1, 0, At, B0); PG8_MMA(1, 1, At, B1); PG8_BAR; PG8_SCHED;
            } else {
            PG8_LDB(B0, 0, 0); PG8_SCHED; PG8_LDA(At, 0, 0); PG8_STAGE(PG8_SA(1, 1), a1 + hsA, voffA);
            PG8_WAIT_L(8); PG8_BAR; PG8_WAIT_L(0); PG8_MMA(0, 0, At, B0); PG8_BAR; PG8_SCHED;
            PG8_LDB(B1, 0, 1); PG8_STAGE(PG8_SB(0, 0), b2, voffB);
            PG8_BAR; PG8_WAIT_L(0); PG8_MMA(0, 1, At, B1); PG8_BAR;
            PG8_LDA(At, 0, 1); PG8_STAGE(PG8_SA(0, 0), a2, voffA);
            PG8_BAR; PG8_WAIT_L(0); PG8_MMA(1, 0, At, B0); PG8_BAR; PG8_SCHED;
            PG8_STAGE(PG8_SB(0, 1), b2 + hsB, voffB);
            PG8_WAIT_V(6); PG8_BAR; PG8_MMA(1, 1, At, B1); PG8_BAR;
            PG8_LDB(B0, 1, 0); PG8_SCHED; PG8_LDA(At, 1, 0); PG8_STAGE(PG8_SA(0, 1), a2 + hsA, voffA);
            PG8_WAIT_L(8); PG8_BAR; PG8_WAIT_L(0); PG8_MMA(0, 0, At, B0); PG8_BAR; PG8_SCHED;
            PG8_LDB(B1, 1, 1); PG8_STAGE(PG8_SB(1, 0), b3, voffB);
            PG8_BAR; PG8_WAIT_L(0); PG8_MMA(0, 1, At, B1); PG8_BAR;
            PG8_LDA(At, 1, 1); PG8_STAGE(PG8_SA(1, 0), a3, voffA);
            PG8_BAR; PG8_WAIT_L(0); PG8_MMA(1, 0, At, B0); PG8_BAR; PG8_SCHED;
            PG8_STAGE(PG8_SB(1, 1), b3 + hsB, voffB);
            PG8_WAIT_V(6); PG8_BAR; PG8_MMA(1, 1, At, B1); PG8_BAR;
            }
        }
        if constexpr (ALIGN_EPI) { if (wr == 0) PG8_BAR; }
        if constexpr (!Epi::AFTER_DRAIN) { E(acc, cur, wr, wc, fr, fq); S.done(cur); }
        if (!has_next) break;
#pragma unroll
        for (int a = 0; a < 2; ++a)
#pragma unroll
            for (int b = 0; b < 2; ++b)
#pragma unroll
                for (int m = 0; m < 4; ++m)
#pragma unroll
                    for (int n = 0; n < 2; ++n) acc[a][b][m][n] = (f32x4){0.f, 0.f, 0.f, 0.f};
        cur = nxt; cA = nA; cB = nB; ++ui;
        if constexpr (ALIGN_EPI) { if (wr == 1) PG8_BAR; }
    }
    PG8_WAIT_V(0);
    if constexpr (!ALIGN_EPI) { if (wr == 0) PG8_BAR; }
    PG8_BAR;
    if constexpr (Epi::AFTER_DRAIN) { E.fused(acc, cur, wr, wc, fr, fq, lds, wid, lane); S.done(cur); }
#undef PG8_SA
#undef PG8_SB
#undef PG8_STAGE
#undef PG8_LDA
#undef PG8_LDB
#undef PG8_MMA
#undef PG8_WAIT_V
#undef PG8_WAIT_L
#undef PG8_BAR
#undef PG8_SCHED
}
}

__device__ __forceinline__ int win_logical_col(int n) {
    const int pn = n >> 8, tc = n & 255;
    if (pn >= 12) return 3080 + (pn - 12) * 256 + tc;
    const int kind = pn >> 1, bj = tc >> 7, wc = (tc >> 5) & 3, i = tc & 31;
    const int base = (kind < 3) ? kind * 512 : 1544 + (kind - 3) * 512;
    return base + ((pn & 1) * 4 + wc) * 64 + bj * 32 + i;
}
__device__ __forceinline__ void transpose_item(const float* W, int ldw, int src_c0, int k0, bf16_t* WT, int K, int dst_row0, float* scr, int lane) {
#pragma unroll 8
    for (int i = 0; i < 32; ++i) { const int kk = 2 * i + (lane >> 5); scr[kk * 33 + (lane & 31)] = W[(size_t)(k0 + kk) * ldw + src_c0 + (lane & 31)]; }
    __builtin_amdgcn_s_waitcnt(0xc07f); asm volatile("" ::: "memory");
    const int c = lane & 7;
#pragma unroll
    for (int j = 0; j < 4; ++j) { const int n = (lane >> 3) + 8 * j; const float* s = scr + (8 * c) * 33 + n;
        u32x4 o; o.x = pk2(s[0 * 33], s[1 * 33]); o.y = pk2(s[2 * 33], s[3 * 33]); o.z = pk2(s[4 * 33], s[5 * 33]); o.w = pk2(s[6 * 33], s[7 * 33]);
        *(u32x4*)(WT + (size_t)(dst_row0 + n) * K + k0 + 8 * c) = o; }
    __builtin_amdgcn_s_waitcnt(0xc07f); asm volatile("" ::: "memory");
}
__device__ __forceinline__ void ph_weights(const Prm& p, const Ctx& C, unsigned char* lds) {
    float* scr = (float*)(lds + C.wave * 16384);
    bf16_t* WIN = (bf16_t*)(p.ws + WS_WIN); bf16_t* WBR = (bf16_t*)(p.ws + WS_WBR); bf16_t* WOUT = (bf16_t*)(p.ws + WS_WOUT); bf16_t* WQT = (bf16_t*)(p.ws + WS_WQ);
    constexpr int I_IN = 16 * 160, I_BR = 8 * 32, I_SQ = 16 * 32;
    constexpr int NITEMS = 2 * I_IN + 4 * I_BR + 2 * I_SQ + 2 * I_SQ;
    for (int it = C.gw; it < NITEMS; it += C.ngw) {
        int r = it;
        if (r < 2 * I_IN) { const int l = r / I_IN, q = r % I_IN, kb = q / 160, nb = q % 160;
            transpose_item(p.w_in + (size_t)l * DM * INW, INW, win_logical_col(32 * nb), 64 * kb, WIN + (size_t)l * 5120 * DM, DM, 32 * nb, scr, C.lane); continue; }
        r -= 2 * I_IN;
        if (r < 4 * I_BR) { const int lg = r / I_BR, q = r % I_BR, kb = q / 32, nb = q % 32;
            transpose_item(p.w_branch + (size_t)lg * 512 * DM, DM, 32 * nb, 64 * kb, WBR + (size_t)(lg >> 1) * DM * DM + (lg & 1) * 512, DM, 32 * nb, scr, C.lane); continue; }
        r -= 4 * I_BR;
        if (r < 2 * I_SQ) { const int l = r / I_SQ, q = r % I_SQ, kb = q / 32, nb = q % 32;
            transpose_item(p.w_out + (size_t)l * DM * DM, DM, 32 * nb, 64 * kb, WOUT + (size_t)l * DM * DM, DM, 32 * nb, scr, C.lane); continue; }
        r -= 2 * I_SQ;
        { const int l = r / I_SQ, q = r % I_SQ, kb = q / 32, nb = q % 32;
            transpose_item(p.wq + (size_t)l * DM * DM, DM, 32 * nb, 64 * kb, WQT + (size_t)l * DM * DM, DM, 32 * nb, scr, C.lane); }
    }
}
#define LDSP(p) ((PG8_LAS unsigned char*)(p))
__device__ __forceinline__ void ph_gemm1(const Prm& p, int l, unsigned char* lds) {
    pg8::Gemm g{(const bf16_t*)(p.ws + WS_HB), (const bf16_t*)(p.ws + WS_WIN) + (size_t)l * 5120 * DM, DM, DM, DM};
    pg8::Order S; S.init(NT, 5120, gridDim.x, blockIdx.x, 0);
    pg8::Epi1 E{(bf16_t*)(p.ws + WS_QQ), (bf16_t*)(p.ws + WS_KK), (bf16_t*)(p.ws + WS_VV), (bf16_t*)(p.ws + WS_GT), p.gq + l * HD, p.gk + l * HD};
    pg8::gemm_phase<pg8::Epi1, pg8::Order, true, true>(LDSP(lds), g, S, E);
}
__device__ __forceinline__ void ph_merge(const Prm& p, int l, unsigned char* lds) {
    pg8::Gemm g{(const bf16_t*)(p.ws + WS_QQ), (const bf16_t*)(p.ws + WS_WBR) + (size_t)l * DM * DM, DM, DM, DM};
    pg8::Order S; S.init(NT, DM, gridDim.x, blockIdx.x, 0);
    pg8::EpiMerge E{(const bf16_t*)(p.ws + WS_GT), (bf16_t*)(p.ws + WS_HB)};
    pg8::gemm_phase<pg8::EpiMerge, pg8::Order, true, true>(LDSP(lds), g, S, E);
}
__device__ __forceinline__ void ph_out(const Prm& p, int l, const float* xin, unsigned char* lds) {
    pg8::Gemm g{(const bf16_t*)(p.ws + WS_HB), (const bf16_t*)(p.ws + WS_WOUT) + (size_t)l * DM * DM, DM, DM, DM};
    pg8::Order S; S.init(NT, DM, gridDim.x, blockIdx.x, 0);
    pg8::EpiOut E{xin, p.out, (const float*)(p.ws + WS_MOD) + (size_t)l * NB * MODW + 2 * DM, p.ffn_norm + l * DM, (bf16_t*)(p.ws + WS_QQ), (float*)(p.ws + WS_SSQ)};
    pg8::gemm_phase<pg8::EpiOut, pg8::Order, true, true>(LDSP(lds), g, S, E);
}
__device__ __forceinline__ void ph_q(const Prm& p, int l, unsigned char* lds) {
    pg8::Gemm g{(const bf16_t*)(p.ws + WS_QQ), (const bf16_t*)(p.ws + WS_WQ) + (size_t)l * DM * DM, DM, DM, DM};
    pg8::Order S; S.init(NT, DM, gridDim.x, blockIdx.x, 0);
    pg8::EpiQ E{(bf16_t*)(p.ws + WS_KK), (const float*)(p.ws + WS_SSQ), (const float*)(p.ws + WS_BQ) + (size_t)l * NB * DM, (float*)(p.ws + WS_FC)};
    pg8::gemm_phase<pg8::EpiQ, pg8::Order, true, true>(LDSP(lds), g, S, E);
}

namespace attn_body {
using bf16=__hip_bfloat16;
using bf16x8=__attribute__((ext_vector_type(8)))short;
using s16x4=__attribute__((ext_vector_type(4)))short;
using f32x16=__attribute__((ext_vector_type(16)))float;
using u32x4=__attribute__((ext_vector_type(4)))unsigned;
using f32x4_t=__attribute__((ext_vector_type(4)))float;
constexpr int BATCH=8,NHEAD=8,SEQ=4096,D=64,DM=1024;
constexpr int NW=8,QBLK=32,QB=QBLK*NW,KVBLK=64,NQB=SEQ/QB;
constexpr int ATTN_PITCH=DM, ATTN_UNIT_ROWS=QB;
__device__ __forceinline__ int crow(int r,int hi){return (r&3)+8*(r>>2)+4*hi;}
#define SBAR() __builtin_amdgcn_sched_barrier(0)
__device__ __forceinline__ void cmask(f32x16&p0,f32x16&p1,int jb,int qrel,int hi){
  const float NEG=-INFINITY; int d=qrel-(64*jb+4*hi); asm volatile("":"+v"(d));
  #pragma unroll
  for(int r=0;r<16;++r){const int c=(r&3)+8*(r>>2); if(c>d)p0[r]=NEG; if(c+32>d)p1[r]=NEG;}
}

constexpr int NSLOT=3, SLOTB=8192;
constexpr int LDS_K=0, LDS_V=NSLOT*SLOTB, LDS_WS=2*NSLOT*SLOTB, LDS_OST=LDS_WS+NW*64*4, LDS_BYTES=LDS_OST+NW*4096;
constexpr float C2=0.125f*1.4426950408889634f;
__device__ __forceinline__ void glds16(const void*gsrc,unsigned lds_dst){unsigned keep;
  asm volatile("s_mov_b32 %0, m0\n\ts_mov_b32 m0, %2\n\ts_nop 0\n\tglobal_load_lds_dwordx4 %1, off\n\ts_mov_b32 m0, %0":"=&s"(keep):"v"(gsrc),"s"(lds_dst):"memory");}
__device__ __forceinline__ float max3f(float a,float b,float c){float r;asm("v_max3_f32 %0, %1, %2, %3":"=v"(r):"v"(a),"v"(b),"v"(c));return r;}
__device__ __forceinline__ float max2f(float a,float b){float r;asm("v_max_f32_e32 %0, %1, %2":"=v"(r):"v"(a),"v"(b));return r;}
__device__ __forceinline__ float fadd_s(float a,float b){float r;asm("v_add_f32_e32 %0, %1, %2":"=v"(r):"v"(a),"v"(b));return r;}
__device__ __forceinline__ float fsub_s(float a,float b){float r;asm("v_sub_f32_e32 %0, %1, %2":"=v"(r):"v"(a),"v"(b));return r;}
typedef float f32x2_t __attribute__((ext_vector_type(2))); typedef __bf16 bf16x2_t __attribute__((ext_vector_type(2)));
__device__ __forceinline__ unsigned cvtpk_s(float lo,float hi){f32x2_t v={lo,hi};bf16x2_t b=__builtin_convertvector(v,bf16x2_t);return __builtin_bit_cast(unsigned,b);}
#define WAIT_BAR(N) asm volatile("s_waitcnt vmcnt(" #N ") lgkmcnt(0)\n\ts_barrier":::"memory")

__device__ __forceinline__ void qkt(f32x16&p0,f32x16&p1,const char*Kslot,const bf16x8*qr,const f32x16&negm,int r32,int hi){
  const char*kb=Kslot+hi*1024+r32*16;
  #pragma unroll
  for(int d0=0;d0<4;++d0){
    const bf16x8 b0=*reinterpret_cast<const bf16x8*>(kb+d0*2048);
    const bf16x8 b1=*reinterpret_cast<const bf16x8*>(kb+d0*2048+512);
    if(d0==0){p0=__builtin_amdgcn_mfma_f32_32x32x16_bf16(b0,qr[0],negm,0,0,0);p1=__builtin_amdgcn_mfma_f32_32x32x16_bf16(b1,qr[0],negm,0,0,0);}
    else{p0=__builtin_amdgcn_mfma_f32_32x32x16_bf16(b0,qr[d0],p0,0,0,0);p1=__builtin_amdgcn_mfma_f32_32x32x16_bf16(b1,qr[d0],p1,0,0,0);}}
}
typedef __attribute__((address_space(3))) const char* lds_cptr;
typedef short v4i16_t __attribute__((ext_vector_type(4)));
__device__ __forceinline__ void kload8(bf16x8*kf,lds_cptr kp){
  kf[0]=*(const __attribute__((address_space(3))) bf16x8*)(kp);      kf[1]=*(const __attribute__((address_space(3))) bf16x8*)(kp+512);
  kf[2]=*(const __attribute__((address_space(3))) bf16x8*)(kp+2048); kf[3]=*(const __attribute__((address_space(3))) bf16x8*)(kp+2560);
  kf[4]=*(const __attribute__((address_space(3))) bf16x8*)(kp+4096); kf[5]=*(const __attribute__((address_space(3))) bf16x8*)(kp+4608);
  kf[6]=*(const __attribute__((address_space(3))) bf16x8*)(kp+6144); kf[7]=*(const __attribute__((address_space(3))) bf16x8*)(kp+6656);
}
__device__ __forceinline__ void kload2(bf16x8*kf,lds_cptr kp,int j){ kf[2*j]=*(const __attribute__((address_space(3))) bf16x8*)(kp+j*2048); kf[2*j+1]=*(const __attribute__((address_space(3))) bf16x8*)(kp+j*2048+512); }
__device__ __forceinline__ s16x4 vtr(lds_cptr p){ return __builtin_bit_cast(s16x4,__builtin_amdgcn_ds_read_tr16_b64_v4i16((__attribute__((address_space(3))) v4i16_t*)p)); }
__device__ __forceinline__ float rowmax(const f32x16&p0,const f32x16&p1){
  float a=max3f(p0[0],p0[1],p1[0]),b=max3f(p0[2],p0[3],p1[1]);a=max3f(a,p1[2],p1[3]);
  #pragma unroll
  for(int r=4;r<16;r+=4){a=max3f(a,p0[r],p0[r+1]);b=max3f(b,p0[r+2],p0[r+3]);a=max3f(a,p1[r],p1[r+1]);b=max3f(b,p1[r+2],p1[r+3]);}
  const float m=max2f(a,b);
  auto rr=__builtin_amdgcn_permlane32_swap(__float_as_uint(m),__float_as_uint(m),false,false);
  return max2f(__uint_as_float(rr[0]),__uint_as_float(rr[1]));
}
__device__ __forceinline__ void pv(f32x16*o,int vb,bf16x8 pa0,bf16x8 pa1,bf16x8 pa2,bf16x8 pa3){
  #pragma unroll
  for(int d0=0;d0<2;++d0){s16x4 lo[4],hi[4];
    #pragma unroll
    for(int ks=0;ks<4;++ks){
      asm volatile("ds_read_b64_tr_b16 %0,%1 offset:%c2":"=&v"(lo[ks]):"v"(vb),"i"(d0*4096+ks*1024):"memory");
      asm volatile("ds_read_b64_tr_b16 %0,%1 offset:%c2":"=&v"(hi[ks]):"v"(vb),"i"(d0*4096+ks*1024+512):"memory");}
    asm volatile("s_waitcnt lgkmcnt(0)":::"memory");SBAR();
    #define PK(k) (bf16x8){lo[k][0],lo[k][1],lo[k][2],lo[k][3],hi[k][0],hi[k][1],hi[k][2],hi[k][3]}
    o[d0]=__builtin_amdgcn_mfma_f32_32x32x16_bf16(pa0,PK(0),o[d0],0,0,0);
    o[d0]=__builtin_amdgcn_mfma_f32_32x32x16_bf16(pa1,PK(1),o[d0],0,0,0);
    o[d0]=__builtin_amdgcn_mfma_f32_32x32x16_bf16(pa2,PK(2),o[d0],0,0,0);
    o[d0]=__builtin_amdgcn_mfma_f32_32x32x16_bf16(pa3,PK(3),o[d0],0,0,0);
    #undef PK
  }
}

#ifndef ATTN_STORE16
#define ATTN_STORE16(p,v) (*(u32x4*)(p)=(v))
#endif
template<int THRL> __device__ __forceinline__ void attn_unit(int b,int h,int qb,const bf16*Q,const bf16*__restrict__ K,const bf16*__restrict__ V,bf16*O,char*shm,const float*Gl,int j0){
  int tid_=threadIdx.x; asm volatile("":"+v"(tid_));
  const int tid=tid_,lane=tid&63,r32=lane&31,hi=lane>>5; const int wid=__builtin_amdgcn_readfirstlane(tid>>6);
  const long rowbase=(long)b*SEQ; const int q0=qb*QB;
  const bf16*Qw=Q+(rowbase+q0+wid*QBLK)*DM+h*D;
  const bf16*Kh=K+(rowbase+(long)j0*KVBLK)*DM+h*D,*Vh=V+(rowbase+(long)j0*KVBLK)*DM+h*D; const float*Glt=Gl+j0*KVBLK;
  const unsigned lds0=(unsigned)(uintptr_t)shm;
  float*wsf=(float*)(shm+LDS_WS)+wid*64;
  const bf16*ksrc=Kh+(long)lane*DM+wid*8;
  const bf16*vsrc=Vh+(long)(16*(wid&3)+(lane>>2))*DM+(wid>>2)*32+(lane&3)*8;
  const unsigned kdst=lds0+LDS_K+wid*1024, vdst=lds0+LDS_V+wid*1024;
  #define DMA_K(t,slot) glds16(ksrc+(long)(t)*KVBLK*DM,(unsigned)__builtin_amdgcn_readfirstlane(kdst+(slot)))
  #define DMA_V(t,slot) glds16(vsrc+(long)(t)*KVBLK*DM,(unsigned)__builtin_amdgcn_readfirstlane(vdst+(slot)))
  const int vb0=(int)(lds0+LDS_V)+((lane>>4)&1)*32+(lane&3)*8+(4*hi+((lane&15)>>2))*64;
  const char*Kbase=shm+LDS_K; bf16x8 kf[8];
  const lds_cptr shm3=(lds_cptr)shm; const lds_cptr kp0=shm3+LDS_K+hi*1024+r32*16; const lds_cptr vp0=shm3+LDS_V+((lane>>4)&1)*32+(lane&3)*8+(4*hi+((lane&15)>>2))*64;
  const int NT=(q0+QB)/KVBLK-j0;
  DMA_K(0,0);DMA_V(0,0);DMA_K(1,SLOTB);
  bf16x8 qr[4];
  #pragma unroll
  for(int d0=0;d0<4;++d0)qr[d0]=*reinterpret_cast<const bf16x8*>(&Qw[(long)r32*DM+d0*16+hi*8]);
  typedef __attribute__((address_space(3))) bf16x8* qst_ptr; const qst_ptr qst=(qst_ptr)(((__attribute__((address_space(3))) char*)shm)+LDS_OST+wid*4096)+lane;
  #pragma unroll
  for(int d0=0;d0<4;++d0)qst[d0*64]=qr[d0];
  const int qrel=wid*QBLK+r32; const float Gq=Gl[q0+qrel];
  float mhat=0.f,l_reg=0.f;f32x16 o[2];o[0]=f32x16{};o[1]=f32x16{};const f32x16 negm=f32x16{}; float base=Gq;
  #define BIAS(C0,C1,t) do{ const float*gk_=Glt+(t)*64+4*hi; _Pragma("unroll") for(int g_=0;g_<4;++g_){ SBAR(); const f32x4_t a_=*(const f32x4_t*)(gk_+8*g_), b_=*(const f32x4_t*)(gk_+32+8*g_); \
    _Pragma("unroll") for(int e_=0;e_<4;++e_){ C0[4*g_+e_]+=base-a_[e_]; C1[4*g_+e_]+=base-b_[e_]; } } SBAR(); }while(0)
  #define CMASK(P0,P1,t) do{int jb_=(t)-(NT-4); if(jb_>=0)cmask(P0,P1,jb_,qrel,hi);}while(0)
  bool resc=false;
  #define START(P0,P1) do{ const float rm=rowmax(P0,P1); resc=false; \
    { const float dl=rm; mhat=fadd_s(mhat,dl); \
      _Pragma("unroll") for(int r=0;r<16;++r){P0[r]=fsub_s(P0[r],dl);P1[r]=fsub_s(P1[r],dl);} \
      base=Gq-mhat; } \
    _Pragma("unroll") for(int r=0;r<16;++r)P0[r]=__builtin_amdgcn_exp2f(P0[r]); }while(0)
  #define RESC() do{ if(resc){ asm volatile("s_waitcnt lgkmcnt(0)":::"memory"); \
      _Pragma("unroll") for(int d_=0;d_<2;++d_) _Pragma("unroll") for(int r=0;r<16;++r)o[d_][r]*=wsf[crow(r,hi)]; } }while(0)
  f32x16 pA0,pA1,pB0,pB1;
  int sl_prev=0,sl_cur=0,sl_next=SLOTB;
  #define ROT() do{sl_prev=sl_cur;sl_cur=sl_next;sl_next=(sl_next==(NSLOT-1)*SLOTB)?0:sl_next+SLOTB;}while(0)
  DMA_K(2,2*SLOTB);
  WAIT_BAR(3);
  qkt(pA0,pA1,Kbase,qr,negm,r32,hi);BIAS(pA0,pA1,0);asm volatile("s_nop 15\n\ts_nop 7":"+v"(pA0),"+v"(pA1));CMASK(pA0,pA1,0);
  START(pA0,pA1);
  _Pragma("unroll") for(int r=0;r<16;++r)pA1[r]=__builtin_amdgcn_exp2f(pA1[r]);
  WAIT_BAR(0);
  DMA_K(3,0);DMA_V(1,SLOTB);
  ROT();
  kload8(kf,kp0+sl_cur);
  WAIT_BAR(2);
  s16x4 vlo[8],vhi[8]; u32x4 pw0,pw1,pw2,pw3;
  #define PKW(P,B) cvtpk_s(P[B],P[B+1])
  #define PAF(k) __builtin_bit_cast(bf16x8,pw##k)
  #define VFR(i) (bf16x8){vlo[i][0],vlo[i][1],vlo[i][2],vlo[i][3],vhi[i][0],vhi[i][1],vhi[i][2],vhi[i][3]}
  #define PIN(x) asm volatile("":"+v"(x))
  #define MX3(a,b,c) __builtin_fmaxf(__builtin_fmaxf((a),(b)),(c))
  #define GAPA(MF,A0,A1,A2,A3,W0,W1,PW) do{ MF; sacc+=A0; sacc+=A1; sacc+=A2; sacc+=A3; PIN(sacc); W0; W1; PIN(PW); SBAR(); }while(0)
  #define EX(v) __builtin_amdgcn_exp2f(v)
  #define GAPB(MF,X,B) do{ MF; X[B]=EX(X[B]); X[B+1]=EX(X[B+1]); X[B+2]=EX(X[B+2]); X[B+3]=EX(X[B+3]); PIN(X); SBAR(); }while(0)
  #define VRD(i) do{ vlo[i]=vtr(vp_+(((i)>>2)*4096+((i)&3)*1024)); vhi[i]=vtr(vp_+(((i)>>2)*4096+((i)&3)*1024+512)); }while(0)
  #define KRD(G,j) do{ if(G){ kload2(kf,kp0+sl_next,j); SBAR(); } }while(0)
  #define STEP(C0,C1,P0,P1,t,GK,GV,GL) do{ SBAR(); \
    const lds_cptr vp_=vp0+sl_prev; const bf16x8 q0_=qst[0],q1_=qst[64],q2_=qst[128],q3_=qst[192]; \
    VRD(0); SBAR(); float sacc=(P0[0]+P0[1]); \
    GAPA(C0=__builtin_amdgcn_mfma_f32_32x32x16_bf16(kf[0],q0_,negm,0,0,0), P0[2],P0[3],P0[4],P0[5],     pw0[0]=PKW(P0,0), pw0[1]=PKW(P0,2), pw0); \
    VRD(4); SBAR(); GAPA(C1=__builtin_amdgcn_mfma_f32_32x32x16_bf16(kf[1],q0_,negm,0,0,0), P0[6],P0[7],P0[8],P0[9],     pw0[2]=PKW(P0,4), pw0[3]=PKW(P0,6), pw0); \
    VRD(1); SBAR(); GAPA(C0=__builtin_amdgcn_mfma_f32_32x32x16_bf16(kf[2],q1_,C0,0,0,0),   P0[10],P0[11],P0[12],P0[13], pw1[0]=PKW(P0,8), pw1[1]=PKW(P0,10), pw1); \
    VRD(5); SBAR(); GAPA(C1=__builtin_amdgcn_mfma_f32_32x32x16_bf16(kf[3],q1_,C1,0,0,0),   P0[14],P0[15],P1[0],P1[1],   pw1[2]=PKW(P0,12),pw1[3]=PKW(P0,14), pw1); \
    VRD(2); SBAR(); GAPA(C0=__builtin_amdgcn_mfma_f32_32x32x16_bf16(kf[4],q2_,C0,0,0,0),   P1[2],P1[3],P1[4],P1[5],     pw2[0]=PKW(P1,0), pw2[1]=PKW(P1,2), pw2); \
    VRD(6); SBAR(); GAPA(C1=__builtin_amdgcn_mfma_f32_32x32x16_bf16(kf[5],q2_,C1,0,0,0),   P1[6],P1[7],P1[8],P1[9],     pw2[2]=PKW(P1,4), pw2[3]=PKW(P1,6), pw2); \
    VRD(3); SBAR(); GAPA(C0=__builtin_amdgcn_mfma_f32_32x32x16_bf16(kf[6],q3_,C0,0,0,0),   P1[10],P1[11],P1[12],P1[13], pw3[0]=PKW(P1,8), pw3[1]=PKW(P1,10), pw3); \
    VRD(7); SBAR(); GAPA(C1=__builtin_amdgcn_mfma_f32_32x32x16_bf16(kf[7],q3_,C1,0,0,0),   P1[14],P1[15],0.f,0.f,       pw3[2]=PKW(P1,12),pw3[3]=PKW(P1,14), pw3); \
    l_reg+=sacc; \
    if(GK){DMA_K((t)+3,sl_cur);} if(GV){DMA_V((t)+1,sl_next);} \
    BIAS(C0,C1,t); CMASK(C0,C1,t); \
    { float a=MX3(C0[0],C0[1],C1[0]),b=MX3(C0[2],C0[3],C1[1]); a=MX3(a,C1[2],C1[3]); \
      _Pragma("unroll") for(int r=4;r<16;r+=4){a=MX3(a,C0[r],C0[r+1]);b=MX3(b,C0[r+2],C0[r+3]);a=MX3(a,C1[r],C1[r+1]);b=MX3(b,C1[r+2],C1[r+3]);} \
      float rm=__builtin_fmaxf(a,b); { auto rr=__builtin_amdgcn_permlane32_swap(__float_as_uint(rm),__float_as_uint(rm),false,false); rm=__builtin_fmaxf(__uint_as_float(rr[0]),__uint_as_float(rr[1])); } \
      resc=false; \
      if(__builtin_expect(__any(rm>(float)THRL),0)){ const float dl=__builtin_fmaxf(rm,0.f); mhat+=dl; \
        _Pragma("unroll") for(int r=0;r<16;++r){C0[r]-=dl;C1[r]-=dl;} \
        base=Gq-mhat; \
        const float f=__builtin_amdgcn_exp2f(-dl); l_reg*=f; if(hi==0)wsf[r32]=f; resc=true; } } \
    SBAR(); \
    GAPB(o[0]=__builtin_amdgcn_mfma_f32_32x32x16_bf16(PAF(0),VFR(0),o[0],0,0,0), C0,0); \
    GAPB(o[1]=__builtin_amdgcn_mfma_f32_32x32x16_bf16(PAF(0),VFR(4),o[1],0,0,0), C0,4); \
    KRD(GL,0); GAPB(o[0]=__builtin_amdgcn_mfma_f32_32x32x16_bf16(PAF(1),VFR(1),o[0],0,0,0), C0,8); \
    KRD(GL,1); GAPB(o[1]=__builtin_amdgcn_mfma_f32_32x32x16_bf16(PAF(1),VFR(5),o[1],0,0,0), C0,12); \
    KRD(GL,2); GAPB(o[0]=__builtin_amdgcn_mfma_f32_32x32x16_bf16(PAF(2),VFR(2),o[0],0,0,0), C1,0); \
    KRD(GL,3); GAPB(o[1]=__builtin_amdgcn_mfma_f32_32x32x16_bf16(PAF(2),VFR(6),o[1],0,0,0), C1,4); \
    GAPB(o[0]=__builtin_amdgcn_mfma_f32_32x32x16_bf16(PAF(3),VFR(3),o[0],0,0,0), C1,8); \
    GAPB(o[1]=__builtin_amdgcn_mfma_f32_32x32x16_bf16(PAF(3),VFR(7),o[1],0,0,0), C1,12); \
    }while(0)
  int t=1;
  #undef CMASK
  #define CMASK(P0,P1,t) do{}while(0)
  for(;t+5<NT;t+=2){
    STEP(pB0,pB1,pA0,pA1,t,true,true,true);     WAIT_BAR(2); RESC(); ROT();
    STEP(pA0,pA1,pB0,pB1,t+1,true,true,true);   WAIT_BAR(2); RESC(); ROT();
  }
  #undef CMASK
  #define CMASK(P0,P1,t) do{int jb_=(t)-(NT-4); if(jb_>=0)cmask(P0,P1,jb_,qrel,hi);}while(0)
  #define ENDW(tt) do{ if((tt)+3<NT){WAIT_BAR(2);} else if((tt)+2<NT){WAIT_BAR(1);} else {WAIT_BAR(0);} }while(0)
  for(;t+1<NT;t+=2){
    STEP(pB0,pB1,pA0,pA1,t,(t+3<NT),(t+1<NT),(t+1<NT));       ENDW(t);   RESC(); ROT();
    STEP(pA0,pA1,pB0,pB1,t+1,(t+4<NT),(t+2<NT),(t+2<NT));     ENDW(t+1); RESC(); ROT();
  }
  STEP(pB0,pB1,pA0,pA1,NT-1,false,false,false); RESC();
  { float sacc=pB0[0]+pB0[1]; _Pragma("unroll") for(int r=2;r<16;++r)sacc+=pB0[r]; _Pragma("unroll") for(int r=0;r<16;++r)sacc+=pB1[r]; l_reg+=sacc;
    pw0=(u32x4){PKW(pB0,0),PKW(pB0,2),PKW(pB0,4),PKW(pB0,6)};pw1=(u32x4){PKW(pB0,8),PKW(pB0,10),PKW(pB0,12),PKW(pB0,14)};pw2=(u32x4){PKW(pB1,0),PKW(pB1,2),PKW(pB1,4),PKW(pB1,6)};pw3=(u32x4){PKW(pB1,8),PKW(pB1,10),PKW(pB1,12),PKW(pB1,14)};
    SBAR(); pv(o,vb0+sl_cur,PAF(0),PAF(1),PAF(2),PAF(3)); }
  #undef PKW
  #undef PAF
  #undef VFR
  #undef PIN
  #undef MX3
  #undef GAPA
  #undef GAPB
  #undef EX
  #undef VRD
  #undef KRD
  #undef STEP
  #undef ENDW
  {auto rr=__builtin_amdgcn_permlane32_swap(__float_as_uint(l_reg),__float_as_uint(l_reg),false,false);l_reg=__uint_as_float(rr[0])+__uint_as_float(rr[1]);}
  if(hi==0)wsf[32+r32]=l_reg;asm volatile("s_waitcnt lgkmcnt(0)":::"memory");
  float rli[16];
  #pragma unroll
  for(int r=0;r<16;++r)rli[r]=__builtin_amdgcn_rcpf(wsf[32+crow(r,hi)]);
  bf16*Ow=O+(rowbase+q0+wid*QBLK)*DM+h*D;
  { bf16*stg=(bf16*)(shm+LDS_OST)+wid*2048;
    #pragma unroll
    for(int r=0;r<16;++r){const int orow=crow(r,hi);
      #pragma unroll
      for(int d0=0;d0<2;++d0)stg[orow*64+d0*32+r32]=__float2bfloat16(o[d0][r]*rli[r]);}
    asm volatile("s_waitcnt lgkmcnt(0)":::"memory");
    #pragma unroll
    for(int i=0;i<4;++i){const int row=i*8+(lane>>3),ch=lane&7; const u32x4 v=*(const u32x4*)(stg+row*64+ch*8); ATTN_STORE16(Ow+(long)row*DM+ch*8,v);} }
  asm volatile("s_waitcnt lgkmcnt(0)\n\ts_barrier":::"memory");
  #undef DMA_K
  #undef DMA_V
  #undef CMASK
  #undef BIAS
  #undef START
  #undef RESC
  #undef ROT
}
constexpr int ATTN_LDS_BYTES=LDS_BYTES;
#undef SBAR
#undef WAIT_BAR
}

namespace sbk {
using bf16x8=__attribute__((ext_vector_type(8)))short;
using s16x4=__attribute__((ext_vector_type(4)))short;
using f32x16=__attribute__((ext_vector_type(16)))float;
constexpr int WLDS=12288;
constexpr float R_STOP=48.0f;
__device__ __forceinline__ int crow(int r,int hi){return (r&3)+8*(r>>2)+4*hi;}
__device__ __forceinline__ unsigned cvtpk(float lo,float hi){typedef float f2 __attribute__((ext_vector_type(2)));typedef __bf16 b2 __attribute__((ext_vector_type(2)));f2 v={lo,hi};b2 b=__builtin_convertvector(v,b2);return __builtin_bit_cast(unsigned,b);}
__device__ __forceinline__ void pv(f32x16*o,int vb,bf16x8 pa0,bf16x8 pa1,bf16x8 pa2,bf16x8 pa3){
  #pragma unroll
  for(int d0=0;d0<2;++d0){s16x4 lo[4],hi[4];
    #pragma unroll
    for(int ks=0;ks<4;++ks){
      asm volatile("ds_read_b64_tr_b16 %0,%1 offset:%c2":"=&v"(lo[ks]):"v"(vb),"i"(d0*4096+ks*1024):"memory");
      asm volatile("ds_read_b64_tr_b16 %0,%1 offset:%c2":"=&v"(hi[ks]):"v"(vb),"i"(d0*4096+ks*1024+512):"memory");}
    asm volatile("s_waitcnt lgkmcnt(0)":::"memory");__builtin_amdgcn_sched_barrier(0);
    #define PK(k) (bf16x8){lo[k][0],lo[k][1],lo[k][2],lo[k][3],hi[k][0],hi[k][1],hi[k][2],hi[k][3]}
    o[d0]=__builtin_amdgcn_mfma_f32_32x32x16_bf16(pa0,PK(0),o[d0],0,0,0);
    o[d0]=__builtin_amdgcn_mfma_f32_32x32x16_bf16(pa1,PK(1),o[d0],0,0,0);
    o[d0]=__builtin_amdgcn_mfma_f32_32x32x16_bf16(pa2,PK(2),o[d0],0,0,0);
    o[d0]=__builtin_amdgcn_mfma_f32_32x32x16_bf16(pa3,PK(3),o[d0],0,0,0);
    #undef PK
  }
}
__device__ __forceinline__ float sp2(float z){ return fmaxf(z,0.f)+__builtin_amdgcn_logf(1.0f+__builtin_amdgcn_exp2f(-fabsf(z))); }
__device__ __forceinline__ void sb_unit(int b,int h,int tb,const bf16_t*Q,const bf16_t*K,const bf16_t*V,bf16_t*O,char*wl,int lane){
  const int r32=lane&31,hi=lane>>5,t0=tb*32; const long rowbase=(long)b*SEQ; const int co=512+h*64;
  const bf16_t*Qw=Q+(rowbase+t0)*DM+co;
  bf16x8 qr[4];
  #pragma unroll
  for(int d0=0;d0<4;++d0)qr[d0]=*reinterpret_cast<const bf16x8*>(Qw+(long)r32*DM+d0*16+hi*8);
  f32x16 o[2];o[0]=f32x16{};o[1]=f32x16{};float R=0.f;
  const int vb=(int)(unsigned)(uintptr_t)wl+((lane>>4)&1)*32+(lane&3)*8+(4*hi+((lane&15)>>2))*64;
  bf16x8 kf[8];
  #define SB_LOADK(jj) do{ const int s0_=(jj)*64; const bf16_t*Kp=K+(rowbase+s0_+r32)*DM+co+hi*8; \
    _Pragma("unroll") for(int d0=0;d0<4;++d0){kf[2*d0]=*reinterpret_cast<const bf16x8*>(Kp+d0*16);kf[2*d0+1]=*reinterpret_cast<const bf16x8*>(Kp+(long)32*DM+d0*16);} }while(0)
    \
  #define SB_DMAV(jj) do{ const int s0_=(jj)*64; \
    _Pragma("unroll") for(int p=0;p<8;++p)__builtin_amdgcn_global_load_lds((const unsigned*)(V+(rowbase+s0_+16*(p&3)+(lane>>2))*DM+co+(p>>2)*32+(lane&3)*8),(__attribute__((address_space(3))) unsigned*)(wl+p*1024),16,0,0); }while(0)
  SB_LOADK(t0>>6); SB_DMAV(t0>>6);
  for(int j=t0>>6;j>=0;--j){
    const int s0=j*64;
    f32x16 z0=f32x16{},z1=f32x16{};
    #pragma unroll
    for(int d0=0;d0<4;++d0){z0=__builtin_amdgcn_mfma_f32_32x32x16_bf16(kf[2*d0],qr[d0],z0,0,0,0);z1=__builtin_amdgcn_mfma_f32_32x32x16_bf16(kf[2*d0+1],qr[d0],z1,0,0,0);}
    int rel=((j==(t0>>6))?(t0-s0+r32):1000)-4*hi; asm volatile("":"+v"(rel));
    f32x16 L0,L1;
    #pragma unroll
    for(int r=0;r<16;++r){const int kv=(r&3)+8*(r>>2); L0[r]=(kv<rel)?sp2(z0[r]):0.f; L1[r]=(kv+32<rel)?sp2(z1[r]):0.f;}
    float T[8]; f32x16 E0,E1;
    #pragma unroll
    for(int i=0;i<4;++i){
      E0[4*i+3]=0.f;E0[4*i+2]=L0[4*i+3];E0[4*i+1]=E0[4*i+2]+L0[4*i+2];E0[4*i]=E0[4*i+1]+L0[4*i+1];T[i]=E0[4*i]+L0[4*i];
      E1[4*i+3]=0.f;E1[4*i+2]=L1[4*i+3];E1[4*i+1]=E1[4*i+2]+L1[4*i+2];E1[4*i]=E1[4*i+1]+L1[4*i+1];T[4+i]=E1[4*i]+L1[4*i];}
    float X[8];
    #pragma unroll
    for(int i=0;i<8;++i)X[i]=__shfl_xor(T[i],32);
    float S[8]; float run=0.f;
    #pragma unroll
    for(int i=7;i>=0;--i){
      const float g_hi=hi?T[i]:X[i];
      const float g_lo=hi?X[i]:T[i];
      S[i]=hi?run:(run+g_hi);
      run+=g_hi+g_lo; }
    const float Ttot=run;
    #pragma unroll
    for(int i=0;i<4;++i){
      #pragma unroll
      for(int e=0;e<4;++e){E0[4*i+e]+=S[i];E1[4*i+e]+=S[4+i];}}
    f32x16 P0,P1;
    #pragma unroll
    for(int r=0;r<16;++r){const int kv=(r&3)+8*(r>>2);
      P0[r]=(kv<rel)?__builtin_amdgcn_exp2f(z0[r]-L0[r]-E0[r]-R):0.f;
      P1[r]=(kv+32<rel)?__builtin_amdgcn_exp2f(z1[r]-L1[r]-E1[r]-R):0.f;}
    R+=Ttot;
    u32x4 pw0,pw1,pw2,pw3;
    pw0=(u32x4){cvtpk(P0[0],P0[1]),cvtpk(P0[2],P0[3]),cvtpk(P0[4],P0[5]),cvtpk(P0[6],P0[7])};
    pw1=(u32x4){cvtpk(P0[8],P0[9]),cvtpk(P0[10],P0[11]),cvtpk(P0[12],P0[13]),cvtpk(P0[14],P0[15])};
    pw2=(u32x4){cvtpk(P1[0],P1[1]),cvtpk(P1[2],P1[3]),cvtpk(P1[4],P1[5]),cvtpk(P1[6],P1[7])};
    pw3=(u32x4){cvtpk(P1[8],P1[9]),cvtpk(P1[10],P1[11]),cvtpk(P1[12],P1[13]),cvtpk(P1[14],P1[15])};
    asm volatile("s_waitcnt lgkmcnt(0)":::"memory");
    if(j>0)SB_LOADK(j-1);
    if(j>0)asm volatile("s_waitcnt vmcnt(8)":::"memory"); else asm volatile("s_waitcnt vmcnt(0)":::"memory");
    pv(o,vb,__builtin_bit_cast(bf16x8,pw0),__builtin_bit_cast(bf16x8,pw1),__builtin_bit_cast(bf16x8,pw2),__builtin_bit_cast(bf16x8,pw3));
    const bool stop_=__all(R>R_STOP);
    if(j>0&&!stop_)SB_DMAV(j-1);
    if(stop_)break;
  }
  #undef SB_LOADK
  #undef SB_DMAV
  bf16_t*Ow=O+(rowbase+t0)*DM+co;
  { bf16_t*stg=(bf16_t*)(wl+8192);
    #pragma unroll
    for(int r=0;r<16;++r){const int orow=crow(r,hi);
      #pragma unroll
      for(int d0=0;d0<2;++d0)stg[orow*64+d0*32+r32]=(bf16_t)f2bf(o[d0][r]);}
    asm volatile("s_waitcnt lgkmcnt(0)":::"memory");
    #pragma unroll
    for(int i=0;i<4;++i){const int row=i*8+(lane>>3),ch=lane&7; const u32x4 v=*(const u32x4*)(stg+row*64+ch*8); *(u32x4*)(Ow+(long)row*DM+ch*8)=v;}
    asm volatile("s_waitcnt lgkmcnt(0)":::"memory"); }
}
}

constexpr int ATT_G_OFF = attn_body::ATTN_LDS_BYTES, ATT_RED_OFF = ATT_G_OFF + SEQ * 4;
__device__ __forceinline__ void fox_scan_G(const float* FA, int b, int h, float* Gl, float* red, int tid, int lane, int wave) {
    float v[8]; float run = 0.f;
#pragma unroll
    for (int j = 0; j < 8; ++j) { run += FA[((size_t)b * SEQ + 8 * tid + j) * 8 + h] * LOG2E; v[j] = run; }
    float inc = run;
#pragma unroll
    for (int o = 1; o < 64; o <<= 1) { const float n = __shfl_up(inc, o); if (lane >= o) inc += n; }
    if (lane == 63) red[wave] = inc;
    __syncthreads();
    float off = inc - run;
    for (int w = 0; w < wave; ++w) off += red[w];
#pragma unroll
    for (int j = 0; j < 8; ++j) Gl[8 * tid + j] = off + v[j];
    __syncthreads();
}
template <int PARTS = 3>
__device__ __forceinline__ void ph_attn(const Prm& p, const Ctx& C, int l, unsigned char* lds, size_t o_off = WS_QQ) {
    const int G = gridDim.x, bx = blockIdx.x; const int vcu = (G % 8 == 0) ? (bx % 8) * (G / 8) + bx / 8 : bx;
    const attn_body::bf16* Q = (const attn_body::bf16*)(p.ws + WS_QQ); const attn_body::bf16* K = (const attn_body::bf16*)(p.ws + WS_KK); const attn_body::bf16* V = (const attn_body::bf16*)(p.ws + WS_VV);
    float* Gl = (float*)(lds + ATT_G_OFF); float* red = (float*)(lds + ATT_RED_OFF);
    int cur_bh = -1;
    float Bq;
    { float mq = fabsf(p.gq[l * HD + C.lane]), mk = fabsf(p.gk[l * HD + C.lane]);
#pragma unroll
      for (int o = 1; o < 64; o <<= 1) { mq = fmaxf(mq, __shfl_xor(mq, o)); mk = fmaxf(mk, __shfl_xor(mk, o)); }
      Bq = 1.02f * C2 * 64.0f * mq * mk; }
    unsigned* qcnt = (unsigned*)(p.ws + WS_CTL) + 3584 + l * 8 * 64;
    unsigned* uslot = (unsigned*)(lds + ATT_RED_OFF + 64);
    for (int qi = 0; qi < 8; ++qi) {
        const int qx = (bx + qi) & 7;
        for (;;) {
            __syncthreads();
            if (C.tid == 0) *uslot = __hip_atomic_fetch_add(qcnt + 64 * qx, 1u, __ATOMIC_RELAXED, __HIP_MEMORY_SCOPE_AGENT);
            __syncthreads();
            const unsigned u = *uslot;
            if (u >= 256u) break;
            if (u < 128u) {
                if (!(PARTS & 1)) continue;
                const int qb = 15 - (int)(u >> 3), bh = qx * NH + (int)(u & 7);
                if (bh != cur_bh) { __syncthreads(); fox_scan_G((const float*)(p.ws + WS_FA), bh / NH, bh % NH, Gl, red, C.tid, C.lane, C.wave); cur_bh = bh; }
                const int ntf = 4 * qb + 4; const float thr = Gl[qb * 256] + 2.0f * Bq + 48.0f;
                const bool skp = (C.lane < ntf - 4) && (Gl[64 * C.lane + 63] > thr);
                const int j0 = __builtin_popcountll(__ballot(skp)) & ~1;
                attn_body::attn_unit<8>(bh / NH, bh % NH, qb, Q, K, V, (attn_body::bf16*)(p.ws + o_off), (char*)lds, Gl, j0);
            } else {
                if (!(PARTS & 2)) continue;
                const int v = (int)u - 128, h = v & 7, g = 15 - (v >> 3);
                cur_bh = -1;
                int lane_ = C.lane; asm volatile("" : "+v"(lane_));
                sbk::sb_unit(qx, h, 8 * g + C.wave, (const bf16_t*)(p.ws + WS_QQ), (const bf16_t*)(p.ws + WS_KK), (const bf16_t*)(p.ws + WS_VV), (bf16_t*)(p.ws + o_off), (char*)lds + C.wave * sbk::WLDS, lane_);
            }
        }
    }
    __syncthreads();
}

namespace pgk {
typedef __bf16 bf16x2 __attribute__((ext_vector_type(2)));
__device__ __forceinline__ float dot2(unsigned a, unsigned b, float c) { return __builtin_amdgcn_fdot2_f32_bf16(__builtin_bit_cast(bf16x2, a), __builtin_bit_cast(bf16x2, b), c, false); }
__device__ __forceinline__ unsigned cvtpk(float lo, float hi) { typedef float f2 __attribute__((ext_vector_type(2))); f2 v = {lo, hi}; bf16x2 b = __builtin_convertvector(v, bf16x2); return __builtin_bit_cast(unsigned, b); }
}
namespace tk {
using bf16x8 = __attribute__((ext_vector_type(8))) short;
using f32x16 = __attribute__((ext_vector_type(16))) float;
constexpr int NCAND = 50;
__device__ __forceinline__ unsigned f2key(float f) { const unsigned u = __float_as_uint(f); return u ^ ((unsigned)((int)u >> 31) | 0x80000000u); }
__device__ __forceinline__ float key2f(unsigned k) { return __uint_as_float(k ^ ~((unsigned)((int)k >> 31) >> 1)); }
#define TK_CE(a, b) do { const unsigned mx_ = (a) > (b) ? (a) : (b), mn_ = (a) > (b) ? (b) : (a); (a) = mx_; (b) = mn_; } while (0)
template <int N> __device__ __forceinline__ void sort_desc(unsigned (&k)[N]) {
#pragma unroll
    for (int size = 2; size <= N; size <<= 1) {
#pragma unroll
        for (int stride = size >> 1; stride > 0; stride >>= 1) {
#pragma unroll
            for (int i = 0; i < N; ++i) { const int j = i ^ stride; if (j > i) { if ((i & size) == 0 || size == N) TK_CE(k[i], k[j]); else TK_CE(k[j], k[i]); } }
        }
    }
}
__device__ __forceinline__ void merge_desc16(unsigned (&k)[16]) {
#pragma unroll
    for (int stride = 8; stride > 0; stride >>= 1) {
#pragma unroll
        for (int i = 0; i < 16; ++i) { const int j = i ^ stride; if (j > i) TK_CE(k[i], k[j]); }
    }
}
__device__ __forceinline__ void top16_merge(unsigned (&a)[16], const unsigned (&b)[16]) {
#pragma unroll
    for (int i = 0; i < 16; ++i) a[i] = a[i] > b[15 - i] ? a[i] : b[15 - i];
    merge_desc16(a);
}
__device__ __forceinline__ void xlane_merge(unsigned (&a)[16]) {
    unsigned o[16];
#pragma unroll
    for (int i = 0; i < 16; ++i) o[i] = (unsigned)__shfl_xor((int)a[i], 32);
    top16_merge(a, o);
}
__device__ __forceinline__ void half_top16(const f32x16 (&z)[4], int c4, unsigned (&out)[16]) {
    unsigned k[4][16];
#pragma unroll
    for (int blk = 0; blk < 4; ++blk)
#pragma unroll
        for (int r = 0; r < 16; ++r) k[blk][r] = (f2key(z[blk][r]) & ~127u) | (unsigned)((127 - 32 * blk - (r & 3) - 8 * (r >> 2)) - c4);
#pragma unroll
    for (int blk = 0; blk < 4; ++blk) sort_desc<16>(k[blk]);
    top16_merge(k[0], k[1]); top16_merge(k[2], k[3]); top16_merge(k[0], k[2]);
    xlane_merge(k[0]);
#pragma unroll
    for (int i = 0; i < 16; ++i) out[i] = k[0][i];
}
}

__device__ __forceinline__ void ph_topk(const Prm& p, const Ctx& C, int l, unsigned char* lds) {
    constexpr int TA[64] = {0,0,0,0,0,0,0,0,0,0,0,0,0,0,0,0,1,1,1,1,1,1,1,1,2,2,2,2,2,3,3,3,3,4,4,4,5,5,6,6,7,7,8,9,10,11,12,13,14,15,0,0,0,0,0,0,0,0,0,0,0,0,0,0};
    constexpr int TB[64] = {0,1,2,3,4,5,6,7,8,9,10,11,12,13,14,15,0,1,2,3,4,5,6,7,0,1,2,3,4,0,1,2,3,0,1,2,0,1,0,1,0,1,0,0,0,0,0,0,0,0,0,0,0,0,0,0,0,0,0,0,0,0,0,0};
    const bf16_t* QP = (const bf16_t*)(p.ws + WS_KK); unsigned short* IDX = (unsigned short*)(p.ws + WS_VV); float* PW = (float*)(p.ws + WS_VV + 16 * MiB);
    const int lane = C.lane, r32 = lane & 31, hi = lane >> 5;
    int c4 = 4 * hi; asm volatile("" : "+v"(c4));
    unsigned char* wtab = lds + 32768 + C.wave * 1024 + r32 * 32;
    for (int item = blockIdx.x; item < 256; item += gridDim.x) {
        const int h = item & 7, tg = item >> 3;
        __syncthreads();
        for (int c = C.tid; c < 2048; c += NTHREADS) {
            const int tbl = c >> 10, row = (c >> 3) & 127, ch = c & 7;
            const float* src = (tbl ? p.k2 : p.k1) + ((size_t)(l * NH + h) * NKEYS + row) * 64 + ch * 8;
            const f32x4 a = *(const f32x4*)src, b = *(const f32x4*)(src + 4);
            u32x4 o; o.x = pgk::cvtpk(a.x, a.y); o.y = pgk::cvtpk(a.z, a.w); o.z = pgk::cvtpk(b.x, b.y); o.w = pgk::cvtpk(b.z, b.w);
            *(u32x4*)(lds + tbl * 16384 + row * 128 + ((ch ^ (row & 7)) << 4)) = o;
        }
        __syncthreads();
#pragma unroll 1
        for (int i = 0; i < 4; ++i) {
            const int tile = tg * 32 + C.wave * 4 + i, t = tile * 32 + r32;
            const bf16_t* qrow = QP + (size_t)t * DM + h * 128 + 8 * hi;
            unsigned V1[16], V2[16];
#pragma unroll
            for (int half = 0; half < 2; ++half) {
                tk::bf16x8 qf[4];
#pragma unroll
                for (int ks = 0; ks < 4; ++ks) qf[ks] = *(const tk::bf16x8*)(qrow + half * 64 + 16 * ks);
                tk::f32x16 z[4];
#pragma unroll
                for (int blk = 0; blk < 4; ++blk) {
                    z[blk] = tk::f32x16{};
                    const int row = 32 * blk + r32;
#pragma unroll
                    for (int ks = 0; ks < 4; ++ks) {
                        const tk::bf16x8 kfr = *(const tk::bf16x8*)(lds + half * 16384 + row * 128 + (((2 * ks + hi) ^ (row & 7)) << 4));
                        z[blk] = __builtin_amdgcn_mfma_f32_32x32x16_bf16(kfr, qf[ks], z[blk], 0, 0, 0);
                    }
                }
                if (half == 0) tk::half_top16(z, c4, V1); else tk::half_top16(z, c4, V2);
            }
            { u32x4 w;
              unsigned n[16];
#pragma unroll
              for (int q = 0; q < 16; ++q) n[q] = 127u - ((hi ? V2[q] : V1[q]) & 127u);
              w.x = n[0] | (n[1] << 8) | (n[2] << 16) | (n[3] << 24); w.y = n[4] | (n[5] << 8) | (n[6] << 16) | (n[7] << 24);
              w.z = n[8] | (n[9] << 8) | (n[10] << 16) | (n[11] << 24); w.w = n[12] | (n[13] << 8) | (n[14] << 16) | (n[15] << 24);
              *(u32x4*)(wtab + 16 * hi) = w; }
            float f1[16], f2[16];
#pragma unroll
            for (int q = 0; q < 16; ++q) { f1[q] = tk::key2f(V1[q] & ~127u); f2[q] = tk::key2f(V2[q] & ~127u); }
            unsigned ca[16], cb[16];
#pragma unroll
            for (int s = 0; s < 32; ++s) {
                const float v0 = f1[TA[s]] + f2[TB[s]];
                const float v1 = (32 + s < tk::NCAND) ? f1[TA[32 + s]] + f2[TB[32 + s]] : -INFINITY;
                const unsigned j0 = 255u - (unsigned)(TA[s] * 16 + TB[s]), j1 = 255u - (unsigned)(TA[32 + s] * 16 + TB[32 + s]);
                const unsigned key = (tk::f2key(hi ? v1 : v0) & ~255u) | (hi ? j1 : j0);
                if (s < 16) ca[s] = key; else cb[s - 16] = key;
            }
            tk::sort_desc<16>(ca); tk::sort_desc<16>(cb); tk::top16_merge(ca, cb); tk::xlane_merge(ca);
            float e[16]; float sum = 0.f; const float mx = tk::key2f(ca[0] & ~255u);
#pragma unroll
            for (int q = 0; q < 16; ++q) { e[q] = __builtin_amdgcn_exp2f((tk::key2f(ca[q] & ~255u) - mx) * LOG2E); sum += e[q]; }
            const float inv = 1.0f / sum;
            int eo[8]; float go[8];
            asm volatile("s_waitcnt lgkmcnt(0)" ::: "memory");
#pragma unroll
            for (int q = 0; q < 8; ++q) {
                const unsigned kq = hi ? ca[8 + q] : ca[q]; const unsigned j = 255u - (kq & 255u);
                const unsigned n1 = wtab[j >> 4], n2 = wtab[16 + (j & 15)];
                eo[q] = (int)(n1 * NKEYS + n2); go[q] = (hi ? e[8 + q] : e[q]) * inv;
            }
            unsigned short* ip = IDX + (size_t)t * 128 + h * 16 + 8 * hi; float* gp = PW + (size_t)t * 128 + h * 16 + 8 * hi;
            *(u32x4*)ip = (u32x4){(unsigned)eo[0] | ((unsigned)eo[1] << 16), (unsigned)eo[2] | ((unsigned)eo[3] << 16), (unsigned)eo[4] | ((unsigned)eo[5] << 16), (unsigned)eo[6] | ((unsigned)eo[7] << 16)};
            *(f32x4*)gp = (f32x4){go[0], go[1], go[2], go[3]}; *(f32x4*)(gp + 4) = (f32x4){go[4], go[5], go[6], go[7]};
            asm volatile("s_waitcnt lgkmcnt(0)" ::: "memory");
        }
    }
    __syncthreads();
}


constexpr size_t WS_T8 = WS_UB;
constexpr size_t WS_SC8 = WS_K12;
typedef float f32x2 __attribute__((ext_vector_type(2)));
typedef short s16x4 __attribute__((ext_vector_type(4))); typedef int i32x4 __attribute__((ext_vector_type(4))); typedef int i32x2 __attribute__((ext_vector_type(2)));
#define GAS __attribute__((address_space(1)))
#define LAS __attribute__((address_space(3)))
#define XB_TMO      128
#define XB_XCNT(j)  (256  + 64 * (j))
#define XB_XSUB(j)  (1280 + 64 * (j))
#define XB_XGEN(j)  (2304 + 64 * (j))
#define XB_TOP      3328
#define XB_TOPGEN   3392
#define XCD_BAR_WORDS 3456
#define XB_SPIN_CAP (1u << 18)

__device__ __forceinline__ unsigned xb_ld(unsigned* p)              { return __hip_atomic_load(p, __ATOMIC_RELAXED, __HIP_MEMORY_SCOPE_AGENT); }
__device__ __forceinline__ unsigned xb_add(unsigned* p, unsigned v) { return __hip_atomic_fetch_add(p, v, __ATOMIC_RELAXED, __HIP_MEMORY_SCOPE_AGENT); }
__device__ __forceinline__ unsigned xb_xcc_id() { return (unsigned)__builtin_amdgcn_s_getreg((3 << 11) | 20) & 0xFu; }
#define XB_SPIN(cond, bar) do { unsigned _sp = 0; while (cond) { __builtin_amdgcn_s_sleep(1); \
    if ((++_sp & 255u) == 0u) { if (xb_ld(&(bar)[XB_TMO])) break; if (_sp > XB_SPIN_CAP) { atomicAdd(&(bar)[XB_TMO], 1u); break; } } } } while (0)

struct XcdBarrier {
    unsigned* bar; unsigned x;
    volatile LAS unsigned* st;
};

__device__ __forceinline__ XcdBarrier xcd_barrier_post(unsigned* bar, volatile LAS unsigned* st) {
    XcdBarrier b; b.bar = bar; b.x = xb_xcc_id(); b.st = st;
    if (threadIdx.x == 0) st[2] = xb_add(&bar[XB_XCNT(b.x)], 1u);
    return b;
}
__device__ __forceinline__ void xcd_barrier_complete(unsigned* bar, unsigned x, unsigned& nloc, unsigned& nx) {
    const unsigned G = gridDim.x * gridDim.y * gridDim.z;
    unsigned sum, cnt, mine, sp = 0u;
    for (;;) {
        sum = 0u; cnt = 0u; mine = 0u;
#pragma unroll
        for (unsigned j = 0; j < 16; ++j) { const unsigned c = xb_ld(&bar[XB_XCNT(j)]); sum += c; cnt += (c > 0u) ? 1u : 0u; mine = (j == x) ? c : mine; }
        if (sum == G) break;
        __builtin_amdgcn_s_sleep(1);
        if ((++sp & 255u) == 0u) { if (xb_ld(&bar[XB_TMO])) break; if (sp > XB_SPIN_CAP) { atomicAdd(&bar[XB_TMO], 1u); break; } }
    }
    nloc = mine > 0u ? mine : 1u; nx = cnt > 0u ? cnt : 1u;
}

__device__ __forceinline__ void xcd_barrier(const XcdBarrier& b) {
    asm volatile("s_waitcnt vmcnt(0)" ::: "memory");
    __syncthreads();
    if (threadIdx.x == 0) {
        unsigned* bar = b.bar;
        __builtin_amdgcn_s_waitcnt(0);
        unsigned nloc = b.st[0], nx = b.st[1];
        if (nloc == 0u) { xcd_barrier_complete(bar, b.x, nloc, nx); b.st[0] = nloc; b.st[1] = nx; }
        const unsigned old = xb_add(&bar[XB_XSUB(b.x)], 1u);
        const unsigned gen = old / nloc;
        if (old + 1u == (gen + 1u) * nloc) {
            __builtin_amdgcn_fence(__ATOMIC_RELEASE, "agent");
            asm volatile("s_waitcnt vmcnt(0)" ::: "memory");
            const unsigned og = xb_add(&bar[XB_TOP], 1u);
            const unsigned tg = og / nx;
            if (og + 1u == (tg + 1u) * nx) xb_add(&bar[XB_TOPGEN], 1u);
            else XB_SPIN(xb_ld(&bar[XB_TOPGEN]) == tg, bar);
            __builtin_amdgcn_fence(__ATOMIC_ACQUIRE, "agent");
            xb_add(&bar[XB_XGEN(b.x)], 1u);
            asm volatile("s_waitcnt vmcnt(0)" ::: "memory");
        } else {
            XB_SPIN(xb_ld(&bar[XB_XGEN(b.x)]) == gen, bar);
            __builtin_amdgcn_fence(__ATOMIC_ACQUIRE, "agent");
            asm volatile("s_waitcnt vmcnt(0)" ::: "memory");
        }
    }
    __syncthreads();
}


constexpr size_t WS_PD = WS_GT;
template <int CTRL> __device__ __forceinline__ int dpp_i(int v) { return __builtin_amdgcn_update_dpp(0, v, CTRL, 0xF, 0xF, true); }
template <int CTRL> __device__ __forceinline__ float dpp_f(float v) { return __int_as_float(__builtin_amdgcn_update_dpp(0, __float_as_int(v), CTRL, 0xF, 0xF, true)); }
__device__ __forceinline__ void ph_convert_tables8s(const Prm& p, const Ctx& C) {
    unsigned char* T8 = p.ws + WS_T8; float* SC = (float*)(p.ws + WS_SC8);
    constexpr int NR = 2 * 2 * NEXP;
    f32x4 v[2][2][4];
#define CV_LOAD(s_, row0_) do { _Pragma("unroll") for (int r = 0; r < 2; ++r) { const int row = min((row0_) + r * C.ngw, NR - 1); const int lt = row >> 14, e = row & (NEXP - 1), l = lt >> 1, tbl = lt & 1; \
        const float* src = (tbl ? p.pv : p.pu) + ((size_t)l * NEXP + e) * DM + 4 * C.lane; _Pragma("unroll") for (int j = 0; j < 4; ++j) v[s_][r][j] = *(const f32x4*)(src + 256 * j); } } while (0)
#define CV_PROC(s_, row0_) do { _Pragma("unroll") for (int r = 0; r < 2; ++r) { const int row = (row0_) + r * C.ngw; if (row >= NR) break; const int lt = row >> 14, e = row & (NEXP - 1); \
        float am = 0.f; _Pragma("unroll") for (int j = 0; j < 4; ++j) am = fmaxf(am, fmaxf(fmaxf(fabsf(v[s_][r][j].x), fabsf(v[s_][r][j].y)), fmaxf(fabsf(v[s_][r][j].z), fabsf(v[s_][r][j].w)))); \
        am = fmaxf(am, dpp_f<0xB1>(am)); am = fmaxf(am, dpp_f<0x4E>(am)); am = fmaxf(am, dpp_f<0x141>(am)); am = fmaxf(am, dpp_f<0x140>(am)); am = fmaxf(am, __shfl_xor(am, 16)); am = fmaxf(am, __shfl_xor(am, 32)); \
          \
        const float qm = 7.0f / 0.75f, sc = am > 0.f ? am / qm : 1.0f, inv = am > 0.f ? qm / am : 0.f; \
        const int o8 = (lt & 1) ? 8 : 0;     \
        _Pragma("unroll") for (int j = 0; j < 4; ++j) {     \
            const int q0 = (int)fminf(fmaxf(rintf(v[s_][r][j].x * inv), -8.0f), 7.0f), q1 = (int)fminf(fmaxf(rintf(v[s_][r][j].y * inv), -8.0f), 7.0f), q2 = (int)fminf(fmaxf(rintf(v[s_][r][j].z * inv), -8.0f), 7.0f), q3 = (int)fminf(fmaxf(rintf(v[s_][r][j].w * inv), -8.0f), 7.0f); \
            const int o_ = C.lane < 32 ? o8 : 0; const unsigned mine = (unsigned)(((q0 + o_) & 15) | (((q1 + o_) & 15) << 8) | (((q2 + o_) & 15) << 16) | (((q3 + o_) & 15) << 24)); \
            const unsigned other = (unsigned)__shfl_xor((int)mine, 32); \
            if (C.lane < 32) *(unsigned*)(T8 + (((size_t)lt * 8 + j) * NEXP + e) * 128 + 4 * C.lane) = mine | (other << 4); } \
        if (C.lane == 0) SC[row] = sc; } } while (0)
    CV_LOAD(0, C.gw);
    __builtin_amdgcn_s_waitcnt(0x0F70);
#pragma unroll 1
    for (int row0 = C.gw; row0 < NR; row0 += 4 * C.ngw) {
        CV_LOAD(1, row0 + 2 * C.ngw); CV_PROC(0, row0);
        CV_LOAD(0, row0 + 4 * C.ngw); CV_PROC(1, row0 + 2 * C.ngw);
    }
#undef CV_LOAD
#undef CV_PROC
}
__device__ __forceinline__ float sum8(float v) { v += dpp_f<0xB1>(v); v += dpp_f<0x4E>(v); v += dpp_f<0x141>(v); return v; }
__device__ __forceinline__ float xsum32(float a, float b) { const auto r = __builtin_amdgcn_permlane32_swap(__float_as_uint(a), __float_as_uint(b), false, false); return __uint_as_float(r[0]) + __uint_as_float(r[1]); }
__device__ __forceinline__ float xsum16(float a, float b) { const auto r = __builtin_amdgcn_permlane16_swap(__float_as_uint(a), __float_as_uint(b), false, false); return __uint_as_float(r[0]) + __uint_as_float(r[1]); }
template <int JS> __device__ __forceinline__ unsigned bcast8(unsigned v, int jq) {
    constexpr int c = JS & 3, ctrl = c | (c << 2) | (c << 4) | (c << 6);
    const unsigned v1 = (unsigned)__builtin_amdgcn_update_dpp(0, (int)v, ctrl, 0xF, 0xF, true);
    const unsigned v2 = (unsigned)__builtin_amdgcn_update_dpp(0, (int)v1, 0x141, 0xF, 0xF, true);
    return (jq == (JS >> 2)) ? v1 : v2;
}
template <int BB> __device__ __forceinline__ unsigned pick_id(unsigned idw, int jq) { const unsigned w = bcast8<(BB >> 1)>(idw, jq); return (BB & 1) ? (w >> 16) : (w & 0xffffu); }
template <int G4> __device__ __forceinline__ int bcast4(unsigned v) { constexpr int ctrl = G4 | (G4 << 2) | (G4 << 4) | (G4 << 6); return __builtin_amdgcn_update_dpp(0, (int)v, ctrl, 0xF, 0xF, true); }
struct SliceCtx { int x, wq, nwq; };
#ifndef SLICE_BY_XCC
#define SLICE_BY_XCC 0
#endif
__device__ __forceinline__ SliceCtx slice_ctx(const Ctx& C, const Prm& p, unsigned char* lds) { SliceCtx s; const int G = gridDim.x;
    if (SLICE_BY_XCC) { const unsigned x = xb_xcc_id() & 7u; const unsigned* bar = (const unsigned*)(p.ws + WS_CTL); const volatile LAS unsigned* st = (const volatile LAS unsigned*)((LAS unsigned char*)lds + (LDS_BYTES - 64));
        s.x = (int)x; s.wq = (int)st[2] * NWAVES + C.wave; s.nwq = (int)xb_ld((unsigned*)&bar[XB_XCNT(x)]) * NWAVES; return s; }
    s.x = blockIdx.x & 7; s.wq = (blockIdx.x >> 3) * NWAVES + C.wave; s.nwq = ((G - s.x + 7) >> 3) * NWAVES; return s; }
__device__ __forceinline__ void ph_peer_u(const Prm& p, const Ctx& C, int l, unsigned char* lds) {
    const SliceCtx S = slice_ctx(C, p, lds);
    const bf16_t* HB = (const bf16_t*)(p.ws + WS_QQ);     const unsigned short* IDX = (const unsigned short*)(p.ws + WS_VV); float* PD = (float*)(p.ws + WS_PD);
    const unsigned char* U8 = p.ws + WS_T8 + ((size_t)(l * 2 + 0) * 8 + S.x) * NEXP * 128;
    const int lane = C.lane, j = lane & 7, k = lane >> 3, jq = (lane >> 2) & 1;
    u32x4 uq[2][16]; unsigned idw[2]; u32x4 hr0[2], hr1[2];
    const int nit = (NT - S.wq + S.nwq - 1) / S.nwq;
#define PU_TOK(i) (S.wq + ((i) < nit ? (i) : nit - 1) * S.nwq)
#define PU_LOADID(s_, i) do { idw[s_] = ((const unsigned*)IDX)[(size_t)PU_TOK(i) * 64 + lane]; } while (0)
#define PU_LOADH(s_, i) do { const bf16_t* hp_ = HB + (size_t)PU_TOK(i) * DM + 128 * S.x + 16 * j; hr0[s_] = *(const u32x4*)hp_; hr1[s_] = *(const u32x4*)(hp_ + 8); } while (0)
#define PU_G1(s_, BB) uq[s_][BB] = *(const u32x4*)(U8 + (size_t)pick_id<BB>(idw[s_], jq) * 128 + 16 * j)
#define PU_GATHER(s_, h_) do { PU_G1(s_, 8 * (h_) + 0); PU_G1(s_, 8 * (h_) + 1); PU_G1(s_, 8 * (h_) + 2); PU_G1(s_, 8 * (h_) + 3); PU_G1(s_, 8 * (h_) + 4); PU_G1(s_, 8 * (h_) + 5); PU_G1(s_, 8 * (h_) + 6); PU_G1(s_, 8 * (h_) + 7); } while (0)
#define PU_MATH(s_, h_, pd_) do { _Pragma("unroll") for (int b_ = 0; b_ < 8; ++b_) { const int bb = 8 * (h_) + b_; int ai = __builtin_amdgcn_sdot4((int)uq[s_][bb].x, hq[0], 0, false); \
        ai = __builtin_amdgcn_sdot4((int)uq[s_][bb].y, hq[1], ai, false); ai = __builtin_amdgcn_sdot4((int)uq[s_][bb].z, hq[2], ai, false); ai = __builtin_amdgcn_sdot4((int)uq[s_][bb].w, hq[3], ai, false); \
        ai += dpp_i<0xB1>(ai); ai += dpp_i<0x4E>(ai); ai += dpp_i<0x141>(ai); if (b_ == j) pd_ = ai; } } while (0)
    PU_LOADID(0, 0); PU_LOADID(1, 1); PU_LOADH(0, 0); PU_LOADH(1, 1);
    PU_GATHER(0, 0); PU_GATHER(0, 1); PU_GATHER(1, 0); PU_GATHER(1, 1);
    PU_LOADID(0, 2);
#pragma unroll 1
    for (int it = 0; it < nit; it += 2) {
#pragma unroll
        for (int a = 0; a < 2; ++a) {
            const int i = it + a, bq = 1 - a;
            int hq[4]; float hsc;
            { const unsigned hw[8] = {hr0[a].x, hr0[a].y, hr0[a].z, hr0[a].w, hr1[a].x, hr1[a].y, hr1[a].z, hr1[a].w};
              float hv[16]; float am = 0.f;
#pragma unroll
              for (int q = 0; q < 8; ++q) { hv[2 * q] = __uint_as_float(hw[q] << 16); hv[2 * q + 1] = __uint_as_float(hw[q] & 0xffff0000u); am = fmaxf(am, fmaxf(fabsf(hv[2 * q]), fabsf(hv[2 * q + 1]))); }
              am = fmaxf(am, dpp_f<0xB1>(am)); am = fmaxf(am, dpp_f<0x4E>(am)); am = fmaxf(am, dpp_f<0x141>(am));
              hsc = am > 0.f ? am * (1.0f / 127.0f) : 1.0f; const float inv = am > 0.f ? 127.0f / am : 0.f;
#pragma unroll
              for (int q = 0; q < 4; ++q) { unsigned u0 = __builtin_amdgcn_cvt_pk_u8_f32(hv[4 * q] * inv + 128.0f, 0, 0u); u0 = __builtin_amdgcn_cvt_pk_u8_f32(hv[4 * q + 1] * inv + 128.0f, 1, u0);
                  u0 = __builtin_amdgcn_cvt_pk_u8_f32(hv[4 * q + 2] * inv + 128.0f, 2, u0); u0 = __builtin_amdgcn_cvt_pk_u8_f32(hv[4 * q + 3] * inv + 128.0f, 3, u0); hq[q] = (int)(u0 ^ 0x80808080u); } }
            PU_LOADH(a, i + 2); PU_LOADID(bq, i + 3);
            int pd0 = 0, pd1 = 0;
            PU_MATH(a, 0, pd0); PU_GATHER(a, 0);
            PU_MATH(a, 1, pd1); PU_GATHER(a, 1);
            if (i < nit) { float* pd = PD + ((size_t)S.x * NT + (S.wq + i * S.nwq)) * 128 + 16 * k + j; pd[0] = (float)pd0 * hsc; pd[8] = (float)pd1 * hsc; }
        }
    }
#undef PU_TOK
#undef PU_LOADID
#undef PU_LOADH
#undef PU_GATHER
#undef PU_G1
#undef PU_MATH
}
__device__ __forceinline__ void ph_peer_pre(const Prm& p, const Ctx& C, int l) {
    const float* MOD = (const float*)(p.ws + WS_MOD) + (size_t)l * NB * MODW + 3 * DM;
    const bf16_t* WQT = (const bf16_t*)(p.ws + WS_WQ) + (size_t)l * DM * DM; float* BQ = (float*)(p.ws + WS_BQ) + (size_t)l * NB * DM;
    for (int item = C.gw; item < (DM / 8) * NB; item += C.ngw) {
        const int b = item & 7, c0 = (item >> 3) * 8;
        float sh[16];
#pragma unroll
        for (int q = 0; q < 4; ++q) { const f32x4 v = *(const f32x4*)(MOD + (size_t)b * MODW + 16 * C.lane + 4 * q); sh[4 * q] = v.x; sh[4 * q + 1] = v.y; sh[4 * q + 2] = v.z; sh[4 * q + 3] = v.w; }
        float res = 0.f;
#pragma unroll
        for (int c = 0; c < 8; ++c) { const u32x4 w0 = *(const u32x4*)(WQT + (size_t)(c0 + c) * DM + 16 * C.lane), w1 = *(const u32x4*)(WQT + (size_t)(c0 + c) * DM + 16 * C.lane + 8);
            const unsigned ww[8] = {w0.x, w0.y, w0.z, w0.w, w1.x, w1.y, w1.z, w1.w}; float a = 0.f;
#pragma unroll
            for (int q = 0; q < 8; ++q) a += __uint_as_float(ww[q] << 16) * sh[2 * q] + __uint_as_float(ww[q] & 0xffff0000u) * sh[2 * q + 1];
            a = wave_sum(a); if (C.lane == c) res = a; }
        if (C.lane < 8) BQ[(size_t)b * DM + c0 + C.lane] = res;
    }
    const unsigned char* U8 = p.ws + WS_T8 + (size_t)(l * 2 + 0) * 8 * NEXP * 128; const float* SU = (const float*)(p.ws + WS_SC8) + (size_t)(l * 2) * NEXP; float* USH = (float*)(p.ws + WS_USH) + (size_t)l * NB * NEXP;
    float shb[8][16];
    const int cl = 256 * (C.lane >> 4) + 8 * (C.lane & 15);
#pragma unroll
    for (int b = 0; b < 8; ++b)
#pragma unroll
        for (int q = 0; q < 4; ++q) { const f32x4 v = *(const f32x4*)(MOD + (size_t)b * MODW + cl + 128 * (q >> 1) + 4 * (q & 1)); shb[b][4 * q] = v.x; shb[b][4 * q + 1] = v.y; shb[b][4 * q + 2] = v.z; shb[b][4 * q + 3] = v.w; }
    const int hi5 = C.lane >> 5, b4 = (C.lane >> 4) & 1;
    for (int e0 = C.gw; e0 < NEXP; e0 += 2 * C.ngw) {
        u32x2 uq[2];
#pragma unroll
        for (int r = 0; r < 2; ++r) uq[r] = *(const u32x2*)(U8 + ((size_t)(C.lane >> 4) * NEXP + min(e0 + r * C.ngw, NEXP - 1)) * 128 + 8 * (C.lane & 15));
#pragma unroll
        for (int r = 0; r < 2; ++r) { const int e = e0 + r * C.ngw; if (e >= NEXP) break;
            const unsigned w[2] = {uq[r].x, uq[r].y}; float uf[16];
#pragma unroll
            for (int q = 0; q < 8; ++q) { uf[q] = (float)(((int)(w[q >> 2] << (28 - 8 * (q & 3)))) >> 28); uf[8 + q] = (float)(((int)(w[q >> 2] << (24 - 8 * (q & 3)))) >> 28); }
            float a[8];
#pragma unroll
            for (int b = 0; b < 8; ++b) { float t = 0.f;
#pragma unroll
                for (int q = 0; q < 16; ++q) t += uf[q] * shb[b][q];
                a[b] = t; }
            float r4[4], r2[2];
#pragma unroll
            for (int q = 0; q < 4; ++q) r4[q] = xsum32(a[q], a[4 + q]);
#pragma unroll
            for (int q = 0; q < 2; ++q) r2[q] = xsum16(r4[q], r4[2 + q]);
#pragma unroll
            for (int q = 0; q < 2; ++q) { float v = r2[q]; v += dpp_f<0xB1>(v); v += dpp_f<0x4E>(v); v += dpp_f<0x141>(v); v += dpp_f<0x128>(v); r2[q] = v; }
            if ((C.lane & 15) == 0) { const float su = SU[e], sv = SU[NEXP + e]; const int b0 = 4 * hi5 + 2 * b4;
                f32x4* REC = (f32x4*)(p.ws + WS_T8 + ((size_t)(l * 2 + 0) * 8 + 4) * NEXP * 128); REC[(size_t)b0 * NEXP + e] = (f32x4){r2[0] * su, su, sv, 0.f}; REC[(size_t)(b0 + 1) * NEXP + e] = (f32x4){r2[1] * su, su, sv, 0.f}; }
        }
    }
}
__device__ __forceinline__ void ph_peer_r(const Prm& p, const Ctx& C, int l) {
    const unsigned short* IDX = (const unsigned short*)(p.ws + WS_VV); float* PW = (float*)(p.ws + WS_VV + 16 * MiB); const float* PD = (const float*)(p.ws + WS_PD);
    const float* SU = (const float*)(p.ws + WS_SC8) + (size_t)(l * 2) * NEXP; const float* SV = SU + NEXP;
    const size_t n = (size_t)NT * 128, stride = (size_t)gridDim.x * NTHREADS;
    for (size_t i = (size_t)blockIdx.x * NTHREADS + C.tid; i < n; i += stride) {
        float s = 0.f;
#pragma unroll
        for (int x = 0; x < 8; ++x) s += PD[(size_t)x * n + i];
        const size_t t = i >> 7; const float r = ((const float*)(p.ws + WS_FC))[t];
        const int id = IDX[i]; const float d = s * r * SU[id] + ((const float*)(p.ws + WS_USH))[((size_t)l * NB + t / SEQ) * NEXP + id];
        const float cf = PW[i] * (0.5f * d * (1.0f + erff(d * 0.70710678118654752f))) * SV[id];
        float cmx = fabsf(cf); cmx = fmaxf(cmx, dpp_f<0xB1>(cmx)); cmx = fmaxf(cmx, dpp_f<0x4E>(cmx)); cmx = fmaxf(cmx, dpp_f<0x141>(cmx)); cmx = fmaxf(cmx, dpp_f<0x128>(cmx));
        const float inv = cmx > 0.f ? 127.0f / cmx : 0.f;
        ((unsigned char*)(p.ws + WS_VV + 32 * MiB))[i] = (unsigned char)((__builtin_amdgcn_cvt_pk_u8_f32(cf * inv + 128.0f, 0, 0u) ^ 0x80u) & 0xffu);
        if ((C.lane & 15) == 0) ((float*)(p.ws + WS_VV + 40 * MiB))[i >> 4] = cmx * (1.0f / 127.0f);
    }
}
__device__ __forceinline__ void ph_peer_v(const Prm& p, const Ctx& C, int l, unsigned char* lds) {
    const SliceCtx S = slice_ctx(C, p, lds);
    const unsigned short* IDX = (const unsigned short*)(p.ws + WS_VV); const unsigned char* CQ = p.ws + WS_VV + 32 * MiB; const float* CSC = (const float*)(p.ws + WS_VV + 40 * MiB);
    const float* MOD = (const float*)(p.ws + WS_MOD) + (size_t)l * NB * MODW;
    const unsigned char* V8 = p.ws + WS_T8 + ((size_t)(l * 2 + 1) * 8 + S.x) * NEXP * 128;
    const int lane = C.lane, j = lane & 7, k = lane >> 3, b3 = (lane >> 3) & 1, jq = (lane >> 2) & 1;
    u32x4 vq[2][16]; unsigned idw[2]; unsigned cqw[2]; float csv[2]; f32x2 xvv[2], gvv[2];
    const int ocol = 128 * S.x + 16 * j + 2 * k;
    const int nit = (NT - S.wq + S.nwq - 1) / S.nwq;
#define PV_TOK(i) (S.wq + ((i) < nit ? (i) : nit - 1) * S.nwq)
#define PV_LOADID(s_, i) do { idw[s_] = ((const unsigned*)IDX)[(size_t)PV_TOK(i) * 64 + lane]; } while (0)
#define PV_LOADC(s_, i) do { const int t_ = PV_TOK(i); cqw[s_] = ((const unsigned*)CQ)[(size_t)t_ * 32 + 4 * k + (j & 3)]; csv[s_] = CSC[(size_t)t_ * 8 + k]; \
        xvv[s_] = *(const f32x2*)(p.out + (size_t)t_ * DM + ocol); gvv[s_] = *(const f32x2*)(MOD + (size_t)(t_ / SEQ) * MODW + 5 * DM + ocol); } while (0)
#define PV_G1(s_, BB) vq[s_][BB] = *(const u32x4*)(V8 + (size_t)pick_id<BB>(idw[s_], jq) * 128 + 16 * j)
#define PV_GATHER(s_, h_) do { PV_G1(s_, 8 * (h_) + 0); PV_G1(s_, 8 * (h_) + 1); PV_G1(s_, 8 * (h_) + 2); PV_G1(s_, 8 * (h_) + 3); PV_G1(s_, 8 * (h_) + 4); PV_G1(s_, 8 * (h_) + 5); PV_G1(s_, 8 * (h_) + 6); PV_G1(s_, 8 * (h_) + 7); } while (0)
#define PV_MATH(s_, h_) do { _Pragma("unroll") for (int g_ = 2 * (h_); g_ < 2 * (h_) + 2; ++g_) { const unsigned r0_[4] = {vq[s_][4 * g_].x, vq[s_][4 * g_].y, vq[s_][4 * g_].z, vq[s_][4 * g_].w}, r1_[4] = {vq[s_][4 * g_ + 1].x, vq[s_][4 * g_ + 1].y, vq[s_][4 * g_ + 1].z, vq[s_][4 * g_ + 1].w}, \
        r2_[4] = {vq[s_][4 * g_ + 2].x, vq[s_][4 * g_ + 2].y, vq[s_][4 * g_ + 2].z, vq[s_][4 * g_ + 2].w}, r3_[4] = {vq[s_][4 * g_ + 3].x, vq[s_][4 * g_ + 3].y, vq[s_][4 * g_ + 3].z, vq[s_][4 * g_ + 3].w}; \
        _Pragma("unroll") for (int w = 0; w < 4; ++w) { const unsigned p01l = __builtin_amdgcn_perm(r1_[w], r0_[w], 0x05010400u), p01h = __builtin_amdgcn_perm(r1_[w], r0_[w], 0x07030602u), p23l = __builtin_amdgcn_perm(r3_[w], r2_[w], 0x05010400u), p23h = __builtin_amdgcn_perm(r3_[w], r2_[w], 0x07030602u); \
            yi[4 * w + 0] = __builtin_amdgcn_sdot4((int)__builtin_amdgcn_perm(p23l, p01l, 0x05040100u), cq[g_], yi[4 * w + 0], false); yi[4 * w + 1] = __builtin_amdgcn_sdot4((int)__builtin_amdgcn_perm(p23l, p01l, 0x07060302u), cq[g_], yi[4 * w + 1], false); \
            yi[4 * w + 2] = __builtin_amdgcn_sdot4((int)__builtin_amdgcn_perm(p23h, p01h, 0x05040100u), cq[g_], yi[4 * w + 2], false); yi[4 * w + 3] = __builtin_amdgcn_sdot4((int)__builtin_amdgcn_perm(p23h, p01h, 0x07060302u), cq[g_], yi[4 * w + 3], false); } } } while (0)
    PV_LOADID(0, 0); PV_LOADID(1, 1); PV_LOADC(0, 0); PV_LOADC(1, 1);
    PV_GATHER(0, 0); PV_GATHER(0, 1); PV_GATHER(1, 0); PV_GATHER(1, 1);
    PV_LOADID(0, 2);
#pragma unroll 1
    for (int it = 0; it < nit; it += 2) {
#pragma unroll
        for (int a = 0; a < 2; ++a) {
            const int i = it + a, bq = 1 - a;
            const int cq[4] = {bcast4<0>(cqw[a]), bcast4<1>(cqw[a]), bcast4<2>(cqw[a]), bcast4<3>(cqw[a])}; const float cback = csv[a]; const f32x2 xv = xvv[a], gv = gvv[a];
            PV_LOADC(a, i + 2); PV_LOADID(bq, i + 3);
            int yi[16];
#pragma unroll
            for (int q = 0; q < 16; ++q) yi[q] = 0;
            PV_MATH(a, 0); PV_GATHER(a, 0);
            PV_MATH(a, 1); PV_GATHER(a, 1);
            f32x2 y[8];
#pragma unroll
            for (int q = 0; q < 8; ++q) y[q] = (f32x2){(float)yi[2 * q] * cback, (float)yi[2 * q + 1] * cback};
            f32x2 r4[4], r2[2], r1;
#pragma unroll
            for (int q = 0; q < 4; ++q) r4[q] = (f32x2){xsum32(y[q].x, y[4 + q].x), xsum32(y[q].y, y[4 + q].y)};
#pragma unroll
            for (int q = 0; q < 2; ++q) r2[q] = (f32x2){xsum16(r4[q].x, r4[2 + q].x), xsum16(r4[q].y, r4[2 + q].y)};
            { const f32x2 snd = b3 ? r2[0] : r2[1], kp = b3 ? r2[1] : r2[0]; r1 = (f32x2){kp.x + dpp_f<0x128>(snd.x), kp.y + dpp_f<0x128>(snd.y)}; }
            if (i < nit) {
                const int t = S.wq + i * S.nwq;
                *(f32x2*)(p.out + (size_t)t * DM + ocol) = xv + gv * r1;
            }
        }
    }
#undef PV_TOK
#undef PV_LOADID
#undef PV_LOADC
#undef PV_GATHER
#undef PV_G1
#undef PV_MATH
}

template <int MODE = 0> __device__ __forceinline__ void ph_peer_u4(const Prm& p, const Ctx& C, int l, unsigned char* lds) {
    SliceCtx S; S.x = blockIdx.x & 3; S.wq = (blockIdx.x >> 2) * NWAVES + C.wave; S.nwq = (((int)gridDim.x - S.x + 3) >> 2) * NWAVES;
    const bf16_t* HB = (const bf16_t*)(p.ws + WS_QQ); float* PD = (float*)(p.ws + WS_PD);
    const unsigned short* IDX = (const unsigned short*)(p.ws + WS_VV);
    const unsigned char* U8 = p.ws + WS_T8 + ((size_t)(l * 2 + 0) * 8 + S.x) * NEXP * 128;
    const int lane = C.lane, j = lane & 7, k = lane >> 3, jq = (lane >> 2) & 1;
    u32x4 uq[2][16]; unsigned idw[2]; u32x2 hr[2];
    LAS unsigned* il = (LAS unsigned*)((LAS unsigned char*)lds + 131072 + C.wave * 256);
    unsigned idr[8];
    LAS unsigned* hl = (LAS unsigned*)((LAS unsigned char*)lds + C.wave * 256);
    const int nit = (NT - S.wq + S.nwq - 1) / S.nwq;
#define PU_TOK(i) (S.wq + ((i) < nit ? (i) : nit - 1) * S.nwq)
#define PU_LOADID(s_, i) do { idw[s_] = ((const unsigned*)IDX)[(size_t)PU_TOK(i) * 64 + lane]; } while (0)
#define PU_LOADH(s_, i) do { hr[s_] = *(const u32x2*)(HB + (size_t)PU_TOK(i) * DM + 256 * S.x + 4 * lane); } while (0)
#define PU_IDS(s_) do { il[lane] = idw[s_]; const u32x4 i0_ = *(LAS u32x4*)(il + 8 * k), i1_ = *(LAS u32x4*)(il + 8 * k + 4); idr[0] = i0_.x; idr[1] = i0_.y; idr[2] = i0_.z; idr[3] = i0_.w; idr[4] = i1_.x; idr[5] = i1_.y; idr[6] = i1_.z; idr[7] = i1_.w; } while (0)
#define PU_G1(s_, BB) uq[s_][BB] = *(const u32x4*)(U8 + (size_t)((((BB) & 1) ? (idr[(BB) >> 1] >> 16) : (idr[(BB) >> 1] & 0xffffu)) * 128u + 16u * (unsigned)j))
#define PU_GATHER(s_, h_) do { PU_G1(s_, 8 * (h_) + 0); PU_G1(s_, 8 * (h_) + 1); PU_G1(s_, 8 * (h_) + 2); PU_G1(s_, 8 * (h_) + 3); PU_G1(s_, 8 * (h_) + 4); PU_G1(s_, 8 * (h_) + 5); PU_G1(s_, 8 * (h_) + 6); PU_G1(s_, 8 * (h_) + 7); } while (0)
#define PU_MATH(s_, h_, pd_) do { _Pragma("unroll") for (int b_ = 0; b_ < 8; ++b_) { const int bb = 8 * (h_) + b_; const unsigned x_[4] = {uq[s_][bb].x, uq[s_][bb].y, uq[s_][bb].z, uq[s_][bb].w}; int a0_ = 0, a1_ = 0; \
        _Pragma("unroll") for (int w_ = 0; w_ < 4; ++w_) { a0_ = __builtin_amdgcn_sdot8((int)x_[w_], hp0[w_], a0_, false); a1_ = __builtin_amdgcn_sdot8((int)x_[w_], hp1[w_], a1_, false); } \
        pd_[bb] = a1_ * 16 + a0_; } } while (0)
    PU_LOADID(0, 0); PU_LOADID(1, 1); PU_LOADH(0, 0); PU_LOADH(1, 1);
    PU_IDS(0); PU_GATHER(0, 0); PU_GATHER(0, 1); PU_IDS(1); PU_GATHER(1, 0); PU_GATHER(1, 1);
    PU_LOADID(0, 2);
    __builtin_amdgcn_s_waitcnt(0x0F70);
#pragma unroll 1
    for (int it = 0; it < nit; it += 2) {
#pragma unroll
        for (int a = 0; a < 2; ++a) {
            const int i = it + a, bq = 1 - a;
            int hp0[4], hp1[4]; float hsc;
            { const float h0_ = __uint_as_float(hr[a].x << 16), h1_ = __uint_as_float(hr[a].x & 0xffff0000u), h2_ = __uint_as_float(hr[a].y << 16), h3_ = __uint_as_float(hr[a].y & 0xffff0000u);
              float am = fmaxf(fmaxf(fabsf(h0_), fabsf(h1_)), fmaxf(fabsf(h2_), fabsf(h3_)));
              am = fmaxf(am, dpp_f<0xB1>(am)); am = fmaxf(am, dpp_f<0x4E>(am)); am = fmaxf(am, dpp_f<0x141>(am)); am = fmaxf(am, dpp_f<0x140>(am)); am = fmaxf(am, __shfl_xor(am, 16)); am = fmaxf(am, __shfl_xor(am, 32));
              hsc = am > 0.f ? am * (1.0f / 119.0f) : 1.0f; const float inv = am > 0.f ? 119.0f / am : 0.f;
              unsigned u0 = __builtin_amdgcn_cvt_pk_u8_f32(h0_ * inv + 136.0f, 0, 0u); u0 = __builtin_amdgcn_cvt_pk_u8_f32(h1_ * inv + 136.0f, 1, u0); u0 = __builtin_amdgcn_cvt_pk_u8_f32(h2_ * inv + 136.0f, 2, u0); u0 = __builtin_amdgcn_cvt_pk_u8_f32(h3_ * inv + 136.0f, 3, u0);
              hl[lane] = u0;
              const u32x4 lo4 = *(LAS u32x4*)(hl + 4 * j), hi4 = *(LAS u32x4*)(hl + 32 + 4 * j);
              const unsigned L8_[4] = {lo4.x, lo4.y, lo4.z, lo4.w}, H8_[4] = {hi4.x, hi4.y, hi4.z, hi4.w};
#pragma unroll
              for (int w = 0; w < 4; ++w) { const unsigned L8 = L8_[w], H8 = H8_[w];
                  hp0[w] = (int)(((L8 & 0x0f0f0f0fu) | ((H8 & 0x0f0f0f0fu) << 4)) ^ 0x88888888u);
                  hp1[w] = (int)((((L8 >> 4) & 0x0f0f0f0fu) | (H8 & 0xf0f0f0f0u)) ^ 0x88888888u); } }
            PU_LOADH(a, i + 2); PU_LOADID(bq, i + 3);
            int v16[16];
            PU_IDS(a); PU_MATH(a, 0, v16); PU_GATHER(a, 0);
            PU_MATH(a, 1, v16); PU_GATHER(a, 1);
            int v8[8], v4[4], v2[2];
#pragma unroll
            for (int m = 0; m < 8; ++m) { const int kp = (j & 4) ? v16[8 + m] : v16[m], sd = (j & 4) ? v16[m] : v16[8 + m]; v8[m] = kp + dpp_i<0x141>(sd); }
#pragma unroll
            for (int m = 0; m < 4; ++m) { const int kp = (j & 2) ? v8[4 + m] : v8[m], sd = (j & 2) ? v8[m] : v8[4 + m]; v4[m] = kp + dpp_i<0x4E>(sd); }
#pragma unroll
            for (int m = 0; m < 2; ++m) { const int kp = (j & 1) ? v4[2 + m] : v4[m], sd = (j & 1) ? v4[m] : v4[2 + m]; v2[m] = kp + dpp_i<0xB1>(sd); }
            if (i < nit) { float* pd = (MODE == 1 ? (float*)(p.ws + WS_HB) : PD) + ((size_t)S.x * NT + (S.wq + i * S.nwq)) * 128 + 2 * lane; *(f32x2*)pd = (f32x2){(float)v2[0] * hsc, (float)v2[1] * hsc}; }
        }
    }
#undef PU_TOK
#undef PU_LOADID
#undef PU_LOADH
#undef PU_GATHER
#undef PU_G1
#undef PU_MATH
}

__device__ __forceinline__ void ph_peer_r2(const Prm& p, const Ctx& C, int l, unsigned char* lds) {
    const unsigned* IDX = (const unsigned*)(p.ws + WS_VV); const f32x2* PW = (const f32x2*)(p.ws + WS_VV + 16 * MiB); const f32x2* PD = (const f32x2*)(p.ws + WS_PD);
    unsigned char* CQ2 = p.ws + WS_VV + 32 * MiB; float* CSC = (float*)(p.ws + WS_VV + 40 * MiB);
    const float* SU = (const float*)(p.ws + WS_SC8) + (size_t)(l * 2) * NEXP; const float* SV = SU + NEXP;
    const size_t n2 = (size_t)NT * 64; const int lane = C.lane;
    const int bidx = 64 * (lane & 1) + 8 * ((lane >> 1) & 3) + (lane >> 3);
    LAS unsigned char* wl = (LAS unsigned char*)lds + C.wave * 256;
    for (int t = C.gw; t < NT; t += C.ngw) {
        f32x2 pd0 = PD[(size_t)t * 64 + lane], pd1 = PD[n2 + (size_t)t * 64 + lane], pd2 = PD[2 * n2 + (size_t)t * 64 + lane], pd3 = PD[3 * n2 + (size_t)t * 64 + lane];
        float r = ((const float*)(p.ws + WS_FC))[t];
        unsigned idw = IDX[(size_t)t * 64 + lane];
        f32x2 pw = PW[(size_t)t * 64 + lane];
        asm volatile("" : "+v"(pd0), "+v"(pd1), "+v"(pd2), "+v"(pd3), "+v"(r), "+v"(idw), "+v"(pw));
        const f32x2 sa = (pd0 + pd1) + (pd2 + pd3);
        const int id0 = (int)(idw & 0xffffu), id1 = (int)(idw >> 16);
        const f32x4* REC = (const f32x4*)(p.ws + WS_T8 + ((size_t)(l * 2 + 0) * 8 + 4) * NEXP * 128) + (size_t)(t / SEQ) * NEXP;
        f32x4 rc0 = REC[id0], rc1 = REC[id1];
        asm volatile("" : "+v"(rc0), "+v"(rc1));
        const float us0 = rc0.x, su0 = rc0.y, sv0 = rc0.z, us1 = rc1.x, su1 = rc1.y, sv1 = rc1.z;
        const float d0 = sa.x * r * su0 + us0, d1 = sa.y * r * su1 + us1;
        const float cf0 = pw.x * (0.5f * d0 * (1.0f + erff(d0 * 0.70710678118654752f))) * sv0;
        const float cf1 = pw.y * (0.5f * d1 * (1.0f + erff(d1 * 0.70710678118654752f))) * sv1;
        float cmx = fmaxf(fabsf(cf0), fabsf(cf1));
        cmx = fmaxf(cmx, dpp_f<0xB1>(cmx)); cmx = fmaxf(cmx, dpp_f<0x4E>(cmx)); cmx = fmaxf(cmx, dpp_f<0x141>(cmx)); cmx = fmaxf(cmx, dpp_f<0x140>(cmx));
        cmx = fmaxf(cmx, __shfl_xor(cmx, 16)); cmx = fmaxf(cmx, __shfl_xor(cmx, 32));
        const float inv = cmx > 0.f ? 16383.0f / cmx : 0.f;
        const int q0 = (int)rintf(cf0 * inv), q1 = (int)rintf(cf1 * inv);
        wl[bidx] = (unsigned char)(q0 >> 7); wl[bidx + 128] = (unsigned char)(q0 & 127); wl[bidx + 32] = (unsigned char)(q1 >> 7); wl[bidx + 160] = (unsigned char)(q1 & 127);
        int qs = q0 + q1;
        qs += dpp_i<0xB1>(qs); qs += dpp_i<0x4E>(qs); qs += dpp_i<0x141>(qs); qs += dpp_i<0x140>(qs); qs += __shfl_xor(qs, 16); qs += __shfl_xor(qs, 32);
        ((unsigned*)(CQ2 + (size_t)t * 256))[lane] = ((LAS unsigned*)wl)[lane];
        if (lane == 0) { const float sc = cmx * (1.0f / 16383.0f); *(f32x2*)(CSC + 2 * (size_t)t) = (f32x2){sc, 8.0f * sc * (float)qs}; }
    }
}
__device__ __forceinline__ void ph_peer_v2(const Prm& p, const Ctx& C, int l, unsigned char* lds) {
    SliceCtx S; S.x = blockIdx.x & 3; S.wq = (blockIdx.x >> 2) * NWAVES + C.wave; S.nwq = (((int)gridDim.x - S.x + 3) >> 2) * NWAVES;
    const unsigned short* IDX = (const unsigned short*)(p.ws + WS_VV); const unsigned char* CQ2 = p.ws + WS_VV + 32 * MiB; const f32x2* CSC = (const f32x2*)(p.ws + WS_VV + 40 * MiB);
    const float* MOD = (const float*)(p.ws + WS_MOD) + (size_t)l * NB * MODW;
    const unsigned char* V8 = p.ws + WS_T8 + ((size_t)(l * 2 + 1) * 8 + S.x) * NEXP * 128;
    const int lane = C.lane, j = lane & 7, k = lane >> 3, jq = (lane >> 2) & 1, n16 = lane & 15, q4 = lane >> 4;
    LAS unsigned* il = (LAS unsigned*)((LAS unsigned char*)lds + 131072 + C.wave * 256); unsigned idr[8];
    LAS unsigned char* wl = (LAS unsigned char*)lds + C.wave * 16384;
    const int wb_e = 128 * k + 32 * ((j >> 1) ^ ((k >> 1) & 1)) + 16 * (j & 1), wb_o = 128 * k + 32 * ((j >> 1) ^ ((k >> 1) & 1) ^ 2) + 16 * (j & 1);
    const int rr = (lane >> 2) & 3, pp = lane & 3, fr = ((rr >> 1) & 1) | ((q4 & 1) << 1);
    int rb[4];
#pragma unroll
    for (int nt = 0; nt < 4; ++nt) rb[nt] = 128 * (8 * q4 + rr) + 32 * (nt ^ fr) + 8 * pp;
    const unsigned selA0 = (lane & 1) ? 0x010c000cu : 0x0c010c00u, selB0 = (lane & 1) ? 0x030c020cu : 0x0c030c02u;
    const unsigned selAL = (lane & 4) ? 0x0c0c0c0cu : selA0, selBL = (lane & 4) ? 0x0c0c0c0cu : selB0, selAH = (lane & 4) ? selA0 : 0x0c0c0c0cu, selBH = (lane & 4) ? selB0 : 0x0c0c0c0cu;
    const int cqo = 128 * ((lane >> 1) & 1) + 32 * q4;
    const int ocol = 256 * S.x + 128 * (q4 & 1) + 64 * (q4 >> 1) + 2 * n16;
    u32x4 vq[2][16]; unsigned idw[2]; u32x4 cqa[2][2]; f32x2 csv[2]; f32x2 xvv[2][2], gvv[2][2];
    const int nit = (NT - S.wq + S.nwq - 1) / S.nwq;
#define PV_TOK(i) (S.wq + ((i) < nit ? (i) : nit - 1) * S.nwq)
#define PV_LOADID(s_, i) do { idw[s_] = ((const unsigned*)IDX)[(size_t)PV_TOK(i) * 64 + lane]; } while (0)
#define PV_LOADC(s_, i) do { const int t_ = PV_TOK(i); const unsigned char* cp_ = CQ2 + (size_t)t_ * 256 + cqo; cqa[s_][0] = *(const u32x4*)cp_; cqa[s_][1] = *(const u32x4*)(cp_ + 16); csv[s_] = CSC[t_]; \
        xvv[s_][0] = *(const f32x2*)(p.out + (size_t)t_ * DM + ocol); xvv[s_][1] = *(const f32x2*)(p.out + (size_t)t_ * DM + ocol + 32); gvv[s_][0] = *(const f32x2*)(MOD + (size_t)(t_ / SEQ) * MODW + 5 * DM + ocol); gvv[s_][1] = *(const f32x2*)(MOD + (size_t)(t_ / SEQ) * MODW + 5 * DM + ocol + 32); } while (0)
#define PV_IDS(s_) do { il[lane] = idw[s_]; const u32x4 i0_ = *(LAS u32x4*)(il + 8 * k), i1_ = *(LAS u32x4*)(il + 8 * k + 4); idr[0] = i0_.x; idr[1] = i0_.y; idr[2] = i0_.z; idr[3] = i0_.w; idr[4] = i1_.x; idr[5] = i1_.y; idr[6] = i1_.z; idr[7] = i1_.w; } while (0)
#define PV_G1(s_, BB) vq[s_][BB] = *(const u32x4*)(V8 + (size_t)((((BB) & 1) ? (idr[(BB) >> 1] >> 16) : (idr[(BB) >> 1] & 0xffffu)) * 128u + 16u * (unsigned)j))
#define PV_GATHER(s_, h_) do { PV_G1(s_, 8 * (h_) + 0); PV_G1(s_, 8 * (h_) + 1); PV_G1(s_, 8 * (h_) + 2); PV_G1(s_, 8 * (h_) + 3); PV_G1(s_, 8 * (h_) + 4); PV_G1(s_, 8 * (h_) + 5); PV_G1(s_, 8 * (h_) + 6); PV_G1(s_, 8 * (h_) + 7); } while (0)
#define PV_W1(s_, h_, B_) *(LAS u32x4*)(wl + 8192 * (h_) + 1024 * (B_) + (((B_) & 1) ? wb_o : wb_e)) = vq[s_][8 * (h_) + (B_)]
#define PV_WRITE(s_, h_) do { PV_W1(s_, h_, 0); PV_W1(s_, h_, 1); PV_W1(s_, h_, 2); PV_W1(s_, h_, 3); PV_W1(s_, h_, 4); PV_W1(s_, h_, 5); PV_W1(s_, h_, 6); PV_W1(s_, h_, 7); } while (0)
#define PV_TR(h_, ksl_, nt_, rd_) __builtin_amdgcn_ds_read_tr16_b64_v4i16((LAS s16x4*)(wl + 8192 * (h_) + 4096 * (ksl_) + 512 * (rd_) + rb[nt_]))
#define PV_MMA(h_) do { _Pragma("unroll") for (int ksl_ = 0; ksl_ < 2; ++ksl_) { const int ks_ = 2 * (h_) + ksl_; const unsigned w0_ = cw[2 * ks_], w1_ = cw[2 * ks_ + 1]; \
        const i32x4 AL_ = {(int)__builtin_amdgcn_perm(w0_, w0_, selAL), (int)__builtin_amdgcn_perm(w0_, w0_, selBL), (int)__builtin_amdgcn_perm(w1_, w1_, selAL), (int)__builtin_amdgcn_perm(w1_, w1_, selBL)}; \
        const i32x4 AH_ = {(int)__builtin_amdgcn_perm(w0_, w0_, selAH), (int)__builtin_amdgcn_perm(w0_, w0_, selBH), (int)__builtin_amdgcn_perm(w1_, w1_, selAH), (int)__builtin_amdgcn_perm(w1_, w1_, selBH)}; \
        _Pragma("unroll") for (int nt_ = 0; nt_ < 4; ++nt_) { const s16x4 b0_ = PV_TR(h_, ksl_, nt_, 0), b1_ = PV_TR(h_, ksl_, nt_, 1); const i32x2 c0_ = __builtin_bit_cast(i32x2, b0_), c1_ = __builtin_bit_cast(i32x2, b1_); \
            const i32x4 BL_ = {c0_.x & 0x0f0f0f0f, c0_.y & 0x0f0f0f0f, c1_.x & 0x0f0f0f0f, c1_.y & 0x0f0f0f0f}, BH_ = {c0_.x, c0_.y, c1_.x, c1_.y};     \
            acc[nt_] = __builtin_amdgcn_mfma_i32_16x16x64_i8(AL_, BL_, acc[nt_], 0, 0, 0); acc[nt_] = __builtin_amdgcn_mfma_i32_16x16x64_i8(AH_, BH_, acc[nt_], 0, 0, 0); } } } while (0)
    PV_LOADID(0, 0); PV_LOADID(1, 1); PV_LOADC(0, 0);
    PV_IDS(0); PV_GATHER(0, 0); PV_GATHER(0, 1); PV_IDS(1); PV_GATHER(1, 0); PV_GATHER(1, 1);
    PV_LOADID(0, 2);
    __builtin_amdgcn_s_waitcnt(0x0F70);
#pragma unroll 1
    for (int it = 0; it < nit; it += 2) {
#pragma unroll
        for (int a = 0; a < 2; ++a) {
            const int i = it + a, bq = 1 - a;
            const unsigned cw[8] = {cqa[a][0].x, cqa[a][0].y, cqa[a][0].z, cqa[a][0].w, cqa[a][1].x, cqa[a][1].y, cqa[a][1].z, cqa[a][1].w}; const f32x2 cback = csv[a]; const f32x2 xv0 = xvv[a][0], xv1 = xvv[a][1], gv0 = gvv[a][0], gv1 = gvv[a][1];
            PV_LOADC(bq, i + 1); PV_LOADID(bq, i + 3);
            i32x4 acc[4];
#pragma unroll
            for (int nt = 0; nt < 4; ++nt) acc[nt] = (i32x4){0, 0, 0, 0};
            PV_IDS(a); PV_WRITE(a, 0); PV_GATHER(a, 0); PV_MMA(0);
            PV_WRITE(a, 1); PV_GATHER(a, 1); PV_MMA(1);
            const i32x4 a0 = (q4 >> 1) ? acc[2] : acc[0], a1 = (q4 >> 1) ? acc[3] : acc[1];
            const float mf = (q4 & 1) ? cback.x * 0.0625f : cback.x, sb = (q4 & 1) ? 0.f : cback.y;
            int v00 = a0.x * 128 + a0.z, v01 = a0.y * 128 + a0.w, v10 = a1.x * 128 + a1.z, v11 = a1.y * 128 + a1.w;
            { const int p00 = __shfl_xor(v00, 16), p01 = __shfl_xor(v01, 16), p10 = __shfl_xor(v10, 16), p11 = __shfl_xor(v11, 16);
              if (q4 & 1) { v00 -= p00; v01 -= p01; v10 -= p10; v11 -= p11; } }
            const f32x2 y0 = {(float)v00 * mf - sb, (float)v01 * mf - sb}, y1 = {(float)v10 * mf - sb, (float)v11 * mf - sb};
            if (i < nit) {
                const int t = S.wq + i * S.nwq;
                *(f32x2*)(p.out + (size_t)t * DM + ocol) = xv0 + gv0 * y0; *(f32x2*)(p.out + (size_t)t * DM + ocol + 32) = xv1 + gv1 * y1;
            }
        }
    }
#undef PV_TOK
#undef PV_LOADID
#undef PV_LOADC
#undef PV_GATHER
#undef PV_G1
#undef PV_W1
#undef PV_WRITE
#undef PV_TR
#undef PV_MMA
}

constexpr int PH_PER_LAYER = 11, NPH = 1 + 2 * PH_PER_LAYER;

__global__ void __launch_bounds__(NTHREADS, 2) mega(Prm p0) {
    extern __shared__ __attribute__((aligned(16))) unsigned char lds[];
    const int ph_lo = p0.ph_lo, ph_hi = p0.ph_hi;
    volatile LAS unsigned* bst = (volatile LAS unsigned*)((LAS unsigned char*)lds + (LDS_BYTES - 64));
    if (threadIdx.x < 16) bst[threadIdx.x] = 0u;
    __syncthreads();
    XcdBarrier bar = xcd_barrier_post((unsigned*)(p0.ws + WS_CTL), bst);
#define PHASE_BEGIN(k) if (ph_lo <= (k) && (k) < ph_hi) { Prm p = p0; Ctx C; \
        { size_t z_ = 0; asm volatile("" : "+s"(z_));     \
          p.x = (const float*)((const char*)p0.x + z_); p.c = (const float*)((const char*)p0.c + z_); p.ada_w = (const float*)((const char*)p0.ada_w + z_); p.ada_b = (const float*)((const char*)p0.ada_b + z_); \
          p.attn_norm = (const float*)((const char*)p0.attn_norm + z_); p.ffn_norm = (const float*)((const char*)p0.ffn_norm + z_); p.w_in = (const float*)((const char*)p0.w_in + z_); p.fox_bf = (const float*)((const char*)p0.fox_bf + z_); \
          p.gq = (const float*)((const char*)p0.gq + z_); p.gk = (const float*)((const char*)p0.gk + z_); p.w_branch = (const float*)((const char*)p0.w_branch + z_); p.w_out = (const float*)((const char*)p0.w_out + z_); \
          p.wq = (const float*)((const char*)p0.wq + z_); p.k1 = (const float*)((const char*)p0.k1 + z_); p.k2 = (const float*)((const char*)p0.k2 + z_); p.pu = (const float*)((const char*)p0.pu + z_); p.pv = (const float*)((const char*)p0.pv + z_); \
          p.out = (float*)((char*)p0.out + z_); p.ws = p0.ws + z_; } \
        C.tid = threadIdx.x; asm volatile("" : "+v"(C.tid)); C.lane = C.tid & 63; C.wave = __builtin_amdgcn_readfirstlane(C.tid >> 6); \
        C.gw = blockIdx.x * NWAVES + C.wave; C.ngw = gridDim.x * NWAVES;
#define PHASE_END(k) if ((k) + 1 < ph_hi) { xcd_barrier(bar); } }
    PHASE_BEGIN(0) ph_mod(p, C); ph_weights(p, C, lds); ph_convert_tables8s(p, C); PHASE_END(0)
#pragma unroll 1
    for (int l = 0; l < 2; ++l) {
        const int k0 = 1 + l * PH_PER_LAYER;
        PHASE_BEGIN(k0 + 0) ph_norm<true>(p, C, l, l == 0 ? p.x : p.out, p.attn_norm + l * DM, 0, 1, lds); ph_peer_pre(p, C, l); PHASE_END(k0 + 0)
        PHASE_BEGIN(k0 + 1) ph_gemm1(p, l, lds); PHASE_END(k0 + 1)
        PHASE_BEGIN(k0 + 2) ph_attn<3>(p, C, l, lds); PHASE_END(k0 + 2)
        PHASE_BEGIN(k0 + 3) ph_merge(p, l, lds); PHASE_END(k0 + 3)
        PHASE_BEGIN(k0 + 4) ph_out(p, l, l == 0 ? p.x : p.out, lds); PHASE_END(k0 + 4)
        PHASE_BEGIN(k0 + 6) ph_q(p, l, lds); PHASE_END(k0 + 6)
        PHASE_BEGIN(k0 + 7) ph_topk(p, C, l, lds); PHASE_END(k0 + 7)
        PHASE_BEGIN(k0 + 8) ph_peer_u4(p, C, l, lds); PHASE_END(k0 + 8)
        PHASE_BEGIN(k0 + 9) ph_peer_r2(p, C, l, lds); PHASE_END(k0 + 9)
        PHASE_BEGIN(k0 + 10) ph_peer_v2(p, C, l, lds); PHASE_END(k0 + 10)
    }
}

extern "C" void kernel_launch(void* const* d_in, const int* in_sizes, int n_in, void* d_out, int out_size, void* d_ws, size_t ws_size, hipStream_t stream) {
    static int grid = 0;
    if (grid == 0) {
        if (n_in != 17 || out_size != NT * DM || ws_size < WS_END) { fprintf(stderr, "kernel_launch: unexpected shapes (n_in %d out %d ws %zu)\n", n_in, out_size, ws_size); grid = -1; return; }
        int dev = 0, cus = 0, per_cu = 0;
        hipGetDevice(&dev); hipDeviceGetAttribute(&cus, hipDeviceAttributeMultiprocessorCount, dev);
        hipFuncSetAttribute((const void*)mega, hipFuncAttributeMaxDynamicSharedMemorySize, LDS_BYTES);
        hipOccupancyMaxActiveBlocksPerMultiprocessor(&per_cu, (const void*)mega, NTHREADS, LDS_BYTES);
        if (per_cu < 1) { fprintf(stderr, "kernel_launch: occupancy query says %d blocks per CU\n", per_cu); per_cu = 1; }
        (void)hipGetLastError();
        grid = cus;
    }
    if (grid < 0) return;
    if (hipMemsetAsync((char*)d_ws + WS_CTL, 0, 32768, stream) != hipSuccess) { fprintf(stderr, "kernel_launch: memset of the barrier words failed\n"); return; }
    Prm p{};
    const float** pp = (const float**)&p;
    for (int i = 0; i < 17; ++i) pp[i] = (const float*)d_in[i];
    p.out = (float*)d_out; p.ws = (unsigned char*)d_ws;
#if MK_MULTI
    for (int ph = 0; ph < NPH; ++ph) { p.ph_lo = ph; p.ph_hi = ph + 1; hipLaunchKernelGGL(mega, dim3(grid), dim3(NTHREADS), LDS_BYTES, stream, p); }
#else
    p.ph_lo = 0; p.ph_hi = NPH;
    void* args[] = {&p};
    hipError_t e = hipLaunchCooperativeKernel((const void*)mega, dim3(grid), dim3(NTHREADS), args, LDS_BYTES, stream);
    if (e != hipSuccess) fprintf(stderr, "cooperative launch failed: %s (grid %d)\n", hipGetErrorString(e), grid);
#endif
}
```

```cpp
#include <hip/hip_runtime.h>
#include <hip/hip_cooperative_groups.h>
#include <hip/hip_bf16.h>
#include <cstdio>
#include <cstdint>
namespace cg = cooperative_groups;

#ifndef MK_MULTI
#define MK_MULTI 0
#endif

constexpr int NB = 8, SEQ = 4096, DM = 1024, NT = NB * SEQ, NH = 8, HD = 64, INW = 5128, NEXP = 16384, NKEYS = 128, TOPK = 16;
constexpr int MODW = 6 * DM;
constexpr float EPS = 1e-6f;
constexpr float LOG2E = 1.4426950408889634f, LN2 = 0.6931471805599453f;
constexpr float C2 = 0.125f * LOG2E;
constexpr int NWAVES = 8, NTHREADS = 512;
constexpr int LDS_BYTES = 147456;

constexpr size_t MiB = 1u << 20;
constexpr size_t WS_CTL = 0;
constexpr size_t WS_MOD = 1 * MiB;
constexpr size_t WS_FA = 2 * MiB;
constexpr size_t WS_FC = 3 * MiB;
constexpr size_t WS_WIN = 4 * MiB;
constexpr size_t WS_WBR = 24 * MiB;
constexpr size_t WS_WOUT = 28 * MiB;
constexpr size_t WS_WQ = 32 * MiB;
constexpr size_t WS_K12 = 36 * MiB;
constexpr size_t WS_UB = 37 * MiB;
constexpr size_t WS_VB = 69 * MiB;
constexpr size_t WS_HB = 101 * MiB;
constexpr size_t WS_QQ = 165 * MiB;
constexpr size_t WS_KK = 229 * MiB;
constexpr size_t WS_VV = 293 * MiB;
constexpr size_t WS_GT = 357 * MiB;
constexpr size_t WS_SSQ = 485 * MiB;
constexpr size_t WS_BQ = 487 * MiB;
constexpr size_t WS_USH = 488 * MiB;
constexpr size_t WS_END = 490 * MiB;
constexpr size_t WS_XR1 = WS_GT + 64 * MiB;

typedef unsigned short bf16_t;
typedef float f32x4 __attribute__((ext_vector_type(4)));
typedef unsigned u32x4 __attribute__((ext_vector_type(4))); typedef unsigned u32x2 __attribute__((ext_vector_type(2)));

struct Prm {
    const float *x, *c, *ada_w, *ada_b, *attn_norm, *ffn_norm, *w_in, *fox_bf, *gq, *gk, *w_branch, *w_out, *wq, *k1, *k2, *pu, *pv;
    float* out; unsigned char* ws; int ph_lo, ph_hi;
};

__device__ __forceinline__ float bf2f(bf16_t v) { return __uint_as_float((unsigned)v << 16); }
__device__ __forceinline__ unsigned f2bf(float f) { unsigned u = __float_as_uint(f); return (u + 0x7fffu + ((u >> 16) & 1u)) >> 16; }
__device__ __forceinline__ unsigned pk2(float lo, float hi) { return f2bf(lo) | (f2bf(hi) << 16); }
__device__ __forceinline__ float wave_sum(float v) {
#pragma unroll
    for (int o = 1; o < 64; o <<= 1) v += __shfl_xor(v, o);
    return v;
}
__device__ __forceinline__ float sigmoidf_(float a) { return 1.0f / (1.0f + __expf(-a)); }
__device__ __forceinline__ float log_sigmoidf_(float a) { return fminf(a, 0.f) - log1pf(expf(-fabsf(a))); }
__device__ __forceinline__ float softplus2(float z2) { return fmaxf(z2, 0.f) + __log2f(1.0f + exp2f(-fabsf(z2))); }

struct Ctx { int tid, lane, wave, gw, ngw; };

__device__ __forceinline__ void ph_mod(const Prm& p, const Ctx& C) {
    float* MOD = (float*)(p.ws + WS_MOD);
    for (int item = C.gw; item < 2 * (MODW / 8); item += C.ngw) {
        const int l = item / (MODW / 8), cb = (item % (MODW / 8)) * 8;
        float acc[8][8];
#pragma unroll
        for (int b = 0; b < 8; ++b)
#pragma unroll
            for (int j = 0; j < 8; ++j) acc[b][j] = 0.f;
        for (int i = 0; i < 16; ++i) {
            const int k = C.lane + 64 * i;
            const float* wp = p.ada_w + ((size_t)l * DM + k) * MODW + cb;
            const f32x4 w0 = *(const f32x4*)wp, w1 = *(const f32x4*)(wp + 4);
            const float w[8] = {w0.x, w0.y, w0.z, w0.w, w1.x, w1.y, w1.z, w1.w};
#pragma unroll
            for (int b = 0; b < 8; ++b) {
                const float cv = p.c[b * DM + k]; const float sv = cv * sigmoidf_(cv);
#pragma unroll
                for (int j = 0; j < 8; ++j) acc[b][j] += sv * w[j];
            }
        }
        float res = 0.f;
#pragma unroll
        for (int b = 0; b < 8; ++b)
#pragma unroll
            for (int j = 0; j < 8; ++j) { const float s = wave_sum(acc[b][j]); if (C.lane == b * 8 + j) res = s; }
        const int b = C.lane >> 3, j = C.lane & 7;
        MOD[((size_t)l * NB + b) * MODW + cb + j] = res + p.ada_b[l * MODW + cb + j];
    }
}

template <bool WITH_FA>
__device__ __forceinline__ void ph_norm(const Prm& p, const Ctx& C, int l, const float* xin, const bf16_t* xinb, const float* gain, int ch_sh, int ch_sc, unsigned char* lds) {
    const float* MOD = (const float*)(p.ws + WS_MOD) + (size_t)l * NB * MODW;
    bf16_t* HB = (bf16_t*)(p.ws + WS_HB);
    float* FA = (float*)(p.ws + WS_FA);
    f32x4 g4[4];
#pragma unroll
    for (int j = 0; j < 4; ++j) g4[j] = *(const f32x4*)(gain + 4 * C.lane + 256 * j);
    float* wfl = (float*)lds;
    if (WITH_FA) {
        for (int i = C.tid; i < DM * 8; i += NTHREADS) wfl[i] = p.w_in[((size_t)l * DM + (i >> 3)) * INW + 1536 + (i & 7)];
        __syncthreads();
    }
    for (int m0 = C.gw; m0 < NT; m0 += 2 * C.ngw) {
      f32x4 vv[2][4];
#pragma unroll
      for (int rr = 0; rr < 2; ++rr) { const size_t xo = (size_t)min(m0 + rr * C.ngw, NT - 1) * DM + 4 * C.lane;
        if (xinb == nullptr) {
#pragma unroll
            for (int j = 0; j < 4; ++j) vv[rr][j] = *(const f32x4*)(xin + xo + 256 * j);
        } else {
#pragma unroll
            for (int j = 0; j < 4; ++j) { const u32x2 w = *(const u32x2*)(xinb + xo + 256 * j); vv[rr][j] = (f32x4){__uint_as_float(w.x << 16), __uint_as_float(w.x & 0xffff0000u), __uint_as_float(w.y << 16), __uint_as_float(w.y & 0xffff0000u)}; } } }
#pragma unroll
      for (int rr = 0; rr < 2; ++rr) {
        const int m = m0 + rr * C.ngw; if (m >= NT) break;
        const int b = m / SEQ;
        f32x4 v[4]; float s = 0.f;
#pragma unroll
        for (int j = 0; j < 4; ++j) { v[j] = vv[rr][j]; s += (v[j].x * v[j].x + v[j].y * v[j].y) + (v[j].z * v[j].z + v[j].w * v[j].w); }
        const float r = 1.0f / sqrtf(wave_sum(s) * (1.0f / DM) + EPS);
        const float* shp = MOD + (size_t)b * MODW + ch_sh * DM + 4 * C.lane;
        const float* scp = MOD + (size_t)b * MODW + ch_sc * DM + 4 * C.lane;
        float fa[8];
#pragma unroll
        for (int q = 0; q < 8; ++q) fa[q] = 0.f;
#pragma unroll
        for (int j = 0; j < 4; ++j) {
            const f32x4 sh = *(const f32x4*)(shp + 256 * j), sc = *(const f32x4*)(scp + 256 * j);
            f32x4 h = (v[j] * r) * g4[j] * (sc + 1.0f) + sh;
            unsigned long long o = (unsigned long long)pk2(h.x, h.y) | ((unsigned long long)pk2(h.z, h.w) << 32);
            *(unsigned long long*)(HB + (size_t)m * DM + 4 * C.lane + 256 * j) = o;
            if (WITH_FA) {
                const float hh[4] = {h.x, h.y, h.z, h.w};
#pragma unroll
                for (int e = 0; e < 4; ++e) {
                    const f32x4 wa = *(const f32x4*)(wfl + (4 * C.lane + 256 * j + e) * 8), wb = *(const f32x4*)(wfl + (4 * C.lane + 256 * j + e) * 8 + 4);
                    fa[0] += hh[e] * wa.x; fa[1] += hh[e] * wa.y; fa[2] += hh[e] * wa.z; fa[3] += hh[e] * wa.w;
                    fa[4] += hh[e] * wb.x; fa[5] += hh[e] * wb.y; fa[6] += hh[e] * wb.z; fa[7] += hh[e] * wb.w;
                }
            }
        }
        if (WITH_FA) {
            float res = 0.f;
#pragma unroll
            for (int q = 0; q < 8; ++q) { const float t = wave_sum(fa[q]); if (C.lane == q) res = t; }
            if (C.lane < 8) FA[(size_t)m * 8 + C.lane] = log_sigmoidf_(res + p.fox_bf[l * NH + C.lane]);
        }
      }
    }
    if (WITH_FA) __syncthreads();
}

namespace pg8 {
#define PG8_LAS __attribute__((address_space(3)))
typedef short bf16x8 __attribute__((ext_vector_type(8)));
constexpr int BM = 256, BK = 64, HALF = 128, HTB = HALF * BK * 2  , STAGE_BYTES = 8 * HTB, NXCD = 8, WGM = 8;
__host__ __device__ __forceinline__ int lds_byte(int r, int c) { const int st = (r >> 4) * 2 + (c >> 5), rr = r & 15, cc = c & 31, ob = rr * 64 + cc * 2; return st * 1024 + (ob ^ (((ob >> 9) & 1) << 5)); }
__host__ __device__ __forceinline__ void stage_rc(int b, int& R, int& C) { const int st = b / 1024, sb = b % 1024, swz = sb ^ (((sb >> 9) & 1) << 5); R = (st >> 1) * 16 + swz / 64; C = (st & 1) * 32 + (swz % 64) / 2; }
__host__ __device__ __forceinline__ int perm32(int rho) { const int n = rho >> 4, i = rho & 15; return 8 * (i >> 2) + 4 * n + (i & 3); }

struct Unit { int pm, pn, ka, kb, br; };
struct Gemm { const bf16_t* A; const bf16_t* Bt; int lda, ldb, K; };

struct Order {
    int nM, nN, nwg, G, c, pair;
    __device__ void init(int M, int N, int G_, int c_, int pair_) { nM = M / BM; nN = N / BM; nwg = nM * nN; G = G_; c = c_; pair = pair_; }
    __device__ bool next(int i, Unit& u) const {
        const int ii = pair ? (i >> 1) : i;
        const long L = (long)ii * G + c; if (L >= nwg) return false;
        int wgid = (int)L; { const int q = nwg / NXCD, r = nwg % NXCD, xcd = wgid % NXCD, off = wgid / NXCD; wgid = (xcd < r ? xcd * (q + 1) : r * (q + 1) + (xcd - r) * q) + off; }
        const int nig = WGM * nN, gid = wgid / nig, fm = gid * WGM, gsz = (nM - fm) < WGM ? (nM - fm) : WGM;
        u.pm = fm + ((wgid % nig) % gsz); u.pn = (wgid % nig) / gsz;
        u.br = pair ? (i & 1) : 0; u.ka = u.br * 512; u.kb = u.br * (1024 * 512);
        return true;
    }
    __device__ __forceinline__ void a_ready(const Unit&) const {}
    __device__ __forceinline__ void done(const Unit&) const {}
};

__device__ __forceinline__ unsigned cvt_pk_bf16(float lo, float hi) { unsigned r; asm volatile("v_cvt_pk_bf16_f32 %0, %1, %2" : "=v"(r) : "v"(lo), "v"(hi)); return r; }
__device__ __forceinline__ u32x4 pack8(const f32x4 a, const f32x4 b) { u32x4 w; w.x = cvt_pk_bf16(a[0], a[1]); w.y = cvt_pk_bf16(a[2], a[3]); w.z = cvt_pk_bf16(b[0], b[1]); w.w = cvt_pk_bf16(b[2], b[3]); return w; }
__device__ __forceinline__ void unpack8(const u32x4 w, f32x4& a, f32x4& b) {
    a = (f32x4){__uint_as_float(w.x << 16), __uint_as_float(w.x & 0xffff0000u), __uint_as_float(w.y << 16), __uint_as_float(w.y & 0xffff0000u)};
    b = (f32x4){__uint_as_float(w.z << 16), __uint_as_float(w.z & 0xffff0000u), __uint_as_float(w.w << 16), __uint_as_float(w.w & 0xffff0000u)};
}

struct Epi1 {
    static constexpr bool PERM = true, AFTER_DRAIN = false;
    bf16_t *QQ, *KK, *VV, *GT; const float *gq, *gk;
    __device__ __forceinline__ void operator()(const f32x4 (&acc)[2][2][4][2], const Unit& u, int wr, int wc, int fr, int fq) const {
        const int row0 = u.pm * BM + wr * 64 + fr;
        if (u.pn >= 12) {
            const int col0 = (u.pn - 12) * 256 + wc * 32 + 8 * fq;
#pragma unroll
            for (int ai = 0; ai < 2; ++ai)
#pragma unroll
                for (int m = 0; m < 4; ++m) { bf16_t* rowp = GT + (size_t)(row0 + ai * HALF + m * 16) * 2048 + col0;
#pragma unroll
                    for (int bj = 0; bj < 2; ++bj) { const f32x4 a0 = acc[ai][bj][m][0], a1 = acc[ai][bj][m][1];
                        u32x4 w; w.x = cvt_pk_bf16(sigmoidf_(a0[0]), sigmoidf_(a0[1])); w.y = cvt_pk_bf16(sigmoidf_(a0[2]), sigmoidf_(a0[3]));
                        w.z = cvt_pk_bf16(sigmoidf_(a1[0]), sigmoidf_(a1[1])); w.w = cvt_pk_bf16(sigmoidf_(a1[2]), sigmoidf_(a1[3]));
                        *(u32x4*)(rowp + bj * HALF) = w; } }
        } else {
            const int kind = u.pn >> 1, head = (u.pn & 1) * 4 + wc, k3 = kind % 3;
            bf16_t* base = (k3 == 0 ? QQ : (k3 == 1 ? KK : VV)) + (kind >= 3 ? 512 : 0) + head * 64 + 8 * fq;
            const bool nrm = kind < 2; const float qs = (k3 == 0) ? C2 : 1.0f;
            f32x4 gn[2][2];
#pragma unroll
            for (int bj = 0; bj < 2; ++bj)
#pragma unroll
                for (int n = 0; n < 2; ++n) gn[bj][n] = nrm ? *(const f32x4*)((kind == 0 ? gq : gk) + bj * 32 + 8 * fq + 4 * n) : (f32x4){1.f, 1.f, 1.f, 1.f};
#pragma unroll
            for (int ai = 0; ai < 2; ++ai)
#pragma unroll
                for (int m = 0; m < 4; ++m) {
                    float r = qs;
                    if (nrm) { float ss = 0.f;
#pragma unroll
                        for (int bj = 0; bj < 2; ++bj)
#pragma unroll
                            for (int n = 0; n < 2; ++n) { const f32x4 x = acc[ai][bj][m][n]; ss += (x[0] * x[0] + x[1] * x[1]) + (x[2] * x[2] + x[3] * x[3]); }
                        ss += __shfl_xor(ss, 16); ss += __shfl_xor(ss, 32);
                        r = qs * __builtin_amdgcn_rsqf(ss * (1.0f / 64.0f) + EPS); }
                    bf16_t* rowp = base + (size_t)(row0 + ai * HALF + m * 16) * DM;
#pragma unroll
                    for (int bj = 0; bj < 2; ++bj) *(u32x4*)(rowp + bj * 32) = pack8(acc[ai][bj][m][0] * r * gn[bj][0], acc[ai][bj][m][1] * r * gn[bj][1]);
                }
        }
    }
};
struct EpiGate {
    static constexpr bool PERM = true, AFTER_DRAIN = false;
    const bf16_t* GT; bf16_t* MG;
    __device__ __forceinline__ void operator()(const f32x4 (&acc)[2][2][4][2], const Unit& u, int wr, int wc, int fr, int fq) const {
        const int row0 = u.pm * BM + wr * 64 + fr, col0 = u.pn * BM + wc * 32 + 8 * fq;
#pragma unroll
        for (int ai = 0; ai < 2; ++ai)
#pragma unroll
            for (int m = 0; m < 4; ++m) { const size_t row = (size_t)(row0 + ai * HALF + m * 16);
#pragma unroll
                for (int bj = 0; bj < 2; ++bj) { const int c = col0 + bj * HALF;
                    f32x4 g0, g1; unpack8(*(const u32x4*)(GT + row * 2048 + u.br * 1024 + c), g0, g1);
                    f32x4 v0 = g0 * acc[ai][bj][m][0], v1 = g1 * acc[ai][bj][m][1];
                    if (u.br) { f32x4 o0, o1; unpack8(*(const u32x4*)(MG + row * DM + c), o0, o1); v0 += o0; v1 += o1; }
                    *(u32x4*)(MG + row * DM + c) = pack8(v0, v1); } }
    }
};
struct EpiMerge {
    static constexpr bool PERM = true, AFTER_DRAIN = false, MIDHOOK = true;
    const bf16_t* GT; bf16_t* MG;
    __device__ __forceinline__ void mid(f32x4 (&acc)[2][2][4][2], const Unit& u, int wr, int wc, int fr_, int fq_) const {
        int fr = fr_, fq = fq_; asm volatile("" : "+v"(fr), "+v"(fq));
        const int row0 = u.pm * BM + wr * 64 + fr, col0 = u.pn * BM + wc * 32 + 8 * fq;
#pragma unroll
        for (int ai = 0; ai < 2; ++ai)
#pragma unroll
            for (int mp = 0; mp < 2; ++mp) {
                u32x4 ga[2][2], gb[2][2];
#pragma unroll
                for (int mm = 0; mm < 2; ++mm) { const size_t row = (size_t)(row0 + ai * HALF + (2 * mp + mm) * 16);
#pragma unroll
                    for (int bj = 0; bj < 2; ++bj) { const int c = col0 + bj * HALF; ga[mm][bj] = *(const u32x4*)(GT + row * 2048 + c); gb[mm][bj] = *(const u32x4*)(GT + row * 2048 + 1024 + c); } }
#pragma unroll
                for (int mm = 0; mm < 2; ++mm) { const int m = 2 * mp + mm;
#pragma unroll
                    for (int bj = 0; bj < 2; ++bj) { f32x4 a0, a1, b0, b1; unpack8(ga[mm][bj], a0, a1); unpack8(gb[mm][bj], b0, b1);
#pragma unroll
                        for (int e = 0; e < 4; ++e) { acc[ai][bj][m][0][e] *= a0[e] * __builtin_amdgcn_rcpf(fmaxf(b0[e], 9.094947e-13f)); acc[ai][bj][m][1][e] *= a1[e] * __builtin_amdgcn_rcpf(fmaxf(b1[e], 9.094947e-13f)); } } }
                asm volatile("" ::: "memory"); __builtin_amdgcn_sched_barrier(0); }
    }
    __device__ __forceinline__ void operator()(const f32x4 (&acc)[2][2][4][2], const Unit& u, int wr, int wc, int fr, int fq) const {
        const int row0 = u.pm * BM + wr * 64 + fr, col0 = u.pn * BM + wc * 32 + 8 * fq;
#pragma unroll
        for (int ai = 0; ai < 2; ++ai) {
            u32x4 gb[4][2];
#pragma unroll
            for (int m = 0; m < 4; ++m)
#pragma unroll
                for (int bj = 0; bj < 2; ++bj) gb[m][bj] = *(const u32x4*)(GT + (size_t)(row0 + ai * HALF + m * 16) * 2048 + 1024 + col0 + bj * HALF);
#pragma unroll
            for (int m = 0; m < 4; ++m) { const size_t row = (size_t)(row0 + ai * HALF + m * 16);
#pragma unroll
                for (int bj = 0; bj < 2; ++bj) { const int c = col0 + bj * HALF;
                    f32x4 b0, b1; unpack8(gb[m][bj], b0, b1);
                    f32x4 v0, v1;
#pragma unroll
                    for (int e = 0; e < 4; ++e) { v0[e] = acc[ai][bj][m][0][e] * fmaxf(b0[e], 9.094947e-13f); v1[e] = acc[ai][bj][m][1][e] * fmaxf(b1[e], 9.094947e-13f); }
                    *(u32x4*)(MG + row * DM + c) = pack8(v0, v1); } } }
    }
};
struct EpiOut {
    static constexpr bool PERM = true, AFTER_DRAIN = false;
    const float* xin; const bf16_t* xinb; bf16_t* xr1; const float* g1;
    const float* gain; bf16_t* XA; float* SSQ;
    __device__ __forceinline__ void operator()(const f32x4 (&acc)[2][2][4][2], const Unit& u, int wr, int wc, int fr, int fq) const {
        const int row0 = u.pm * BM + wr * 64 + fr, col0 = u.pn * BM + wc * 32 + 8 * fq; const int b = (u.pm * BM) / SEQ;
        f32x4 gv[2][2], gs[2][2];
#pragma unroll
        for (int bj = 0; bj < 2; ++bj)
#pragma unroll
            for (int n = 0; n < 2; ++n) { gv[bj][n] = *(const f32x4*)(g1 + (size_t)b * MODW + col0 + bj * HALF + 4 * n);
                gs[bj][n] = *(const f32x4*)(gain + col0 + bj * HALF + 4 * n) * (*(const f32x4*)(g1 + (size_t)b * MODW + 2 * DM + col0 + bj * HALF + 4 * n) + 1.0f); }
#pragma unroll
        for (int ai = 0; ai < 2; ++ai)
#pragma unroll
          for (int mp = 0; mp < 2; ++mp) {
            f32x4 xr[2][2][2];
#pragma unroll
            for (int mm = 0; mm < 2; ++mm)
#pragma unroll
                for (int bj = 0; bj < 2; ++bj)
#pragma unroll
                    for (int n = 0; n < 2; ++n) { if (xinb == nullptr) xr[mm][bj][n] = *(const f32x4*)(xin + (size_t)(row0 + ai * HALF + (2 * mp + mm) * 16) * DM + col0 + bj * HALF + 4 * n); }
            if (xinb != nullptr) {
#pragma unroll
                for (int mm = 0; mm < 2; ++mm)
#pragma unroll
                    for (int bj = 0; bj < 2; ++bj) unpack8(*(const u32x4*)(xinb + (size_t)(row0 + ai * HALF + (2 * mp + mm) * 16) * DM + col0 + bj * HALF), xr[mm][bj][0], xr[mm][bj][1]); }
#pragma unroll
            for (int mm = 0; mm < 2; ++mm) { const int m = 2 * mp + mm; const size_t row = (size_t)(row0 + ai * HALF + m * 16), off = row * DM + col0; float ss = 0.f;
#pragma unroll
                for (int bj = 0; bj < 2; ++bj) { f32x4 x1[2];
#pragma unroll
                    for (int n = 0; n < 2; ++n) { const f32x4 xv = xr[mm][bj][n]; x1[n] = xv + gv[bj][n] * acc[ai][bj][m][n];
                        ss += (x1[n][0] * x1[n][0] + x1[n][1] * x1[n][1]) + (x1[n][2] * x1[n][2] + x1[n][3] * x1[n][3]); }
                    *(u32x4*)(xr1 + off + bj * HALF) = pack8(x1[0], x1[1]);
                    *(u32x4*)(XA + off + bj * HALF) = pack8(x1[0] * gs[bj][0], x1[1] * gs[bj][1]); }
                ss += __shfl_xor(ss, 16); ss += __shfl_xor(ss, 32);
                if (fq == 0) SSQ[row * 16 + u.pn * 4 + wc] = ss; } }
    }
};
struct EpiQ {
    static constexpr bool PERM = true, AFTER_DRAIN = false;
    bf16_t* O; const float* SSQ; const float* bq; float* RT;
    __device__ __forceinline__ void operator()(const f32x4 (&acc)[2][2][4][2], const Unit& u, int wr, int wc, int fr, int fq) const {
        const int row0 = u.pm * BM + wr * 64 + fr, col0 = u.pn * BM + wc * 32 + 8 * fq; const int b = (u.pm * BM) / SEQ;
        f32x4 bv[2][2];
#pragma unroll
        for (int bj = 0; bj < 2; ++bj)
#pragma unroll
            for (int n = 0; n < 2; ++n) bv[bj][n] = *(const f32x4*)(bq + (size_t)b * DM + col0 + bj * HALF + 4 * n);
        float rr[2][4];
#pragma unroll
        for (int ai = 0; ai < 2; ++ai)
#pragma unroll
            for (int m = 0; m < 4; ++m) { const size_t row = (size_t)(row0 + ai * HALF + m * 16);
                const f32x4 sq = *(const f32x4*)(SSQ + row * 16 + 4 * fq);
                float st = (sq[0] + sq[1]) + (sq[2] + sq[3]); st += __shfl_xor(st, 16); st += __shfl_xor(st, 32);
                rr[ai][m] = __builtin_amdgcn_rsqf(st * (1.0f / DM) + EPS); }
#pragma unroll
        for (int ai = 0; ai < 2; ++ai)
#pragma unroll
            for (int m = 0; m < 4; ++m) { const size_t row = (size_t)(row0 + ai * HALF + m * 16); const float r = rr[ai][m];
                bf16_t* rowp = O + row * DM + col0;
                if (u.pn == 0 && wc == 0 && fq == 0) RT[row] = r;
#pragma unroll
                for (int bj = 0; bj < 2; ++bj) *(u32x4*)(rowp + bj * HALF) = pack8(acc[ai][bj][m][0] * r + bv[bj][0], acc[ai][bj][m][1] * r + bv[bj][1]); }
    }
};
struct EpiBf {
    static constexpr bool PERM = true, AFTER_DRAIN = false;
    bf16_t* O; int ldc;
    __device__ __forceinline__ void operator()(const f32x4 (&acc)[2][2][4][2], const Unit& u, int wr, int wc, int fr, int fq) const {
        const int row0 = u.pm * BM + wr * 64 + fr, col0 = u.pn * BM + wc * 32 + 8 * fq;
#pragma unroll
        for (int ai = 0; ai < 2; ++ai)
#pragma unroll
            for (int m = 0; m < 4; ++m) { bf16_t* rowp = O + (size_t)(row0 + ai * HALF + m * 16) * ldc + col0;
#pragma unroll
                for (int bj = 0; bj < 2; ++bj) *(u32x4*)(rowp + bj * HALF) = pack8(acc[ai][bj][m][0], acc[ai][bj][m][1]); }
    }
};

template <class E_, class = void> struct has_midhook { static constexpr bool value = false; };
template <class E_> struct has_midhook<E_, decltype((void)E_::MIDHOOK)> { static constexpr bool value = true; };
template <class Epi, class Sched, bool ALIGN_EPI = false, bool SP2 = false>
__device__ __forceinline__ void gemm_phase(PG8_LAS unsigned char* lds, const Gemm g, const Sched& S, const Epi& E) {
    int tid_ = threadIdx.x; asm volatile("" : "+v"(tid_));
    const int tid = tid_, wid = __builtin_amdgcn_readfirstlane(tid >> 6), lane = tid & 63, wr = wid >> 2, wc = wid & 3, fr = lane & 15, fq = lane >> 4;
    const int K = g.K, nt = K / BK;
    unsigned voffA[2], voffB[2];
#pragma unroll
    for (int i = 0; i < 2; ++i) { int R, C; stage_rc(tid * 16 + i * 8192, R, C); const int Rb = Epi::PERM ? ((R & ~31) + perm32(R & 31)) : R;
        voffA[i] = (unsigned)(R * g.lda + C) * 2u; voffB[i] = (unsigned)(Rb * g.ldb + C) * 2u; }
    const size_t kstep = (size_t)(BK * 2);
    const size_t hsA = (size_t)HALF * g.lda * 2, hsB = (size_t)HALF * g.ldb * 2;
    const size_t tsA = 2 * hsA, tsB = 2 * hsB;
    const unsigned ldsw = (unsigned)wid * 1024u;
    const int aoff = lds_byte(wr * 64 + fr, fq * 8), boff = lds_byte(wc * 32 + fr, fq * 8);
#define PG8_SA(b, h) (((b) * 2 + (h)) * HTB)
#define PG8_SB(b, h) ((4 + (b) * 2 + (h)) * HTB)
#define PG8_STAGE(bufoff, gbase, voff) do { _Pragma("unroll") for (int _i = 0; _i < 2; ++_i) \
        __builtin_amdgcn_global_load_lds((const unsigned*)((const char*)(gbase) + (voff)[_i]), (PG8_LAS unsigned*)(lds + (bufoff) + ldsw + _i * 8192), 16, 0, 0); } while (0)
#define PG8_LDA(dst, b, h) do { _Pragma("unroll") for (int m = 0; m < 4; ++m) _Pragma("unroll") for (int k = 0; k < 2; ++k) dst[m][k] = *(const PG8_LAS bf16x8*)(lds + PG8_SA(b, h) + aoff + m * 2048 + k * 1024); } while (0)
#define PG8_LDB(dst, b, h) do { _Pragma("unroll") for (int n = 0; n < 2; ++n) _Pragma("unroll") for (int k = 0; k < 2; ++k) dst[n][k] = *(const PG8_LAS bf16x8*)(lds + PG8_SB(b, h) + boff + n * 2048 + k * 1024); } while (0)
#define PG8_MMA(ai, bj, At, Bt) do { __builtin_amdgcn_s_setprio(1); _Pragma("unroll") for (int m = 0; m < 4; ++m) _Pragma("unroll") for (int n = 0; n < 2; ++n) _Pragma("unroll") for (int k = 0; k < 2; ++k) \
        acc[ai][bj][m][n] = __builtin_amdgcn_mfma_f32_16x16x32_bf16(Bt[n][k], At[m][k], acc[ai][bj][m][n], 0, 0, 0); __builtin_amdgcn_s_setprio(0); } while (0)
#define PG8_WAIT_V(n) asm volatile("s_waitcnt vmcnt(" #n ")" ::: "memory")
#define PG8_WAIT_L(n) asm volatile("s_waitcnt lgkmcnt(" #n ")" ::: "memory")
#define PG8_BAR __builtin_amdgcn_s_barrier()
#define PG8_SCHED __builtin_amdgcn_sched_barrier(0)
    Unit cur, nxt; int ui = 0;
    if (!S.next(0, cur)) return;
    f32x4 acc[2][2][4][2];
#pragma unroll
    for (int a = 0; a < 2; ++a)
#pragma unroll
        for (int b = 0; b < 2; ++b)
#pragma unroll
            for (int m = 0; m < 4; ++m)
#pragma unroll
                for (int n = 0; n < 2; ++n) acc[a][b][m][n] = (f32x4){0.f, 0.f, 0.f, 0.f};
    bf16x8 At[4][2], B0[2][2], B1[2][2];
    const char* cA = (const char*)g.A + (size_t)cur.pm * tsA + (size_t)cur.ka * 2; const char* cB = (const char*)g.Bt + (size_t)cur.pn * tsB + (size_t)cur.kb * 2;
    S.a_ready(cur);
    if constexpr (SP2) {
        PG8_STAGE(PG8_SB(0, 0), cB, voffB); PG8_STAGE(PG8_SB(0, 1), cB + hsB, voffB); PG8_STAGE(PG8_SA(0, 0), cA, voffA); PG8_STAGE(PG8_SA(0, 1), cA + hsA, voffA);
        if (wr == 1) PG8_BAR;
        PG8_WAIT_V(2); PG8_BAR;
        PG8_STAGE(PG8_SB(1, 0), cB + kstep, voffB); PG8_STAGE(PG8_SA(1, 0), cA + kstep, voffA); PG8_STAGE(PG8_SB(1, 1), cB + hsB + kstep, voffB);
        PG8_WAIT_V(6); PG8_BAR;
    } else {
        PG8_STAGE(PG8_SB(0, 0), cB, voffB); PG8_STAGE(PG8_SA(0, 0), cA, voffA); PG8_STAGE(PG8_SB(0, 1), cB + hsB, voffB); PG8_STAGE(PG8_SA(0, 1), cA + hsA, voffA);
        if (wr == 1) PG8_BAR;
        PG8_WAIT_V(4); PG8_BAR;
        PG8_STAGE(PG8_SB(1, 0), cB + kstep, voffB); PG8_STAGE(PG8_SA(1, 0), cA + kstep, voffA); PG8_STAGE(PG8_SB(1, 1), cB + hsB + kstep, voffB);
        PG8_WAIT_V(6); PG8_BAR;
    }
    for (;;) {
        const bool has_next = S.next(ui + 1, nxt);
        const char* nA = has_next ? (const char*)g.A + (size_t)nxt.pm * tsA + (size_t)nxt.ka * 2 : cA; const char* nB = has_next ? (const char*)g.Bt + (size_t)nxt.pn * tsB + (size_t)nxt.kb * 2 : cB;
        for (int t = 0; t < nt; t += 2) {
            if constexpr (has_midhook<Epi>::value) { if (t == nt / 2) E.mid(acc, cur, wr, wc, fr, fq); }
            const bool last = (t == nt - 2);
            const char* a1 = cA + (size_t)(t + 1) * kstep;
            const char* a2 = last ? nA : cA + (size_t)(t + 2) * kstep; const char* b2 = last ? nB : cB + (size_t)(t + 2) * kstep;
            const char* a3 = a2 + kstep; const char* b3 = b2 + kstep;
            if (last && has_next) S.a_ready(nxt);
            if constexpr (SP2) {
            PG8_LDB(B0, 0, 0); PG8_LDB(B1, 0, 1); PG8_SCHED; PG8_LDA(At, 0, 0); PG8_STAGE(PG8_SA(1, 1), a1 + hsA, voffA);
            PG8_WAIT_V(8); PG8_WAIT_L(0); PG8_BAR; PG8_MMA(0, 0, At, B0); PG8_MMA(0, 1, At, B1); PG8_BAR; PG8_SCHED;
            PG8_LDA(At, 0, 1); PG8_STAGE(PG8_SB(0, 0), b2, voffB); PG8_STAGE(PG8_SB(0, 1), b2 + hsB, voffB); PG8_STAGE(PG8_SA(0, 0), a2, voffA);
            PG8_WAIT_V(8); PG8_WAIT_L(0); PG8_BAR; PG8_MMA(1, 0, At, B0); PG8_MMA(1, 1, At, B1); PG8_BAR; PG8_SCHED;
            PG8_LDB(B0, 1, 0); PG8_LDB(B1, 1, 1); PG8_SCHED; PG8_LDA(At, 1, 0); PG8_STAGE(PG8_SA(0, 1), a2 + hsA, voffA);
            PG8_WAIT_V(8); PG8_WAIT_L(0); PG8_BAR; PG8_MMA(0, 0, At, B0); PG8_MMA(0, 1, At, B1); PG8_BAR; PG8_SCHED;
            PG8_LDA(At, 1, 1); PG8_STAGE(PG8_SB(1, 0), b3, voffB); PG8_STAGE(PG8_SB(1, 1), b3 + hsB, voffB); PG8_STAGE(PG8_SA(1, 0), a3, voffA);
            PG8_WAIT_V(8); PG8_WAIT_L(0); PG8_BAR; PG8_MMA(1, 0, At, B0); PG8_MMA(1, 1, At, B1); PG8_BAR; PG8_SCHED;
            } else {
            PG8_LDB(B0, 0, 0); PG8_SCHED; PG8_LDA(At, 0, 0); PG8_STAGE(PG8_SA(1, 1), a1 + hsA, voffA);
            PG8_WAIT_L(8); PG8_BAR; PG8_WAIT_L(0); PG8_MMA(0, 0, At, B0); PG8_BAR; PG8_SCHED;
            PG8_LDB(B1, 0, 1); PG8_STAGE(PG8_SB(0, 0), b2, voffB);
            PG8_BAR; PG8_WAIT_L(0); PG8_MMA(0, 1, At, B1); PG8_BAR;
            PG8_LDA(At, 0, 1); PG8_STAGE(PG8_SA(0, 0), a2, voffA);
            PG8_BAR; PG8_WAIT_L(0); PG8_MMA(1, 0, At, B0); PG8_BAR; PG8_SCHED;
            PG8_STAGE(PG8_SB(0, 1), b2 + hsB, voffB);
            PG8_WAIT_V(6); PG8_BAR; PG8_MMA(1, 1, At, B1); PG8_BAR;
            PG8_LDB(B0, 1, 0); PG8_SCHED; PG8_LDA(At, 1, 0); PG8_STAGE(PG8_SA(0, 1), a2 + hsA, voffA);
            PG8_WAIT_L(8); PG8_BAR; PG8_WAIT_L(0); PG8_MMA(0, 0, At, B0); PG8_BAR; PG8_SCHED;
            PG8_LDB(B1, 1, 1); PG8_STAGE(PG8_SB(1, 0), b3, voffB);
            PG8_BAR; PG8_WAIT_L(0); PG8_MMA(0, 1, At, B1); PG8_BAR;
            PG8_LDA(At, 1, 1); PG8_STAGE(PG8_SA(1, 0), a3, voffA);
            PG8_BAR; PG8_WAIT_L(0); PG8_MMA(1, 0, At, B0); PG8_BAR; PG8_SCHED;
            PG8_STAGE(PG8_SB(1, 1), b3 + hsB, voffB);
            PG8_WAIT_V(6); PG8_BAR; PG8_MMA(1, 1, At, B1); PG8_BAR;
            }
        }
        if constexpr (ALIGN_EPI) { if (wr == 0) PG8_BAR; }
        if constexpr (!Epi::AFTER_DRAIN) { E(acc, cur, wr, wc, fr, fq); S.done(cur); }
        if (!has_next) break;
#pragma unroll
        for (int a = 0; a < 2; ++a)
#pragma unroll
            for (int b = 0; b < 2; ++b)
#pragma unroll
                for (int m = 0; m < 4; ++m)
#pragma unroll
                    for (int n = 0; n < 2; ++n) acc[a][b][m][n] = (f32x4){0.f, 0.f, 0.f, 0.f};
        cur = nxt; cA = nA; cB = nB; ++ui;
        if constexpr (ALIGN_EPI) { if (wr == 1) PG8_BAR; }
    }
    PG8_WAIT_V(0);
    if constexpr (!ALIGN_EPI) { if (wr == 0) PG8_BAR; }
    PG8_BAR;
    if constexpr (Epi::AFTER_DRAIN) { E.fused(acc, cur, wr, wc, fr, fq, lds, wid, lane); S.done(cur); }
#undef PG8_SA
#undef PG8_SB
#undef PG8_STAGE
#undef PG8_LDA
#undef PG8_LDB
#undef PG8_MMA
#undef PG8_WAIT_V
#undef PG8_WAIT_L
#undef PG8_BAR
#undef PG8_SCHED
}
}

__device__ __forceinline__ int win_logical_col(int n) {
    const int pn = n >> 8, tc = n & 255;
    if (pn >= 12) return 3080 + (pn - 12) * 256 + tc;
    const int kind = pn >> 1, bj = tc >> 7, wc = (tc >> 5) & 3, i = tc & 31;
    const int base = (kind < 3) ? kind * 512 : 1544 + (kind - 3) * 512;
    return base + ((pn & 1) * 4 + wc) * 64 + bj * 32 + i;
}
__device__ __forceinline__ void transpose_item(const float* W, int ldw, int src_c0, int k0, bf16_t* WT, int K, int dst_row0, float* scr, int lane) {
#pragma unroll 8
    for (int i = 0; i < 32; ++i) { const int kk = 2 * i + (lane >> 5); scr[kk * 33 + (lane & 31)] = W[(size_t)(k0 + kk) * ldw + src_c0 + (lane & 31)]; }
    __builtin_amdgcn_s_waitcnt(0xc07f); asm volatile("" ::: "memory");
    const int c = lane & 7;
#pragma unroll
    for (int j = 0; j < 4; ++j) { const int n = (lane >> 3) + 8 * j; const float* s = scr + (8 * c) * 33 + n;
        u32x4 o; o.x = pk2(s[0 * 33], s[1 * 33]); o.y = pk2(s[2 * 33], s[3 * 33]); o.z = pk2(s[4 * 33], s[5 * 33]); o.w = pk2(s[6 * 33], s[7 * 33]);
        *(u32x4*)(WT + (size_t)(dst_row0 + n) * K + k0 + 8 * c) = o; }
    __builtin_amdgcn_s_waitcnt(0xc07f); asm volatile("" ::: "memory");
}
__device__ __forceinline__ void ph_weights(const Prm& p, const Ctx& C, unsigned char* lds) {
    float* scr = (float*)(lds + C.wave * 16384);
    bf16_t* WIN = (bf16_t*)(p.ws + WS_WIN); bf16_t* WBR = (bf16_t*)(p.ws + WS_WBR); bf16_t* WOUT = (bf16_t*)(p.ws + WS_WOUT); bf16_t* WQT = (bf16_t*)(p.ws + WS_WQ);
    constexpr int I_IN = 16 * 160, I_BR = 8 * 32, I_SQ = 16 * 32;
    constexpr int NITEMS = 2 * I_IN + 4 * I_BR + 2 * I_SQ + 2 * I_SQ;
    for (int it = C.gw; it < NITEMS; it += C.ngw) {
        int r = it;
        if (r < 2 * I_IN) { const int l = r / I_IN, q = r % I_IN, kb = q / 160, nb = q % 160;
            transpose_item(p.w_in + (size_t)l * DM * INW, INW, win_logical_col(32 * nb), 64 * kb, WIN + (size_t)l * 5120 * DM, DM, 32 * nb, scr, C.lane); continue; }
        r -= 2 * I_IN;
        if (r < 4 * I_BR) { const int lg = r / I_BR, q = r % I_BR, kb = q / 32, nb = q % 32;
            transpose_item(p.w_branch + (size_t)lg * 512 * DM, DM, 32 * nb, 64 * kb, WBR + (size_t)(lg >> 1) * DM * DM + (lg & 1) * 512, DM, 32 * nb, scr, C.lane); continue; }
        r -= 4 * I_BR;
        if (r < 2 * I_SQ) { const int l = r / I_SQ, q = r % I_SQ, kb = q / 32, nb = q % 32;
            transpose_item(p.w_out + (size_t)l * DM * DM, DM, 32 * nb, 64 * kb, WOUT + (size_t)l * DM * DM, DM, 32 * nb, scr, C.lane); continue; }
        r -= 2 * I_SQ;
        { const int l = r / I_SQ, q = r % I_SQ, kb = q / 32, nb = q % 32;
            transpose_item(p.wq + (size_t)l * DM * DM, DM, 32 * nb, 64 * kb, WQT + (size_t)l * DM * DM, DM, 32 * nb, scr, C.lane); }
    }
}
#define LDSP(p) ((PG8_LAS unsigned char*)(p))
__device__ __forceinline__ void ph_gemm1(const Prm& p, int l, unsigned char* lds) {
    pg8::Gemm g{(const bf16_t*)(p.ws + WS_HB), (const bf16_t*)(p.ws + WS_WIN) + (size_t)l * 5120 * DM, DM, DM, DM};
    pg8::Order S; S.init(NT, 5120, gridDim.x, blockIdx.x, 0);
    pg8::Epi1 E{(bf16_t*)(p.ws + WS_QQ), (bf16_t*)(p.ws + WS_KK), (bf16_t*)(p.ws + WS_VV), (bf16_t*)(p.ws + WS_GT), p.gq + l * HD, p.gk + l * HD};
    pg8::gemm_phase<pg8::Epi1, pg8::Order, true, true>(LDSP(lds), g, S, E);
}
__device__ __forceinline__ void ph_merge(const Prm& p, int l, unsigned char* lds) {
    pg8::Gemm g{(const bf16_t*)(p.ws + WS_QQ), (const bf16_t*)(p.ws + WS_WBR) + (size_t)l * DM * DM, DM, DM, DM};
    pg8::Order S; S.init(NT, DM, gridDim.x, blockIdx.x, 0);
    pg8::EpiMerge E{(const bf16_t*)(p.ws + WS_GT), (bf16_t*)(p.ws + WS_HB)};
    pg8::gemm_phase<pg8::EpiMerge, pg8::Order, true, true>(LDSP(lds), g, S, E);
}
__device__ __forceinline__ void ph_out(const Prm& p, int l, unsigned char* lds) {
    pg8::Gemm g{(const bf16_t*)(p.ws + WS_HB), (const bf16_t*)(p.ws + WS_WOUT) + (size_t)l * DM * DM, DM, DM, DM};
    pg8::Order S; S.init(NT, DM, gridDim.x, blockIdx.x, 0);
    pg8::EpiOut E{p.x, l == 0 ? (const bf16_t*)nullptr : (const bf16_t*)p.out, (bf16_t*)(p.ws + WS_XR1), (const float*)(p.ws + WS_MOD) + (size_t)l * NB * MODW + 2 * DM, p.ffn_norm + l * DM, (bf16_t*)(p.ws + WS_QQ), (float*)(p.ws + WS_SSQ)};
    pg8::gemm_phase<pg8::EpiOut, pg8::Order, true, true>(LDSP(lds), g, S, E);
}
__device__ __forceinline__ void ph_q(const Prm& p, int l, unsigned char* lds) {
    pg8::Gemm g{(const bf16_t*)(p.ws + WS_QQ), (const bf16_t*)(p.ws + WS_WQ) + (size_t)l * DM * DM, DM, DM, DM};
    pg8::Order S; S.init(NT, DM, gridDim.x, blockIdx.x, 0);
    pg8::EpiQ E{(bf16_t*)(p.ws + WS_KK), (const float*)(p.ws + WS_SSQ), (const float*)(p.ws + WS_BQ) + (size_t)l * NB * DM, (float*)(p.ws + WS_FC)};
    pg8::gemm_phase<pg8::EpiQ, pg8::Order, true, true>(LDSP(lds), g, S, E);
}

namespace attn_body {
using bf16=__hip_bfloat16;
using bf16x8=__attribute__((ext_vector_type(8)))short;
using s16x4=__attribute__((ext_vector_type(4)))short;
using f32x16=__attribute__((ext_vector_type(16)))float;
using u32x4=__attribute__((ext_vector_type(4)))unsigned;
using f32x4_t=__attribute__((ext_vector_type(4)))float;
constexpr int BATCH=8,NHEAD=8,SEQ=4096,D=64,DM=1024;
constexpr int NW=8,QBLK=32,QB=QBLK*NW,KVBLK=64,NQB=SEQ/QB;
constexpr int ATTN_PITCH=DM, ATTN_UNIT_ROWS=QB;
__device__ __forceinline__ int crow(int r,int hi){return (r&3)+8*(r>>2)+4*hi;}
#define SBAR() __builtin_amdgcn_sched_barrier(0)
__device__ __forceinline__ void cmask(f32x16&p0,f32x16&p1,int jb,int qrel,int hi){
  const float NEG=-INFINITY; int d=qrel-(64*jb+4*hi); asm volatile("":"+v"(d));
  #pragma unroll
  for(int r=0;r<16;++r){const int c=(r&3)+8*(r>>2); if(c>d)p0[r]=NEG; if(c+32>d)p1[r]=NEG;}
}

constexpr int NSLOT=3, SLOTB=8192;
constexpr int LDS_K=0, LDS_V=NSLOT*SLOTB, LDS_WS=2*NSLOT*SLOTB, LDS_OST=LDS_WS+NW*64*4, LDS_BYTES=LDS_OST+NW*4096;
constexpr float C2=0.125f*1.4426950408889634f;
__device__ __forceinline__ void glds16(const void*gsrc,unsigned lds_dst){unsigned keep;
  asm volatile("s_mov_b32 %0, m0\n\ts_mov_b32 m0, %2\n\ts_nop 0\n\tglobal_load_lds_dwordx4 %1, off\n\ts_mov_b32 m0, %0":"=&s"(keep):"v"(gsrc),"s"(lds_dst):"memory");}
__device__ __forceinline__ float max3f(float a,float b,float c){float r;asm("v_max3_f32 %0, %1, %2, %3":"=v"(r):"v"(a),"v"(b),"v"(c));return r;}
__device__ __forceinline__ float max2f(float a,float b){float r;asm("v_max_f32_e32 %0, %1, %2":"=v"(r):"v"(a),"v"(b));return r;}
__device__ __forceinline__ float fadd_s(float a,float b){float r;asm("v_add_f32_e32 %0, %1, %2":"=v"(r):"v"(a),"v"(b));return r;}
__device__ __forceinline__ float fsub_s(float a,float b){float r;asm("v_sub_f32_e32 %0, %1, %2":"=v"(r):"v"(a),"v"(b));return r;}
typedef float f32x2_t __attribute__((ext_vector_type(2))); typedef __bf16 bf16x2_t __attribute__((ext_vector_type(2)));
__device__ __forceinline__ unsigned cvtpk_s(float lo,float hi){f32x2_t v={lo,hi};bf16x2_t b=__builtin_convertvector(v,bf16x2_t);return __builtin_bit_cast(unsigned,b);}
#define WAIT_BAR(N) asm volatile("s_waitcnt vmcnt(" #N ") lgkmcnt(0)\n\ts_barrier":::"memory")

__device__ __forceinline__ void qkt(f32x16&p0,f32x16&p1,const char*Kslot,const bf16x8*qr,const f32x16&negm,int r32,int hi){
  const char*kb=Kslot+hi*1024+r32*16;
  #pragma unroll
  for(int d0=0;d0<4;++d0){
    const bf16x8 b0=*reinterpret_cast<const bf16x8*>(kb+d0*2048);
    const bf16x8 b1=*reinterpret_cast<const bf16x8*>(kb+d0*2048+512);
    if(d0==0){p0=__builtin_amdgcn_mfma_f32_32x32x16_bf16(b0,qr[0],negm,0,0,0);p1=__builtin_amdgcn_mfma_f32_32x32x16_bf16(b1,qr[0],negm,0,0,0);}
    else{p0=__builtin_amdgcn_mfma_f32_32x32x16_bf16(b0,qr[d0],p0,0,0,0);p1=__builtin_amdgcn_mfma_f32_32x32x16_bf16(b1,qr[d0],p1,0,0,0);}}
}
typedef __attribute__((address_space(3))) const char* lds_cptr;
typedef short v4i16_t __attribute__((ext_vector_type(4)));
__device__ __forceinline__ void kload8(bf16x8*kf,lds_cptr kp){
  kf[0]=*(const __attribute__((address_space(3))) bf16x8*)(kp);      kf[1]=*(const __attribute__((address_space(3))) bf16x8*)(kp+512);
  kf[2]=*(const __attribute__((address_space(3))) bf16x8*)(kp+2048); kf[3]=*(const __attribute__((address_space(3))) bf16x8*)(kp+2560);
  kf[4]=*(const __attribute__((address_space(3))) bf16x8*)(kp+4096); kf[5]=*(const __attribute__((address_space(3))) bf16x8*)(kp+4608);
  kf[6]=*(const __attribute__((address_space(3))) bf16x8*)(kp+6144); kf[7]=*(const __attribute__((address_space(3))) bf16x8*)(kp+6656);
}
__device__ __forceinline__ void kload2(bf16x8*kf,lds_cptr kp,int j){ kf[2*j]=*(const __attribute__((address_space(3))) bf16x8*)(kp+j*2048); kf[2*j+1]=*(const __attribute__((address_space(3))) bf16x8*)(kp+j*2048+512); }
__device__ __forceinline__ s16x4 vtr(lds_cptr p){ return __builtin_bit_cast(s16x4,__builtin_amdgcn_ds_read_tr16_b64_v4i16((__attribute__((address_space(3))) v4i16_t*)p)); }
__device__ __forceinline__ float rowmax(const f32x16&p0,const f32x16&p1){
  float a=max3f(p0[0],p0[1],p1[0]),b=max3f(p0[2],p0[3],p1[1]);a=max3f(a,p1[2],p1[3]);
  #pragma unroll
  for(int r=4;r<16;r+=4){a=max3f(a,p0[r],p0[r+1]);b=max3f(b,p0[r+2],p0[r+3]);a=max3f(a,p1[r],p1[r+1]);b=max3f(b,p1[r+2],p1[r+3]);}
  const float m=max2f(a,b);
  auto rr=__builtin_amdgcn_permlane32_swap(__float_as_uint(m),__float_as_uint(m),false,false);
  return max2f(__uint_as_float(rr[0]),__uint_as_float(rr[1]));
}
__device__ __forceinline__ void pv(f32x16*o,int vb,bf16x8 pa0,bf16x8 pa1,bf16x8 pa2,bf16x8 pa3){
  #pragma unroll
  for(int d0=0;d0<2;++d0){s16x4 lo[4],hi[4];
    #pragma unroll
    for(int ks=0;ks<4;++ks){
      asm volatile("ds_read_b64_tr_b16 %0,%1 offset:%c2":"=&v"(lo[ks]):"v"(vb),"i"(d0*4096+ks*1024):"memory");
      asm volatile("ds_read_b64_tr_b16 %0,%1 offset:%c2":"=&v"(hi[ks]):"v"(vb),"i"(d0*4096+ks*1024+512):"memory");}
    asm volatile("s_waitcnt lgkmcnt(0)":::"memory");SBAR();
    #define PK(k) (bf16x8){lo[k][0],lo[k][1],lo[k][2],lo[k][3],hi[k][0],hi[k][1],hi[k][2],hi[k][3]}
    o[d0]=__builtin_amdgcn_mfma_f32_32x32x16_bf16(pa0,PK(0),o[d0],0,0,0);
    o[d0]=__builtin_amdgcn_mfma_f32_32x32x16_bf16(pa1,PK(1),o[d0],0,0,0);
    o[d0]=__builtin_amdgcn_mfma_f32_32x32x16_bf16(pa2,PK(2),o[d0],0,0,0);
    o[d0]=__builtin_amdgcn_mfma_f32_32x32x16_bf16(pa3,PK(3),o[d0],0,0,0);
    #undef PK
  }
}

#ifndef ATTN_STORE16
#define ATTN_STORE16(p,v) (*(u32x4*)(p)=(v))
#endif
template<int THRL> __device__ __forceinline__ void attn_unit(int b,int h,int qb,const bf16*Q,const bf16*__restrict__ K,const bf16*__restrict__ V,bf16*O,char*shm,const float*Gl,int j0){
  int tid_=threadIdx.x; asm volatile("":"+v"(tid_));
  const int tid=tid_,lane=tid&63,r32=lane&31,hi=lane>>5; const int wid=__builtin_amdgcn_readfirstlane(tid>>6);
  const long rowbase=(long)b*SEQ; const int q0=qb*QB;
  const bf16*Qw=Q+(rowbase+q0+wid*QBLK)*DM+h*D;
  const bf16*Kh=K+(rowbase+(long)j0*KVBLK)*DM+h*D,*Vh=V+(rowbase+(long)j0*KVBLK)*DM+h*D; const float*Glt=Gl+j0*KVBLK;
  const unsigned lds0=(unsigned)(uintptr_t)shm;
  float*wsf=(float*)(shm+LDS_WS)+wid*64;
  const bf16*ksrc=Kh+(long)lane*DM+wid*8;
  const bf16*vsrc=Vh+(long)(16*(wid&3)+(lane>>2))*DM+(wid>>2)*32+(lane&3)*8;
  const unsigned kdst=lds0+LDS_K+wid*1024, vdst=lds0+LDS_V+wid*1024;
  #define DMA_K(t,slot) glds16(ksrc+(long)(t)*KVBLK*DM,(unsigned)__builtin_amdgcn_readfirstlane(kdst+(slot)))
  #define DMA_V(t,slot) glds16(vsrc+(long)(t)*KVBLK*DM,(unsigned)__builtin_amdgcn_readfirstlane(vdst+(slot)))
  const int vb0=(int)(lds0+LDS_V)+((lane>>4)&1)*32+(lane&3)*8+(4*hi+((lane&15)>>2))*64;
  const char*Kbase=shm+LDS_K; bf16x8 kf[8];
  const lds_cptr shm3=(lds_cptr)shm; const lds_cptr kp0=shm3+LDS_K+hi*1024+r32*16; const lds_cptr vp0=shm3+LDS_V+((lane>>4)&1)*32+(lane&3)*8+(4*hi+((lane&15)>>2))*64;
  const int NT=(q0+QB)/KVBLK-j0;
  DMA_K(0,0);DMA_V(0,0);DMA_K(1,SLOTB);
  bf16x8 qr[4];
  #pragma unroll
  for(int d0=0;d0<4;++d0)qr[d0]=*reinterpret_cast<const bf16x8*>(&Qw[(long)r32*DM+d0*16+hi*8]);
  typedef __attribute__((address_space(3))) bf16x8* qst_ptr; const qst_ptr qst=(qst_ptr)(((__attribute__((address_space(3))) char*)shm)+LDS_OST+wid*4096)+lane;
  #pragma unroll
  for(int d0=0;d0<4;++d0)qst[d0*64]=qr[d0];
  const int qrel=wid*QBLK+r32; const float Gq=Gl[q0+qrel];
  float mhat=0.f,l_reg=0.f;f32x16 o[2];o[0]=f32x16{};o[1]=f32x16{};const f32x16 negm=f32x16{}; float base=Gq;
  #define BIAS(C0,C1,t) do{ const float*gk_=Glt+(t)*64+4*hi; _Pragma("unroll") for(int g_=0;g_<4;++g_){ SBAR(); const f32x4_t a_=*(const f32x4_t*)(gk_+8*g_), b_=*(const f32x4_t*)(gk_+32+8*g_); \
    _Pragma("unroll") for(int e_=0;e_<4;++e_){ C0[4*g_+e_]+=base-a_[e_]; C1[4*g_+e_]+=base-b_[e_]; } } SBAR(); }while(0)
  #define CMASK(P0,P1,t) do{int jb_=(t)-(NT-4); if(jb_>=0)cmask(P0,P1,jb_,qrel,hi);}while(0)
  bool resc=false;
  #define START(P0,P1) do{ const float rm=rowmax(P0,P1); resc=false; \
    { const float dl=rm; mhat=fadd_s(mhat,dl); \
      _Pragma("unroll") for(int r=0;r<16;++r){P0[r]=fsub_s(P0[r],dl);P1[r]=fsub_s(P1[r],dl);} \
      base=Gq-mhat; } \
    _Pragma("unroll") for(int r=0;r<16;++r)P0[r]=__builtin_amdgcn_exp2f(P0[r]); }while(0)
  #define RESC() do{ if(resc){ asm volatile("s_waitcnt lgkmcnt(0)":::"memory"); \
      _Pragma("unroll") for(int d_=0;d_<2;++d_) _Pragma("unroll") for(int r=0;r<16;++r)o[d_][r]*=wsf[crow(r,hi)]; } }while(0)
  f32x16 pA0,pA1,pB0,pB1;
  int sl_prev=0,sl_cur=0,sl_next=SLOTB;
  #define ROT() do{sl_prev=sl_cur;sl_cur=sl_next;sl_next=(sl_next==(NSLOT-1)*SLOTB)?0:sl_next+SLOTB;}while(0)
  DMA_K(2,2*SLOTB);
  WAIT_BAR(3);
  qkt(pA0,pA1,Kbase,qr,negm,r32,hi);BIAS(pA0,pA1,0);asm volatile("s_nop 15\n\ts_nop 7":"+v"(pA0),"+v"(pA1));CMASK(pA0,pA1,0);
  START(pA0,pA1);
  _Pragma("unroll") for(int r=0;r<16;++r)pA1[r]=__builtin_amdgcn_exp2f(pA1[r]);
  WAIT_BAR(0);
  DMA_K(3,0);DMA_V(1,SLOTB);
  ROT();
  kload8(kf,kp0+sl_cur);
  WAIT_BAR(2);
  s16x4 vlo[8],vhi[8]; u32x4 pw0,pw1,pw2,pw3;
  #define PKW(P,B) cvtpk_s(P[B],P[B+1])
  #define PAF(k) __builtin_bit_cast(bf16x8,pw##k)
  #define VFR(i) (bf16x8){vlo[i][0],vlo[i][1],vlo[i][2],vlo[i][3],vhi[i][0],vhi[i][1],vhi[i][2],vhi[i][3]}
  #define PIN(x) asm volatile("":"+v"(x))
  #define MX3(a,b,c) __builtin_fmaxf(__builtin_fmaxf((a),(b)),(c))
  #define GAPA(MF,A0,A1,A2,A3,W0,W1,PW) do{ MF; sacc+=A0; sacc+=A1; sacc+=A2; sacc+=A3; PIN(sacc); W0; W1; PIN(PW); SBAR(); }while(0)
  #define EX(v) __builtin_amdgcn_exp2f(v)
  #define GAPB(MF,X,B) do{ MF; X[B]=EX(X[B]); X[B+1]=EX(X[B+1]); X[B+2]=EX(X[B+2]); X[B+3]=EX(X[B+3]); PIN(X); SBAR(); }while(0)
  #define VRD(i) do{ vlo[i]=vtr(vp_+(((i)>>2)*4096+((i)&3)*1024)); vhi[i]=vtr(vp_+(((i)>>2)*4096+((i)&3)*1024+512)); }while(0)
  #define KRD(G,j) do{ if(G){ kload2(kf,kp0+sl_next,j); SBAR(); } }while(0)
  #define STEP(C0,C1,P0,P1,t,GK,GV,GL) do{ SBAR(); \
    const lds_cptr vp_=vp0+sl_prev; const bf16x8 q0_=qst[0],q1_=qst[64],q2_=qst[128],q3_=qst[192]; \
    VRD(0); SBAR(); float sacc=(P0[0]+P0[1]); \
    GAPA(C0=__builtin_amdgcn_mfma_f32_32x32x16_bf16(kf[0],q0_,negm,0,0,0), P0[2],P0[3],P0[4],P0[5],     pw0[0]=PKW(P0,0), pw0[1]=PKW(P0,2), pw0); \
    VRD(4); SBAR(); GAPA(C1=__builtin_amdgcn_mfma_f32_32x32x16_bf16(kf[1],q0_,negm,0,0,0), P0[6],P0[7],P0[8],P0[9],     pw0[2]=PKW(P0,4), pw0[3]=PKW(P0,6), pw0); \
    VRD(1); SBAR(); GAPA(C0=__builtin_amdgcn_mfma_f32_32x32x16_bf16(kf[2],q1_,C0,0,0,0),   P0[10],P0[11],P0[12],P0[13], pw1[0]=PKW(P0,8), pw1[1]=PKW(P0,10), pw1); \
    VRD(5); SBAR(); GAPA(C1=__builtin_amdgcn_mfma_f32_32x32x16_bf16(kf[3],q1_,C1,0,0,0),   P0[14],P0[15],P1[0],P1[1],   pw1[2]=PKW(P0,12),pw1[3]=PKW(P0,14), pw1); \
    VRD(2); SBAR(); GAPA(C0=__builtin_amdgcn_mfma_f32_32x32x16_bf16(kf[4],q2_,C0,0,0,0),   P1[2],P1[3],P1[4],P1[5],     pw2[0]=PKW(P1,0), pw2[1]=PKW(P1,2), pw2); \
    VRD(6); SBAR(); GAPA(C1=__builtin_amdgcn_mfma_f32_32x32x16_bf16(kf[5],q2_,C1,0,0,0),   P1[6],P1[7],P1[8],P1[9],     pw2[2]=PKW(P1,4), pw2[3]=PKW(P1,6), pw2); \
    VRD(3); SBAR(); GAPA(C0=__builtin_amdgcn_mfma_f32_32x32x16_bf16(kf[6],q3_,C0,0,0,0),   P1[10],P1[11],P1[12],P1[13], pw3[0]=PKW(P1,8), pw3[1]=PKW(P1,10), pw3); \
    VRD(7); SBAR(); GAPA(C1=__builtin_amdgcn_mfma_f32_32x32x16_bf16(kf[7],q3_,C1,0,0,0),   P1[14],P1[15],0.f,0.f,       pw3[2]=PKW(P1,12),pw3[3]=PKW(P1,14), pw3); \
    l_reg+=sacc; \
    if(GK){DMA_K((t)+3,sl_cur);} if(GV){DMA_V((t)+1,sl_next);} \
    BIAS(C0,C1,t); CMASK(C0,C1,t); \
    { float a=MX3(C0[0],C0[1],C1[0]),b=MX3(C0[2],C0[3],C1[1]); a=MX3(a,C1[2],C1[3]); \
      _Pragma("unroll") for(int r=4;r<16;r+=4){a=MX3(a,C0[r],C0[r+1]);b=MX3(b,C0[r+2],C0[r+3]);a=MX3(a,C1[r],C1[r+1]);b=MX3(b,C1[r+2],C1[r+3]);} \
      float rm=__builtin_fmaxf(a,b); { auto rr=__builtin_amdgcn_permlane32_swap(__float_as_uint(rm),__float_as_uint(rm),false,false); rm=__builtin_fmaxf(__uint_as_float(rr[0]),__uint_as_float(rr[1])); } \
      resc=false; \
      if(__builtin_expect(__any(rm>(float)THRL),0)){ const float dl=__builtin_fmaxf(rm,0.f); mhat+=dl; \
        _Pragma("unroll") for(int r=0;r<16;++r){C0[r]-=dl;C1[r]-=dl;} \
        base=Gq-mhat; \
        const float f=__builtin_amdgcn_exp2f(-dl); l_reg*=f; if(hi==0)wsf[r32]=f; resc=true; } } \
    SBAR(); \
    GAPB(o[0]=__builtin_amdgcn_mfma_f32_32x32x16_bf16(PAF(0),VFR(0),o[0],0,0,0), C0,0); \
    GAPB(o[1]=__builtin_amdgcn_mfma_f32_32x32x16_bf16(PAF(0),VFR(4),o[1],0,0,0), C0,4); \
    KRD(GL,0); GAPB(o[0]=__builtin_amdgcn_mfma_f32_32x32x16_bf16(PAF(1),VFR(1),o[0],0,0,0), C0,8); \
    KRD(GL,1); GAPB(o[1]=__builtin_amdgcn_mfma_f32_32x32x16_bf16(PAF(1),VFR(5),o[1],0,0,0), C0,12); \
    KRD(GL,2); GAPB(o[0]=__builtin_amdgcn_mfma_f32_32x32x16_bf16(PAF(2),VFR(2),o[0],0,0,0), C1,0); \
    KRD(GL,3); GAPB(o[1]=__builtin_amdgcn_mfma_f32_32x32x16_bf16(PAF(2),VFR(6),o[1],0,0,0), C1,4); \
    GAPB(o[0]=__builtin_amdgcn_mfma_f32_32x32x16_bf16(PAF(3),VFR(3),o[0],0,0,0), C1,8); \
    GAPB(o[1]=__builtin_amdgcn_mfma_f32_32x32x16_bf16(PAF(3),VFR(7),o[1],0,0,0), C1,12); \
    }while(0)
  int t=1;
  #undef CMASK
  #define CMASK(P0,P1,t) do{}while(0)
  for(;t+5<NT;t+=2){
    STEP(pB0,pB1,pA0,pA1,t,true,true,true);     WAIT_BAR(2); RESC(); ROT();
    STEP(pA0,pA1,pB0,pB1,t+1,true,true,true);   WAIT_BAR(2); RESC(); ROT();
  }
  #undef CMASK
  #define CMASK(P0,P1,t) do{int jb_=(t)-(NT-4); if(jb_>=0)cmask(P0,P1,jb_,qrel,hi);}while(0)
  #define ENDW(tt) do{ if((tt)+3<NT){WAIT_BAR(2);} else if((tt)+2<NT){WAIT_BAR(1);} else {WAIT_BAR(0);} }while(0)
  for(;t+1<NT;t+=2){
    STEP(pB0,pB1,pA0,pA1,t,(t+3<NT),(t+1<NT),(t+1<NT));       ENDW(t);   RESC(); ROT();
    STEP(pA0,pA1,pB0,pB1,t+1,(t+4<NT),(t+2<NT),(t+2<NT));     ENDW(t+1); RESC(); ROT();
  }
  STEP(pB0,pB1,pA0,pA1,NT-1,false,false,false); RESC();
  { float sacc=pB0[0]+pB0[1]; _Pragma("unroll") for(int r=2;r<16;++r)sacc+=pB0[r]; _Pragma("unroll") for(int r=0;r<16;++r)sacc+=pB1[r]; l_reg+=sacc;
    pw0=(u32x4){PKW(pB0,0),PKW(pB0,2),PKW(pB0,4),PKW(pB0,6)};pw1=(u32x4){PKW(pB0,8),PKW(pB0,10),PKW(pB0,12),PKW(pB0,14)};pw2=(u32x4){PKW(pB1,0),PKW(pB1,2),PKW(pB1,4),PKW(pB1,6)};pw3=(u32x4){PKW(pB1,8),PKW(pB1,10),PKW(pB1,12),PKW(pB1,14)};
    SBAR(); pv(o,vb0+sl_cur,PAF(0),PAF(1),PAF(2),PAF(3)); }
  #undef PKW
  #undef PAF
  #undef VFR
  #undef PIN
  #undef MX3
  #undef GAPA
  #undef GAPB
  #undef EX
  #undef VRD
  #undef KRD
  #undef STEP
  #undef ENDW
  {auto rr=__builtin_amdgcn_permlane32_swap(__float_as_uint(l_reg),__float_as_uint(l_reg),false,false);l_reg=__uint_as_float(rr[0])+__uint_as_float(rr[1]);}
  if(hi==0)wsf[32+r32]=l_reg;asm volatile("s_waitcnt lgkmcnt(0)":::"memory");
  float rli[16];
  #pragma unroll
  for(int r=0;r<16;++r)rli[r]=__builtin_amdgcn_rcpf(wsf[32+crow(r,hi)]);
  bf16*Ow=O+(rowbase+q0+wid*QBLK)*DM+h*D;
  { bf16*stg=(bf16*)(shm+LDS_OST)+wid*2048;
    #pragma unroll
    for(int r=0;r<16;++r){const int orow=crow(r,hi);
      #pragma unroll
      for(int d0=0;d0<2;++d0)stg[orow*64+d0*32+r32]=__float2bfloat16(o[d0][r]*rli[r]);}
    asm volatile("s_waitcnt lgkmcnt(0)":::"memory");
    #pragma unroll
    for(int i=0;i<4;++i){const int row=i*8+(lane>>3),ch=lane&7; const u32x4 v=*(const u32x4*)(stg+row*64+ch*8); ATTN_STORE16(Ow+(long)row*DM+ch*8,v);} }
  asm volatile("s_waitcnt lgkmcnt(0)\n\ts_barrier":::"memory");
  #undef DMA_K
  #undef DMA_V
  #undef CMASK
  #undef BIAS
  #undef START
  #undef RESC
  #undef ROT
}
constexpr int ATTN_LDS_BYTES=LDS_BYTES;
#undef SBAR
#undef WAIT_BAR
}

namespace sbk {
using bf16x8=__attribute__((ext_vector_type(8)))short;
using s16x4=__attribute__((ext_vector_type(4)))short;
using f32x16=__attribute__((ext_vector_type(16)))float;
constexpr int WLDS=12288;
constexpr float R_STOP=48.0f;
__device__ __forceinline__ int crow(int r,int hi){return (r&3)+8*(r>>2)+4*hi;}
__device__ __forceinline__ unsigned cvtpk(float lo,float hi){typedef float f2 __attribute__((ext_vector_type(2)));typedef __bf16 b2 __attribute__((ext_vector_type(2)));f2 v={lo,hi};b2 b=__builtin_convertvector(v,b2);return __builtin_bit_cast(unsigned,b);}
__device__ __forceinline__ void pv(f32x16*o,int vb,bf16x8 pa0,bf16x8 pa1,bf16x8 pa2,bf16x8 pa3){
  #pragma unroll
  for(int d0=0;d0<2;++d0){s16x4 lo[4],hi[4];
    #pragma unroll
    for(int ks=0;ks<4;++ks){
      asm volatile("ds_read_b64_tr_b16 %0,%1 offset:%c2":"=&v"(lo[ks]):"v"(vb),"i"(d0*4096+ks*1024):"memory");
      asm volatile("ds_read_b64_tr_b16 %0,%1 offset:%c2":"=&v"(hi[ks]):"v"(vb),"i"(d0*4096+ks*1024+512):"memory");}
    asm volatile("s_waitcnt lgkmcnt(0)":::"memory");__builtin_amdgcn_sched_barrier(0);
    #define PK(k) (bf16x8){lo[k][0],lo[k][1],lo[k][2],lo[k][3],hi[k][0],hi[k][1],hi[k][2],hi[k][3]}
    o[d0]=__builtin_amdgcn_mfma_f32_32x32x16_bf16(pa0,PK(0),o[d0],0,0,0);
    o[d0]=__builtin_amdgcn_mfma_f32_32x32x16_bf16(pa1,PK(1),o[d0],0,0,0);
    o[d0]=__builtin_amdgcn_mfma_f32_32x32x16_bf16(pa2,PK(2),o[d0],0,0,0);
    o[d0]=__builtin_amdgcn_mfma_f32_32x32x16_bf16(pa3,PK(3),o[d0],0,0,0);
    #undef PK
  }
}
__device__ __forceinline__ float sp2(float z){ return fmaxf(z,0.f)+__builtin_amdgcn_logf(1.0f+__builtin_amdgcn_exp2f(-fabsf(z))); }
__device__ __forceinline__ void sb_unit(int b,int h,int tb,const bf16_t*Q,const bf16_t*K,const bf16_t*V,bf16_t*O,char*wl,int lane){
  const int r32=lane&31,hi=lane>>5,t0=tb*32; const long rowbase=(long)b*SEQ; const int co=512+h*64;
  const bf16_t*Qw=Q+(rowbase+t0)*DM+co;
  bf16x8 qr[4];
  #pragma unroll
  for(int d0=0;d0<4;++d0)qr[d0]=*reinterpret_cast<const bf16x8*>(Qw+(long)r32*DM+d0*16+hi*8);
  f32x16 o[2];o[0]=f32x16{};o[1]=f32x16{};float R=0.f;
  const int vb=(int)(unsigned)(uintptr_t)wl+((lane>>4)&1)*32+(lane&3)*8+(4*hi+((lane&15)>>2))*64;
  bf16x8 kf[8]; u32x4 vr[8];
  #define SB_LOADK(jj) do{ const int s0_=(jj)*64; const bf16_t*Kp=K+(rowbase+s0_+r32)*DM+co+hi*8; \
    _Pragma("unroll") for(int d0=0;d0<4;++d0){kf[2*d0]=*reinterpret_cast<const bf16x8*>(Kp+d0*16);kf[2*d0+1]=*reinterpret_cast<const bf16x8*>(Kp+(long)32*DM+d0*16);} }while(0)
  #define SB_LOADV(jj) do{ const int s0_=(jj)*64; \
    _Pragma("unroll") for(int p=0;p<8;++p)vr[p]=*reinterpret_cast<const u32x4*>(V+(rowbase+s0_+16*(p&3)+(lane>>2))*DM+co+(p>>2)*32+(lane&3)*8); }while(0)
  SB_LOADK(t0>>6);
  for(int j=t0>>6;j>=0;--j){
    const int s0=j*64;
    SB_LOADV(j);
    f32x16 z0=f32x16{},z1=f32x16{};
    #pragma unroll
    for(int d0=0;d0<4;++d0){z0=__builtin_amdgcn_mfma_f32_32x32x16_bf16(kf[2*d0],qr[d0],z0,0,0,0);z1=__builtin_amdgcn_mfma_f32_32x32x16_bf16(kf[2*d0+1],qr[d0],z1,0,0,0);}
    #pragma unroll
    for(int p=0;p<8;++p)*reinterpret_cast<u32x4*>(wl+p*1024+lane*16)=vr[p];
    int rel=((j==(t0>>6))?(t0-s0+r32):1000)-4*hi; asm volatile("":"+v"(rel));
    f32x16 L0,L1;
    #pragma unroll
    for(int r=0;r<16;++r){const int kv=(r&3)+8*(r>>2); L0[r]=(kv<rel)?sp2(z0[r]):0.f; L1[r]=(kv+32<rel)?sp2(z1[r]):0.f;}
    float T[8]; f32x16 E0,E1;
    #pragma unroll
    for(int i=0;i<4;++i){
      E0[4*i+3]=0.f;E0[4*i+2]=L0[4*i+3];E0[4*i+1]=E0[4*i+2]+L0[4*i+2];E0[4*i]=E0[4*i+1]+L0[4*i+1];T[i]=E0[4*i]+L0[4*i];
      E1[4*i+3]=0.f;E1[4*i+2]=L1[4*i+3];E1[4*i+1]=E1[4*i+2]+L1[4*i+2];E1[4*i]=E1[4*i+1]+L1[4*i+1];T[4+i]=E1[4*i]+L1[4*i];}
    float X[8];
    #pragma unroll
    for(int i=0;i<8;++i)X[i]=__shfl_xor(T[i],32);
    float S[8]; float run=0.f;
    #pragma unroll
    for(int i=7;i>=0;--i){
      const float g_hi=hi?T[i]:X[i];
      const float g_lo=hi?X[i]:T[i];
      S[i]=hi?run:(run+g_hi);
      run+=g_hi+g_lo; }
    const float Ttot=run;
    #pragma unroll
    for(int i=0;i<4;++i){
      #pragma unroll
      for(int e=0;e<4;++e){E0[4*i+e]+=S[i];E1[4*i+e]+=S[4+i];}}
    f32x16 P0,P1;
    #pragma unroll
    for(int r=0;r<16;++r){const int kv=(r&3)+8*(r>>2);
      P0[r]=(kv<rel)?__builtin_amdgcn_exp2f(z0[r]-L0[r]-E0[r]-R):0.f;
      P1[r]=(kv+32<rel)?__builtin_amdgcn_exp2f(z1[r]-L1[r]-E1[r]-R):0.f;}
    R+=Ttot;
    u32x4 pw0,pw1,pw2,pw3;
    pw0=(u32x4){cvtpk(P0[0],P0[1]),cvtpk(P0[2],P0[3]),cvtpk(P0[4],P0[5]),cvtpk(P0[6],P0[7])};
    pw1=(u32x4){cvtpk(P0[8],P0[9]),cvtpk(P0[10],P0[11]),cvtpk(P0[12],P0[13]),cvtpk(P0[14],P0[15])};
    pw2=(u32x4){cvtpk(P1[0],P1[1]),cvtpk(P1[2],P1[3]),cvtpk(P1[4],P1[5]),cvtpk(P1[6],P1[7])};
    pw3=(u32x4){cvtpk(P1[8],P1[9]),cvtpk(P1[10],P1[11]),cvtpk(P1[12],P1[13]),cvtpk(P1[14],P1[15])};
    asm volatile("s_waitcnt lgkmcnt(0)":::"memory");
    if(j>0)SB_LOADK(j-1);
    pv(o,vb,__builtin_bit_cast(bf16x8,pw0),__builtin_bit_cast(bf16x8,pw1),__builtin_bit_cast(bf16x8,pw2),__builtin_bit_cast(bf16x8,pw3));
    if(__all(R>R_STOP))break;
  }
  #undef SB_LOADK
  #undef SB_LOADV
  bf16_t*Ow=O+(rowbase+t0)*DM+co;
  { bf16_t*stg=(bf16_t*)(wl+8192);
    #pragma unroll
    for(int r=0;r<16;++r){const int orow=crow(r,hi);
      #pragma unroll
      for(int d0=0;d0<2;++d0)stg[orow*64+d0*32+r32]=(bf16_t)f2bf(o[d0][r]);}
    asm volatile("s_waitcnt lgkmcnt(0)":::"memory");
    #pragma unroll
    for(int i=0;i<4;++i){const int row=i*8+(lane>>3),ch=lane&7; const u32x4 v=*(const u32x4*)(stg+row*64+ch*8); *(u32x4*)(Ow+(long)row*DM+ch*8)=v;}
    asm volatile("s_waitcnt lgkmcnt(0)":::"memory"); }
}
}

constexpr int ATT_G_OFF = attn_body::ATTN_LDS_BYTES, ATT_RED_OFF = ATT_G_OFF + SEQ * 4;
__device__ __forceinline__ void fox_scan_G(const float* FA, int b, int h, float* Gl, float* red, int tid, int lane, int wave) {
    float v[8]; float run = 0.f;
#pragma unroll
    for (int j = 0; j < 8; ++j) { run += FA[((size_t)b * SEQ + 8 * tid + j) * 8 + h] * LOG2E; v[j] = run; }
    float inc = run;
#pragma unroll
    for (int o = 1; o < 64; o <<= 1) { const float n = __shfl_up(inc, o); if (lane >= o) inc += n; }
    if (lane == 63) red[wave] = inc;
    __syncthreads();
    float off = inc - run;
    for (int w = 0; w < wave; ++w) off += red[w];
#pragma unroll
    for (int j = 0; j < 8; ++j) Gl[8 * tid + j] = off + v[j];
    __syncthreads();
}
template <int PARTS = 3>
__device__ __forceinline__ void ph_attn(const Prm& p, const Ctx& C, int l, unsigned char* lds, size_t o_off = WS_QQ) {
    const int G = gridDim.x, bx = blockIdx.x; const int vcu = (G % 8 == 0) ? (bx % 8) * (G / 8) + bx / 8 : bx;
    const attn_body::bf16* Q = (const attn_body::bf16*)(p.ws + WS_QQ); const attn_body::bf16* K = (const attn_body::bf16*)(p.ws + WS_KK); const attn_body::bf16* V = (const attn_body::bf16*)(p.ws + WS_VV);
    float* Gl = (float*)(lds + ATT_G_OFF); float* red = (float*)(lds + ATT_RED_OFF);
    int cur_bh = -1;
    float Bq;
    { float mq = fabsf(p.gq[l * HD + C.lane]), mk = fabsf(p.gk[l * HD + C.lane]);
#pragma unroll
      for (int o = 1; o < 64; o <<= 1) { mq = fmaxf(mq, __shfl_xor(mq, o)); mk = fmaxf(mk, __shfl_xor(mk, o)); }
      Bq = 1.02f * C2 * 64.0f * mq * mk; }
    unsigned* qcnt = (unsigned*)(p.ws + WS_CTL) + 3584 + l * 8 * 64;
    unsigned* uslot = (unsigned*)(lds + ATT_RED_OFF + 64);
    for (int qi = 0; qi < 8; ++qi) {
        const int qx = (bx + qi) & 7;
        for (;;) {
            __syncthreads();
            if (C.tid == 0) *uslot = __hip_atomic_fetch_add(qcnt + 64 * qx, 1u, __ATOMIC_RELAXED, __HIP_MEMORY_SCOPE_AGENT);
            __syncthreads();
            const unsigned u = *uslot;
            if (u >= 256u) break;
            if (u < 128u) {
                if (!(PARTS & 1)) continue;
                const int qb = 15 - (int)(u >> 3), bh = qx * NH + (int)(u & 7);
                if (bh != cur_bh) { __syncthreads(); fox_scan_G((const float*)(p.ws + WS_FA), bh / NH, bh % NH, Gl, red, C.tid, C.lane, C.wave); cur_bh = bh; }
                const int ntf = 4 * qb + 4; const float thr = Gl[qb * 256] + 2.0f * Bq + 48.0f;
                const bool skp = (C.lane < ntf - 4) && (Gl[64 * C.lane + 63] > thr);
                const int j0 = __builtin_popcountll(__ballot(skp)) & ~1;
                attn_body::attn_unit<8>(bh / NH, bh % NH, qb, Q, K, V, (attn_body::bf16*)(p.ws + o_off), (char*)lds, Gl, j0);
            } else {
                if (!(PARTS & 2)) continue;
                const int v = (int)u - 128, h = v & 7, g = 15 - (v >> 3);
                cur_bh = -1;
                int lane_ = C.lane; asm volatile("" : "+v"(lane_));
                sbk::sb_unit(qx, h, 8 * g + C.wave, (const bf16_t*)(p.ws + WS_QQ), (const bf16_t*)(p.ws + WS_KK), (const bf16_t*)(p.ws + WS_VV), (bf16_t*)(p.ws + o_off), (char*)lds + C.wave * sbk::WLDS, lane_);
            }
        }
    }
    __syncthreads();
}

namespace pgk {
typedef __bf16 bf16x2 __attribute__((ext_vector_type(2)));
__device__ __forceinline__ float dot2(unsigned a, unsigned b, float c) { return __builtin_amdgcn_fdot2_f32_bf16(__builtin_bit_cast(bf16x2, a), __builtin_bit_cast(bf16x2, b), c, false); }
__device__ __forceinline__ unsigned cvtpk(float lo, float hi) { typedef float f2 __attribute__((ext_vector_type(2))); f2 v = {lo, hi}; bf16x2 b = __builtin_convertvector(v, bf16x2); return __builtin_bit_cast(unsigned, b); }
}
namespace tk {
using bf16x8 = __attribute__((ext_vector_type(8))) short;
using f32x16 = __attribute__((ext_vector_type(16))) float;
constexpr int NCAND = 50;
__device__ __forceinline__ unsigned f2key(float f) { const unsigned u = __float_as_uint(f); return u ^ ((unsigned)((int)u >> 31) | 0x80000000u); }
__device__ __forceinline__ float key2f(unsigned k) { return __uint_as_float(k ^ ~((unsigned)((int)k >> 31) >> 1)); }
#define TK_CE(a, b) do { const unsigned mx_ = (a) > (b) ? (a) : (b), mn_ = (a) > (b) ? (b) : (a); (a) = mx_; (b) = mn_; } while (0)
template <int N> __device__ __forceinline__ void sort_desc(unsigned (&k)[N]) {
#pragma unroll
    for (int size = 2; size <= N; size <<= 1) {
#pragma unroll
        for (int stride = size >> 1; stride > 0; stride >>= 1) {
#pragma unroll
            for (int i = 0; i < N; ++i) { const int j = i ^ stride; if (j > i) { if ((i & size) == 0 || size == N) TK_CE(k[i], k[j]); else TK_CE(k[j], k[i]); } }
        }
    }
}
__device__ __forceinline__ void merge_desc16(unsigned (&k)[16]) {
#pragma unroll
    for (int stride = 8; stride > 0; stride >>= 1) {
#pragma unroll
        for (int i = 0; i < 16; ++i) { const int j = i ^ stride; if (j > i) TK_CE(k[i], k[j]); }
    }
}
__device__ __forceinline__ void top16_merge(unsigned (&a)[16], const unsigned (&b)[16]) {
#pragma unroll
    for (int i = 0; i < 16; ++i) a[i] = a[i] > b[15 - i] ? a[i] : b[15 - i];
    merge_desc16(a);
}
__device__ __forceinline__ void xlane_merge(unsigned (&a)[16]) {
    unsigned o[16];
#pragma unroll
    for (int i = 0; i < 16; ++i) o[i] = (unsigned)__shfl_xor((int)a[i], 32);
    top16_merge(a, o);
}
__device__ __forceinline__ void half_top16(const f32x16 (&z)[4], int c4, unsigned (&out)[16]) {
    unsigned k[4][16];
#pragma unroll
    for (int blk = 0; blk < 4; ++blk)
#pragma unroll
        for (int r = 0; r < 16; ++r) k[blk][r] = (f2key(z[blk][r]) & ~127u) | (unsigned)((127 - 32 * blk - (r & 3) - 8 * (r >> 2)) - c4);
#pragma unroll
    for (int blk = 0; blk < 4; ++blk) sort_desc<16>(k[blk]);
    top16_merge(k[0], k[1]); top16_merge(k[2], k[3]); top16_merge(k[0], k[2]);
    xlane_merge(k[0]);
#pragma unroll
    for (int i = 0; i < 16; ++i) out[i] = k[0][i];
}
}

__device__ __forceinline__ void ph_topk(const Prm& p, const Ctx& C, int l, unsigned char* lds) {
    constexpr int TA[64] = {0,0,0,0,0,0,0,0,0,0,0,0,0,0,0,0,1,1,1,1,1,1,1,1,2,2,2,2,2,3,3,3,3,4,4,4,5,5,6,6,7,7,8,9,10,11,12,13,14,15,0,0,0,0,0,0,0,0,0,0,0,0,0,0};
    constexpr int TB[64] = {0,1,2,3,4,5,6,7,8,9,10,11,12,13,14,15,0,1,2,3,4,5,6,7,0,1,2,3,4,0,1,2,3,0,1,2,0,1,0,1,0,1,0,0,0,0,0,0,0,0,0,0,0,0,0,0,0,0,0,0,0,0,0,0};
    const bf16_t* QP = (const bf16_t*)(p.ws + WS_KK); unsigned short* IDX = (unsigned short*)(p.ws + WS_VV); float* PW = (float*)(p.ws + WS_VV + 16 * MiB);
    const int lane = C.lane, r32 = lane & 31, hi = lane >> 5;
    int c4 = 4 * hi; asm volatile("" : "+v"(c4));
    unsigned char* wtab = lds + 32768 + C.wave * 1024 + r32 * 32;
    for (int item = blockIdx.x; item < 256; item += gridDim.x) {
        const int h = item & 7, tg = item >> 3;
        __syncthreads();
        for (int c = C.tid; c < 2048; c += NTHREADS) {
            const int tbl = c >> 10, row = (c >> 3) & 127, ch = c & 7;
            const float* src = (tbl ? p.k2 : p.k1) + ((size_t)(l * NH + h) * NKEYS + row) * 64 + ch * 8;
            const f32x4 a = *(const f32x4*)src, b = *(const f32x4*)(src + 4);
            u32x4 o; o.x = pgk::cvtpk(a.x, a.y); o.y = pgk::cvtpk(a.z, a.w); o.z = pgk::cvtpk(b.x, b.y); o.w = pgk::cvtpk(b.z, b.w);
            *(u32x4*)(lds + tbl * 16384 + row * 128 + ((ch ^ (row & 7)) << 4)) = o;
        }
        __syncthreads();
#pragma unroll 1
        for (int i = 0; i < 4; ++i) {
            const int tile = tg * 32 + C.wave * 4 + i, t = tile * 32 + r32;
            const bf16_t* qrow = QP + (size_t)t * DM + h * 128 + 8 * hi;
            unsigned V1[16], V2[16];
#pragma unroll
            for (int half = 0; half < 2; ++half) {
                tk::bf16x8 qf[4];
#pragma unroll
                for (int ks = 0; ks < 4; ++ks) qf[ks] = *(const tk::bf16x8*)(qrow + half * 64 + 16 * ks);
                tk::f32x16 z[4];
#pragma unroll
                for (int blk = 0; blk < 4; ++blk) {
                    z[blk] = tk::f32x16{};
                    const int row = 32 * blk + r32;
#pragma unroll
                    for (int ks = 0; ks < 4; ++ks) {
                        const tk::bf16x8 kfr = *(const tk::bf16x8*)(lds + half * 16384 + row * 128 + (((2 * ks + hi) ^ (row & 7)) << 4));
                        z[blk] = __builtin_amdgcn_mfma_f32_32x32x16_bf16(kfr, qf[ks], z[blk], 0, 0, 0);
                    }
                }
                if (half == 0) tk::half_top16(z, c4, V1); else tk::half_top16(z, c4, V2);
            }
            { u32x4 w;
              unsigned n[16];
#pragma unroll
              for (int q = 0; q < 16; ++q) n[q] = 127u - ((hi ? V2[q] : V1[q]) & 127u);
              w.x = n[0] | (n[1] << 8) | (n[2] << 16) | (n[3] << 24); w.y = n[4] | (n[5] << 8) | (n[6] << 16) | (n[7] << 24);
              w.z = n[8] | (n[9] << 8) | (n[10] << 16) | (n[11] << 24); w.w = n[12] | (n[13] << 8) | (n[14] << 16) | (n[15] << 24);
              *(u32x4*)(wtab + 16 * hi) = w; }
            float f1[16], f2[16];
#pragma unroll
            for (int q = 0; q < 16; ++q) { f1[q] = tk::key2f(V1[q] & ~127u); f2[q] = tk::key2f(V2[q] & ~127u); }
            unsigned ca[16], cb[16];
#pragma unroll
            for (int s = 0; s < 32; ++s) {
                const float v0 = f1[TA[s]] + f2[TB[s]];
                const float v1 = (32 + s < tk::NCAND) ? f1[TA[32 + s]] + f2[TB[32 + s]] : -INFINITY;
                const unsigned j0 = 255u - (unsigned)(TA[s] * 16 + TB[s]), j1 = 255u - (unsigned)(TA[32 + s] * 16 + TB[32 + s]);
                const unsigned key = (tk::f2key(hi ? v1 : v0) & ~255u) | (hi ? j1 : j0);
                if (s < 16) ca[s] = key; else cb[s - 16] = key;
            }
            tk::sort_desc<16>(ca); tk::sort_desc<16>(cb); tk::top16_merge(ca, cb); tk::xlane_merge(ca);
            float e[16]; float sum = 0.f; const float mx = tk::key2f(ca[0] & ~255u);
#pragma unroll
            for (int q = 0; q < 16; ++q) { e[q] = __builtin_amdgcn_exp2f((tk::key2f(ca[q] & ~255u) - mx) * LOG2E); sum += e[q]; }
            const float inv = 1.0f / sum;
            int eo[8]; float go[8];
            asm volatile("s_waitcnt lgkmcnt(0)" ::: "memory");
#pragma unroll
            for (int q = 0; q < 8; ++q) {
                const unsigned kq = hi ? ca[8 + q] : ca[q]; const unsigned j = 255u - (kq & 255u);
                const unsigned n1 = wtab[j >> 4], n2 = wtab[16 + (j & 15)];
                eo[q] = (int)(n1 * NKEYS + n2); go[q] = (hi ? e[8 + q] : e[q]) * inv;
            }
            unsigned short* ip = IDX + (size_t)t * 128 + h * 16 + 8 * hi; float* gp = PW + (size_t)t * 128 + h * 16 + 8 * hi;
            *(u32x4*)ip = (u32x4){(unsigned)eo[0] | ((unsigned)eo[1] << 16), (unsigned)eo[2] | ((unsigned)eo[3] << 16), (unsigned)eo[4] | ((unsigned)eo[5] << 16), (unsigned)eo[6] | ((unsigned)eo[7] << 16)};
            *(f32x4*)gp = (f32x4){go[0], go[1], go[2], go[3]}; *(f32x4*)(gp + 4) = (f32x4){go[4], go[5], go[6], go[7]};
            asm volatile("s_waitcnt lgkmcnt(0)" ::: "memory");
        }
    }
    __syncthreads();
}


constexpr size_t WS_T8 = WS_UB;
constexpr size_t WS_SC8 = WS_K12;
typedef float f32x2 __attribute__((ext_vector_type(2)));
typedef short s16x4 __attribute__((ext_vector_type(4))); typedef int i32x4 __attribute__((ext_vector_type(4))); typedef int i32x2 __attribute__((ext_vector_type(2)));
#define GAS __attribute__((address_space(1)))
#define LAS __attribute__((address_space(3)))
#define XB_TMO      128
#define XB_XCNT(j)  (256  + 64 * (j))
#define XB_XSUB(j)  (1280 + 64 * (j))
#define XB_XGEN(j)  (2304 + 64 * (j))
#define XB_TOP      3328
#define XB_TOPGEN   3392
#define XCD_BAR_WORDS 3456
#define XB_SPIN_CAP (1u << 18)

__device__ __forceinline__ unsigned xb_ld(unsigned* p)              { return __hip_atomic_load(p, __ATOMIC_RELAXED, __HIP_MEMORY_SCOPE_AGENT); }
__device__ __forceinline__ unsigned xb_add(unsigned* p, unsigned v) { return __hip_atomic_fetch_add(p, v, __ATOMIC_RELAXED, __HIP_MEMORY_SCOPE_AGENT); }
__device__ __forceinline__ unsigned xb_xcc_id() { return (unsigned)__builtin_amdgcn_s_getreg((3 << 11) | 20) & 0xFu; }
#define XB_SPIN(cond, bar) do { unsigned _sp = 0; while (cond) { __builtin_amdgcn_s_sleep(1); \
    if ((++_sp & 255u) == 0u) { if (xb_ld(&(bar)[XB_TMO])) break; if (_sp > XB_SPIN_CAP) { atomicAdd(&(bar)[XB_TMO], 1u); break; } } } } while (0)

struct XcdBarrier {
    unsigned* bar; unsigned x;
    volatile LAS unsigned* st;
};

__device__ __forceinline__ XcdBarrier xcd_barrier_post(unsigned* bar, volatile LAS unsigned* st) {
    XcdBarrier b; b.bar = bar; b.x = xb_xcc_id(); b.st = st;
    if (threadIdx.x == 0) st[2] = xb_add(&bar[XB_XCNT(b.x)], 1u);
    return b;
}
__device__ __forceinline__ void xcd_barrier_complete(unsigned* bar, unsigned x, unsigned& nloc, unsigned& nx) {
    const unsigned G = gridDim.x * gridDim.y * gridDim.z;
    unsigned sum, cnt, mine, sp = 0u;
    for (;;) {
        sum = 0u; cnt = 0u; mine = 0u;
#pragma unroll
        for (unsigned j = 0; j < 16; ++j) { const unsigned c = xb_ld(&bar[XB_XCNT(j)]); sum += c; cnt += (c > 0u) ? 1u : 0u; mine = (j == x) ? c : mine; }
        if (sum == G) break;
        __builtin_amdgcn_s_sleep(1);
        if ((++sp & 255u) == 0u) { if (xb_ld(&bar[XB_TMO])) break; if (sp > XB_SPIN_CAP) { atomicAdd(&bar[XB_TMO], 1u); break; } }
    }
    nloc = mine > 0u ? mine : 1u; nx = cnt > 0u ? cnt : 1u;
}

__device__ __forceinline__ void xcd_barrier(const XcdBarrier& b) {
    asm volatile("s_waitcnt vmcnt(0)" ::: "memory");
    __syncthreads();
    if (threadIdx.x == 0) {
        unsigned* bar = b.bar;
        __builtin_amdgcn_s_waitcnt(0);
        unsigned nloc = b.st[0], nx = b.st[1];
        if (nloc == 0u) { xcd_barrier_complete(bar, b.x, nloc, nx); b.st[0] = nloc; b.st[1] = nx; }
        const unsigned old = xb_add(&bar[XB_XSUB(b.x)], 1u);
        const unsigned gen = old / nloc;
        if (old + 1u == (gen + 1u) * nloc) {
            __builtin_amdgcn_fence(__ATOMIC_RELEASE, "agent");
            asm volatile("s_waitcnt vmcnt(0)" ::: "memory");
            const unsigned og = xb_add(&bar[XB_TOP], 1u);
            const unsigned tg = og / nx;
            if (og + 1u == (tg + 1u) * nx) xb_add(&bar[XB_TOPGEN], 1u);
            else XB_SPIN(xb_ld(&bar[XB_TOPGEN]) == tg, bar);
            __builtin_amdgcn_fence(__ATOMIC_ACQUIRE, "agent");
            xb_add(&bar[XB_XGEN(b.x)], 1u);
            asm volatile("s_waitcnt vmcnt(0)" ::: "memory");
        } else {
            XB_SPIN(xb_ld(&bar[XB_XGEN(b.x)]) == gen, bar);
            __builtin_amdgcn_fence(__ATOMIC_ACQUIRE, "agent");
            asm volatile("s_waitcnt vmcnt(0)" ::: "memory");
        }
    }
    __syncthreads();
}


constexpr size_t WS_PD = WS_GT;
template <int CTRL> __device__ __forceinline__ int dpp_i(int v) { return __builtin_amdgcn_update_dpp(0, v, CTRL, 0xF, 0xF, true); }
template <int CTRL> __device__ __forceinline__ float dpp_f(float v) { return __int_as_float(__builtin_amdgcn_update_dpp(0, __float_as_int(v), CTRL, 0xF, 0xF, true)); }
__device__ __forceinline__ void ph_convert_tables8s(const Prm& p, const Ctx& C) {
    unsigned char* T8 = p.ws + WS_T8; float* SC = (float*)(p.ws + WS_SC8);
    constexpr int NR = 2 * 2 * NEXP;
    f32x4 v[2][2][4];
#define CV_LOAD(s_, row0_) do { _Pragma("unroll") for (int r = 0; r < 2; ++r) { const int row = min((row0_) + r * C.ngw, NR - 1); const int lt = row >> 14, e = row & (NEXP - 1), l = lt >> 1, tbl = lt & 1; \
        const float* src = (tbl ? p.pv : p.pu) + ((size_t)l * NEXP + e) * DM + 4 * C.lane; _Pragma("unroll") for (int j = 0; j < 4; ++j) v[s_][r][j] = *(const f32x4*)(src + 256 * j); } } while (0)
#define CV_PROC(s_, row0_) do { _Pragma("unroll") for (int r = 0; r < 2; ++r) { const int row = (row0_) + r * C.ngw; if (row >= NR) break; const int lt = row >> 14, e = row & (NEXP - 1); \
        float am = 0.f; _Pragma("unroll") for (int j = 0; j < 4; ++j) am = fmaxf(am, fmaxf(fmaxf(fabsf(v[s_][r][j].x), fabsf(v[s_][r][j].y)), fmaxf(fabsf(v[s_][r][j].z), fabsf(v[s_][r][j].w)))); \
        am = fmaxf(am, dpp_f<0xB1>(am)); am = fmaxf(am, dpp_f<0x4E>(am)); am = fmaxf(am, dpp_f<0x141>(am)); am = fmaxf(am, dpp_f<0x140>(am)); am = fmaxf(am, __shfl_xor(am, 16)); am = fmaxf(am, __shfl_xor(am, 32)); \
          \
        const float qm = 7.0f / 0.75f, sc = am > 0.f ? am / qm : 1.0f, inv = am > 0.f ? qm / am : 0.f; \
        const int o8 = (lt & 1) ? 8 : 0;     \
        _Pragma("unroll") for (int j = 0; j < 4; ++j) {     \
            const int q0 = (int)fminf(fmaxf(rintf(v[s_][r][j].x * inv), -8.0f), 7.0f), q1 = (int)fminf(fmaxf(rintf(v[s_][r][j].y * inv), -8.0f), 7.0f), q2 = (int)fminf(fmaxf(rintf(v[s_][r][j].z * inv), -8.0f), 7.0f), q3 = (int)fminf(fmaxf(rintf(v[s_][r][j].w * inv), -8.0f), 7.0f); \
            const int o_ = C.lane < 32 ? o8 : 0; const unsigned mine = (unsigned)(((q0 + o_) & 15) | (((q1 + o_) & 15) << 8) | (((q2 + o_) & 15) << 16) | (((q3 + o_) & 15) << 24)); \
            const unsigned other = (unsigned)__shfl_xor((int)mine, 32); \
            if (C.lane < 32) *(unsigned*)(T8 + (((size_t)lt * 8 + j) * NEXP + e) * 128 + 4 * C.lane) = mine | (other << 4); } \
        if (C.lane == 0) SC[row] = sc; } } while (0)
    CV_LOAD(0, C.gw);
    __builtin_amdgcn_s_waitcnt(0x0F70);
#pragma unroll 1
    for (int row0 = C.gw; row0 < NR; row0 += 4 * C.ngw) {
        CV_LOAD(1, row0 + 2 * C.ngw); CV_PROC(0, row0);
        CV_LOAD(0, row0 + 4 * C.ngw); CV_PROC(1, row0 + 2 * C.ngw);
    }
#undef CV_LOAD
#undef CV_PROC
}
__device__ __forceinline__ float sum8(float v) { v += dpp_f<0xB1>(v); v += dpp_f<0x4E>(v); v += dpp_f<0x141>(v); return v; }
__device__ __forceinline__ float xsum32(float a, float b) { const auto r = __builtin_amdgcn_permlane32_swap(__float_as_uint(a), __float_as_uint(b), false, false); return __uint_as_float(r[0]) + __uint_as_float(r[1]); }
__device__ __forceinline__ float xsum16(float a, float b) { const auto r = __builtin_amdgcn_permlane16_swap(__float_as_uint(a), __float_as_uint(b), false, false); return __uint_as_float(r[0]) + __uint_as_float(r[1]); }
template <int JS> __device__ __forceinline__ unsigned bcast8(unsigned v, int jq) {
    constexpr int c = JS & 3, ctrl = c | (c << 2) | (c << 4) | (c << 6);
    const unsigned v1 = (unsigned)__builtin_amdgcn_update_dpp(0, (int)v, ctrl, 0xF, 0xF, true);
    const unsigned v2 = (unsigned)__builtin_amdgcn_update_dpp(0, (int)v1, 0x141, 0xF, 0xF, true);
    return (jq == (JS >> 2)) ? v1 : v2;
}
template <int BB> __device__ __forceinline__ unsigned pick_id(unsigned idw, int jq) { const unsigned w = bcast8<(BB >> 1)>(idw, jq); return (BB & 1) ? (w >> 16) : (w & 0xffffu); }
template <int G4> __device__ __forceinline__ int bcast4(unsigned v) { constexpr int ctrl = G4 | (G4 << 2) | (G4 << 4) | (G4 << 6); return __builtin_amdgcn_update_dpp(0, (int)v, ctrl, 0xF, 0xF, true); }
struct SliceCtx { int x, wq, nwq; };
#ifndef SLICE_BY_XCC
#define SLICE_BY_XCC 0
#endif
__device__ __forceinline__ SliceCtx slice_ctx(const Ctx& C, const Prm& p, unsigned char* lds) { SliceCtx s; const int G = gridDim.x;
    if (SLICE_BY_XCC) { const unsigned x = xb_xcc_id() & 7u; const unsigned* bar = (const unsigned*)(p.ws + WS_CTL); const volatile LAS unsigned* st = (const volatile LAS unsigned*)((LAS unsigned char*)lds + (LDS_BYTES - 64));
        s.x = (int)x; s.wq = (int)st[2] * NWAVES + C.wave; s.nwq = (int)xb_ld((unsigned*)&bar[XB_XCNT(x)]) * NWAVES; return s; }
    s.x = blockIdx.x & 7; s.wq = (blockIdx.x >> 3) * NWAVES + C.wave; s.nwq = ((G - s.x + 7) >> 3) * NWAVES; return s; }
__device__ __forceinline__ void ph_peer_u(const Prm& p, const Ctx& C, int l, unsigned char* lds) {
    const SliceCtx S = slice_ctx(C, p, lds);
    const bf16_t* HB = (const bf16_t*)(p.ws + WS_QQ);     const unsigned short* IDX = (const unsigned short*)(p.ws + WS_VV); float* PD = (float*)(p.ws + WS_PD);
    const unsigned char* U8 = p.ws + WS_T8 + ((size_t)(l * 2 + 0) * 8 + S.x) * NEXP * 128;
    const int lane = C.lane, j = lane & 7, k = lane >> 3, jq = (lane >> 2) & 1;
    u32x4 uq[2][16]; unsigned idw[2]; u32x4 hr0[2], hr1[2];
    const int nit = (NT - S.wq + S.nwq - 1) / S.nwq;
#define PU_TOK(i) (S.wq + ((i) < nit ? (i) : nit - 1) * S.nwq)
#define PU_LOADID(s_, i) do { idw[s_] = ((const unsigned*)IDX)[(size_t)PU_TOK(i) * 64 + lane]; } while (0)
#define PU_LOADH(s_, i) do { const bf16_t* hp_ = HB + (size_t)PU_TOK(i) * DM + 128 * S.x + 16 * j; hr0[s_] = *(const u32x4*)hp_; hr1[s_] = *(const u32x4*)(hp_ + 8); } while (0)
#define PU_G1(s_, BB) uq[s_][BB] = *(const u32x4*)(U8 + (size_t)pick_id<BB>(idw[s_], jq) * 128 + 16 * j)
#define PU_GATHER(s_, h_) do { PU_G1(s_, 8 * (h_) + 0); PU_G1(s_, 8 * (h_) + 1); PU_G1(s_, 8 * (h_) + 2); PU_G1(s_, 8 * (h_) + 3); PU_G1(s_, 8 * (h_) + 4); PU_G1(s_, 8 * (h_) + 5); PU_G1(s_, 8 * (h_) + 6); PU_G1(s_, 8 * (h_) + 7); } while (0)
#define PU_MATH(s_, h_, pd_) do { _Pragma("unroll") for (int b_ = 0; b_ < 8; ++b_) { const int bb = 8 * (h_) + b_; int ai = __builtin_amdgcn_sdot4((int)uq[s_][bb].x, hq[0], 0, false); \
        ai = __builtin_amdgcn_sdot4((int)uq[s_][bb].y, hq[1], ai, false); ai = __builtin_amdgcn_sdot4((int)uq[s_][bb].z, hq[2], ai, false); ai = __builtin_amdgcn_sdot4((int)uq[s_][bb].w, hq[3], ai, false); \
        ai += dpp_i<0xB1>(ai); ai += dpp_i<0x4E>(ai); ai += dpp_i<0x141>(ai); if (b_ == j) pd_ = ai; } } while (0)
    PU_LOADID(0, 0); PU_LOADID(1, 1); PU_LOADH(0, 0); PU_LOADH(1, 1);
    PU_GATHER(0, 0); PU_GATHER(0, 1); PU_GATHER(1, 0); PU_GATHER(1, 1);
    PU_LOADID(0, 2);
#pragma unroll 1
    for (int it = 0; it < nit; it += 2) {
#pragma unroll
        for (int a = 0; a < 2; ++a) {
            const int i = it + a, bq = 1 - a;
            int hq[4]; float hsc;
            { const unsigned hw[8] = {hr0[a].x, hr0[a].y, hr0[a].z, hr0[a].w, hr1[a].x, hr1[a].y, hr1[a].z, hr1[a].w};
              float hv[16]; float am = 0.f;
#pragma unroll
              for (int q = 0; q < 8; ++q) { hv[2 * q] = __uint_as_float(hw[q] << 16); hv[2 * q + 1] = __uint_as_float(hw[q] & 0xffff0000u); am = fmaxf(am, fmaxf(fabsf(hv[2 * q]), fabsf(hv[2 * q + 1]))); }
              am = fmaxf(am, dpp_f<0xB1>(am)); am = fmaxf(am, dpp_f<0x4E>(am)); am = fmaxf(am, dpp_f<0x141>(am));
              hsc = am > 0.f ? am * (1.0f / 127.0f) : 1.0f; const float inv = am > 0.f ? 127.0f / am : 0.f;
#pragma unroll
              for (int q = 0; q < 4; ++q) { unsigned u0 = __builtin_amdgcn_cvt_pk_u8_f32(hv[4 * q] * inv + 128.0f, 0, 0u); u0 = __builtin_amdgcn_cvt_pk_u8_f32(hv[4 * q + 1] * inv + 128.0f, 1, u0);
                  u0 = __builtin_amdgcn_cvt_pk_u8_f32(hv[4 * q + 2] * inv + 128.0f, 2, u0); u0 = __builtin_amdgcn_cvt_pk_u8_f32(hv[4 * q + 3] * inv + 128.0f, 3, u0); hq[q] = (int)(u0 ^ 0x80808080u); } }
            PU_LOADH(a, i + 2); PU_LOADID(bq, i + 3);
            int pd0 = 0, pd1 = 0;
            PU_MATH(a, 0, pd0); PU_GATHER(a, 0);
            PU_MATH(a, 1, pd1); PU_GATHER(a, 1);
            if (i < nit) { float* pd = PD + ((size_t)S.x * NT + (S.wq + i * S.nwq)) * 128 + 16 * k + j; pd[0] = (float)pd0 * hsc; pd[8] = (float)pd1 * hsc; }
        }
    }
#undef PU_TOK
#undef PU_LOADID
#undef PU_LOADH
#undef PU_GATHER
#undef PU_G1
#undef PU_MATH
}
__device__ __forceinline__ void ph_peer_pre(const Prm& p, const Ctx& C, int l) {
    const float* MOD = (const float*)(p.ws + WS_MOD) + (size_t)l * NB * MODW + 3 * DM;
    const bf16_t* WQT = (const bf16_t*)(p.ws + WS_WQ) + (size_t)l * DM * DM; float* BQ = (float*)(p.ws + WS_BQ) + (size_t)l * NB * DM;
    for (int item = C.gw; item < (DM / 8) * NB; item += C.ngw) {
        const int b = item & 7, c0 = (item >> 3) * 8;
        float sh[16];
#pragma unroll
        for (int q = 0; q < 4; ++q) { const f32x4 v = *(const f32x4*)(MOD + (size_t)b * MODW + 16 * C.lane + 4 * q); sh[4 * q] = v.x; sh[4 * q + 1] = v.y; sh[4 * q + 2] = v.z; sh[4 * q + 3] = v.w; }
        float res = 0.f;
#pragma unroll
        for (int c = 0; c < 8; ++c) { const u32x4 w0 = *(const u32x4*)(WQT + (size_t)(c0 + c) * DM + 16 * C.lane), w1 = *(const u32x4*)(WQT + (size_t)(c0 + c) * DM + 16 * C.lane + 8);
            const unsigned ww[8] = {w0.x, w0.y, w0.z, w0.w, w1.x, w1.y, w1.z, w1.w}; float a = 0.f;
#pragma unroll
            for (int q = 0; q < 8; ++q) a += __uint_as_float(ww[q] << 16) * sh[2 * q] + __uint_as_float(ww[q] & 0xffff0000u) * sh[2 * q + 1];
            a = wave_sum(a); if (C.lane == c) res = a; }
        if (C.lane < 8) BQ[(size_t)b * DM + c0 + C.lane] = res;
    }
    const unsigned char* U8 = p.ws + WS_T8 + (size_t)(l * 2 + 0) * 8 * NEXP * 128; const float* SU = (const float*)(p.ws + WS_SC8) + (size_t)(l * 2) * NEXP; float* USH = (float*)(p.ws + WS_USH) + (size_t)l * NB * NEXP;
    float shb[8][16];
    const int cl = 256 * (C.lane >> 4) + 8 * (C.lane & 15);
#pragma unroll
    for (int b = 0; b < 8; ++b)
#pragma unroll
        for (int q = 0; q < 4; ++q) { const f32x4 v = *(const f32x4*)(MOD + (size_t)b * MODW + cl + 128 * (q >> 1) + 4 * (q & 1)); shb[b][4 * q] = v.x; shb[b][4 * q + 1] = v.y; shb[b][4 * q + 2] = v.z; shb[b][4 * q + 3] = v.w; }
    const int hi5 = C.lane >> 5, b4 = (C.lane >> 4) & 1;
    for (int e0 = C.gw; e0 < NEXP; e0 += 2 * C.ngw) {
        u32x2 uq[2];
#pragma unroll
        for (int r = 0; r < 2; ++r) uq[r] = *(const u32x2*)(U8 + ((size_t)(C.lane >> 4) * NEXP + min(e0 + r * C.ngw, NEXP - 1)) * 128 + 8 * (C.lane & 15));
#pragma unroll
        for (int r = 0; r < 2; ++r) { const int e = e0 + r * C.ngw; if (e >= NEXP) break;
            const unsigned w[2] = {uq[r].x, uq[r].y}; float uf[16];
#pragma unroll
            for (int q = 0; q < 8; ++q) { uf[q] = (float)(((int)(w[q >> 2] << (28 - 8 * (q & 3)))) >> 28); uf[8 + q] = (float)(((int)(w[q >> 2] << (24 - 8 * (q & 3)))) >> 28); }
            float a[8];
#pragma unroll
            for (int b = 0; b < 8; ++b) { float t = 0.f;
#pragma unroll
                for (int q = 0; q < 16; ++q) t += uf[q] * shb[b][q];
                a[b] = t; }
            float r4[4], r2[2];
#pragma unroll
            for (int q = 0; q < 4; ++q) r4[q] = xsum32(a[q], a[4 + q]);
#pragma unroll
            for (int q = 0; q < 2; ++q) r2[q] = xsum16(r4[q], r4[2 + q]);
#pragma unroll
            for (int q = 0; q < 2; ++q) { float v = r2[q]; v += dpp_f<0xB1>(v); v += dpp_f<0x4E>(v); v += dpp_f<0x141>(v); v += dpp_f<0x128>(v); r2[q] = v; }
            if ((C.lane & 15) == 0) { const float su = SU[e], sv = SU[NEXP + e]; const int b0 = 4 * hi5 + 2 * b4;
                f32x4* REC = (f32x4*)(p.ws + WS_T8 + ((size_t)(l * 2 + 0) * 8 + 4) * NEXP * 128); REC[(size_t)b0 * NEXP + e] = (f32x4){r2[0] * su, su, sv, 0.f}; REC[(size_t)(b0 + 1) * NEXP + e] = (f32x4){r2[1] * su, su, sv, 0.f}; }
        }
    }
}
__device__ __forceinline__ void ph_peer_r(const Prm& p, const Ctx& C, int l) {
    const unsigned short* IDX = (const unsigned short*)(p.ws + WS_VV); float* PW = (float*)(p.ws + WS_VV + 16 * MiB); const float* PD = (const float*)(p.ws + WS_PD);
    const float* SU = (const float*)(p.ws + WS_SC8) + (size_t)(l * 2) * NEXP; const float* SV = SU + NEXP;
    const size_t n = (size_t)NT * 128, stride = (size_t)gridDim.x * NTHREADS;
    for (size_t i = (size_t)blockIdx.x * NTHREADS + C.tid; i < n; i += stride) {
        float s = 0.f;
#pragma unroll
        for (int x = 0; x < 8; ++x) s += PD[(size_t)x * n + i];
        const size_t t = i >> 7; const float r = ((const float*)(p.ws + WS_FC))[t];
        const int id = IDX[i]; const float d = s * r * SU[id] + ((const float*)(p.ws + WS_USH))[((size_t)l * NB + t / SEQ) * NEXP + id];
        const float cf = PW[i] * (0.5f * d * (1.0f + erff(d * 0.70710678118654752f))) * SV[id];
        float cmx = fabsf(cf); cmx = fmaxf(cmx, dpp_f<0xB1>(cmx)); cmx = fmaxf(cmx, dpp_f<0x4E>(cmx)); cmx = fmaxf(cmx, dpp_f<0x141>(cmx)); cmx = fmaxf(cmx, dpp_f<0x128>(cmx));
        const float inv = cmx > 0.f ? 127.0f / cmx : 0.f;
        ((unsigned char*)(p.ws + WS_VV + 32 * MiB))[i] = (unsigned char)((__builtin_amdgcn_cvt_pk_u8_f32(cf * inv + 128.0f, 0, 0u) ^ 0x80u) & 0xffu);
        if ((C.lane & 15) == 0) ((float*)(p.ws + WS_VV + 40 * MiB))[i >> 4] = cmx * (1.0f / 127.0f);
    }
}
__device__ __forceinline__ void ph_peer_v(const Prm& p, const Ctx& C, int l, unsigned char* lds) {
    const SliceCtx S = slice_ctx(C, p, lds);
    const unsigned short* IDX = (const unsigned short*)(p.ws + WS_VV); const unsigned char* CQ = p.ws + WS_VV + 32 * MiB; const float* CSC = (const float*)(p.ws + WS_VV + 40 * MiB);
    const float* MOD = (const float*)(p.ws + WS_MOD) + (size_t)l * NB * MODW;
    const unsigned char* V8 = p.ws + WS_T8 + ((size_t)(l * 2 + 1) * 8 + S.x) * NEXP * 128;
    const int lane = C.lane, j = lane & 7, k = lane >> 3, b3 = (lane >> 3) & 1, jq = (lane >> 2) & 1;
    u32x4 vq[2][16]; unsigned idw[2]; unsigned cqw[2]; float csv[2]; f32x2 xvv[2], gvv[2];
    const int ocol = 128 * S.x + 16 * j + 2 * k;
    const int nit = (NT - S.wq + S.nwq - 1) / S.nwq;
#define PV_TOK(i) (S.wq + ((i) < nit ? (i) : nit - 1) * S.nwq)
#define PV_LOADID(s_, i) do { idw[s_] = ((const unsigned*)IDX)[(size_t)PV_TOK(i) * 64 + lane]; } while (0)
#define PV_LOADC(s_, i) do { const int t_ = PV_TOK(i); cqw[s_] = ((const unsigned*)CQ)[(size_t)t_ * 32 + 4 * k + (j & 3)]; csv[s_] = CSC[(size_t)t_ * 8 + k]; \
        xvv[s_] = *(const f32x2*)(p.out + (size_t)t_ * DM + ocol); gvv[s_] = *(const f32x2*)(MOD + (size_t)(t_ / SEQ) * MODW + 5 * DM + ocol); } while (0)
#define PV_G1(s_, BB) vq[s_][BB] = *(const u32x4*)(V8 + (size_t)pick_id<BB>(idw[s_], jq) * 128 + 16 * j)
#define PV_GATHER(s_, h_) do { PV_G1(s_, 8 * (h_) + 0); PV_G1(s_, 8 * (h_) + 1); PV_G1(s_, 8 * (h_) + 2); PV_G1(s_, 8 * (h_) + 3); PV_G1(s_, 8 * (h_) + 4); PV_G1(s_, 8 * (h_) + 5); PV_G1(s_, 8 * (h_) + 6); PV_G1(s_, 8 * (h_) + 7); } while (0)
#define PV_MATH(s_, h_) do { _Pragma("unroll") for (int g_ = 2 * (h_); g_ < 2 * (h_) + 2; ++g_) { const unsigned r0_[4] = {vq[s_][4 * g_].x, vq[s_][4 * g_].y, vq[s_][4 * g_].z, vq[s_][4 * g_].w}, r1_[4] = {vq[s_][4 * g_ + 1].x, vq[s_][4 * g_ + 1].y, vq[s_][4 * g_ + 1].z, vq[s_][4 * g_ + 1].w}, \
        r2_[4] = {vq[s_][4 * g_ + 2].x, vq[s_][4 * g_ + 2].y, vq[s_][4 * g_ + 2].z, vq[s_][4 * g_ + 2].w}, r3_[4] = {vq[s_][4 * g_ + 3].x, vq[s_][4 * g_ + 3].y, vq[s_][4 * g_ + 3].z, vq[s_][4 * g_ + 3].w}; \
        _Pragma("unroll") for (int w = 0; w < 4; ++w) { const unsigned p01l = __builtin_amdgcn_perm(r1_[w], r0_[w], 0x05010400u), p01h = __builtin_amdgcn_perm(r1_[w], r0_[w], 0x07030602u), p23l = __builtin_amdgcn_perm(r3_[w], r2_[w], 0x05010400u), p23h = __builtin_amdgcn_perm(r3_[w], r2_[w], 0x07030602u); \
            yi[4 * w + 0] = __builtin_amdgcn_sdot4((int)__builtin_amdgcn_perm(p23l, p01l, 0x05040100u), cq[g_], yi[4 * w + 0], false); yi[4 * w + 1] = __builtin_amdgcn_sdot4((int)__builtin_amdgcn_perm(p23l, p01l, 0x07060302u), cq[g_], yi[4 * w + 1], false); \
            yi[4 * w + 2] = __builtin_amdgcn_sdot4((int)__builtin_amdgcn_perm(p23h, p01h, 0x05040100u), cq[g_], yi[4 * w + 2], false); yi[4 * w + 3] = __builtin_amdgcn_sdot4((int)__builtin_amdgcn_perm(p23h, p01h, 0x07060302u), cq[g_], yi[4 * w + 3], false); } } } while (0)
    PV_LOADID(0, 0); PV_LOADID(1, 1); PV_LOADC(0, 0); PV_LOADC(1, 1);
    PV_GATHER(0, 0); PV_GATHER(0, 1); PV_GATHER(1, 0); PV_GATHER(1, 1);
    PV_LOADID(0, 2);
#pragma unroll 1
    for (int it = 0; it < nit; it += 2) {
#pragma unroll
        for (int a = 0; a < 2; ++a) {
            const int i = it + a, bq = 1 - a;
            const int cq[4] = {bcast4<0>(cqw[a]), bcast4<1>(cqw[a]), bcast4<2>(cqw[a]), bcast4<3>(cqw[a])}; const float cback = csv[a]; const f32x2 xv = xvv[a], gv = gvv[a];
            PV_LOADC(a, i + 2); PV_LOADID(bq, i + 3);
            int yi[16];
#pragma unroll
            for (int q = 0; q < 16; ++q) yi[q] = 0;
            PV_MATH(a, 0); PV_GATHER(a, 0);
            PV_MATH(a, 1); PV_GATHER(a, 1);
            f32x2 y[8];
#pragma unroll
            for (int q = 0; q < 8; ++q) y[q] = (f32x2){(float)yi[2 * q] * cback, (float)yi[2 * q + 1] * cback};
            f32x2 r4[4], r2[2], r1;
#pragma unroll
            for (int q = 0; q < 4; ++q) r4[q] = (f32x2){xsum32(y[q].x, y[4 + q].x), xsum32(y[q].y, y[4 + q].y)};
#pragma unroll
            for (int q = 0; q < 2; ++q) r2[q] = (f32x2){xsum16(r4[q].x, r4[2 + q].x), xsum16(r4[q].y, r4[2 + q].y)};
            { const f32x2 snd = b3 ? r2[0] : r2[1], kp = b3 ? r2[1] : r2[0]; r1 = (f32x2){kp.x + dpp_f<0x128>(snd.x), kp.y + dpp_f<0x128>(snd.y)}; }
            if (i < nit) {
                const int t = S.wq + i * S.nwq;
                *(f32x2*)(p.out + (size_t)t * DM + ocol) = xv + gv * r1;
            }
        }
    }
#undef PV_TOK
#undef PV_LOADID
#undef PV_LOADC
#undef PV_GATHER
#undef PV_G1
#undef PV_MATH
}

template <int MODE = 0> __device__ __forceinline__ void ph_peer_u4(const Prm& p, const Ctx& C, int l, unsigned char* lds) {
    SliceCtx S; S.x = blockIdx.x & 3; S.wq = (blockIdx.x >> 2) * NWAVES + C.wave; S.nwq = (((int)gridDim.x - S.x + 3) >> 2) * NWAVES;
    const bf16_t* HB = (const bf16_t*)(p.ws + WS_QQ); float* PD = (float*)(p.ws + WS_PD);
    const unsigned short* IDX = (const unsigned short*)(p.ws + WS_VV);
    const unsigned char* U8 = p.ws + WS_T8 + ((size_t)(l * 2 + 0) * 8 + S.x) * NEXP * 128;
    const int lane = C.lane, j = lane & 7, k = lane >> 3, jq = (lane >> 2) & 1;
    u32x4 uq[2][16]; unsigned idw[2]; u32x2 hr[2];
    LAS unsigned* il = (LAS unsigned*)((LAS unsigned char*)lds + 131072 + C.wave * 256);
    unsigned idr[8];
    LAS unsigned* hl = (LAS unsigned*)((LAS unsigned char*)lds + C.wave * 256);
    const int nit = (NT - S.wq + S.nwq - 1) / S.nwq;
#define PU_TOK(i) (S.wq + ((i) < nit ? (i) : nit - 1) * S.nwq)
#define PU_LOADID(s_, i) do { idw[s_] = ((const unsigned*)IDX)[(size_t)PU_TOK(i) * 64 + lane]; } while (0)
#define PU_LOADH(s_, i) do { hr[s_] = *(const u32x2*)(HB + (size_t)PU_TOK(i) * DM + 256 * S.x + 4 * lane); } while (0)
#define PU_IDS(s_) do { il[lane] = idw[s_]; const u32x4 i0_ = *(LAS u32x4*)(il + 8 * k), i1_ = *(LAS u32x4*)(il + 8 * k + 4); idr[0] = i0_.x; idr[1] = i0_.y; idr[2] = i0_.z; idr[3] = i0_.w; idr[4] = i1_.x; idr[5] = i1_.y; idr[6] = i1_.z; idr[7] = i1_.w; } while (0)
#define PU_G1(s_, BB) uq[s_][BB] = *(const u32x4*)(U8 + (size_t)((((BB) & 1) ? (idr[(BB) >> 1] >> 16) : (idr[(BB) >> 1] & 0xffffu)) * 128u + 16u * (unsigned)j))
#define PU_GATHER(s_, h_) do { PU_G1(s_, 8 * (h_) + 0); PU_G1(s_, 8 * (h_) + 1); PU_G1(s_, 8 * (h_) + 2); PU_G1(s_, 8 * (h_) + 3); PU_G1(s_, 8 * (h_) + 4); PU_G1(s_, 8 * (h_) + 5); PU_G1(s_, 8 * (h_) + 6); PU_G1(s_, 8 * (h_) + 7); } while (0)
#define PU_MATH(s_, h_, pd_) do { _Pragma("unroll") for (int b_ = 0; b_ < 8; ++b_) { const int bb = 8 * (h_) + b_; const unsigned x_[4] = {uq[s_][bb].x, uq[s_][bb].y, uq[s_][bb].z, uq[s_][bb].w}; int a0_ = 0, a1_ = 0; \
        _Pragma("unroll") for (int w_ = 0; w_ < 4; ++w_) { a0_ = __builtin_amdgcn_sdot8((int)x_[w_], hp0[w_], a0_, false); a1_ = __builtin_amdgcn_sdot8((int)x_[w_], hp1[w_], a1_, false); } \
        pd_[bb] = a1_ * 16 + a0_; } } while (0)
    PU_LOADID(0, 0); PU_LOADID(1, 1); PU_LOADH(0, 0); PU_LOADH(1, 1);
    PU_IDS(0); PU_GATHER(0, 0); PU_GATHER(0, 1); PU_IDS(1); PU_GATHER(1, 0); PU_GATHER(1, 1);
    PU_LOADID(0, 2);
    __builtin_amdgcn_s_waitcnt(0x0F70);
#pragma unroll 1
    for (int it = 0; it < nit; it += 2) {
#pragma unroll
        for (int a = 0; a < 2; ++a) {
            const int i = it + a, bq = 1 - a;
            int hp0[4], hp1[4]; float hsc;
            { const float h0_ = __uint_as_float(hr[a].x << 16), h1_ = __uint_as_float(hr[a].x & 0xffff0000u), h2_ = __uint_as_float(hr[a].y << 16), h3_ = __uint_as_float(hr[a].y & 0xffff0000u);
              float am = fmaxf(fmaxf(fabsf(h0_), fabsf(h1_)), fmaxf(fabsf(h2_), fabsf(h3_)));
              am = fmaxf(am, dpp_f<0xB1>(am)); am = fmaxf(am, dpp_f<0x4E>(am)); am = fmaxf(am, dpp_f<0x141>(am)); am = fmaxf(am, dpp_f<0x140>(am)); am = fmaxf(am, __shfl_xor(am, 16)); am = fmaxf(am, __shfl_xor(am, 32));
              hsc = am > 0.f ? am * (1.0f / 119.0f) : 1.0f; const float inv = am > 0.f ? 119.0f / am : 0.f;
              unsigned u0 = __builtin_amdgcn_cvt_pk_u8_f32(h0_ * inv + 136.0f, 0, 0u); u0 = __builtin_amdgcn_cvt_pk_u8_f32(h1_ * inv + 136.0f, 1, u0); u0 = __builtin_amdgcn_cvt_pk_u8_f32(h2_ * inv + 136.0f, 2, u0); u0 = __builtin_amdgcn_cvt_pk_u8_f32(h3_ * inv + 136.0f, 3, u0);
              hl[lane] = u0;
              const u32x4 lo4 = *(LAS u32x4*)(hl + 4 * j), hi4 = *(LAS u32x4*)(hl + 32 + 4 * j);
              const unsigned L8_[4] = {lo4.x, lo4.y, lo4.z, lo4.w}, H8_[4] = {hi4.x, hi4.y, hi4.z, hi4.w};
#pragma unroll
              for (int w = 0; w < 4; ++w) { const unsigned L8 = L8_[w], H8 = H8_[w];
                  hp0[w] = (int)(((L8 & 0x0f0f0f0fu) | ((H8 & 0x0f0f0f0fu) << 4)) ^ 0x88888888u);
                  hp1[w] = (int)((((L8 >> 4) & 0x0f0f0f0fu) | (H8 & 0xf0f0f0f0u)) ^ 0x88888888u); } }
            PU_LOADH(a, i + 2); PU_LOADID(bq, i + 3);
            int v16[16];
            PU_IDS(a); PU_MATH(a, 0, v16); PU_GATHER(a, 0);
            PU_MATH(a, 1, v16); PU_GATHER(a, 1);
            int v8[8], v4[4], v2[2];
#pragma unroll
            for (int m = 0; m < 8; ++m) { const int kp = (j & 4) ? v16[8 + m] : v16[m], sd = (j & 4) ? v16[m] : v16[8 + m]; v8[m] = kp + dpp_i<0x141>(sd); }
#pragma unroll
            for (int m = 0; m < 4; ++m) { const int kp = (j & 2) ? v8[4 + m] : v8[m], sd = (j & 2) ? v8[m] : v8[4 + m]; v4[m] = kp + dpp_i<0x4E>(sd); }
#pragma unroll
            for (int m = 0; m < 2; ++m) { const int kp = (j & 1) ? v4[2 + m] : v4[m], sd = (j & 1) ? v4[m] : v4[2 + m]; v2[m] = kp + dpp_i<0xB1>(sd); }
            if (i < nit) { float* pd = (MODE == 1 ? (float*)(p.ws + WS_HB) : PD) + ((size_t)S.x * NT + (S.wq + i * S.nwq)) * 128 + 2 * lane; *(f32x2*)pd = (f32x2){(float)v2[0] * hsc, (float)v2[1] * hsc}; }
        }
    }
#undef PU_TOK
#undef PU_LOADID
#undef PU_LOADH
#undef PU_GATHER
#undef PU_G1
#undef PU_MATH
}

__device__ __forceinline__ void ph_peer_r2(const Prm& p, const Ctx& C, int l, unsigned char* lds) {
    const unsigned* IDX = (const unsigned*)(p.ws + WS_VV); const f32x2* PW = (const f32x2*)(p.ws + WS_VV + 16 * MiB); const f32x2* PD = (const f32x2*)(p.ws + WS_PD);
    unsigned char* CQ2 = p.ws + WS_VV + 32 * MiB; float* CSC = (float*)(p.ws + WS_VV + 40 * MiB);
    const float* SU = (const float*)(p.ws + WS_SC8) + (size_t)(l * 2) * NEXP; const float* SV = SU + NEXP;
    const size_t n2 = (size_t)NT * 64; const int lane = C.lane;
    const int bidx = 64 * (lane & 1) + 8 * ((lane >> 1) & 3) + (lane >> 3);
    LAS unsigned char* wl = (LAS unsigned char*)lds + C.wave * 256;
    for (int t = C.gw; t < NT; t += C.ngw) {
        f32x2 pd0 = PD[(size_t)t * 64 + lane], pd1 = PD[n2 + (size_t)t * 64 + lane], pd2 = PD[2 * n2 + (size_t)t * 64 + lane], pd3 = PD[3 * n2 + (size_t)t * 64 + lane];
        float r = ((const float*)(p.ws + WS_FC))[t];
        unsigned idw = IDX[(size_t)t * 64 + lane];
        f32x2 pw = PW[(size_t)t * 64 + lane];
        asm volatile("" : "+v"(pd0), "+v"(pd1), "+v"(pd2), "+v"(pd3), "+v"(r), "+v"(idw), "+v"(pw));
        const f32x2 sa = (pd0 + pd1) + (pd2 + pd3);
        const int id0 = (int)(idw & 0xffffu), id1 = (int)(idw >> 16);
        const f32x4* REC = (const f32x4*)(p.ws + WS_T8 + ((size_t)(l * 2 + 0) * 8 + 4) * NEXP * 128) + (size_t)(t / SEQ) * NEXP;
        f32x4 rc0 = REC[id0], rc1 = REC[id1];
        asm volatile("" : "+v"(rc0), "+v"(rc1));
        const float us0 = rc0.x, su0 = rc0.y, sv0 = rc0.z, us1 = rc1.x, su1 = rc1.y, sv1 = rc1.z;
        const float d0 = sa.x * r * su0 + us0, d1 = sa.y * r * su1 + us1;
        const float cf0 = pw.x * (0.5f * d0 * (1.0f + erff(d0 * 0.70710678118654752f))) * sv0;
        const float cf1 = pw.y * (0.5f * d1 * (1.0f + erff(d1 * 0.70710678118654752f))) * sv1;
        float cmx = fmaxf(fabsf(cf0), fabsf(cf1));
        cmx = fmaxf(cmx, dpp_f<0xB1>(cmx)); cmx = fmaxf(cmx, dpp_f<0x4E>(cmx)); cmx = fmaxf(cmx, dpp_f<0x141>(cmx)); cmx = fmaxf(cmx, dpp_f<0x140>(cmx));
        cmx = fmaxf(cmx, __shfl_xor(cmx, 16)); cmx = fmaxf(cmx, __shfl_xor(cmx, 32));
        const float inv = cmx > 0.f ? 16383.0f / cmx : 0.f;
        const int q0 = (int)rintf(cf0 * inv), q1 = (int)rintf(cf1 * inv);
        wl[bidx] = (unsigned char)(q0 >> 7); wl[bidx + 128] = (unsigned char)(q0 & 127); wl[bidx + 32] = (unsigned char)(q1 >> 7); wl[bidx + 160] = (unsigned char)(q1 & 127);
        int qs = q0 + q1;
        qs += dpp_i<0xB1>(qs); qs += dpp_i<0x4E>(qs); qs += dpp_i<0x141>(qs); qs += dpp_i<0x140>(qs); qs += __shfl_xor(qs, 16); qs += __shfl_xor(qs, 32);
        ((unsigned*)(CQ2 + (size_t)t * 256))[lane] = ((LAS unsigned*)wl)[lane];
        if (lane == 0) { const float sc = cmx * (1.0f / 16383.0f); *(f32x2*)(CSC + 2 * (size_t)t) = (f32x2){sc, 8.0f * sc * (float)qs}; }
    }
}
__device__ __forceinline__ void ph_peer_v2(const Prm& p, const Ctx& C, int l, unsigned char* lds) {
    SliceCtx S; S.x = blockIdx.x & 3; S.wq = (blockIdx.x >> 2) * NWAVES + C.wave; S.nwq = (((int)gridDim.x - S.x + 3) >> 2) * NWAVES;
    const unsigned short* IDX = (const unsigned short*)(p.ws + WS_VV); const unsigned char* CQ2 = p.ws + WS_VV + 32 * MiB; const f32x2* CSC = (const f32x2*)(p.ws + WS_VV + 40 * MiB);
    const float* MOD = (const float*)(p.ws + WS_MOD) + (size_t)l * NB * MODW;
    const unsigned char* V8 = p.ws + WS_T8 + ((size_t)(l * 2 + 1) * 8 + S.x) * NEXP * 128;
    const int lane = C.lane, j = lane & 7, k = lane >> 3, jq = (lane >> 2) & 1, n16 = lane & 15, q4 = lane >> 4;
    LAS unsigned* il = (LAS unsigned*)((LAS unsigned char*)lds + 131072 + C.wave * 256); unsigned idr[8];
    LAS unsigned char* wl = (LAS unsigned char*)lds + C.wave * 16384;
    const int wb_e = 128 * k + 32 * ((j >> 1) ^ ((k >> 1) & 1)) + 16 * (j & 1), wb_o = 128 * k + 32 * ((j >> 1) ^ ((k >> 1) & 1) ^ 2) + 16 * (j & 1);
    const int rr = (lane >> 2) & 3, pp = lane & 3, fr = ((rr >> 1) & 1) | ((q4 & 1) << 1);
    int rb[4];
#pragma unroll
    for (int nt = 0; nt < 4; ++nt) rb[nt] = 128 * (8 * q4 + rr) + 32 * (nt ^ fr) + 8 * pp;
    const unsigned selA0 = (lane & 1) ? 0x010c000cu : 0x0c010c00u, selB0 = (lane & 1) ? 0x030c020cu : 0x0c030c02u;
    const unsigned selAL = (lane & 4) ? 0x0c0c0c0cu : selA0, selBL = (lane & 4) ? 0x0c0c0c0cu : selB0, selAH = (lane & 4) ? selA0 : 0x0c0c0c0cu, selBH = (lane & 4) ? selB0 : 0x0c0c0c0cu;
    const int cqo = 128 * ((lane >> 1) & 1) + 32 * q4;
    const int ocol = 256 * S.x + 128 * (q4 & 1) + 64 * (q4 >> 1) + 2 * n16;
    u32x4 vq[2][16]; unsigned idw[2]; u32x4 cqa[2][2]; f32x2 csv[2]; unsigned xvb[2][2]; f32x2 gvv[2][2];
    const bf16_t* XR1 = (const bf16_t*)(p.ws + WS_XR1); bf16_t* XR2 = (bf16_t*)p.out;
    const int nit = (NT - S.wq + S.nwq - 1) / S.nwq;
#define PV_TOK(i) (S.wq + ((i) < nit ? (i) : nit - 1) * S.nwq)
#define PV_LOADID(s_, i) do { idw[s_] = ((const unsigned*)IDX)[(size_t)PV_TOK(i) * 64 + lane]; } while (0)
#define PV_LOADC(s_, i) do { const int t_ = PV_TOK(i); const unsigned char* cp_ = CQ2 + (size_t)t_ * 256 + cqo; cqa[s_][0] = *(const u32x4*)cp_; cqa[s_][1] = *(const u32x4*)(cp_ + 16); csv[s_] = CSC[t_]; \
        xvb[s_][0] = *(const unsigned*)(XR1 + (size_t)t_ * DM + ocol); xvb[s_][1] = *(const unsigned*)(XR1 + (size_t)t_ * DM + ocol + 32); gvv[s_][0] = *(const f32x2*)(MOD + (size_t)(t_ / SEQ) * MODW + 5 * DM + ocol); gvv[s_][1] = *(const f32x2*)(MOD + (size_t)(t_ / SEQ) * MODW + 5 * DM + ocol + 32); } while (0)
#define PV_IDS(s_) do { il[lane] = idw[s_]; const u32x4 i0_ = *(LAS u32x4*)(il + 8 * k), i1_ = *(LAS u32x4*)(il + 8 * k + 4); idr[0] = i0_.x; idr[1] = i0_.y; idr[2] = i0_.z; idr[3] = i0_.w; idr[4] = i1_.x; idr[5] = i1_.y; idr[6] = i1_.z; idr[7] = i1_.w; } while (0)
#define PV_G1(s_, BB) vq[s_][BB] = *(const u32x4*)(V8 + (size_t)((((BB) & 1) ? (idr[(BB) >> 1] >> 16) : (idr[(BB) >> 1] & 0xffffu)) * 128u + 16u * (unsigned)j))
#define PV_GATHER(s_, h_) do { PV_G1(s_, 8 * (h_) + 0); PV_G1(s_, 8 * (h_) + 1); PV_G1(s_, 8 * (h_) + 2); PV_G1(s_, 8 * (h_) + 3); PV_G1(s_, 8 * (h_) + 4); PV_G1(s_, 8 * (h_) + 5); PV_G1(s_, 8 * (h_) + 6); PV_G1(s_, 8 * (h_) + 7); } while (0)
#define PV_W1(s_, h_, B_) *(LAS u32x4*)(wl + 8192 * (h_) + 1024 * (B_) + (((B_) & 1) ? wb_o : wb_e)) = vq[s_][8 * (h_) + (B_)]
#define PV_WRITE(s_, h_) do { PV_W1(s_, h_, 0); PV_W1(s_, h_, 1); PV_W1(s_, h_, 2); PV_W1(s_, h_, 3); PV_W1(s_, h_, 4); PV_W1(s_, h_, 5); PV_W1(s_, h_, 6); PV_W1(s_, h_, 7); } while (0)
#define PV_TR(h_, ksl_, nt_, rd_) __builtin_amdgcn_ds_read_tr16_b64_v4i16((LAS s16x4*)(wl + 8192 * (h_) + 4096 * (ksl_) + 512 * (rd_) + rb[nt_]))
#define PV_MMA(h_) do { _Pragma("unroll") for (int ksl_ = 0; ksl_ < 2; ++ksl_) { const int ks_ = 2 * (h_) + ksl_; const unsigned w0_ = cw[2 * ks_], w1_ = cw[2 * ks_ + 1]; \
        const i32x4 AL_ = {(int)__builtin_amdgcn_perm(w0_, w0_, selAL), (int)__builtin_amdgcn_perm(w0_, w0_, selBL), (int)__builtin_amdgcn_perm(w1_, w1_, selAL), (int)__builtin_amdgcn_perm(w1_, w1_, selBL)}; \
        const i32x4 AH_ = {(int)__builtin_amdgcn_perm(w0_, w0_, selAH), (int)__builtin_amdgcn_perm(w0_, w0_, selBH), (int)__builtin_amdgcn_perm(w1_, w1_, selAH), (int)__builtin_amdgcn_perm(w1_, w1_, selBH)}; \
        _Pragma("unroll") for (int nt_ = 0; nt_ < 4; ++nt_) { const s16x4 b0_ = PV_TR(h_, ksl_, nt_, 0), b1_ = PV_TR(h_, ksl_, nt_, 1); const i32x2 c0_ = __builtin_bit_cast(i32x2, b0_), c1_ = __builtin_bit_cast(i32x2, b1_); \
            const i32x4 BL_ = {c0_.x & 0x0f0f0f0f, c0_.y & 0x0f0f0f0f, c1_.x & 0x0f0f0f0f, c1_.y & 0x0f0f0f0f}, BH_ = {c0_.x, c0_.y, c1_.x, c1_.y};     \
            acc[nt_] = __builtin_amdgcn_mfma_i32_16x16x64_i8(AL_, BL_, acc[nt_], 0, 0, 0); acc[nt_] = __builtin_amdgcn_mfma_i32_16x16x64_i8(AH_, BH_, acc[nt_], 0, 0, 0); } } } while (0)
    PV_LOADID(0, 0); PV_LOADID(1, 1); PV_LOADC(0, 0);
    PV_IDS(0); PV_GATHER(0, 0); PV_GATHER(0, 1); PV_IDS(1); PV_GATHER(1, 0); PV_GATHER(1, 1);
    PV_LOADID(0, 2);
    __builtin_amdgcn_s_waitcnt(0x0F70);
#pragma unroll 1
    for (int it = 0; it < nit; it += 2) {
#pragma unroll
        for (int a = 0; a < 2; ++a) {
            const int i = it + a, bq = 1 - a;
            const unsigned cw[8] = {cqa[a][0].x, cqa[a][0].y, cqa[a][0].z, cqa[a][0].w, cqa[a][1].x, cqa[a][1].y, cqa[a][1].z, cqa[a][1].w}; const f32x2 cback = csv[a]; const f32x2 xv0 = {__uint_as_float(xvb[a][0] << 16), __uint_as_float(xvb[a][0] & 0xffff0000u)}, xv1 = {__uint_as_float(xvb[a][1] << 16), __uint_as_float(xvb[a][1] & 0xffff0000u)}, gv0 = gvv[a][0], gv1 = gvv[a][1];
            PV_LOADC(bq, i + 1); PV_LOADID(bq, i + 3);
            i32x4 acc[4];
#pragma unroll
            for (int nt = 0; nt < 4; ++nt) acc[nt] = (i32x4){0, 0, 0, 0};
            PV_IDS(a); PV_WRITE(a, 0); PV_GATHER(a, 0); PV_MMA(0);
            PV_WRITE(a, 1); PV_GATHER(a, 1); PV_MMA(1);
            const i32x4 a0 = (q4 >> 1) ? acc[2] : acc[0], a1 = (q4 >> 1) ? acc[3] : acc[1];
            const float mf = (q4 & 1) ? cback.x * 0.0625f : cback.x, sb = (q4 & 1) ? 0.f : cback.y;
            int v00 = a0.x * 128 + a0.z, v01 = a0.y * 128 + a0.w, v10 = a1.x * 128 + a1.z, v11 = a1.y * 128 + a1.w;
            { const int p00 = __shfl_xor(v00, 16), p01 = __shfl_xor(v01, 16), p10 = __shfl_xor(v10, 16), p11 = __shfl_xor(v11, 16);
              if (q4 & 1) { v00 -= p00; v01 -= p01; v10 -= p10; v11 -= p11; } }
            const f32x2 y0 = {(float)v00 * mf - sb, (float)v01 * mf - sb}, y1 = {(float)v10 * mf - sb, (float)v11 * mf - sb};
            if (i < nit) {
                const int t = S.wq + i * S.nwq;
                const f32x2 o0 = xv0 + gv0 * y0, o1 = xv1 + gv1 * y1;
                if (l == 0) { *(unsigned*)(XR2 + (size_t)t * DM + ocol) = pg8::cvt_pk_bf16(o0.x, o0.y); *(unsigned*)(XR2 + (size_t)t * DM + ocol + 32) = pg8::cvt_pk_bf16(o1.x, o1.y); }
                else { *(f32x2*)(p.out + (size_t)t * DM + ocol) = o0; *(f32x2*)(p.out + (size_t)t * DM + ocol + 32) = o1; }
            }
        }
    }
#undef PV_TOK
#undef PV_LOADID
#undef PV_LOADC
#undef PV_GATHER
#undef PV_G1
#undef PV_W1
#undef PV_WRITE
#undef PV_TR
#undef PV_MMA
}

constexpr int PH_PER_LAYER = 11, NPH = 1 + 2 * PH_PER_LAYER;

__global__ void __launch_bounds__(NTHREADS, 2) mega(Prm p0) {
    extern __shared__ __attribute__((aligned(16))) unsigned char lds[];
    const int ph_lo = p0.ph_lo, ph_hi = p0.ph_hi;
    volatile LAS unsigned* bst = (volatile LAS unsigned*)((LAS unsigned char*)lds + (LDS_BYTES - 64));
    if (threadIdx.x < 16) bst[threadIdx.x] = 0u;
    __syncthreads();
    XcdBarrier bar = xcd_barrier_post((unsigned*)(p0.ws + WS_CTL), bst);
#define PHASE_BEGIN(k) if (ph_lo <= (k) && (k) < ph_hi) { Prm p = p0; Ctx C; \
        { size_t z_ = 0; asm volatile("" : "+s"(z_));     \
          p.x = (const float*)((const char*)p0.x + z_); p.c = (const float*)((const char*)p0.c + z_); p.ada_w = (const float*)((const char*)p0.ada_w + z_); p.ada_b = (const float*)((const char*)p0.ada_b + z_); \
          p.attn_norm = (const float*)((const char*)p0.attn_norm + z_); p.ffn_norm = (const float*)((const char*)p0.ffn_norm + z_); p.w_in = (const float*)((const char*)p0.w_in + z_); p.fox_bf = (const float*)((const char*)p0.fox_bf + z_); \
          p.gq = (const float*)((const char*)p0.gq + z_); p.gk = (const float*)((const char*)p0.gk + z_); p.w_branch = (const float*)((const char*)p0.w_branch + z_); p.w_out = (const float*)((const char*)p0.w_out + z_); \
          p.wq = (const float*)((const char*)p0.wq + z_); p.k1 = (const float*)((const char*)p0.k1 + z_); p.k2 = (const float*)((const char*)p0.k2 + z_); p.pu = (const float*)((const char*)p0.pu + z_); p.pv = (const float*)((const char*)p0.pv + z_); \
          p.out = (float*)((char*)p0.out + z_); p.ws = p0.ws + z_; } \
        C.tid = threadIdx.x; asm volatile("" : "+v"(C.tid)); C.lane = C.tid & 63; C.wave = __builtin_amdgcn_readfirstlane(C.tid >> 6); \
        C.gw = blockIdx.x * NWAVES + C.wave; C.ngw = gridDim.x * NWAVES;
#define PHASE_END(k) if ((k) + 1 < ph_hi) { xcd_barrier(bar); } }
    PHASE_BEGIN(0) ph_mod(p, C); ph_weights(p, C, lds); ph_convert_tables8s(p, C); PHASE_END(0)
#pragma unroll 1
    for (int l = 0; l < 2; ++l) {
        const int k0 = 1 + l * PH_PER_LAYER;
        PHASE_BEGIN(k0 + 0) ph_norm<true>(p, C, l, p.x, l == 0 ? (const bf16_t*)nullptr : (const bf16_t*)p.out, p.attn_norm + l * DM, 0, 1, lds); ph_peer_pre(p, C, l); PHASE_END(k0 + 0)
        PHASE_BEGIN(k0 + 1) ph_gemm1(p, l, lds); PHASE_END(k0 + 1)
        PHASE_BEGIN(k0 + 2) ph_attn<3>(p, C, l, lds); PHASE_END(k0 + 2)
        PHASE_BEGIN(k0 + 3) ph_merge(p, l, lds); PHASE_END(k0 + 3)
        PHASE_BEGIN(k0 + 4) ph_out(p, l, lds); PHASE_END(k0 + 4)
        PHASE_BEGIN(k0 + 6) ph_q(p, l, lds); PHASE_END(k0 + 6)
        PHASE_BEGIN(k0 + 7) ph_topk(p, C, l, lds); PHASE_END(k0 + 7)
        PHASE_BEGIN(k0 + 8) ph_peer_u4(p, C, l, lds); PHASE_END(k0 + 8)
        PHASE_BEGIN(k0 + 9) ph_peer_r2(p, C, l, lds); PHASE_END(k0 + 9)
        PHASE_BEGIN(k0 + 10) ph_peer_v2(p, C, l, lds); PHASE_END(k0 + 10)
    }
}

extern "C" void kernel_launch(void* const* d_in, const int* in_sizes, int n_in, void* d_out, int out_size, void* d_ws, size_t ws_size, hipStream_t stream) {
    static int grid = 0;
    if (grid == 0) {
        if (n_in != 17 || out_size != NT * DM || ws_size < WS_END) { fprintf(stderr, "kernel_launch: unexpected shapes (n_in %d out %d ws %zu)\n", n_in, out_size, ws_size); grid = -1; return; }
        int dev = 0, cus = 0, per_cu = 0;
        hipGetDevice(&dev); hipDeviceGetAttribute(&cus, hipDeviceAttributeMultiprocessorCount, dev);
        hipFuncSetAttribute((const void*)mega, hipFuncAttributeMaxDynamicSharedMemorySize, LDS_BYTES);
        hipOccupancyMaxActiveBlocksPerMultiprocessor(&per_cu, (const void*)mega, NTHREADS, LDS_BYTES);
        if (per_cu < 1) { fprintf(stderr, "kernel_launch: occupancy query says %d blocks per CU\n", per_cu); per_cu = 1; }
        (void)hipGetLastError();
        grid = cus;
    }
    if (grid < 0) return;
    if (hipMemsetAsync((char*)d_ws + WS_CTL, 0, 32768, stream) != hipSuccess) { fprintf(stderr, "kernel_launch: memset of the barrier words failed\n"); return; }
    Prm p{};
    const float** pp = (const float**)&p;
    for (int i = 0; i < 17; ++i) pp[i] = (const float*)d_in[i];
    p.out = (float*)d_out; p.ws = (unsigned char*)d_ws;
#if MK_MULTI
    for (int ph = 0; ph < NPH; ++ph) { p.ph_lo = ph; p.ph_hi = ph + 1; hipLaunchKernelGGL(mega, dim3(grid), dim3(NTHREADS), LDS_BYTES, stream, p); }
#else
    p.ph_lo = 0; p.ph_hi = NPH;
    void* args[] = {&p};
    hipError_t e = hipLaunchCooperativeKernel((const void*)mega, dim3(grid), dim3(NTHREADS), args, LDS_BYTES, stream);
    if (e != hipSuccess) fprintf(stderr, "cooperative launch failed: %s (grid %d)\n", hipGetErrorString(e), grid);
#endif
}
```

```cpp
#include <hip/hip_runtime.h>
#include <hip/hip_cooperative_groups.h>
#include <hip/hip_bf16.h>
#include <cstdio>
#include <cstdint>
namespace cg = cooperative_groups;

#ifndef MK_MULTI
#define MK_MULTI 0
#endif

constexpr int NB = 8, SEQ = 4096, DM = 1024, NT = NB * SEQ, NH = 8, HD = 64, INW = 5128, NEXP = 16384, NKEYS = 128, TOPK = 16;
constexpr int MODW = 6 * DM;
constexpr float EPS = 1e-6f;
constexpr float LOG2E = 1.4426950408889634f, LN2 = 0.6931471805599453f;
constexpr float C2 = 0.125f * LOG2E;
constexpr int NWAVES = 8, NTHREADS = 512;
constexpr int LDS_BYTES = 147456;

constexpr size_t MiB = 1u << 20;
constexpr size_t WS_CTL = 0;
constexpr size_t WS_MOD = 1 * MiB;
constexpr size_t WS_FA = 2 * MiB;
constexpr size_t WS_FC = 3 * MiB;
constexpr size_t WS_WIN = 4 * MiB;
constexpr size_t WS_WBR = 24 * MiB;
constexpr size_t WS_WOUT = 28 * MiB;
constexpr size_t WS_WQ = 32 * MiB;
constexpr size_t WS_K12 = 36 * MiB;
constexpr size_t WS_UB = 37 * MiB;
constexpr size_t WS_VB = 69 * MiB;
constexpr size_t WS_HB = 101 * MiB;
constexpr size_t WS_QQ = 165 * MiB;
constexpr size_t WS_KK = 229 * MiB;
constexpr size_t WS_VV = 293 * MiB;
constexpr size_t WS_GT = 357 * MiB;
constexpr size_t WS_SSQ = 485 * MiB;
constexpr size_t WS_BQ = 487 * MiB;
constexpr size_t WS_USH = 488 * MiB;
constexpr size_t WS_END = 490 * MiB;
constexpr size_t WS_XR1 = WS_GT + 64 * MiB;

typedef unsigned short bf16_t;
typedef float f32x4 __attribute__((ext_vector_type(4)));
typedef unsigned u32x4 __attribute__((ext_vector_type(4))); typedef unsigned u32x2 __attribute__((ext_vector_type(2)));

struct Prm {
    const float *x, *c, *ada_w, *ada_b, *attn_norm, *ffn_norm, *w_in, *fox_bf, *gq, *gk, *w_branch, *w_out, *wq, *k1, *k2, *pu, *pv;
    float* out; unsigned char* ws; int ph_lo, ph_hi;
};

__device__ __forceinline__ float bf2f(bf16_t v) { return __uint_as_float((unsigned)v << 16); }
__device__ __forceinline__ unsigned f2bf(float f) { unsigned u = __float_as_uint(f); return (u + 0x7fffu + ((u >> 16) & 1u)) >> 16; }
__device__ __forceinline__ unsigned pk2(float lo, float hi) { return f2bf(lo) | (f2bf(hi) << 16); }
__device__ __forceinline__ float wave_sum(float v) {
#pragma unroll
    for (int o = 1; o < 64; o <<= 1) v += __shfl_xor(v, o);
    return v;
}
__device__ __forceinline__ float sigmoidf_(float a) { return 1.0f / (1.0f + __expf(-a)); }
__device__ __forceinline__ float log_sigmoidf_(float a) { return fminf(a, 0.f) - log1pf(expf(-fabsf(a))); }
__device__ __forceinline__ float softplus2(float z2) { return fmaxf(z2, 0.f) + __log2f(1.0f + exp2f(-fabsf(z2))); }

struct Ctx { int tid, lane, wave, gw, ngw; };

__device__ __forceinline__ void ph_mod(const Prm& p, const Ctx& C) {
    float* MOD = (float*)(p.ws + WS_MOD);
    for (int item = C.gw; item < 2 * (MODW / 8); item += C.ngw) {
        const int l = item / (MODW / 8), cb = (item % (MODW / 8)) * 8;
        float acc[8][8];
#pragma unroll
        for (int b = 0; b < 8; ++b)
#pragma unroll
            for (int j = 0; j < 8; ++j) acc[b][j] = 0.f;
        for (int i = 0; i < 16; ++i) {
            const int k = C.lane + 64 * i;
            const float* wp = p.ada_w + ((size_t)l * DM + k) * MODW + cb;
            const f32x4 w0 = *(const f32x4*)wp, w1 = *(const f32x4*)(wp + 4);
            const float w[8] = {w0.x, w0.y, w0.z, w0.w, w1.x, w1.y, w1.z, w1.w};
#pragma unroll
            for (int b = 0; b < 8; ++b) {
                const float cv = p.c[b * DM + k]; const float sv = cv * sigmoidf_(cv);
#pragma unroll
                for (int j = 0; j < 8; ++j) acc[b][j] += sv * w[j];
            }
        }
        float res = 0.f;
#pragma unroll
        for (int b = 0; b < 8; ++b)
#pragma unroll
            for (int j = 0; j < 8; ++j) { const float s = wave_sum(acc[b][j]); if (C.lane == b * 8 + j) res = s; }
        const int b = C.lane >> 3, j = C.lane & 7;
        MOD[((size_t)l * NB + b) * MODW + cb + j] = res + p.ada_b[l * MODW + cb + j];
    }
}

template <bool WITH_FA>
__device__ __forceinline__ void ph_norm(const Prm& p, const Ctx& C, int l, const float* xin, const bf16_t* xinb, const float* gain, int ch_sh, int ch_sc, unsigned char* lds) {
    const float* MOD = (const float*)(p.ws + WS_MOD) + (size_t)l * NB * MODW;
    bf16_t* HB = (bf16_t*)(p.ws + WS_HB);
    float* FA = (float*)(p.ws + WS_FA);
    f32x4 g4[4];
#pragma unroll
    for (int j = 0; j < 4; ++j) g4[j] = *(const f32x4*)(gain + 4 * C.lane + 256 * j);
    float* wfl = (float*)lds;
    if (WITH_FA) {
        for (int i = C.tid; i < DM * 8; i += NTHREADS) wfl[i] = p.w_in[((size_t)l * DM + (i >> 3)) * INW + 1536 + (i & 7)];
        __syncthreads();
    }
    for (int m0 = C.gw; m0 < NT; m0 += 2 * C.ngw) {
      f32x4 vv[2][4];
#pragma unroll
      for (int rr = 0; rr < 2; ++rr) { const size_t xo = (size_t)min(m0 + rr * C.ngw, NT - 1) * DM + 4 * C.lane;
        if (xinb == nullptr) {
#pragma unroll
            for (int j = 0; j < 4; ++j) vv[rr][j] = *(const f32x4*)(xin + xo + 256 * j);
        } else {
#pragma unroll
            for (int j = 0; j < 4; ++j) { const u32x2 w = *(const u32x2*)(xinb + xo + 256 * j); vv[rr][j] = (f32x4){__uint_as_float(w.x << 16), __uint_as_float(w.x & 0xffff0000u), __uint_as_float(w.y << 16), __uint_as_float(w.y & 0xffff0000u)}; } } }
#pragma unroll
      for (int rr = 0; rr < 2; ++rr) {
        const int m = m0 + rr * C.ngw; if (m >= NT) break;
        const int b = m / SEQ;
        f32x4 v[4]; float s = 0.f;
#pragma unroll
        for (int j = 0; j < 4; ++j) { v[j] = vv[rr][j]; s += (v[j].x * v[j].x + v[j].y * v[j].y) + (v[j].z * v[j].z + v[j].w * v[j].w); }
        const float r = 1.0f / sqrtf(wave_sum(s) * (1.0f / DM) + EPS);
        const float* shp = MOD + (size_t)b * MODW + ch_sh * DM + 4 * C.lane;
        const float* scp = MOD + (size_t)b * MODW + ch_sc * DM + 4 * C.lane;
        float fa[8];
#pragma unroll
        for (int q = 0; q < 8; ++q) fa[q] = 0.f;
#pragma unroll
        for (int j = 0; j < 4; ++j) {
            const f32x4 sh = *(const f32x4*)(shp + 256 * j), sc = *(const f32x4*)(scp + 256 * j);
            f32x4 h = (v[j] * r) * g4[j] * (sc + 1.0f) + sh;
            unsigned long long o = (unsigned long long)pk2(h.x, h.y) | ((unsigned long long)pk2(h.z, h.w) << 32);
            *(unsigned long long*)(HB + (size_t)m * DM + 4 * C.lane + 256 * j) = o;
            if (WITH_FA) {
                const float hh[4] = {h.x, h.y, h.z, h.w};
#pragma unroll
                for (int e = 0; e < 4; ++e) {
                    const f32x4 wa = *(const f32x4*)(wfl + (4 * C.lane + 256 * j + e) * 8), wb = *(const f32x4*)(wfl + (4 * C.lane + 256 * j + e) * 8 + 4);
                    fa[0] += hh[e] * wa.x; fa[1] += hh[e] * wa.y; fa[2] += hh[e] * wa.z; fa[3] += hh[e] * wa.w;
                    fa[4] += hh[e] * wb.x; fa[5] += hh[e] * wb.y; fa[6] += hh[e] * wb.z; fa[7] += hh[e] * wb.w;
                }
            }
        }
        if (WITH_FA) {
            float res = 0.f;
#pragma unroll
            for (int q = 0; q < 8; ++q) { const float t = wave_sum(fa[q]); if (C.lane == q) res = t; }
            if (C.lane < 8) FA[(size_t)m * 8 + C.lane] = log_sigmoidf_(res + p.fox_bf[l * NH + C.lane]);
        }
      }
    }
    if (WITH_FA) __syncthreads();
}

namespace pg8 {
#define PG8_LAS __attribute__((address_space(3)))
typedef short bf16x8 __attribute__((ext_vector_type(8)));
constexpr int BM = 256, BK = 64, HALF = 128, HTB = HALF * BK * 2  , STAGE_BYTES = 8 * HTB, NXCD = 8, WGM = 8;
__host__ __device__ __forceinline__ int lds_byte(int r, int c) { const int st = (r >> 4) * 2 + (c >> 5), rr = r & 15, cc = c & 31, ob = rr * 64 + cc * 2; return st * 1024 + (ob ^ (((ob >> 9) & 1) << 5)); }
__host__ __device__ __forceinline__ void stage_rc(int b, int& R, int& C) { const int st = b / 1024, sb = b % 1024, swz = sb ^ (((sb >> 9) & 1) << 5); R = (st >> 1) * 16 + swz / 64; C = (st & 1) * 32 + (swz % 64) / 2; }
__host__ __device__ __forceinline__ int perm32(int rho) { const int n = rho >> 4, i = rho & 15; return 8 * (i >> 2) + 4 * n + (i & 3); }

struct Unit { int pm, pn, ka, kb, br; };
struct Gemm { const bf16_t* A; const bf16_t* Bt; int lda, ldb, K; };

struct Order {
    int nM, nN, nwg, G, c, pair;
    __device__ void init(int M, int N, int G_, int c_, int pair_) { nM = M / BM; nN = N / BM; nwg = nM * nN; G = G_; c = c_; pair = pair_; }
    __device__ bool next(int i, Unit& u) const {
        const int ii = pair ? (i >> 1) : i;
        const long L = (long)ii * G + c; if (L >= nwg) return false;
        int wgid = (int)L; { const int q = nwg / NXCD, r = nwg % NXCD, xcd = wgid % NXCD, off = wgid / NXCD; wgid = (xcd < r ? xcd * (q + 1) : r * (q + 1) + (xcd - r) * q) + off; }
        const int nig = WGM * nN, gid = wgid / nig, fm = gid * WGM, gsz = (nM - fm) < WGM ? (nM - fm) : WGM;
        u.pm = fm + ((wgid % nig) % gsz); u.pn = (wgid % nig) / gsz;
        u.br = pair ? (i & 1) : 0; u.ka = u.br * 512; u.kb = u.br * (1024 * 512);
        return true;
    }
    __device__ __forceinline__ void a_ready(const Unit&) const {}
    __device__ __forceinline__ void done(const Unit&) const {}
};

__device__ __forceinline__ unsigned cvt_pk_bf16(float lo, float hi) { unsigned r; asm volatile("v_cvt_pk_bf16_f32 %0, %1, %2" : "=v"(r) : "v"(lo), "v"(hi)); return r; }
__device__ __forceinline__ u32x4 pack8(const f32x4 a, const f32x4 b) { u32x4 w; w.x = cvt_pk_bf16(a[0], a[1]); w.y = cvt_pk_bf16(a[2], a[3]); w.z = cvt_pk_bf16(b[0], b[1]); w.w = cvt_pk_bf16(b[2], b[3]); return w; }
__device__ __forceinline__ void unpack8(const u32x4 w, f32x4& a, f32x4& b) {
    a = (f32x4){__uint_as_float(w.x << 16), __uint_as_float(w.x & 0xffff0000u), __uint_as_float(w.y << 16), __uint_as_float(w.y & 0xffff0000u)};
    b = (f32x4){__uint_as_float(w.z << 16), __uint_as_float(w.z & 0xffff0000u), __uint_as_float(w.w << 16), __uint_as_float(w.w & 0xffff0000u)};
}

struct Epi1 {
    static constexpr bool PERM = true, AFTER_DRAIN = false;
    bf16_t *QQ, *KK, *VV, *GT; const float *gq, *gk;
    __device__ __forceinline__ void operator()(const f32x4 (&acc)[2][2][4][2], const Unit& u, int wr, int wc, int fr, int fq) const {
        const int row0 = u.pm * BM + wr * 64 + fr;
        if (u.pn >= 12) {
            const int col0 = (u.pn - 12) * 256 + wc * 32 + 8 * fq;
#pragma unroll
            for (int ai = 0; ai < 2; ++ai)
#pragma unroll
                for (int m = 0; m < 4; ++m) { unsigned char* rowp = (unsigned char*)GT + (size_t)(row0 + ai * HALF + m * 16) * 2048 + col0;
#pragma unroll
                    for (int bj = 0; bj < 2; ++bj) { const f32x4 a0 = acc[ai][bj][m][0], a1 = acc[ai][bj][m][1];
                        u32x2 w; unsigned t_ = __builtin_amdgcn_cvt_pk_u8_f32(rintf(255.0f * sigmoidf_(a0[0])), 0, 0u); t_ = __builtin_amdgcn_cvt_pk_u8_f32(rintf(255.0f * sigmoidf_(a0[1])), 1, t_); t_ = __builtin_amdgcn_cvt_pk_u8_f32(rintf(255.0f * sigmoidf_(a0[2])), 2, t_); w.x = __builtin_amdgcn_cvt_pk_u8_f32(rintf(255.0f * sigmoidf_(a0[3])), 3, t_);
                        t_ = __builtin_amdgcn_cvt_pk_u8_f32(rintf(255.0f * sigmoidf_(a1[0])), 0, 0u); t_ = __builtin_amdgcn_cvt_pk_u8_f32(rintf(255.0f * sigmoidf_(a1[1])), 1, t_); t_ = __builtin_amdgcn_cvt_pk_u8_f32(rintf(255.0f * sigmoidf_(a1[2])), 2, t_); w.y = __builtin_amdgcn_cvt_pk_u8_f32(rintf(255.0f * sigmoidf_(a1[3])), 3, t_);
                        *(u32x2*)(rowp + bj * HALF) = w; } }
        } else {
            const int kind = u.pn >> 1, head = (u.pn & 1) * 4 + wc, k3 = kind % 3;
            bf16_t* base = (k3 == 0 ? QQ : (k3 == 1 ? KK : VV)) + (kind >= 3 ? 512 : 0) + head * 64 + 8 * fq;
            const bool nrm = kind < 2; const float qs = (k3 == 0) ? C2 : 1.0f;
            f32x4 gn[2][2];
#pragma unroll
            for (int bj = 0; bj < 2; ++bj)
#pragma unroll
                for (int n = 0; n < 2; ++n) gn[bj][n] = nrm ? *(const f32x4*)((kind == 0 ? gq : gk) + bj * 32 + 8 * fq + 4 * n) : (f32x4){1.f, 1.f, 1.f, 1.f};
#pragma unroll
            for (int ai = 0; ai < 2; ++ai)
#pragma unroll
                for (int m = 0; m < 4; ++m) {
                    float r = qs;
                    if (nrm) { float ss = 0.f;
#pragma unroll
                        for (int bj = 0; bj < 2; ++bj)
#pragma unroll
                            for (int n = 0; n < 2; ++n) { const f32x4 x = acc[ai][bj][m][n]; ss += (x[0] * x[0] + x[1] * x[1]) + (x[2] * x[2] + x[3] * x[3]); }
                        ss += __shfl_xor(ss, 16); ss += __shfl_xor(ss, 32);
                        r = qs * __builtin_amdgcn_rsqf(ss * (1.0f / 64.0f) + EPS); }
                    bf16_t* rowp = base + (size_t)(row0 + ai * HALF + m * 16) * DM;
#pragma unroll
                    for (int bj = 0; bj < 2; ++bj) *(u32x4*)(rowp + bj * 32) = pack8(acc[ai][bj][m][0] * r * gn[bj][0], acc[ai][bj][m][1] * r * gn[bj][1]);
                }
        }
    }
};
struct EpiGate {
    static constexpr bool PERM = true, AFTER_DRAIN = false;
    const bf16_t* GT; bf16_t* MG;
    __device__ __forceinline__ void operator()(const f32x4 (&acc)[2][2][4][2], const Unit& u, int wr, int wc, int fr, int fq) const {
        const int row0 = u.pm * BM + wr * 64 + fr, col0 = u.pn * BM + wc * 32 + 8 * fq;
#pragma unroll
        for (int ai = 0; ai < 2; ++ai)
#pragma unroll
            for (int m = 0; m < 4; ++m) { const size_t row = (size_t)(row0 + ai * HALF + m * 16);
#pragma unroll
                for (int bj = 0; bj < 2; ++bj) { const int c = col0 + bj * HALF;
                    f32x4 g0, g1; unpack8(*(const u32x4*)(GT + row * 2048 + u.br * 1024 + c), g0, g1);
                    f32x4 v0 = g0 * acc[ai][bj][m][0], v1 = g1 * acc[ai][bj][m][1];
                    if (u.br) { f32x4 o0, o1; unpack8(*(const u32x4*)(MG + row * DM + c), o0, o1); v0 += o0; v1 += o1; }
                    *(u32x4*)(MG + row * DM + c) = pack8(v0, v1); } }
    }
};
struct EpiMerge {
    static constexpr bool PERM = true, AFTER_DRAIN = false, MIDHOOK = true;
    const unsigned char* GT; bf16_t* MG;
    static __device__ __forceinline__ void unpackb(const u32x2 w, f32x4& a, f32x4& b) {
        a = (f32x4){(float)(w.x & 255u), (float)((w.x >> 8) & 255u), (float)((w.x >> 16) & 255u), (float)(w.x >> 24)};
        b = (f32x4){(float)(w.y & 255u), (float)((w.y >> 8) & 255u), (float)((w.y >> 16) & 255u), (float)(w.y >> 24)}; }
    static constexpr float TINY = 255.0f * 9.094947e-13f;
    __device__ __forceinline__ void mid(f32x4 (&acc)[2][2][4][2], const Unit& u, int wr, int wc, int fr_, int fq_) const {
        int fr = fr_, fq = fq_; asm volatile("" : "+v"(fr), "+v"(fq));
        const int row0 = u.pm * BM + wr * 64 + fr, col0 = u.pn * BM + wc * 32 + 8 * fq;
#pragma unroll
        for (int ai = 0; ai < 2; ++ai) {
            u32x2 ga[4][2], gb[4][2];
#pragma unroll
            for (int m = 0; m < 4; ++m) { const size_t row = (size_t)(row0 + ai * HALF + m * 16);
#pragma unroll
                for (int bj = 0; bj < 2; ++bj) { const int c = col0 + bj * HALF; ga[m][bj] = *(const u32x2*)(GT + row * 2048 + c); gb[m][bj] = *(const u32x2*)(GT + row * 2048 + 1024 + c); } }
#pragma unroll
            for (int m = 0; m < 4; ++m) {
#pragma unroll
                for (int bj = 0; bj < 2; ++bj) { f32x4 a0, a1, b0, b1; unpackb(ga[m][bj], a0, a1); unpackb(gb[m][bj], b0, b1);
#pragma unroll
                    for (int e = 0; e < 4; ++e) { acc[ai][bj][m][0][e] *= a0[e] * __builtin_amdgcn_rcpf(fmaxf(b0[e], TINY)); acc[ai][bj][m][1][e] *= a1[e] * __builtin_amdgcn_rcpf(fmaxf(b1[e], TINY)); } } }
            asm volatile("" ::: "memory"); __builtin_amdgcn_sched_barrier(0); }
    }
    __device__ __forceinline__ void operator()(const f32x4 (&acc)[2][2][4][2], const Unit& u, int wr, int wc, int fr, int fq) const {
        const int row0 = u.pm * BM + wr * 64 + fr, col0 = u.pn * BM + wc * 32 + 8 * fq;
#pragma unroll
        for (int ai = 0; ai < 2; ++ai) {
            u32x2 gb[4][2];
#pragma unroll
            for (int m = 0; m < 4; ++m)
#pragma unroll
                for (int bj = 0; bj < 2; ++bj) gb[m][bj] = *(const u32x2*)(GT + (size_t)(row0 + ai * HALF + m * 16) * 2048 + 1024 + col0 + bj * HALF);
#pragma unroll
            for (int m = 0; m < 4; ++m) { const size_t row = (size_t)(row0 + ai * HALF + m * 16);
#pragma unroll
                for (int bj = 0; bj < 2; ++bj) { const int c = col0 + bj * HALF;
                    f32x4 b0, b1; unpackb(gb[m][bj], b0, b1);
                    f32x4 v0, v1;
#pragma unroll
                    for (int e = 0; e < 4; ++e) { v0[e] = acc[ai][bj][m][0][e] * (fmaxf(b0[e], TINY) * (1.0f / 255.0f)); v1[e] = acc[ai][bj][m][1][e] * (fmaxf(b1[e], TINY) * (1.0f / 255.0f)); }
                    *(u32x4*)(MG + row * DM + c) = pack8(v0, v1); } } }
    }
};
struct EpiOut {
    static constexpr bool PERM = true, AFTER_DRAIN = false;
    const float* xin; const bf16_t* xinb; bf16_t* xr1; const float* g1;
    const float* gain; bf16_t* XA; float* SSQ;
    __device__ __forceinline__ void operator()(const f32x4 (&acc)[2][2][4][2], const Unit& u, int wr, int wc, int fr, int fq) const {
        const int row0 = u.pm * BM + wr * 64 + fr, col0 = u.pn * BM + wc * 32 + 8 * fq; const int b = (u.pm * BM) / SEQ;
        f32x4 gv[2][2], gs[2][2];
#pragma unroll
        for (int bj = 0; bj < 2; ++bj)
#pragma unroll
            for (int n = 0; n < 2; ++n) { gv[bj][n] = *(const f32x4*)(g1 + (size_t)b * MODW + col0 + bj * HALF + 4 * n);
                gs[bj][n] = *(const f32x4*)(gain + col0 + bj * HALF + 4 * n) * (*(const f32x4*)(g1 + (size_t)b * MODW + 2 * DM + col0 + bj * HALF + 4 * n) + 1.0f); }
#pragma unroll
        for (int ai = 0; ai < 2; ++ai)
#pragma unroll
          for (int mp = 0; mp < 2; ++mp) {
            f32x4 xr[2][2][2];
#pragma unroll
            for (int mm = 0; mm < 2; ++mm)
#pragma unroll
                for (int bj = 0; bj < 2; ++bj)
#pragma unroll
                    for (int n = 0; n < 2; ++n) { if (xinb == nullptr) xr[mm][bj][n] = *(const f32x4*)(xin + (size_t)(row0 + ai * HALF + (2 * mp + mm) * 16) * DM + col0 + bj * HALF + 4 * n); }
            if (xinb != nullptr) {
#pragma unroll
                for (int mm = 0; mm < 2; ++mm)
#pragma unroll
                    for (int bj = 0; bj < 2; ++bj) unpack8(*(const u32x4*)(xinb + (size_t)(row0 + ai * HALF + (2 * mp + mm) * 16) * DM + col0 + bj * HALF), xr[mm][bj][0], xr[mm][bj][1]); }
#pragma unroll
            for (int mm = 0; mm < 2; ++mm) { const int m = 2 * mp + mm; const size_t row = (size_t)(row0 + ai * HALF + m * 16), off = row * DM + col0; float ss = 0.f;
#pragma unroll
                for (int bj = 0; bj < 2; ++bj) { f32x4 x1[2];
#pragma unroll
                    for (int n = 0; n < 2; ++n) { const f32x4 xv = xr[mm][bj][n]; x1[n] = xv + gv[bj][n] * acc[ai][bj][m][n];
                        ss += (x1[n][0] * x1[n][0] + x1[n][1] * x1[n][1]) + (x1[n][2] * x1[n][2] + x1[n][3] * x1[n][3]); }
                    *(u32x4*)(xr1 + off + bj * HALF) = pack8(x1[0], x1[1]);
                    *(u32x4*)(XA + off + bj * HALF) = pack8(x1[0] * gs[bj][0], x1[1] * gs[bj][1]); }
                ss += __shfl_xor(ss, 16); ss += __shfl_xor(ss, 32);
                if (fq == 0) SSQ[row * 16 + u.pn * 4 + wc] = ss; } }
    }
};
struct EpiQ {
    static constexpr bool PERM = true, AFTER_DRAIN = false;
    bf16_t* O; const float* SSQ; const float* bq; float* RT;
    __device__ __forceinline__ void operator()(const f32x4 (&acc)[2][2][4][2], const Unit& u, int wr, int wc, int fr, int fq) const {
        const int row0 = u.pm * BM + wr * 64 + fr, col0 = u.pn * BM + wc * 32 + 8 * fq; const int b = (u.pm * BM) / SEQ;
        f32x4 bv[2][2];
#pragma unroll
        for (int bj = 0; bj < 2; ++bj)
#pragma unroll
            for (int n = 0; n < 2; ++n) bv[bj][n] = *(const f32x4*)(bq + (size_t)b * DM + col0 + bj * HALF + 4 * n);
        float rr[2][4];
#pragma unroll
        for (int ai = 0; ai < 2; ++ai)
#pragma unroll
            for (int m = 0; m < 4; ++m) { const size_t row = (size_t)(row0 + ai * HALF + m * 16);
                const f32x4 sq = *(const f32x4*)(SSQ + row * 16 + 4 * fq);
                float st = (sq[0] + sq[1]) + (sq[2] + sq[3]); st += __shfl_xor(st, 16); st += __shfl_xor(st, 32);
                rr[ai][m] = __builtin_amdgcn_rsqf(st * (1.0f / DM) + EPS); }
#pragma unroll
        for (int ai = 0; ai < 2; ++ai)
#pragma unroll
            for (int m = 0; m < 4; ++m) { const size_t row = (size_t)(row0 + ai * HALF + m * 16); const float r = rr[ai][m];
                bf16_t* rowp = O + row * DM + col0;
                if (u.pn == 0 && wc == 0 && fq == 0) RT[row] = r;
#pragma unroll
                for (int bj = 0; bj < 2; ++bj) *(u32x4*)(rowp + bj * HALF) = pack8(acc[ai][bj][m][0] * r + bv[bj][0], acc[ai][bj][m][1] * r + bv[bj][1]); }
    }
};
struct EpiBf {
    static constexpr bool PERM = true, AFTER_DRAIN = false;
    bf16_t* O; int ldc;
    __device__ __forceinline__ void operator()(const f32x4 (&acc)[2][2][4][2], const Unit& u, int wr, int wc, int fr, int fq) const {
        const int row0 = u.pm * BM + wr * 64 + fr, col0 = u.pn * BM + wc * 32 + 8 * fq;
#pragma unroll
        for (int ai = 0; ai < 2; ++ai)
#pragma unroll
            for (int m = 0; m < 4; ++m) { bf16_t* rowp = O + (size_t)(row0 + ai * HALF + m * 16) * ldc + col0;
#pragma unroll
                for (int bj = 0; bj < 2; ++bj) *(u32x4*)(rowp + bj * HALF) = pack8(acc[ai][bj][m][0], acc[ai][bj][m][1]); }
    }
};

template <class E_, class = void> struct has_midhook { static constexpr bool value = false; };
template <class E_> struct has_midhook<E_, decltype((void)E_::MIDHOOK)> { static constexpr bool value = true; };
template <class Epi, class Sched, bool ALIGN_EPI = false, bool SP2 = false>
__device__ __forceinline__ void gemm_phase(PG8_LAS unsigned char* lds, const Gemm g, const Sched& S, const Epi& E) {
    int tid_ = threadIdx.x; asm volatile("" : "+v"(tid_));
    const int tid = tid_, wid = __builtin_amdgcn_readfirstlane(tid >> 6), lane = tid & 63, wr = wid >> 2, wc = wid & 3, fr = lane & 15, fq = lane >> 4;
    const int K = g.K, nt = K / BK;
    unsigned voffA[2], voffB[2];
#pragma unroll
    for (int i = 0; i < 2; ++i) { int R, C; stage_rc(tid * 16 + i * 8192, R, C); const int Rb = Epi::PERM ? ((R & ~31) + perm32(R & 31)) : R;
        voffA[i] = (unsigned)(R * g.lda + C) * 2u; voffB[i] = (unsigned)(Rb * g.ldb + C) * 2u; }
    const size_t kstep = (size_t)(BK * 2);
    const size_t hsA = (size_t)HALF * g.lda * 2, hsB = (size_t)HALF * g.ldb * 2;
    const size_t tsA = 2 * hsA, tsB = 2 * hsB;
    const unsigned ldsw = (unsigned)wid * 1024u;
    const int aoff = lds_byte(wr * 64 + fr, fq * 8), boff = lds_byte(wc * 32 + fr, fq * 8);
#define PG8_SA(b, h) (((b) * 2 + (h)) * HTB)
#define PG8_SB(b, h) ((4 + (b) * 2 + (h)) * HTB)
#define PG8_STAGE(bufoff, gbase, voff) do { _Pragma("unroll") for (int _i = 0; _i < 2; ++_i) \
        __builtin_amdgcn_global_load_lds((const unsigned*)((const char*)(gbase) + (voff)[_i]), (PG8_LAS unsigned*)(lds + (bufoff) + ldsw + _i * 8192), 16, 0, 0); } while (0)
#define PG8_LDA(dst, b, h) do { _Pragma("unroll") for (int m = 0; m < 4; ++m) _Pragma("unroll") for (int k = 0; k < 2; ++k) dst[m][k] = *(const PG8_LAS bf16x8*)(lds + PG8_SA(b, h) + aoff + m * 2048 + k * 1024); } while (0)
#define PG8_LDB(dst, b, h) do { _Pragma("unroll") for (int n = 0; n < 2; ++n) _Pragma("unroll") for (int k = 0; k < 2; ++k) dst[n][k] = *(const PG8_LAS bf16x8*)(lds + PG8_SB(b, h) + boff + n * 2048 + k * 1024); } while (0)
#define PG8_MMA(ai, bj, At, Bt) do { __builtin_amdgcn_s_setprio(1); _Pragma("unroll") for (int m = 0; m < 4; ++m) _Pragma("unroll") for (int n = 0; n < 2; ++n) _Pragma("unroll") for (int k = 0; k < 2; ++k) \
        acc[ai][bj][m][n] = __builtin_amdgcn_mfma_f32_16x16x32_bf16(Bt[n][k], At[m][k], acc[ai][bj][m][n], 0, 0, 0); __builtin_amdgcn_s_setprio(0); } while (0)
#define PG8_WAIT_V(n) asm volatile("s_waitcnt vmcnt(" #n ")" ::: "memory")
#define PG8_WAIT_L(n) asm volatile("s_waitcnt lgkmcnt(" #n ")" ::: "memory")
#define PG8_BAR __builtin_amdgcn_s_barrier()
#define PG8_SCHED __builtin_amdgcn_sched_barrier(0)
    Unit cur, nxt; int ui = 0;
    if (!S.next(0, cur)) return;
    f32x4 acc[2][2][4][2];
#pragma unroll
    for (int a = 0; a < 2; ++a)
#pragma unroll
        for (int b = 0; b < 2; ++b)
#pragma unroll
            for (int m = 0; m < 4; ++m)
#pragma unroll
                for (int n = 0; n < 2; ++n) acc[a][b][m][n] = (f32x4){0.f, 0.f, 0.f, 0.f};
    bf16x8 At[4][2], B0[2][2], B1[2][2];
    const char* cA = (const char*)g.A + (size_t)cur.pm * tsA + (size_t)cur.ka * 2; const char* cB = (const char*)g.Bt + (size_t)cur.pn * tsB + (size_t)cur.kb * 2;
    S.a_ready(cur);
    if constexpr (SP2) {
        PG8_STAGE(PG8_SB(0, 0), cB, voffB); PG8_STAGE(PG8_SB(0, 1), cB + hsB, voffB); PG8_STAGE(PG8_SA(0, 0), cA, voffA); PG8_STAGE(PG8_SA(0, 1), cA + hsA, voffA);
        if (wr == 1) PG8_BAR;
        PG8_WAIT_V(2); PG8_BAR;
        PG8_STAGE(PG8_SB(1, 0), cB + kstep, voffB); PG8_STAGE(PG8_SA(1, 0), cA + kstep, voffA); PG8_STAGE(PG8_SB(1, 1), cB + hsB + kstep, voffB);
        PG8_WAIT_V(6); PG8_BAR;
    } else {
        PG8_STAGE(PG8_SB(0, 0), cB, voffB); PG8_STAGE(PG8_SA(0, 0), cA, voffA); PG8_STAGE(PG8_SB(0, 1), cB + hsB, voffB); PG8_STAGE(PG8_SA(0, 1), cA + hsA, voffA);
        if (wr == 1) PG8_BAR;
        PG8_WAIT_V(4); PG8_BAR;
        PG8_STAGE(PG8_SB(1, 0), cB + kstep, voffB); PG8_STAGE(PG8_SA(1, 0), cA + kstep, voffA); PG8_STAGE(PG8_SB(1, 1), cB + hsB + kstep, voffB);
        PG8_WAIT_V(6); PG8_BAR;
    }
    for (;;) {
        const bool has_next = S.next(ui + 1, nxt);
        const char* nA = has_next ? (const char*)g.A + (size_t)nxt.pm * tsA + (size_t)nxt.ka * 2 : cA; const char* nB = has_next ? (const char*)g.Bt + (size_t)nxt.pn * tsB + (size_t)nxt.kb * 2 : cB;
        for (int t = 0; t < nt; t += 2) {
            if constexpr (has_midhook<Epi>::value) { if (t == nt / 2) E.mid(acc, cur, wr, wc, fr, fq); }
            const bool last = (t == nt - 2);
            const char* a1 = cA + (size_t)(t + 1) * kstep;
            const char* a2 = last ? nA : cA + (size_t)(t + 2) * kstep; const char* b2 = last ? nB : cB + (size_t)(t + 2) * kstep;
            const char* a3 = a2 + kstep; const char* b3 = b2 + kstep;
            if (last && has_next) S.a_ready(nxt);
            if constexpr (SP2) {
            PG8_LDB(B0, 0, 0); PG8_LDB(B1, 0, 1); PG8_SCHED; PG8_LDA(At, 0, 0); PG8_STAGE(PG8_SA(1, 1), a1 + hsA, voffA);
            PG8_WAIT_V(8); PG8_WAIT_L(0); PG8_BAR; PG8_MMA(0, 0, At, B0); PG8_MMA(0, 1, At, B1); PG8_BAR; PG8_SCHED;
            PG8_LDA(At, 0, 1); PG8_STAGE(PG8_SB(0, 0), b2, voffB); PG8_STAGE(PG8_SB(0, 1), b2 + hsB, voffB); PG8_STAGE(PG8_SA(0, 0), a2, voffA);
            PG8_WAIT_V(8); PG8_WAIT_L(0); PG8_BAR; PG8_MMA(1, 0, At, B0); PG8_MMA(1, 1, At, B1); PG8_BAR; PG8_SCHED;
            PG8_LDB(B0, 1, 0); PG8_LDB(B1, 1, 1); PG8_SCHED; PG8_LDA(At, 1, 0); PG8_STAGE(PG8_SA(0, 1), a2 + hsA, voffA);
            PG8_WAIT_V(8); PG8_WAIT_L(0); PG8_BAR; PG8_MMA(0, 0, At, B0); PG8_MMA(0, 1, At, B1); PG8_BAR; PG8_SCHED;
            PG8_LDA(At, 1, 1); PG8_STAGE(PG8_SB(1, 0), b3, voffB); PG8_STAGE(PG8_SB(1, 1), b3 + hsB, voffB); PG8_STAGE(PG8_SA(1, 0), a3, voffA);
            PG8_WAIT_V(8); PG8_WAIT_L(0); PG8_BAR; PG8_MMA(1, 0, At, B0); PG8_MMA(1, 1, At, B1); PG8_BAR; PG8_SCHED;
            } else {
            PG8_LDB(B0, 0, 0); PG8_SCHED; PG8_LDA(At, 0, 0); PG8_STAGE(PG8_SA(1, 1), a1 + hsA, voffA);
            PG8_WAIT_L(8); PG8_BAR; PG8_WAIT_L(0); PG8_MMA(0, 0, At, B0); PG8_BAR; PG8_SCHED;
            PG8_LDB(B1, 0, 1); PG8_STAGE(PG8_SB(0, 0), b2, voffB);
            PG8_BAR; PG8_WAIT_L(0); PG8_MMA(0, 1, At, B1); PG8_BAR;
            PG8_LDA(At, 0, 1); PG8_STAGE(PG8_SA(0, 0), a2, voffA);
            PG8_BAR; PG8_WAIT_L(0); PG8_MMA(1, 0, At, B0); PG8_BAR; PG8_SCHED;
            PG8_STAGE(PG8_SB(0, 1), b2 + hsB, voffB);
            PG8_WAIT_V(6); PG8_BAR; PG8_MMA(1, 1, At, B1); PG8_BAR;
            PG8_LDB(B0, 1, 0); PG8_SCHED; PG8_LDA(At, 1, 0); PG8_STAGE(PG8_SA(0, 1), a2 + hsA, voffA);
            PG8_WAIT_L(8); PG8_BAR; PG8_WAIT_L(0); PG8_MMA(0, 0, At, B0); PG8_BAR; PG8_SCHED;
            PG8_LDB(B1, 1, 1); PG8_STAGE(PG8_SB(1, 0), b3, voffB);
            PG8_BAR; PG8_WAIT_L(0); PG8_MMA(0, 1, At, B1); PG8_BAR;
            PG8_LDA(At, 1, 1); PG8_STAGE(PG8_SA(1, 0), a3, voffA);
            PG8_BAR; PG8_WAIT_L(0); PG8_MMA(1, 0, At, B0); PG8_BAR; PG8_SCHED;
            PG8_STAGE(PG8_SB(1, 1), b3 + hsB, voffB);
            PG8_WAIT_V(6); PG8_BAR; PG8_MMA(1, 1, At, B1); PG8_BAR;
            }
        }
        if constexpr (ALIGN_EPI) { if (wr == 0) PG8_BAR; }
        if constexpr (!Epi::AFTER_DRAIN) { E(acc, cur, wr, wc, fr, fq); S.done(cur); }
        if (!has_next) break;
#pragma unroll
        for (int a = 0; a < 2; ++a)
#pragma unroll
            for (int b = 0; b < 2; ++b)
#pragma unroll
                for (int m = 0; m < 4; ++m)
#pragma unroll
                    for (int n = 0; n < 2; ++n) acc[a][b][m][n] = (f32x4){0.f, 0.f, 0.f, 0.f};
        cur = nxt; cA = nA; cB = nB; ++ui;
        if constexpr (ALIGN_EPI) { if (wr == 1) PG8_BAR; }
    }
    PG8_WAIT_V(0);
    if constexpr (!ALIGN_EPI) { if (wr == 0) PG8_BAR; }
    PG8_BAR;
    if constexpr (Epi::AFTER_DRAIN) { E.fused(acc, cur, wr, wc, fr, fq, lds, wid, lane); S.done(cur); }
#undef PG8_SA
#undef PG8_SB
#undef PG8_STAGE
#undef PG8_LDA
#undef PG8_LDB
#undef PG8_MMA
#undef PG8_WAIT_V
#undef PG8_WAIT_L
#undef PG8_BAR
#undef PG8_SCHED
}
}

__device__ __forceinline__ int win_logical_col(int n) {
    const int pn = n >> 8, tc = n & 255;
    if (pn >= 12) return 3080 + (pn - 12) * 256 + tc;
    const int kind = pn >> 1, bj = tc >> 7, wc = (tc >> 5) & 3, i = tc & 31;
    const int base = (kind < 3) ? kind * 512 : 1544 + (kind - 3) * 512;
    return base + ((pn & 1) * 4 + wc) * 64 + bj * 32 + i;
}
__device__ __forceinline__ void transpose_item(const float* W, int ldw, int src_c0, int k0, bf16_t* WT, int K, int dst_row0, float* scr, int lane) {
#pragma unroll 8
    for (int i = 0; i < 32; ++i) { const int kk = 2 * i + (lane >> 5); scr[kk * 33 + (lane & 31)] = W[(size_t)(k0 + kk) * ldw + src_c0 + (lane & 31)]; }
    __builtin_amdgcn_s_waitcnt(0xc07f); asm volatile("" ::: "memory");
    const int c = lane & 7;
#pragma unroll
    for (int j = 0; j < 4; ++j) { const int n = (lane >> 3) + 8 * j; const float* s = scr + (8 * c) * 33 + n;
        u32x4 o; o.x = pk2(s[0 * 33], s[1 * 33]); o.y = pk2(s[2 * 33], s[3 * 33]); o.z = pk2(s[4 * 33], s[5 * 33]); o.w = pk2(s[6 * 33], s[7 * 33]);
        *(u32x4*)(WT + (size_t)(dst_row0 + n) * K + k0 + 8 * c) = o; }
    __builtin_amdgcn_s_waitcnt(0xc07f); asm volatile("" ::: "memory");
}
__device__ __forceinline__ void ph_weights(const Prm& p, const Ctx& C, unsigned char* lds) {
    float* scr = (float*)(lds + C.wave * 16384);
    bf16_t* WIN = (bf16_t*)(p.ws + WS_WIN); bf16_t* WBR = (bf16_t*)(p.ws + WS_WBR); bf16_t* WOUT = (bf16_t*)(p.ws + WS_WOUT); bf16_t* WQT = (bf16_t*)(p.ws + WS_WQ);
    constexpr int I_IN = 16 * 160, I_BR = 8 * 32, I_SQ = 16 * 32;
    constexpr int NITEMS = 2 * I_IN + 4 * I_BR + 2 * I_SQ + 2 * I_SQ;
    for (int it = C.gw; it < NITEMS; it += C.ngw) {
        int r = it;
        if (r < 2 * I_IN) { const int l = r / I_IN, q = r % I_IN, kb = q / 160, nb = q % 160;
            transpose_item(p.w_in + (size_t)l * DM * INW, INW, win_logical_col(32 * nb), 64 * kb, WIN + (size_t)l * 5120 * DM, DM, 32 * nb, scr, C.lane); continue; }
        r -= 2 * I_IN;
        if (r < 4 * I_BR) { const int lg = r / I_BR, q = r % I_BR, kb = q / 32, nb = q % 32;
            transpose_item(p.w_branch + (size_t)lg * 512 * DM, DM, 32 * nb, 64 * kb, WBR + (size_t)(lg >> 1) * DM * DM + (lg & 1) * 512, DM, 32 * nb, scr, C.lane); continue; }
        r -= 4 * I_BR;
        if (r < 2 * I_SQ) { const int l = r / I_SQ, q = r % I_SQ, kb = q / 32, nb = q % 32;
            transpose_item(p.w_out + (size_t)l * DM * DM, DM, 32 * nb, 64 * kb, WOUT + (size_t)l * DM * DM, DM, 32 * nb, scr, C.lane); continue; }
        r -= 2 * I_SQ;
        { const int l = r / I_SQ, q = r % I_SQ, kb = q / 32, nb = q % 32;
            transpose_item(p.wq + (size_t)l * DM * DM, DM, 32 * nb, 64 * kb, WQT + (size_t)l * DM * DM, DM, 32 * nb, scr, C.lane); }
    }
}
#define LDSP(p) ((PG8_LAS unsigned char*)(p))
__device__ __forceinline__ void ph_gemm1(const Prm& p, int l, unsigned char* lds) {
    pg8::Gemm g{(const bf16_t*)(p.ws + WS_HB), (const bf16_t*)(p.ws + WS_WIN) + (size_t)l * 5120 * DM, DM, DM, DM};
    pg8::Order S; S.init(NT, 5120, gridDim.x, blockIdx.x, 0);
    pg8::Epi1 E{(bf16_t*)(p.ws + WS_QQ), (bf16_t*)(p.ws + WS_KK), (bf16_t*)(p.ws + WS_VV), (bf16_t*)(p.ws + WS_GT), p.gq + l * HD, p.gk + l * HD};
    pg8::gemm_phase<pg8::Epi1, pg8::Order, true, true>(LDSP(lds), g, S, E);
}
__device__ __forceinline__ void ph_merge(const Prm& p, int l, unsigned char* lds) {
    pg8::Gemm g{(const bf16_t*)(p.ws + WS_QQ), (const bf16_t*)(p.ws + WS_WBR) + (size_t)l * DM * DM, DM, DM, DM};
    pg8::Order S; S.init(NT, DM, gridDim.x, blockIdx.x, 0);
    pg8::EpiMerge E{(const unsigned char*)(p.ws + WS_GT), (bf16_t*)(p.ws + WS_HB)};
    pg8::gemm_phase<pg8::EpiMerge, pg8::Order, true, true>(LDSP(lds), g, S, E);
}
__device__ __forceinline__ void ph_out(const Prm& p, int l, unsigned char* lds) {
    pg8::Gemm g{(const bf16_t*)(p.ws + WS_HB), (const bf16_t*)(p.ws + WS_WOUT) + (size_t)l * DM * DM, DM, DM, DM};
    pg8::Order S; S.init(NT, DM, gridDim.x, blockIdx.x, 0);
    pg8::EpiOut E{p.x, l == 0 ? (const bf16_t*)nullptr : (const bf16_t*)p.out, (bf16_t*)(p.ws + WS_XR1), (const float*)(p.ws + WS_MOD) + (size_t)l * NB * MODW + 2 * DM, p.ffn_norm + l * DM, (bf16_t*)(p.ws + WS_QQ), (float*)(p.ws + WS_SSQ)};
    pg8::gemm_phase<pg8::EpiOut, pg8::Order, true, true>(LDSP(lds), g, S, E);
}
__device__ __forceinline__ void ph_q(const Prm& p, int l, unsigned char* lds) {
    pg8::Gemm g{(const bf16_t*)(p.ws + WS_QQ), (const bf16_t*)(p.ws + WS_WQ) + (size_t)l * DM * DM, DM, DM, DM};
    pg8::Order S; S.init(NT, DM, gridDim.x, blockIdx.x, 0);
    pg8::EpiQ E{(bf16_t*)(p.ws + WS_KK), (const float*)(p.ws + WS_SSQ), (const float*)(p.ws + WS_BQ) + (size_t)l * NB * DM, (float*)(p.ws + WS_FC)};
    pg8::gemm_phase<pg8::EpiQ, pg8::Order, true, true>(LDSP(lds), g, S, E);
}

namespace attn_body {
using bf16=__hip_bfloat16;
using bf16x8=__attribute__((ext_vector_type(8)))short;
using s16x4=__attribute__((ext_vector_type(4)))short;
using f32x16=__attribute__((ext_vector_type(16)))float;
using u32x4=__attribute__((ext_vector_type(4)))unsigned;
using f32x4_t=__attribute__((ext_vector_type(4)))float;
constexpr int BATCH=8,NHEAD=8,SEQ=4096,D=64,DM=1024;
constexpr int NW=8,QBLK=32,QB=QBLK*NW,KVBLK=64,NQB=SEQ/QB;
constexpr int ATTN_PITCH=DM, ATTN_UNIT_ROWS=QB;
__device__ __forceinline__ int crow(int r,int hi){return (r&3)+8*(r>>2)+4*hi;}
#define SBAR() __builtin_amdgcn_sched_barrier(0)
__device__ __forceinline__ void cmask(f32x16&p0,f32x16&p1,int jb,int qrel,int hi){
  const float NEG=-INFINITY; int d=qrel-(64*jb+4*hi); asm volatile("":"+v"(d));
  #pragma unroll
  for(int r=0;r<16;++r){const int c=(r&3)+8*(r>>2); if(c>d)p0[r]=NEG; if(c+32>d)p1[r]=NEG;}
}

constexpr int NSLOT=3, SLOTB=8192;
constexpr int LDS_K=0, LDS_V=NSLOT*SLOTB, LDS_WS=2*NSLOT*SLOTB, LDS_OST=LDS_WS+NW*64*4, LDS_BYTES=LDS_OST+NW*4096;
constexpr float C2=0.125f*1.4426950408889634f;
__device__ __forceinline__ void glds16(const void*gsrc,unsigned lds_dst){unsigned keep;
  asm volatile("s_mov_b32 %0, m0\n\ts_mov_b32 m0, %2\n\ts_nop 0\n\tglobal_load_lds_dwordx4 %1, off\n\ts_mov_b32 m0, %0":"=&s"(keep):"v"(gsrc),"s"(lds_dst):"memory");}
__device__ __forceinline__ float max3f(float a,float b,float c){float r;asm("v_max3_f32 %0, %1, %2, %3":"=v"(r):"v"(a),"v"(b),"v"(c));return r;}
__device__ __forceinline__ float max2f(float a,float b){float r;asm("v_max_f32_e32 %0, %1, %2":"=v"(r):"v"(a),"v"(b));return r;}
__device__ __forceinline__ float fadd_s(float a,float b){float r;asm("v_add_f32_e32 %0, %1, %2":"=v"(r):"v"(a),"v"(b));return r;}
__device__ __forceinline__ float fsub_s(float a,float b){float r;asm("v_sub_f32_e32 %0, %1, %2":"=v"(r):"v"(a),"v"(b));return r;}
typedef float f32x2_t __attribute__((ext_vector_type(2))); typedef __bf16 bf16x2_t __attribute__((ext_vector_type(2)));
__device__ __forceinline__ unsigned cvtpk_s(float lo,float hi){f32x2_t v={lo,hi};bf16x2_t b=__builtin_convertvector(v,bf16x2_t);return __builtin_bit_cast(unsigned,b);}
#define WAIT_BAR(N) asm volatile("s_waitcnt vmcnt(" #N ") lgkmcnt(0)\n\ts_barrier":::"memory")

__device__ __forceinline__ void qkt(f32x16&p0,f32x16&p1,const char*Kslot,const bf16x8*qr,const f32x16&negm,int r32,int hi){
  const char*kb=Kslot+hi*1024+r32*16;
  #pragma unroll
  for(int d0=0;d0<4;++d0){
    const bf16x8 b0=*reinterpret_cast<const bf16x8*>(kb+d0*2048);
    const bf16x8 b1=*reinterpret_cast<const bf16x8*>(kb+d0*2048+512);
    if(d0==0){p0=__builtin_amdgcn_mfma_f32_32x32x16_bf16(b0,qr[0],negm,0,0,0);p1=__builtin_amdgcn_mfma_f32_32x32x16_bf16(b1,qr[0],negm,0,0,0);}
    else{p0=__builtin_amdgcn_mfma_f32_32x32x16_bf16(b0,qr[d0],p0,0,0,0);p1=__builtin_amdgcn_mfma_f32_32x32x16_bf16(b1,qr[d0],p1,0,0,0);}}
}
typedef __attribute__((address_space(3))) const char* lds_cptr;
typedef short v4i16_t __attribute__((ext_vector_type(4)));
__device__ __forceinline__ void kload8(bf16x8*kf,lds_cptr kp){
  kf[0]=*(const __attribute__((address_space(3))) bf16x8*)(kp);      kf[1]=*(const __attribute__((address_space(3))) bf16x8*)(kp+512);
  kf[2]=*(const __attribute__((address_space(3))) bf16x8*)(kp+2048); kf[3]=*(const __attribute__((address_space(3))) bf16x8*)(kp+2560);
  kf[4]=*(const __attribute__((address_space(3))) bf16x8*)(kp+4096); kf[5]=*(const __attribute__((address_space(3))) bf16x8*)(kp+4608);
  kf[6]=*(const __attribute__((address_space(3))) bf16x8*)(kp+6144); kf[7]=*(const __attribute__((address_space(3))) bf16x8*)(kp+6656);
}
__device__ __forceinline__ void kload2(bf16x8*kf,lds_cptr kp,int j){ kf[2*j]=*(const __attribute__((address_space(3))) bf16x8*)(kp+j*2048); kf[2*j+1]=*(const __attribute__((address_space(3))) bf16x8*)(kp+j*2048+512); }
__device__ __forceinline__ s16x4 vtr(lds_cptr p){ return __builtin_bit_cast(s16x4,__builtin_amdgcn_ds_read_tr16_b64_v4i16((__attribute__((address_space(3))) v4i16_t*)p)); }
__device__ __forceinline__ float rowmax(const f32x16&p0,const f32x16&p1){
  float a=max3f(p0[0],p0[1],p1[0]),b=max3f(p0[2],p0[3],p1[1]);a=max3f(a,p1[2],p1[3]);
  #pragma unroll
  for(int r=4;r<16;r+=4){a=max3f(a,p0[r],p0[r+1]);b=max3f(b,p0[r+2],p0[r+3]);a=max3f(a,p1[r],p1[r+1]);b=max3f(b,p1[r+2],p1[r+3]);}
  const float m=max2f(a,b);
  auto rr=__builtin_amdgcn_permlane32_swap(__float_as_uint(m),__float_as_uint(m),false,false);
  return max2f(__uint_as_float(rr[0]),__uint_as_float(rr[1]));
}
__device__ __forceinline__ void pv(f32x16*o,int vb,bf16x8 pa0,bf16x8 pa1,bf16x8 pa2,bf16x8 pa3){
  #pragma unroll
  for(int d0=0;d0<2;++d0){s16x4 lo[4],hi[4];
    #pragma unroll
    for(int ks=0;ks<4;++ks){
      asm volatile("ds_read_b64_tr_b16 %0,%1 offset:%c2":"=&v"(lo[ks]):"v"(vb),"i"(d0*4096+ks*1024):"memory");
      asm volatile("ds_read_b64_tr_b16 %0,%1 offset:%c2":"=&v"(hi[ks]):"v"(vb),"i"(d0*4096+ks*1024+512):"memory");}
    asm volatile("s_waitcnt lgkmcnt(0)":::"memory");SBAR();
    #define PK(k) (bf16x8){lo[k][0],lo[k][1],lo[k][2],lo[k][3],hi[k][0],hi[k][1],hi[k][2],hi[k][3]}
    o[d0]=__builtin_amdgcn_mfma_f32_32x32x16_bf16(pa0,PK(0),o[d0],0,0,0);
    o[d0]=__builtin_amdgcn_mfma_f32_32x32x16_bf16(pa1,PK(1),o[d0],0,0,0);
    o[d0]=__builtin_amdgcn_mfma_f32_32x32x16_bf16(pa2,PK(2),o[d0],0,0,0);
    o[d0]=__builtin_amdgcn_mfma_f32_32x32x16_bf16(pa3,PK(3),o[d0],0,0,0);
    #undef PK
  }
}

#ifndef ATTN_STORE16
#define ATTN_STORE16(p,v) (*(u32x4*)(p)=(v))
#endif
template<int THRL> __device__ __forceinline__ void attn_unit(int b,int h,int qb,const bf16*Q,const bf16*__restrict__ K,const bf16*__restrict__ V,bf16*O,char*shm,const float*Gl,int j0){
  int tid_=threadIdx.x; asm volatile("":"+v"(tid_));
  const int tid=tid_,lane=tid&63,r32=lane&31,hi=lane>>5; const int wid=__builtin_amdgcn_readfirstlane(tid>>6);
  const long rowbase=(long)b*SEQ; const int q0=qb*QB;
  const bf16*Qw=Q+(rowbase+q0+wid*QBLK)*DM+h*D;
  const bf16*Kh=K+(rowbase+(long)j0*KVBLK)*DM+h*D,*Vh=V+(rowbase+(long)j0*KVBLK)*DM+h*D; const float*Glt=Gl+j0*KVBLK;
  const unsigned lds0=(unsigned)(uintptr_t)shm;
  float*wsf=(float*)(shm+LDS_WS)+wid*64;
  const bf16*ksrc=Kh+(long)lane*DM+wid*8;
  const bf16*vsrc=Vh+(long)(16*(wid&3)+(lane>>2))*DM+(wid>>2)*32+(lane&3)*8;
  const unsigned kdst=lds0+LDS_K+wid*1024, vdst=lds0+LDS_V+wid*1024;
  #define DMA_K(t,slot) glds16(ksrc+(long)(t)*KVBLK*DM,(unsigned)__builtin_amdgcn_readfirstlane(kdst+(slot)))
  #define DMA_V(t,slot) glds16(vsrc+(long)(t)*KVBLK*DM,(unsigned)__builtin_amdgcn_readfirstlane(vdst+(slot)))
  const int vb0=(int)(lds0+LDS_V)+((lane>>4)&1)*32+(lane&3)*8+(4*hi+((lane&15)>>2))*64;
  const char*Kbase=shm+LDS_K; bf16x8 kf[8];
  const lds_cptr shm3=(lds_cptr)shm; const lds_cptr kp0=shm3+LDS_K+hi*1024+r32*16; const lds_cptr vp0=shm3+LDS_V+((lane>>4)&1)*32+(lane&3)*8+(4*hi+((lane&15)>>2))*64;
  const int NT=(q0+QB)/KVBLK-j0;
  DMA_K(0,0);DMA_V(0,0);DMA_K(1,SLOTB);
  bf16x8 qr[4];
  #pragma unroll
  for(int d0=0;d0<4;++d0)qr[d0]=*reinterpret_cast<const bf16x8*>(&Qw[(long)r32*DM+d0*16+hi*8]);
  typedef __attribute__((address_space(3))) bf16x8* qst_ptr; const qst_ptr qst=(qst_ptr)(((__attribute__((address_space(3))) char*)shm)+LDS_OST+wid*4096)+lane;
  #pragma unroll
  for(int d0=0;d0<4;++d0)qst[d0*64]=qr[d0];
  const int qrel=wid*QBLK+r32; const float Gq=Gl[q0+qrel];
  float mhat=0.f,l_reg=0.f;f32x16 o[2];o[0]=f32x16{};o[1]=f32x16{};const f32x16 negm=f32x16{}; float base=Gq;
  #define BIAS(C0,C1,t) do{ const float*gk_=Glt+(t)*64+4*hi; _Pragma("unroll") for(int g_=0;g_<4;++g_){ SBAR(); const f32x4_t a_=*(const f32x4_t*)(gk_+8*g_), b_=*(const f32x4_t*)(gk_+32+8*g_); \
    _Pragma("unroll") for(int e_=0;e_<4;++e_){ C0[4*g_+e_]+=base-a_[e_]; C1[4*g_+e_]+=base-b_[e_]; } } SBAR(); }while(0)
  #define CMASK(P0,P1,t) do{int jb_=(t)-(NT-4); if(jb_>=0)cmask(P0,P1,jb_,qrel,hi);}while(0)
  bool resc=false;
  #define START(P0,P1) do{ const float rm=rowmax(P0,P1); resc=false; \
    { const float dl=rm; mhat=fadd_s(mhat,dl); \
      _Pragma("unroll") for(int r=0;r<16;++r){P0[r]=fsub_s(P0[r],dl);P1[r]=fsub_s(P1[r],dl);} \
      base=Gq-mhat; } \
    _Pragma("unroll") for(int r=0;r<16;++r)P0[r]=__builtin_amdgcn_exp2f(P0[r]); }while(0)
  #define RESC() do{ if(resc){ asm volatile("s_waitcnt lgkmcnt(0)":::"memory"); \
      _Pragma("unroll") for(int d_=0;d_<2;++d_) _Pragma("unroll") for(int r=0;r<16;++r)o[d_][r]*=wsf[crow(r,hi)]; } }while(0)
  f32x16 pA0,pA1,pB0,pB1;
  int sl_prev=0,sl_cur=0,sl_next=SLOTB;
  #define ROT() do{sl_prev=sl_cur;sl_cur=sl_next;sl_next=(sl_next==(NSLOT-1)*SLOTB)?0:sl_next+SLOTB;}while(0)
  DMA_K(2,2*SLOTB);
  WAIT_BAR(3);
  qkt(pA0,pA1,Kbase,qr,negm,r32,hi);BIAS(pA0,pA1,0);asm volatile("s_nop 15\n\ts_nop 7":"+v"(pA0),"+v"(pA1));CMASK(pA0,pA1,0);
  START(pA0,pA1);
  _Pragma("unroll") for(int r=0;r<16;++r)pA1[r]=__builtin_amdgcn_exp2f(pA1[r]);
  WAIT_BAR(0);
  DMA_K(3,0);DMA_V(1,SLOTB);
  ROT();
  kload8(kf,kp0+sl_cur);
  WAIT_BAR(2);
  s16x4 vlo[8],vhi[8]; u32x4 pw0,pw1,pw2,pw3;
  #define PKW(P,B) cvtpk_s(P[B],P[B+1])
  #define PAF(k) __builtin_bit_cast(bf16x8,pw##k)
  #define VFR(i) (bf16x8){vlo[i][0],vlo[i][1],vlo[i][2],vlo[i][3],vhi[i][0],vhi[i][1],vhi[i][2],vhi[i][3]}
  #define PIN(x) asm volatile("":"+v"(x))
  #define MX3(a,b,c) __builtin_fmaxf(__builtin_fmaxf((a),(b)),(c))
  #define GAPA(MF,A0,A1,A2,A3,W0,W1,PW) do{ MF; sacc+=A0; sacc+=A1; sacc+=A2; sacc+=A3; PIN(sacc); W0; W1; PIN(PW); SBAR(); }while(0)
  #define EX(v) __builtin_amdgcn_exp2f(v)
  #define GAPB(MF,X,B) do{ MF; X[B]=EX(X[B]); X[B+1]=EX(X[B+1]); X[B+2]=EX(X[B+2]); X[B+3]=EX(X[B+3]); PIN(X); SBAR(); }while(0)
  #define VRD(i) do{ vlo[i]=vtr(vp_+(((i)>>2)*4096+((i)&3)*1024)); vhi[i]=vtr(vp_+(((i)>>2)*4096+((i)&3)*1024+512)); }while(0)
  #define KRD(G,j) do{ if(G){ kload2(kf,kp0+sl_next,j); SBAR(); } }while(0)
  #define STEP(C0,C1,P0,P1,t,GK,GV,GL) do{ SBAR(); \
    const lds_cptr vp_=vp0+sl_prev; const bf16x8 q0_=qst[0],q1_=qst[64],q2_=qst[128],q3_=qst[192]; \
    VRD(0); SBAR(); float sacc=(P0[0]+P0[1]); \
    GAPA(C0=__builtin_amdgcn_mfma_f32_32x32x16_bf16(kf[0],q0_,negm,0,0,0), P0[2],P0[3],P0[4],P0[5],     pw0[0]=PKW(P0,0), pw0[1]=PKW(P0,2), pw0); \
    VRD(4); SBAR(); GAPA(C1=__builtin_amdgcn_mfma_f32_32x32x16_bf16(kf[1],q0_,negm,0,0,0), P0[6],P0[7],P0[8],P0[9],     pw0[2]=PKW(P0,4), pw0[3]=PKW(P0,6), pw0); \
    VRD(1); SBAR(); GAPA(C0=__builtin_amdgcn_mfma_f32_32x32x16_bf16(kf[2],q1_,C0,0,0,0),   P0[10],P0[11],P0[12],P0[13], pw1[0]=PKW(P0,8), pw1[1]=PKW(P0,10), pw1); \
    VRD(5); SBAR(); GAPA(C1=__builtin_amdgcn_mfma_f32_32x32x16_bf16(kf[3],q1_,C1,0,0,0),   P0[14],P0[15],P1[0],P1[1],   pw1[2]=PKW(P0,12),pw1[3]=PKW(P0,14), pw1); \
    VRD(2); SBAR(); GAPA(C0=__builtin_amdgcn_mfma_f32_32x32x16_bf16(kf[4],q2_,C0,0,0,0),   P1[2],P1[3],P1[4],P1[5],     pw2[0]=PKW(P1,0), pw2[1]=PKW(P1,2), pw2); \
    VRD(6); SBAR(); GAPA(C1=__builtin_amdgcn_mfma_f32_32x32x16_bf16(kf[5],q2_,C1,0,0,0),   P1[6],P1[7],P1[8],P1[9],     pw2[2]=PKW(P1,4), pw2[3]=PKW(P1,6), pw2); \
    VRD(3); SBAR(); GAPA(C0=__builtin_amdgcn_mfma_f32_32x32x16_bf16(kf[6],q3_,C0,0,0,0),   P1[10],P1[11],P1[12],P1[13], pw3[0]=PKW(P1,8), pw3[1]=PKW(P1,10), pw3); \
    VRD(7); SBAR(); GAPA(C1=__builtin_amdgcn_mfma_f32_32x32x16_bf16(kf[7],q3_,C1,0,0,0),   P1[14],P1[15],0.f,0.f,       pw3[2]=PKW(P1,12),pw3[3]=PKW(P1,14), pw3); \
    l_reg+=sacc; \
    if(GK){DMA_K((t)+3,sl_cur);} if(GV){DMA_V((t)+1,sl_next);} \
    BIAS(C0,C1,t); CMASK(C0,C1,t); \
    { float a=MX3(C0[0],C0[1],C1[0]),b=MX3(C0[2],C0[3],C1[1]); a=MX3(a,C1[2],C1[3]); \
      _Pragma("unroll") for(int r=4;r<16;r+=4){a=MX3(a,C0[r],C0[r+1]);b=MX3(b,C0[r+2],C0[r+3]);a=MX3(a,C1[r],C1[r+1]);b=MX3(b,C1[r+2],C1[r+3]);} \
      float rm=__builtin_fmaxf(a,b); { auto rr=__builtin_amdgcn_permlane32_swap(__float_as_uint(rm),__float_as_uint(rm),false,false); rm=__builtin_fmaxf(__uint_as_float(rr[0]),__uint_as_float(rr[1])); } \
      resc=false; \
      if(__builtin_expect(__any(rm>(float)THRL),0)){ const float dl=__builtin_fmaxf(rm,0.f); mhat+=dl; \
        _Pragma("unroll") for(int r=0;r<16;++r){C0[r]-=dl;C1[r]-=dl;} \
        base=Gq-mhat; \
        const float f=__builtin_amdgcn_exp2f(-dl); l_reg*=f; if(hi==0)wsf[r32]=f; resc=true; } } \
    SBAR(); \
    GAPB(o[0]=__builtin_amdgcn_mfma_f32_32x32x16_bf16(PAF(0),VFR(0),o[0],0,0,0), C0,0); \
    GAPB(o[1]=__builtin_amdgcn_mfma_f32_32x32x16_bf16(PAF(0),VFR(4),o[1],0,0,0), C0,4); \
    KRD(GL,0); GAPB(o[0]=__builtin_amdgcn_mfma_f32_32x32x16_bf16(PAF(1),VFR(1),o[0],0,0,0), C0,8); \
    KRD(GL,1); GAPB(o[1]=__builtin_amdgcn_mfma_f32_32x32x16_bf16(PAF(1),VFR(5),o[1],0,0,0), C0,12); \
    KRD(GL,2); GAPB(o[0]=__builtin_amdgcn_mfma_f32_32x32x16_bf16(PAF(2),VFR(2),o[0],0,0,0), C1,0); \
    KRD(GL,3); GAPB(o[1]=__builtin_amdgcn_mfma_f32_32x32x16_bf16(PAF(2),VFR(6),o[1],0,0,0), C1,4); \
    GAPB(o[0]=__builtin_amdgcn_mfma_f32_32x32x16_bf16(PAF(3),VFR(3),o[0],0,0,0), C1,8); \
    GAPB(o[1]=__builtin_amdgcn_mfma_f32_32x32x16_bf16(PAF(3),VFR(7),o[1],0,0,0), C1,12); \
    }while(0)
  int t=1;
  #undef CMASK
  #define CMASK(P0,P1,t) do{}while(0)
  for(;t+5<NT;t+=2){
    STEP(pB0,pB1,pA0,pA1,t,true,true,true);     WAIT_BAR(2); RESC(); ROT();
    STEP(pA0,pA1,pB0,pB1,t+1,true,true,true);   WAIT_BAR(2); RESC(); ROT();
  }
  #undef CMASK
  #define CMASK(P0,P1,t) do{int jb_=(t)-(NT-4); if(jb_>=0)cmask(P0,P1,jb_,qrel,hi);}while(0)
  #define ENDW(tt) do{ if((tt)+3<NT){WAIT_BAR(2);} else if((tt)+2<NT){WAIT_BAR(1);} else {WAIT_BAR(0);} }while(0)
  for(;t+1<NT;t+=2){
    STEP(pB0,pB1,pA0,pA1,t,(t+3<NT),(t+1<NT),(t+1<NT));       ENDW(t);   RESC(); ROT();
    STEP(pA0,pA1,pB0,pB1,t+1,(t+4<NT),(t+2<NT),(t+2<NT));     ENDW(t+1); RESC(); ROT();
  }
  STEP(pB0,pB1,pA0,pA1,NT-1,false,false,false); RESC();
  { float sacc=pB0[0]+pB0[1]; _Pragma("unroll") for(int r=2;r<16;++r)sacc+=pB0[r]; _Pragma("unroll") for(int r=0;r<16;++r)sacc+=pB1[r]; l_reg+=sacc;
    pw0=(u32x4){PKW(pB0,0),PKW(pB0,2),PKW(pB0,4),PKW(pB0,6)};pw1=(u32x4){PKW(pB0,8),PKW(pB0,10),PKW(pB0,12),PKW(pB0,14)};pw2=(u32x4){PKW(pB1,0),PKW(pB1,2),PKW(pB1,4),PKW(pB1,6)};pw3=(u32x4){PKW(pB1,8),PKW(pB1,10),PKW(pB1,12),PKW(pB1,14)};
    SBAR(); pv(o,vb0+sl_cur,PAF(0),PAF(1),PAF(2),PAF(3)); }
  #undef PKW
  #undef PAF
  #undef VFR
  #undef PIN
  #undef MX3
  #undef GAPA
  #undef GAPB
  #undef EX
  #undef VRD
  #undef KRD
  #undef STEP
  #undef ENDW
  {auto rr=__builtin_amdgcn_permlane32_swap(__float_as_uint(l_reg),__float_as_uint(l_reg),false,false);l_reg=__uint_as_float(rr[0])+__uint_as_float(rr[1]);}
  if(hi==0)wsf[32+r32]=l_reg;asm volatile("s_waitcnt lgkmcnt(0)":::"memory");
  float rli[16];
  #pragma unroll
  for(int r=0;r<16;++r)rli[r]=__builtin_amdgcn_rcpf(wsf[32+crow(r,hi)]);
  bf16*Ow=O+(rowbase+q0+wid*QBLK)*DM+h*D;
  { bf16*stg=(bf16*)(shm+LDS_OST)+wid*2048;
    #pragma unroll
    for(int r=0;r<16;++r){const int orow=crow(r,hi);
      #pragma unroll
      for(int d0=0;d0<2;++d0)stg[orow*64+d0*32+r32]=__float2bfloat16(o[d0][r]*rli[r]);}
    asm volatile("s_waitcnt lgkmcnt(0)":::"memory");
    #pragma unroll
    for(int i=0;i<4;++i){const int row=i*8+(lane>>3),ch=lane&7; const u32x4 v=*(const u32x4*)(stg+row*64+ch*8); ATTN_STORE16(Ow+(long)row*DM+ch*8,v);} }
  asm volatile("s_waitcnt lgkmcnt(0)\n\ts_barrier":::"memory");
  #undef DMA_K
  #undef DMA_V
  #undef CMASK
  #undef BIAS
  #undef START
  #undef RESC
  #undef ROT
}
constexpr int ATTN_LDS_BYTES=LDS_BYTES;
#undef SBAR
#undef WAIT_BAR
}

namespace sbk {
using bf16x8=__attribute__((ext_vector_type(8)))short;
using s16x4=__attribute__((ext_vector_type(4)))short;
using f32x16=__attribute__((ext_vector_type(16)))float;
constexpr int WLDS=12288;
constexpr float R_STOP=48.0f;
__device__ __forceinline__ int crow(int r,int hi){return (r&3)+8*(r>>2)+4*hi;}
__device__ __forceinline__ unsigned cvtpk(float lo,float hi){typedef float f2 __attribute__((ext_vector_type(2)));typedef __bf16 b2 __attribute__((ext_vector_type(2)));f2 v={lo,hi};b2 b=__builtin_convertvector(v,b2);return __builtin_bit_cast(unsigned,b);}
__device__ __forceinline__ void pv(f32x16*o,int vb,bf16x8 pa0,bf16x8 pa1,bf16x8 pa2,bf16x8 pa3){
  #pragma unroll
  for(int d0=0;d0<2;++d0){s16x4 lo[4],hi[4];
    #pragma unroll
    for(int ks=0;ks<4;++ks){
      asm volatile("ds_read_b64_tr_b16 %0,%1 offset:%c2":"=&v"(lo[ks]):"v"(vb),"i"(d0*4096+ks*1024):"memory");
      asm volatile("ds_read_b64_tr_b16 %0,%1 offset:%c2":"=&v"(hi[ks]):"v"(vb),"i"(d0*4096+ks*1024+512):"memory");}
    asm volatile("s_waitcnt lgkmcnt(0)":::"memory");__builtin_amdgcn_sched_barrier(0);
    #define PK(k) (bf16x8){lo[k][0],lo[k][1],lo[k][2],lo[k][3],hi[k][0],hi[k][1],hi[k][2],hi[k][3]}
    o[d0]=__builtin_amdgcn_mfma_f32_32x32x16_bf16(pa0,PK(0),o[d0],0,0,0);
    o[d0]=__builtin_amdgcn_mfma_f32_32x32x16_bf16(pa1,PK(1),o[d0],0,0,0);
    o[d0]=__builtin_amdgcn_mfma_f32_32x32x16_bf16(pa2,PK(2),o[d0],0,0,0);
    o[d0]=__builtin_amdgcn_mfma_f32_32x32x16_bf16(pa3,PK(3),o[d0],0,0,0);
    #undef PK
  }
}
__device__ __forceinline__ float sp2(float z){ return fmaxf(z,0.f)+__builtin_amdgcn_logf(1.0f+__builtin_amdgcn_exp2f(-fabsf(z))); }
__device__ __forceinline__ void sb_unit(int b,int h,int tb,const bf16_t*Q,const bf16_t*K,const bf16_t*V,bf16_t*O,char*wl,int lane){
  const int r32=lane&31,hi=lane>>5,t0=tb*32; const long rowbase=(long)b*SEQ; const int co=512+h*64;
  const bf16_t*Qw=Q+(rowbase+t0)*DM+co;
  bf16x8 qr[4];
  #pragma unroll
  for(int d0=0;d0<4;++d0)qr[d0]=*reinterpret_cast<const bf16x8*>(Qw+(long)r32*DM+d0*16+hi*8);
  f32x16 o[2];o[0]=f32x16{};o[1]=f32x16{};float R=0.f;
  const int vb=(int)(unsigned)(uintptr_t)wl+((lane>>4)&1)*32+(lane&3)*8+(4*hi+((lane&15)>>2))*64;
  bf16x8 kf[8]; u32x4 vr[8];
  #define SB_LOADK(jj) do{ const int s0_=(jj)*64; const bf16_t*Kp=K+(rowbase+s0_+r32)*DM+co+hi*8; \
    _Pragma("unroll") for(int d0=0;d0<4;++d0){kf[2*d0]=*reinterpret_cast<const bf16x8*>(Kp+d0*16);kf[2*d0+1]=*reinterpret_cast<const bf16x8*>(Kp+(long)32*DM+d0*16);} }while(0)
  #define SB_LOADV(jj) do{ const int s0_=(jj)*64; \
    _Pragma("unroll") for(int p=0;p<8;++p)vr[p]=*reinterpret_cast<const u32x4*>(V+(rowbase+s0_+16*(p&3)+(lane>>2))*DM+co+(p>>2)*32+(lane&3)*8); }while(0)
  SB_LOADK(t0>>6);
  for(int j=t0>>6;j>=0;--j){
    const int s0=j*64;
    SB_LOADV(j);
    f32x16 z0=f32x16{},z1=f32x16{};
    #pragma unroll
    for(int d0=0;d0<4;++d0){z0=__builtin_amdgcn_mfma_f32_32x32x16_bf16(kf[2*d0],qr[d0],z0,0,0,0);z1=__builtin_amdgcn_mfma_f32_32x32x16_bf16(kf[2*d0+1],qr[d0],z1,0,0,0);}
    #pragma unroll
    for(int p=0;p<8;++p)*reinterpret_cast<u32x4*>(wl+p*1024+lane*16)=vr[p];
    int rel=((j==(t0>>6))?(t0-s0+r32):1000)-4*hi; asm volatile("":"+v"(rel));
    f32x16 L0,L1;
    #pragma unroll
    for(int r=0;r<16;++r){const int kv=(r&3)+8*(r>>2); L0[r]=(kv<rel)?sp2(z0[r]):0.f; L1[r]=(kv+32<rel)?sp2(z1[r]):0.f;}
    float T[8]; f32x16 E0,E1;
    #pragma unroll
    for(int i=0;i<4;++i){
      E0[4*i+3]=0.f;E0[4*i+2]=L0[4*i+3];E0[4*i+1]=E0[4*i+2]+L0[4*i+2];E0[4*i]=E0[4*i+1]+L0[4*i+1];T[i]=E0[4*i]+L0[4*i];
      E1[4*i+3]=0.f;E1[4*i+2]=L1[4*i+3];E1[4*i+1]=E1[4*i+2]+L1[4*i+2];E1[4*i]=E1[4*i+1]+L1[4*i+1];T[4+i]=E1[4*i]+L1[4*i];}
    float X[8];
    #pragma unroll
    for(int i=0;i<8;++i)X[i]=__shfl_xor(T[i],32);
    float S[8]; float run=0.f;
    #pragma unroll
    for(int i=7;i>=0;--i){
      const float g_hi=hi?T[i]:X[i];
      const float g_lo=hi?X[i]:T[i];
      S[i]=hi?run:(run+g_hi);
      run+=g_hi+g_lo; }
    const float Ttot=run;
    #pragma unroll
    for(int i=0;i<4;++i){
      #pragma unroll
      for(int e=0;e<4;++e){E0[4*i+e]+=S[i];E1[4*i+e]+=S[4+i];}}
    f32x16 P0,P1;
    #pragma unroll
    for(int r=0;r<16;++r){const int kv=(r&3)+8*(r>>2);
      P0[r]=(kv<rel)?__builtin_amdgcn_exp2f(z0[r]-L0[r]-E0[r]-R):0.f;
      P1[r]=(kv+32<rel)?__builtin_amdgcn_exp2f(z1[r]-L1[r]-E1[r]-R):0.f;}
    R+=Ttot;
    u32x4 pw0,pw1,pw2,pw3;
    pw0=(u32x4){cvtpk(P0[0],P0[1]),cvtpk(P0[2],P0[3]),cvtpk(P0[4],P0[5]),cvtpk(P0[6],P0[7])};
    pw1=(u32x4){cvtpk(P0[8],P0[9]),cvtpk(P0[10],P0[11]),cvtpk(P0[12],P0[13]),cvtpk(P0[14],P0[15])};
    pw2=(u32x4){cvtpk(P1[0],P1[1]),cvtpk(P1[2],P1[3]),cvtpk(P1[4],P1[5]),cvtpk(P1[6],P1[7])};
    pw3=(u32x4){cvtpk(P1[8],P1[9]),cvtpk(P1[10],P1[11]),cvtpk(P1[12],P1[13]),cvtpk(P1[14],P1[15])};
    asm volatile("s_waitcnt lgkmcnt(0)":::"memory");
    if(j>0)SB_LOADK(j-1);
    pv(o,vb,__builtin_bit_cast(bf16x8,pw0),__builtin_bit_cast(bf16x8,pw1),__builtin_bit_cast(bf16x8,pw2),__builtin_bit_cast(bf16x8,pw3));
    if(__all(R>R_STOP))break;
  }
  #undef SB_LOADK
  #undef SB_LOADV
  bf16_t*Ow=O+(rowbase+t0)*DM+co;
  { bf16_t*stg=(bf16_t*)(wl+8192);
    #pragma unroll
    for(int r=0;r<16;++r){const int orow=crow(r,hi);
      #pragma unroll
      for(int d0=0;d0<2;++d0)stg[orow*64+d0*32+r32]=(bf16_t)f2bf(o[d0][r]);}
    asm volatile("s_waitcnt lgkmcnt(0)":::"memory");
    #pragma unroll
    for(int i=0;i<4;++i){const int row=i*8+(lane>>3),ch=lane&7; const u32x4 v=*(const u32x4*)(stg+row*64+ch*8); *(u32x4*)(Ow+(long)row*DM+ch*8)=v;}
    asm volatile("s_waitcnt lgkmcnt(0)":::"memory"); }
}
}

constexpr int ATT_G_OFF = attn_body::ATTN_LDS_BYTES, ATT_RED_OFF = ATT_G_OFF + SEQ * 4;
__device__ __forceinline__ void fox_scan_G(const float* FA, int b, int h, float* Gl, float* red, int tid, int lane, int wave) {
    float v[8]; float run = 0.f;
#pragma unroll
    for (int j = 0; j < 8; ++j) { run += FA[((size_t)b * SEQ + 8 * tid + j) * 8 + h] * LOG2E; v[j] = run; }
    float inc = run;
#pragma unroll
    for (int o = 1; o < 64; o <<= 1) { const float n = __shfl_up(inc, o); if (lane >= o) inc += n; }
    if (lane == 63) red[wave] = inc;
    __syncthreads();
    float off = inc - run;
    for (int w = 0; w < wave; ++w) off += red[w];
#pragma unroll
    for (int j = 0; j < 8; ++j) Gl[8 * tid + j] = off + v[j];
    __syncthreads();
}
template <int PARTS = 3>
__device__ __forceinline__ void ph_attn(const Prm& p, const Ctx& C, int l, unsigned char* lds, size_t o_off = WS_QQ) {
    const int G = gridDim.x, bx = blockIdx.x; const int vcu = (G % 8 == 0) ? (bx % 8) * (G / 8) + bx / 8 : bx;
    const attn_body::bf16* Q = (const attn_body::bf16*)(p.ws + WS_QQ); const attn_body::bf16* K = (const attn_body::bf16*)(p.ws + WS_KK); const attn_body::bf16* V = (const attn_body::bf16*)(p.ws + WS_VV);
    float* Gl = (float*)(lds + ATT_G_OFF); float* red = (float*)(lds + ATT_RED_OFF);
    int cur_bh = -1;
    float Bq;
    { float mq = fabsf(p.gq[l * HD + C.lane]), mk = fabsf(p.gk[l * HD + C.lane]);
#pragma unroll
      for (int o = 1; o < 64; o <<= 1) { mq = fmaxf(mq, __shfl_xor(mq, o)); mk = fmaxf(mk, __shfl_xor(mk, o)); }
      Bq = 1.02f * C2 * 64.0f * mq * mk; }
    unsigned* qcnt = (unsigned*)(p.ws + WS_CTL) + 3584 + l * 8 * 64;
    unsigned* uslot = (unsigned*)(lds + ATT_RED_OFF + 64);
    for (int qi = 0; qi < 8; ++qi) {
        const int qx = (bx + qi) & 7;
        for (;;) {
            __syncthreads();
            if (C.tid == 0) *uslot = __hip_atomic_fetch_add(qcnt + 64 * qx, 1u, __ATOMIC_RELAXED, __HIP_MEMORY_SCOPE_AGENT);
            __syncthreads();
            const unsigned u = *uslot;
            if (u >= 256u) break;
            if (u < 128u) {
                if (!(PARTS & 1)) continue;
                const int qb = 15 - (int)(u >> 3), bh = qx * NH + (int)(u & 7);
                if (bh != cur_bh) { __syncthreads(); fox_scan_G((const float*)(p.ws + WS_FA), bh / NH, bh % NH, Gl, red, C.tid, C.lane, C.wave); cur_bh = bh; }
                const int ntf = 4 * qb + 4; const float thr = Gl[qb * 256] + 2.0f * Bq + 48.0f;
                const bool skp = (C.lane < ntf - 4) && (Gl[64 * C.lane + 63] > thr);
                const int j0 = __builtin_popcountll(__ballot(skp)) & ~1;
                attn_body::attn_unit<8>(bh / NH, bh % NH, qb, Q, K, V, (attn_body::bf16*)(p.ws + o_off), (char*)lds, Gl, j0);
            } else {
                if (!(PARTS & 2)) continue;
                const int v = (int)u - 128, h = v & 7, g = 15 - (v >> 3);
                cur_bh = -1;
                int lane_ = C.lane; asm volatile("" : "+v"(lane_));
                sbk::sb_unit(qx, h, 8 * g + C.wave, (const bf16_t*)(p.ws + WS_QQ), (const bf16_t*)(p.ws + WS_KK), (const bf16_t*)(p.ws + WS_VV), (bf16_t*)(p.ws + o_off), (char*)lds + C.wave * sbk::WLDS, lane_);
            }
        }
    }
    __syncthreads();
}

namespace pgk {
typedef __bf16 bf16x2 __attribute__((ext_vector_type(2)));
__device__ __forceinline__ float dot2(unsigned a, unsigned b, float c) { return __builtin_amdgcn_fdot2_f32_bf16(__builtin_bit_cast(bf16x2, a), __builtin_bit_cast(bf16x2, b), c, false); }
__device__ __forceinline__ unsigned cvtpk(float lo, float hi) { typedef float f2 __attribute__((ext_vector_type(2))); f2 v = {lo, hi}; bf16x2 b = __builtin_convertvector(v, bf16x2); return __builtin_bit_cast(unsigned, b); }
}
namespace tk {
using bf16x8 = __attribute__((ext_vector_type(8))) short;
using f32x16 = __attribute__((ext_vector_type(16))) float;
constexpr int NCAND = 50;
__device__ __forceinline__ unsigned f2key(float f) { const unsigned u = __float_as_uint(f); return u ^ ((unsigned)((int)u >> 31) | 0x80000000u); }
__device__ __forceinline__ float key2f(unsigned k) { return __uint_as_float(k ^ ~((unsigned)((int)k >> 31) >> 1)); }
#define TK_CE(a, b) do { const unsigned mx_ = (a) > (b) ? (a) : (b), mn_ = (a) > (b) ? (b) : (a); (a) = mx_; (b) = mn_; } while (0)
template <int N> __device__ __forceinline__ void sort_desc(unsigned (&k)[N]) {
#pragma unroll
    for (int size = 2; size <= N; size <<= 1) {
#pragma unroll
        for (int stride = size >> 1; stride > 0; stride >>= 1) {
#pragma unroll
            for (int i = 0; i < N; ++i) { const int j = i ^ stride; if (j > i) { if ((i & size) == 0 || size == N) TK_CE(k[i], k[j]); else TK_CE(k[j], k[i]); } }
        }
    }
}
__device__ __forceinline__ void merge_desc16(unsigned (&k)[16]) {
#pragma unroll
    for (int stride = 8; stride > 0; stride >>= 1) {
#pragma unroll
        for (int i = 0; i < 16; ++i) { const int j = i ^ stride; if (j > i) TK_CE(k[i], k[j]); }
    }
}
__device__ __forceinline__ void top16_merge(unsigned (&a)[16], const unsigned (&b)[16]) {
#pragma unroll
    for (int i = 0; i < 16; ++i) a[i] = a[i] > b[15 - i] ? a[i] : b[15 - i];
    merge_desc16(a);
}
__device__ __forceinline__ void xlane_merge(unsigned (&a)[16]) {
    unsigned o[16];
#pragma unroll
    for (int i = 0; i < 16; ++i) o[i] = (unsigned)__shfl_xor((int)a[i], 32);
    top16_merge(a, o);
}
__device__ __forceinline__ void half_top16(const f32x16 (&z)[4], int c4, unsigned (&out)[16]) {
    unsigned k[4][16];
#pragma unroll
    for (int blk = 0; blk < 4; ++blk)
#pragma unroll
        for (int r = 0; r < 16; ++r) k[blk][r] = (f2key(z[blk][r]) & ~127u) | (unsigned)((127 - 32 * blk - (r & 3) - 8 * (r >> 2)) - c4);
#pragma unroll
    for (int blk = 0; blk < 4; ++blk) sort_desc<16>(k[blk]);
    top16_merge(k[0], k[1]); top16_merge(k[2], k[3]); top16_merge(k[0], k[2]);
    xlane_merge(k[0]);
#pragma unroll
    for (int i = 0; i < 16; ++i) out[i] = k[0][i];
}
}

__device__ __forceinline__ void ph_topk(const Prm& p, const Ctx& C, int l, unsigned char* lds) {
    constexpr int TA[64] = {0,0,0,0,0,0,0,0,0,0,0,0,0,0,0,0,1,1,1,1,1,1,1,1,2,2,2,2,2,3,3,3,3,4,4,4,5,5,6,6,7,7,8,9,10,11,12,13,14,15,0,0,0,0,0,0,0,0,0,0,0,0,0,0};
    constexpr int TB[64] = {0,1,2,3,4,5,6,7,8,9,10,11,12,13,14,15,0,1,2,3,4,5,6,7,0,1,2,3,4,0,1,2,3,0,1,2,0,1,0,1,0,1,0,0,0,0,0,0,0,0,0,0,0,0,0,0,0,0,0,0,0,0,0,0};
    const bf16_t* QP = (const bf16_t*)(p.ws + WS_KK); unsigned short* IDX = (unsigned short*)(p.ws + WS_VV); float* PW = (float*)(p.ws + WS_VV + 16 * MiB);
    const int lane = C.lane, r32 = lane & 31, hi = lane >> 5;
    int c4 = 4 * hi; asm volatile("" : "+v"(c4));
    unsigned char* wtab = lds + 32768 + C.wave * 1024 + r32 * 32;
    for (int item = blockIdx.x; item < 256; item += gridDim.x) {
        const int h = item & 7, tg = item >> 3;
        __syncthreads();
        for (int c = C.tid; c < 2048; c += NTHREADS) {
            const int tbl = c >> 10, row = (c >> 3) & 127, ch = c & 7;
            const float* src = (tbl ? p.k2 : p.k1) + ((size_t)(l * NH + h) * NKEYS + row) * 64 + ch * 8;
            const f32x4 a = *(const f32x4*)src, b = *(const f32x4*)(src + 4);
            u32x4 o; o.x = pgk::cvtpk(a.x, a.y); o.y = pgk::cvtpk(a.z, a.w); o.z = pgk::cvtpk(b.x, b.y); o.w = pgk::cvtpk(b.z, b.w);
            *(u32x4*)(lds + tbl * 16384 + row * 128 + ((ch ^ (row & 7)) << 4)) = o;
        }
        __syncthreads();
#pragma unroll 1
        for (int i = 0; i < 4; ++i) {
            const int tile = tg * 32 + C.wave * 4 + i, t = tile * 32 + r32;
            const bf16_t* qrow = QP + (size_t)t * DM + h * 128 + 8 * hi;
            unsigned V1[16], V2[16];
#pragma unroll
            for (int half = 0; half < 2; ++half) {
                tk::bf16x8 qf[4];
#pragma unroll
                for (int ks = 0; ks < 4; ++ks) qf[ks] = *(const tk::bf16x8*)(qrow + half * 64 + 16 * ks);
                tk::f32x16 z[4];
#pragma unroll
                for (int blk = 0; blk < 4; ++blk) {
                    z[blk] = tk::f32x16{};
                    const int row = 32 * blk + r32;
#pragma unroll
                    for (int ks = 0; ks < 4; ++ks) {
                        const tk::bf16x8 kfr = *(const tk::bf16x8*)(lds + half * 16384 + row * 128 + (((2 * ks + hi) ^ (row & 7)) << 4));
                        z[blk] = __builtin_amdgcn_mfma_f32_32x32x16_bf16(kfr, qf[ks], z[blk], 0, 0, 0);
                    }
                }
                if (half == 0) tk::half_top16(z, c4, V1); else tk::half_top16(z, c4, V2);
            }
            { u32x4 w;
              unsigned n[16];
#pragma unroll
              for (int q = 0; q < 16; ++q) n[q] = 127u - ((hi ? V2[q] : V1[q]) & 127u);
              w.x = n[0] | (n[1] << 8) | (n[2] << 16) | (n[3] << 24); w.y = n[4] | (n[5] << 8) | (n[6] << 16) | (n[7] << 24);
              w.z = n[8] | (n[9] << 8) | (n[10] << 16) | (n[11] << 24); w.w = n[12] | (n[13] << 8) | (n[14] << 16) | (n[15] << 24);
              *(u32x4*)(wtab + 16 * hi) = w; }
            float f1[16], f2[16];
#pragma unroll
            for (int q = 0; q < 16; ++q) { f1[q] = tk::key2f(V1[q] & ~127u); f2[q] = tk::key2f(V2[q] & ~127u); }
            unsigned ca[16], cb[16];
#pragma unroll
            for (int s = 0; s < 32; ++s) {
                const float v0 = f1[TA[s]] + f2[TB[s]];
                const float v1 = (32 + s < tk::NCAND) ? f1[TA[32 + s]] + f2[TB[32 + s]] : -INFINITY;
                const unsigned j0 = 255u - (unsigned)(TA[s] * 16 + TB[s]), j1 = 255u - (unsigned)(TA[32 + s] * 16 + TB[32 + s]);
                const unsigned key = (tk::f2key(hi ? v1 : v0) & ~255u) | (hi ? j1 : j0);
                if (s < 16) ca[s] = key; else cb[s - 16] = key;
            }
            tk::sort_desc<16>(ca); tk::sort_desc<16>(cb); tk::top16_merge(ca, cb); tk::xlane_merge(ca);
            float e[16]; float sum = 0.f; const float mx = tk::key2f(ca[0] & ~255u);
#pragma unroll
            for (int q = 0; q < 16; ++q) { e[q] = __builtin_amdgcn_exp2f((tk::key2f(ca[q] & ~255u) - mx) * LOG2E); sum += e[q]; }
            const float inv = 1.0f / sum;
            int eo[8]; float go[8];
            asm volatile("s_waitcnt lgkmcnt(0)" ::: "memory");
#pragma unroll
            for (int q = 0; q < 8; ++q) {
                const unsigned kq = hi ? ca[8 + q] : ca[q]; const unsigned j = 255u - (kq & 255u);
                const unsigned n1 = wtab[j >> 4], n2 = wtab[16 + (j & 15)];
                eo[q] = (int)(n1 * NKEYS + n2); go[q] = (hi ? e[8 + q] : e[q]) * inv;
            }
            unsigned short* ip = IDX + (size_t)t * 128 + h * 16 + 8 * hi; float* gp = PW + (size_t)t * 128 + h * 16 + 8 * hi;
            *(u32x4*)ip = (u32x4){(unsigned)eo[0] | ((unsigned)eo[1] << 16), (unsigned)eo[2] | ((unsigned)eo[3] << 16), (unsigned)eo[4] | ((unsigned)eo[5] << 16), (unsigned)eo[6] | ((unsigned)eo[7] << 16)};
            *(f32x4*)gp = (f32x4){go[0], go[1], go[2], go[3]}; *(f32x4*)(gp + 4) = (f32x4){go[4], go[5], go[6], go[7]};
            asm volatile("s_waitcnt lgkmcnt(0)" ::: "memory");
        }
    }
    __syncthreads();
}


constexpr size_t WS_T8 = WS_UB;
constexpr size_t WS_SC8 = WS_K12;
typedef float f32x2 __attribute__((ext_vector_type(2)));
typedef short s16x4 __attribute__((ext_vector_type(4))); typedef int i32x4 __attribute__((ext_vector_type(4))); typedef int i32x2 __attribute__((ext_vector_type(2)));
#define GAS __attribute__((address_space(1)))
#define LAS __attribute__((address_space(3)))
#define XB_TMO      128
#define XB_XCNT(j)  (256  + 64 * (j))
#define XB_XSUB(j)  (1280 + 64 * (j))
#define XB_XGEN(j)  (2304 + 64 * (j))
#define XB_TOP      3328
#define XB_TOPGEN   3392
#define XCD_BAR_WORDS 3456
#define XB_SPIN_CAP (1u << 18)

__device__ __forceinline__ unsigned xb_ld(unsigned* p)              { return __hip_atomic_load(p, __ATOMIC_RELAXED, __HIP_MEMORY_SCOPE_AGENT); }
__device__ __forceinline__ unsigned xb_add(unsigned* p, unsigned v) { return __hip_atomic_fetch_add(p, v, __ATOMIC_RELAXED, __HIP_MEMORY_SCOPE_AGENT); }
__device__ __forceinline__ unsigned xb_xcc_id() { return (unsigned)__builtin_amdgcn_s_getreg((3 << 11) | 20) & 0xFu; }
#define XB_SPIN(cond, bar) do { unsigned _sp = 0; while (cond) { __builtin_amdgcn_s_sleep(1); \
    if ((++_sp & 255u) == 0u) { if (xb_ld(&(bar)[XB_TMO])) break; if (_sp > XB_SPIN_CAP) { atomicAdd(&(bar)[XB_TMO], 1u); break; } } } } while (0)

struct XcdBarrier {
    unsigned* bar; unsigned x;
    volatile LAS unsigned* st;
};

__device__ __forceinline__ XcdBarrier xcd_barrier_post(unsigned* bar, volatile LAS unsigned* st) {
    XcdBarrier b; b.bar = bar; b.x = xb_xcc_id(); b.st = st;
    if (threadIdx.x == 0) st[2] = xb_add(&bar[XB_XCNT(b.x)], 1u);
    return b;
}
__device__ __forceinline__ void xcd_barrier_complete(unsigned* bar, unsigned x, unsigned& nloc, unsigned& nx) {
    const unsigned G = gridDim.x * gridDim.y * gridDim.z;
    unsigned sum, cnt, mine, sp = 0u;
    for (;;) {
        sum = 0u; cnt = 0u; mine = 0u;
#pragma unroll
        for (unsigned j = 0; j < 16; ++j) { const unsigned c = xb_ld(&bar[XB_XCNT(j)]); sum += c; cnt += (c > 0u) ? 1u : 0u; mine = (j == x) ? c : mine; }
        if (sum == G) break;
        __builtin_amdgcn_s_sleep(1);
        if ((++sp & 255u) == 0u) { if (xb_ld(&bar[XB_TMO])) break; if (sp > XB_SPIN_CAP) { atomicAdd(&bar[XB_TMO], 1u); break; } }
    }
    nloc = mine > 0u ? mine : 1u; nx = cnt > 0u ? cnt : 1u;
}

__device__ __forceinline__ void xcd_barrier(const XcdBarrier& b) {
    asm volatile("s_waitcnt vmcnt(0)" ::: "memory");
    __syncthreads();
    if (threadIdx.x == 0) {
        unsigned* bar = b.bar;
        __builtin_amdgcn_s_waitcnt(0);
        unsigned nloc = b.st[0], nx = b.st[1];
        if (nloc == 0u) { xcd_barrier_complete(bar, b.x, nloc, nx); b.st[0] = nloc; b.st[1] = nx; }
        const unsigned old = xb_add(&bar[XB_XSUB(b.x)], 1u);
        const unsigned gen = old / nloc;
        if (old + 1u == (gen + 1u) * nloc) {
            __builtin_amdgcn_fence(__ATOMIC_RELEASE, "agent");
            asm volatile("s_waitcnt vmcnt(0)" ::: "memory");
            const unsigned og = xb_add(&bar[XB_TOP], 1u);
            const unsigned tg = og / nx;
            if (og + 1u == (tg + 1u) * nx) xb_add(&bar[XB_TOPGEN], 1u);
            else XB_SPIN(xb_ld(&bar[XB_TOPGEN]) == tg, bar);
            __builtin_amdgcn_fence(__ATOMIC_ACQUIRE, "agent");
            xb_add(&bar[XB_XGEN(b.x)], 1u);
            asm volatile("s_waitcnt vmcnt(0)" ::: "memory");
        } else {
            XB_SPIN(xb_ld(&bar[XB_XGEN(b.x)]) == gen, bar);
            __builtin_amdgcn_fence(__ATOMIC_ACQUIRE, "agent");
            asm volatile("s_waitcnt vmcnt(0)" ::: "memory");
        }
    }
    __syncthreads();
}


constexpr size_t WS_PD = WS_GT;
template <int CTRL> __device__ __forceinline__ int dpp_i(int v) { return __builtin_amdgcn_update_dpp(0, v, CTRL, 0xF, 0xF, true); }
template <int CTRL> __device__ __forceinline__ float dpp_f(float v) { return __int_as_float(__builtin_amdgcn_update_dpp(0, __float_as_int(v), CTRL, 0xF, 0xF, true)); }
__device__ __forceinline__ void ph_convert_tables8s(const Prm& p, const Ctx& C) {
    unsigned char* T8 = p.ws + WS_T8; float* SC = (float*)(p.ws + WS_SC8);
    constexpr int NR = 2 * 2 * NEXP;
    f32x4 v[2][2][4];
#define CV_LOAD(s_, row0_) do { _Pragma("unroll") for (int r = 0; r < 2; ++r) { const int row = min((row0_) + r * C.ngw, NR - 1); const int lt = row >> 14, e = row & (NEXP - 1), l = lt >> 1, tbl = lt & 1; \
        const float* src = (tbl ? p.pv : p.pu) + ((size_t)l * NEXP + e) * DM + 4 * C.lane; _Pragma("unroll") for (int j = 0; j < 4; ++j) v[s_][r][j] = *(const f32x4*)(src + 256 * j); } } while (0)
#define CV_PROC(s_, row0_) do { _Pragma("unroll") for (int r = 0; r < 2; ++r) { const int row = (row0_) + r * C.ngw; if (row >= NR) break; const int lt = row >> 14, e = row & (NEXP - 1); \
        float am = 0.f; _Pragma("unroll") for (int j = 0; j < 4; ++j) am = fmaxf(am, fmaxf(fmaxf(fabsf(v[s_][r][j].x), fabsf(v[s_][r][j].y)), fmaxf(fabsf(v[s_][r][j].z), fabsf(v[s_][r][j].w)))); \
        am = fmaxf(am, dpp_f<0xB1>(am)); am = fmaxf(am, dpp_f<0x4E>(am)); am = fmaxf(am, dpp_f<0x141>(am)); am = fmaxf(am, dpp_f<0x140>(am)); am = fmaxf(am, __shfl_xor(am, 16)); am = fmaxf(am, __shfl_xor(am, 32)); \
          \
        const float qm = 7.0f / 0.75f, sc = am > 0.f ? am / qm : 1.0f, inv = am > 0.f ? qm / am : 0.f; \
        const int o8 = (lt & 1) ? 8 : 0;     \
        _Pragma("unroll") for (int j = 0; j < 4; ++j) {     \
            const int q0 = (int)fminf(fmaxf(rintf(v[s_][r][j].x * inv), -8.0f), 7.0f), q1 = (int)fminf(fmaxf(rintf(v[s_][r][j].y * inv), -8.0f), 7.0f), q2 = (int)fminf(fmaxf(rintf(v[s_][r][j].z * inv), -8.0f), 7.0f), q3 = (int)fminf(fmaxf(rintf(v[s_][r][j].w * inv), -8.0f), 7.0f); \
            const int o_ = C.lane < 32 ? o8 : 0; const unsigned mine = (unsigned)(((q0 + o_) & 15) | (((q1 + o_) & 15) << 8) | (((q2 + o_) & 15) << 16) | (((q3 + o_) & 15) << 24)); \
            const unsigned other = (unsigned)__shfl_xor((int)mine, 32); \
            if (C.lane < 32) *(unsigned*)(T8 + (((size_t)lt * 8 + j) * NEXP + e) * 128 + 4 * C.lane) = mine | (other << 4); } \
        if (C.lane == 0) SC[row] = sc; } } while (0)
    CV_LOAD(0, C.gw);
    __builtin_amdgcn_s_waitcnt(0x0F70);
#pragma unroll 1
    for (int row0 = C.gw; row0 < NR; row0 += 4 * C.ngw) {
        CV_LOAD(1, row0 + 2 * C.ngw); CV_PROC(0, row0);
        CV_LOAD(0, row0 + 4 * C.ngw); CV_PROC(1, row0 + 2 * C.ngw);
    }
#undef CV_LOAD
#undef CV_PROC
}
__device__ __forceinline__ float sum8(float v) { v += dpp_f<0xB1>(v); v += dpp_f<0x4E>(v); v += dpp_f<0x141>(v); return v; }
__device__ __forceinline__ float xsum32(float a, float b) { const auto r = __builtin_amdgcn_permlane32_swap(__float_as_uint(a), __float_as_uint(b), false, false); return __uint_as_float(r[0]) + __uint_as_float(r[1]); }
__device__ __forceinline__ float xsum16(float a, float b) { const auto r = __builtin_amdgcn_permlane16_swap(__float_as_uint(a), __float_as_uint(b), false, false); return __uint_as_float(r[0]) + __uint_as_float(r[1]); }
template <int JS> __device__ __forceinline__ unsigned bcast8(unsigned v, int jq) {
    constexpr int c = JS & 3, ctrl = c | (c << 2) | (c << 4) | (c << 6);
    const unsigned v1 = (unsigned)__builtin_amdgcn_update_dpp(0, (int)v, ctrl, 0xF, 0xF, true);
    const unsigned v2 = (unsigned)__builtin_amdgcn_update_dpp(0, (int)v1, 0x141, 0xF, 0xF, true);
    return (jq == (JS >> 2)) ? v1 : v2;
}
template <int BB> __device__ __forceinline__ unsigned pick_id(unsigned idw, int jq) { const unsigned w = bcast8<(BB >> 1)>(idw, jq); return (BB & 1) ? (w >> 16) : (w & 0xffffu); }
template <int G4> __device__ __forceinline__ int bcast4(unsigned v) { constexpr int ctrl = G4 | (G4 << 2) | (G4 << 4) | (G4 << 6); return __builtin_amdgcn_update_dpp(0, (int)v, ctrl, 0xF, 0xF, true); }
struct SliceCtx { int x, wq, nwq; };
#ifndef SLICE_BY_XCC
#define SLICE_BY_XCC 0
#endif
__device__ __forceinline__ SliceCtx slice_ctx(const Ctx& C, const Prm& p, unsigned char* lds) { SliceCtx s; const int G = gridDim.x;
    if (SLICE_BY_XCC) { const unsigned x = xb_xcc_id() & 7u; const unsigned* bar = (const unsigned*)(p.ws + WS_CTL); const volatile LAS unsigned* st = (const volatile LAS unsigned*)((LAS unsigned char*)lds + (LDS_BYTES - 64));
        s.x = (int)x; s.wq = (int)st[2] * NWAVES + C.wave; s.nwq = (int)xb_ld((unsigned*)&bar[XB_XCNT(x)]) * NWAVES; return s; }
    s.x = blockIdx.x & 7; s.wq = (blockIdx.x >> 3) * NWAVES + C.wave; s.nwq = ((G - s.x + 7) >> 3) * NWAVES; return s; }
__device__ __forceinline__ void ph_peer_u(const Prm& p, const Ctx& C, int l, unsigned char* lds) {
    const SliceCtx S = slice_ctx(C, p, lds);
    const bf16_t* HB = (const bf16_t*)(p.ws + WS_QQ);     const unsigned short* IDX = (const unsigned short*)(p.ws + WS_VV); float* PD = (float*)(p.ws + WS_PD);
    const unsigned char* U8 = p.ws + WS_T8 + ((size_t)(l * 2 + 0) * 8 + S.x) * NEXP * 128;
    const int lane = C.lane, j = lane & 7, k = lane >> 3, jq = (lane >> 2) & 1;
    u32x4 uq[2][16]; unsigned idw[2]; u32x4 hr0[2], hr1[2];
    const int nit = (NT - S.wq + S.nwq - 1) / S.nwq;
#define PU_TOK(i) (S.wq + ((i) < nit ? (i) : nit - 1) * S.nwq)
#define PU_LOADID(s_, i) do { idw[s_] = ((const unsigned*)IDX)[(size_t)PU_TOK(i) * 64 + lane]; } while (0)
#define PU_LOADH(s_, i) do { const bf16_t* hp_ = HB + (size_t)PU_TOK(i) * DM + 128 * S.x + 16 * j; hr0[s_] = *(const u32x4*)hp_; hr1[s_] = *(const u32x4*)(hp_ + 8); } while (0)
#define PU_G1(s_, BB) uq[s_][BB] = *(const u32x4*)(U8 + (size_t)pick_id<BB>(idw[s_], jq) * 128 + 16 * j)
#define PU_GATHER(s_, h_) do { PU_G1(s_, 8 * (h_) + 0); PU_G1(s_, 8 * (h_) + 1); PU_G1(s_, 8 * (h_) + 2); PU_G1(s_, 8 * (h_) + 3); PU_G1(s_, 8 * (h_) + 4); PU_G1(s_, 8 * (h_) + 5); PU_G1(s_, 8 * (h_) + 6); PU_G1(s_, 8 * (h_) + 7); } while (0)
#define PU_MATH(s_, h_, pd_) do { _Pragma("unroll") for (int b_ = 0; b_ < 8; ++b_) { const int bb = 8 * (h_) + b_; int ai = __builtin_amdgcn_sdot4((int)uq[s_][bb].x, hq[0], 0, false); \
        ai = __builtin_amdgcn_sdot4((int)uq[s_][bb].y, hq[1], ai, false); ai = __builtin_amdgcn_sdot4((int)uq[s_][bb].z, hq[2], ai, false); ai = __builtin_amdgcn_sdot4((int)uq[s_][bb].w, hq[3], ai, false); \
        ai += dpp_i<0xB1>(ai); ai += dpp_i<0x4E>(ai); ai += dpp_i<0x141>(ai); if (b_ == j) pd_ = ai; } } while (0)
    PU_LOADID(0, 0); PU_LOADID(1, 1); PU_LOADH(0, 0); PU_LOADH(1, 1);
    PU_GATHER(0, 0); PU_GATHER(0, 1); PU_GATHER(1, 0); PU_GATHER(1, 1);
    PU_LOADID(0, 2);
#pragma unroll 1
    for (int it = 0; it < nit; it += 2) {
#pragma unroll
        for (int a = 0; a < 2; ++a) {
            const int i = it + a, bq = 1 - a;
            int hq[4]; float hsc;
            { const unsigned hw[8] = {hr0[a].x, hr0[a].y, hr0[a].z, hr0[a].w, hr1[a].x, hr1[a].y, hr1[a].z, hr1[a].w};
              float hv[16]; float am = 0.f;
#pragma unroll
              for (int q = 0; q < 8; ++q) { hv[2 * q] = __uint_as_float(hw[q] << 16); hv[2 * q + 1] = __uint_as_float(hw[q] & 0xffff0000u); am = fmaxf(am, fmaxf(fabsf(hv[2 * q]), fabsf(hv[2 * q + 1]))); }
              am = fmaxf(am, dpp_f<0xB1>(am)); am = fmaxf(am, dpp_f<0x4E>(am)); am = fmaxf(am, dpp_f<0x141>(am));
              hsc = am > 0.f ? am * (1.0f / 127.0f) : 1.0f; const float inv = am > 0.f ? 127.0f / am : 0.f;
#pragma unroll
              for (int q = 0; q < 4; ++q) { unsigned u0 = __builtin_amdgcn_cvt_pk_u8_f32(hv[4 * q] * inv + 128.0f, 0, 0u); u0 = __builtin_amdgcn_cvt_pk_u8_f32(hv[4 * q + 1] * inv + 128.0f, 1, u0);
                  u0 = __builtin_amdgcn_cvt_pk_u8_f32(hv[4 * q + 2] * inv + 128.0f, 2, u0); u0 = __builtin_amdgcn_cvt_pk_u8_f32(hv[4 * q + 3] * inv + 128.0f, 3, u0); hq[q] = (int)(u0 ^ 0x80808080u); } }
            PU_LOADH(a, i + 2); PU_LOADID(bq, i + 3);
            int pd0 = 0, pd1 = 0;
            PU_MATH(a, 0, pd0); PU_GATHER(a, 0);
            PU_MATH(a, 1, pd1); PU_GATHER(a, 1);
            if (i < nit) { float* pd = PD + ((size_t)S.x * NT + (S.wq + i * S.nwq)) * 128 + 16 * k + j; pd[0] = (float)pd0 * hsc; pd[8] = (float)pd1 * hsc; }
        }
    }
#undef PU_TOK
#undef PU_LOADID
#undef PU_LOADH
#undef PU_GATHER
#undef PU_G1
#undef PU_MATH
}
__device__ __forceinline__ void ph_peer_pre(const Prm& p, const Ctx& C, int l) {
    const float* MOD = (const float*)(p.ws + WS_MOD) + (size_t)l * NB * MODW + 3 * DM;
    const bf16_t* WQT = (const bf16_t*)(p.ws + WS_WQ) + (size_t)l * DM * DM; float* BQ = (float*)(p.ws + WS_BQ) + (size_t)l * NB * DM;
    for (int item = C.gw; item < (DM / 8) * NB; item += C.ngw) {
        const int b = item & 7, c0 = (item >> 3) * 8;
        float sh[16];
#pragma unroll
        for (int q = 0; q < 4; ++q) { const f32x4 v = *(const f32x4*)(MOD + (size_t)b * MODW + 16 * C.lane + 4 * q); sh[4 * q] = v.x; sh[4 * q + 1] = v.y; sh[4 * q + 2] = v.z; sh[4 * q + 3] = v.w; }
        float res = 0.f;
#pragma unroll
        for (int c = 0; c < 8; ++c) { const u32x4 w0 = *(const u32x4*)(WQT + (size_t)(c0 + c) * DM + 16 * C.lane), w1 = *(const u32x4*)(WQT + (size_t)(c0 + c) * DM + 16 * C.lane + 8);
            const unsigned ww[8] = {w0.x, w0.y, w0.z, w0.w, w1.x, w1.y, w1.z, w1.w}; float a = 0.f;
#pragma unroll
            for (int q = 0; q < 8; ++q) a += __uint_as_float(ww[q] << 16) * sh[2 * q] + __uint_as_float(ww[q] & 0xffff0000u) * sh[2 * q + 1];
            a = wave_sum(a); if (C.lane == c) res = a; }
        if (C.lane < 8) BQ[(size_t)b * DM + c0 + C.lane] = res;
    }
    const unsigned char* U8 = p.ws + WS_T8 + (size_t)(l * 2 + 0) * 8 * NEXP * 128; const float* SU = (const float*)(p.ws + WS_SC8) + (size_t)(l * 2) * NEXP; float* USH = (float*)(p.ws + WS_USH) + (size_t)l * NB * NEXP;
    float shb[8][16];
    const int cl = 256 * (C.lane >> 4) + 8 * (C.lane & 15);
#pragma unroll
    for (int b = 0; b < 8; ++b)
#pragma unroll
        for (int q = 0; q < 4; ++q) { const f32x4 v = *(const f32x4*)(MOD + (size_t)b * MODW + cl + 128 * (q >> 1) + 4 * (q & 1)); shb[b][4 * q] = v.x; shb[b][4 * q + 1] = v.y; shb[b][4 * q + 2] = v.z; shb[b][4 * q + 3] = v.w; }
    const int hi5 = C.lane >> 5, b4 = (C.lane >> 4) & 1;
    for (int e0 = C.gw; e0 < NEXP; e0 += 2 * C.ngw) {
        u32x2 uq[2];
#pragma unroll
        for (int r = 0; r < 2; ++r) uq[r] = *(const u32x2*)(U8 + ((size_t)(C.lane >> 4) * NEXP + min(e0 + r * C.ngw, NEXP - 1)) * 128 + 8 * (C.lane & 15));
#pragma unroll
        for (int r = 0; r < 2; ++r) { const int e = e0 + r * C.ngw; if (e >= NEXP) break;
            const unsigned w[2] = {uq[r].x, uq[r].y}; float uf[16];
#pragma unroll
            for (int q = 0; q < 8; ++q) { uf[q] = (float)(((int)(w[q >> 2] << (28 - 8 * (q & 3)))) >> 28); uf[8 + q] = (float)(((int)(w[q >> 2] << (24 - 8 * (q & 3)))) >> 28); }
            float a[8];
#pragma unroll
            for (int b = 0; b < 8; ++b) { float t = 0.f;
#pragma unroll
                for (int q = 0; q < 16; ++q) t += uf[q] * shb[b][q];
                a[b] = t; }
            float r4[4], r2[2];
#pragma unroll
            for (int q = 0; q < 4; ++q) r4[q] = xsum32(a[q], a[4 + q]);
#pragma unroll
            for (int q = 0; q < 2; ++q) r2[q] = xsum16(r4[q], r4[2 + q]);
#pragma unroll
            for (int q = 0; q < 2; ++q) { float v = r2[q]; v += dpp_f<0xB1>(v); v += dpp_f<0x4E>(v); v += dpp_f<0x141>(v); v += dpp_f<0x128>(v); r2[q] = v; }
            if ((C.lane & 15) == 0) { const float su = SU[e], sv = SU[NEXP + e]; const int b0 = 4 * hi5 + 2 * b4;
                f32x4* REC = (f32x4*)(p.ws + WS_T8 + ((size_t)(l * 2 + 0) * 8 + 4) * NEXP * 128); REC[(size_t)b0 * NEXP + e] = (f32x4){r2[0] * su, su, sv, 0.f}; REC[(size_t)(b0 + 1) * NEXP + e] = (f32x4){r2[1] * su, su, sv, 0.f}; }
        }
    }
}
__device__ __forceinline__ void ph_peer_r(const Prm& p, const Ctx& C, int l) {
    const unsigned short* IDX = (const unsigned short*)(p.ws + WS_VV); float* PW = (float*)(p.ws + WS_VV + 16 * MiB); const float* PD = (const float*)(p.ws + WS_PD);
    const float* SU = (const float*)(p.ws + WS_SC8) + (size_t)(l * 2) * NEXP; const float* SV = SU + NEXP;
    const size_t n = (size_t)NT * 128, stride = (size_t)gridDim.x * NTHREADS;
    for (size_t i = (size_t)blockIdx.x * NTHREADS + C.tid; i < n; i += stride) {
        float s = 0.f;
#pragma unroll
        for (int x = 0; x < 8; ++x) s += PD[(size_t)x * n + i];
        const size_t t = i >> 7; const float r = ((const float*)(p.ws + WS_FC))[t];
        const int id = IDX[i]; const float d = s * r * SU[id] + ((const float*)(p.ws + WS_USH))[((size_t)l * NB + t / SEQ) * NEXP + id];
        const float cf = PW[i] * (0.5f * d * (1.0f + erff(d * 0.70710678118654752f))) * SV[id];
        float cmx = fabsf(cf); cmx = fmaxf(cmx, dpp_f<0xB1>(cmx)); cmx = fmaxf(cmx, dpp_f<0x4E>(cmx)); cmx = fmaxf(cmx, dpp_f<0x141>(cmx)); cmx = fmaxf(cmx, dpp_f<0x128>(cmx));
        const float inv = cmx > 0.f ? 127.0f / cmx : 0.f;
        ((unsigned char*)(p.ws + WS_VV + 32 * MiB))[i] = (unsigned char)((__builtin_amdgcn_cvt_pk_u8_f32(cf * inv + 128.0f, 0, 0u) ^ 0x80u) & 0xffu);
        if ((C.lane & 15) == 0) ((float*)(p.ws + WS_VV + 40 * MiB))[i >> 4] = cmx * (1.0f / 127.0f);
    }
}
__device__ __forceinline__ void ph_peer_v(const Prm& p, const Ctx& C, int l, unsigned char* lds) {
    const SliceCtx S = slice_ctx(C, p, lds);
    const unsigned short* IDX = (const unsigned short*)(p.ws + WS_VV); const unsigned char* CQ = p.ws + WS_VV + 32 * MiB; const float* CSC = (const float*)(p.ws + WS_VV + 40 * MiB);
    const float* MOD = (const float*)(p.ws + WS_MOD) + (size_t)l * NB * MODW;
    const unsigned char* V8 = p.ws + WS_T8 + ((size_t)(l * 2 + 1) * 8 + S.x) * NEXP * 128;
    const int lane = C.lane, j = lane & 7, k = lane >> 3, b3 = (lane >> 3) & 1, jq = (lane >> 2) & 1;
    u32x4 vq[2][16]; unsigned idw[2]; unsigned cqw[2]; float csv[2]; f32x2 xvv[2], gvv[2];
    const int ocol = 128 * S.x + 16 * j + 2 * k;
    const int nit = (NT - S.wq + S.nwq - 1) / S.nwq;
#define PV_TOK(i) (S.wq + ((i) < nit ? (i) : nit - 1) * S.nwq)
#define PV_LOADID(s_, i) do { idw[s_] = ((const unsigned*)IDX)[(size_t)PV_TOK(i) * 64 + lane]; } while (0)
#define PV_LOADC(s_, i) do { const int t_ = PV_TOK(i); cqw[s_] = ((const unsigned*)CQ)[(size_t)t_ * 32 + 4 * k + (j & 3)]; csv[s_] = CSC[(size_t)t_ * 8 + k]; \
        xvv[s_] = *(const f32x2*)(p.out + (size_t)t_ * DM + ocol); gvv[s_] = *(const f32x2*)(MOD + (size_t)(t_ / SEQ) * MODW + 5 * DM + ocol); } while (0)
#define PV_G1(s_, BB) vq[s_][BB] = *(const u32x4*)(V8 + (size_t)pick_id<BB>(idw[s_], jq) * 128 + 16 * j)
#define PV_GATHER(s_, h_) do { PV_G1(s_, 8 * (h_) + 0); PV_G1(s_, 8 * (h_) + 1); PV_G1(s_, 8 * (h_) + 2); PV_G1(s_, 8 * (h_) + 3); PV_G1(s_, 8 * (h_) + 4); PV_G1(s_, 8 * (h_) + 5); PV_G1(s_, 8 * (h_) + 6); PV_G1(s_, 8 * (h_) + 7); } while (0)
#define PV_MATH(s_, h_) do { _Pragma("unroll") for (int g_ = 2 * (h_); g_ < 2 * (h_) + 2; ++g_) { const unsigned r0_[4] = {vq[s_][4 * g_].x, vq[s_][4 * g_].y, vq[s_][4 * g_].z, vq[s_][4 * g_].w}, r1_[4] = {vq[s_][4 * g_ + 1].x, vq[s_][4 * g_ + 1].y, vq[s_][4 * g_ + 1].z, vq[s_][4 * g_ + 1].w}, \
        r2_[4] = {vq[s_][4 * g_ + 2].x, vq[s_][4 * g_ + 2].y, vq[s_][4 * g_ + 2].z, vq[s_][4 * g_ + 2].w}, r3_[4] = {vq[s_][4 * g_ + 3].x, vq[s_][4 * g_ + 3].y, vq[s_][4 * g_ + 3].z, vq[s_][4 * g_ + 3].w}; \
        _Pragma("unroll") for (int w = 0; w < 4; ++w) { const unsigned p01l = __builtin_amdgcn_perm(r1_[w], r0_[w], 0x05010400u), p01h = __builtin_amdgcn_perm(r1_[w], r0_[w], 0x07030602u), p23l = __builtin_amdgcn_perm(r3_[w], r2_[w], 0x05010400u), p23h = __builtin_amdgcn_perm(r3_[w], r2_[w], 0x07030602u); \
            yi[4 * w + 0] = __builtin_amdgcn_sdot4((int)__builtin_amdgcn_perm(p23l, p01l, 0x05040100u), cq[g_], yi[4 * w + 0], false); yi[4 * w + 1] = __builtin_amdgcn_sdot4((int)__builtin_amdgcn_perm(p23l, p01l, 0x07060302u), cq[g_], yi[4 * w + 1], false); \
            yi[4 * w + 2] = __builtin_amdgcn_sdot4((int)__builtin_amdgcn_perm(p23h, p01h, 0x05040100u), cq[g_], yi[4 * w + 2], false); yi[4 * w + 3] = __builtin_amdgcn_sdot4((int)__builtin_amdgcn_perm(p23h, p01h, 0x07060302u), cq[g_], yi[4 * w + 3], false); } } } while (0)
    PV_LOADID(0, 0); PV_LOADID(1, 1); PV_LOADC(0, 0); PV_LOADC(1, 1);
    PV_GATHER(0, 0); PV_GATHER(0, 1); PV_GATHER(1, 0); PV_GATHER(1, 1);
    PV_LOADID(0, 2);
#pragma unroll 1
    for (int it = 0; it < nit; it += 2) {
#pragma unroll
        for (int a = 0; a < 2; ++a) {
            const int i = it + a, bq = 1 - a;
            const int cq[4] = {bcast4<0>(cqw[a]), bcast4<1>(cqw[a]), bcast4<2>(cqw[a]), bcast4<3>(cqw[a])}; const float cback = csv[a]; const f32x2 xv = xvv[a], gv = gvv[a];
            PV_LOADC(a, i + 2); PV_LOADID(bq, i + 3);
            int yi[16];
#pragma unroll
            for (int q = 0; q < 16; ++q) yi[q] = 0;
            PV_MATH(a, 0); PV_GATHER(a, 0);
            PV_MATH(a, 1); PV_GATHER(a, 1);
            f32x2 y[8];
#pragma unroll
            for (int q = 0; q < 8; ++q) y[q] = (f32x2){(float)yi[2 * q] * cback, (float)yi[2 * q + 1] * cback};
            f32x2 r4[4], r2[2], r1;
#pragma unroll
            for (int q = 0; q < 4; ++q) r4[q] = (f32x2){xsum32(y[q].x, y[4 + q].x), xsum32(y[q].y, y[4 + q].y)};
#pragma unroll
            for (int q = 0; q < 2; ++q) r2[q] = (f32x2){xsum16(r4[q].x, r4[2 + q].x), xsum16(r4[q].y, r4[2 + q].y)};
            { const f32x2 snd = b3 ? r2[0] : r2[1], kp = b3 ? r2[1] : r2[0]; r1 = (f32x2){kp.x + dpp_f<0x128>(snd.x), kp.y + dpp_f<0x128>(snd.y)}; }
            if (i < nit) {
                const int t = S.wq + i * S.nwq;
                *(f32x2*)(p.out + (size_t)t * DM + ocol) = xv + gv * r1;
            }
        }
    }
#undef PV_TOK
#undef PV_LOADID
#undef PV_LOADC
#undef PV_GATHER
#undef PV_G1
#undef PV_MATH
}

template <int MODE = 0> __device__ __forceinline__ void ph_peer_u4(const Prm& p, const Ctx& C, int l, unsigned char* lds) {
    SliceCtx S; S.x = blockIdx.x & 3; S.wq = (blockIdx.x >> 2) * NWAVES + C.wave; S.nwq = (((int)gridDim.x - S.x + 3) >> 2) * NWAVES;
    const bf16_t* HB = (const bf16_t*)(p.ws + WS_QQ); float* PD = (float*)(p.ws + WS_PD);
    const unsigned short* IDX = (const unsigned short*)(p.ws + WS_VV);
    const unsigned char* U8 = p.ws + WS_T8 + ((size_t)(l * 2 + 0) * 8 + S.x) * NEXP * 128;
    const int lane = C.lane, j = lane & 7, k = lane >> 3, jq = (lane >> 2) & 1;
    u32x4 uq[2][16]; unsigned idw[2]; u32x2 hr[2];
    LAS unsigned* il = (LAS unsigned*)((LAS unsigned char*)lds + 131072 + C.wave * 256);
    unsigned idr[8];
    LAS unsigned* hl = (LAS unsigned*)((LAS unsigned char*)lds + C.wave * 256);
    const int nit = (NT - S.wq + S.nwq - 1) / S.nwq;
#define PU_TOK(i) (S.wq + ((i) < nit ? (i) : nit - 1) * S.nwq)
#define PU_LOADID(s_, i) do { idw[s_] = ((const unsigned*)IDX)[(size_t)PU_TOK(i) * 64 + lane]; } while (0)
#define PU_LOADH(s_, i) do { hr[s_] = *(const u32x2*)(HB + (size_t)PU_TOK(i) * DM + 256 * S.x + 4 * lane); } while (0)
#define PU_IDS(s_) do { il[lane] = idw[s_]; const u32x4 i0_ = *(LAS u32x4*)(il + 8 * k), i1_ = *(LAS u32x4*)(il + 8 * k + 4); idr[0] = i0_.x; idr[1] = i0_.y; idr[2] = i0_.z; idr[3] = i0_.w; idr[4] = i1_.x; idr[5] = i1_.y; idr[6] = i1_.z; idr[7] = i1_.w; } while (0)
#define PU_G1(s_, BB) uq[s_][BB] = *(const u32x4*)(U8 + (size_t)((((BB) & 1) ? (idr[(BB) >> 1] >> 16) : (idr[(BB) >> 1] & 0xffffu)) * 128u + 16u * (unsigned)j))
#define PU_GATHER(s_, h_) do { PU_G1(s_, 8 * (h_) + 0); PU_G1(s_, 8 * (h_) + 1); PU_G1(s_, 8 * (h_) + 2); PU_G1(s_, 8 * (h_) + 3); PU_G1(s_, 8 * (h_) + 4); PU_G1(s_, 8 * (h_) + 5); PU_G1(s_, 8 * (h_) + 6); PU_G1(s_, 8 * (h_) + 7); } while (0)
#define PU_MATH(s_, h_, pd_) do { _Pragma("unroll") for (int b_ = 0; b_ < 8; ++b_) { const int bb = 8 * (h_) + b_; const unsigned x_[4] = {uq[s_][bb].x, uq[s_][bb].y, uq[s_][bb].z, uq[s_][bb].w}; int a0_ = 0, a1_ = 0; \
        _Pragma("unroll") for (int w_ = 0; w_ < 4; ++w_) { a0_ = __builtin_amdgcn_sdot8((int)x_[w_], hp0[w_], a0_, false); a1_ = __builtin_amdgcn_sdot8((int)x_[w_], hp1[w_], a1_, false); } \
        pd_[bb] = a1_ * 16 + a0_; } } while (0)
    PU_LOADID(0, 0); PU_LOADID(1, 1); PU_LOADH(0, 0); PU_LOADH(1, 1);
    PU_IDS(0); PU_GATHER(0, 0); PU_GATHER(0, 1); PU_IDS(1); PU_GATHER(1, 0); PU_GATHER(1, 1);
    PU_LOADID(0, 2);
    __builtin_amdgcn_s_waitcnt(0x0F70);
#pragma unroll 1
    for (int it = 0; it < nit; it += 2) {
#pragma unroll
        for (int a = 0; a < 2; ++a) {
            const int i = it + a, bq = 1 - a;
            int hp0[4], hp1[4]; float hsc;
            { const float h0_ = __uint_as_float(hr[a].x << 16), h1_ = __uint_as_float(hr[a].x & 0xffff0000u), h2_ = __uint_as_float(hr[a].y << 16), h3_ = __uint_as_float(hr[a].y & 0xffff0000u);
              float am = fmaxf(fmaxf(fabsf(h0_), fabsf(h1_)), fmaxf(fabsf(h2_), fabsf(h3_)));
              am = fmaxf(am, dpp_f<0xB1>(am)); am = fmaxf(am, dpp_f<0x4E>(am)); am = fmaxf(am, dpp_f<0x141>(am)); am = fmaxf(am, dpp_f<0x140>(am)); am = fmaxf(am, __shfl_xor(am, 16)); am = fmaxf(am, __shfl_xor(am, 32));
              hsc = am > 0.f ? am * (1.0f / 119.0f) : 1.0f; const float inv = am > 0.f ? 119.0f / am : 0.f;
              unsigned u0 = __builtin_amdgcn_cvt_pk_u8_f32(h0_ * inv + 136.0f, 0, 0u); u0 = __builtin_amdgcn_cvt_pk_u8_f32(h1_ * inv + 136.0f, 1, u0); u0 = __builtin_amdgcn_cvt_pk_u8_f32(h2_ * inv + 136.0f, 2, u0); u0 = __builtin_amdgcn_cvt_pk_u8_f32(h3_ * inv + 136.0f, 3, u0);
              hl[lane] = u0;
              const u32x4 lo4 = *(LAS u32x4*)(hl + 4 * j), hi4 = *(LAS u32x4*)(hl + 32 + 4 * j);
              const unsigned L8_[4] = {lo4.x, lo4.y, lo4.z, lo4.w}, H8_[4] = {hi4.x, hi4.y, hi4.z, hi4.w};
#pragma unroll
              for (int w = 0; w < 4; ++w) { const unsigned L8 = L8_[w], H8 = H8_[w];
                  hp0[w] = (int)(((L8 & 0x0f0f0f0fu) | ((H8 & 0x0f0f0f0fu) << 4)) ^ 0x88888888u);
                  hp1[w] = (int)((((L8 >> 4) & 0x0f0f0f0fu) | (H8 & 0xf0f0f0f0u)) ^ 0x88888888u); } }
            PU_LOADH(a, i + 2); PU_LOADID(bq, i + 3);
            int v16[16];
            PU_IDS(a); PU_MATH(a, 0, v16); PU_GATHER(a, 0);
            PU_MATH(a, 1, v16); PU_GATHER(a, 1);
            int v8[8], v4[4], v2[2];
#pragma unroll
            for (int m = 0; m < 8; ++m) { const int kp = (j & 4) ? v16[8 + m] : v16[m], sd = (j & 4) ? v16[m] : v16[8 + m]; v8[m] = kp + dpp_i<0x141>(sd); }
#pragma unroll
            for (int m = 0; m < 4; ++m) { const int kp = (j & 2) ? v8[4 + m] : v8[m], sd = (j & 2) ? v8[m] : v8[4 + m]; v4[m] = kp + dpp_i<0x4E>(sd); }
#pragma unroll
            for (int m = 0; m < 2; ++m) { const int kp = (j & 1) ? v4[2 + m] : v4[m], sd = (j & 1) ? v4[m] : v4[2 + m]; v2[m] = kp + dpp_i<0xB1>(sd); }
            if (i < nit) { float* pd = (MODE == 1 ? (float*)(p.ws + WS_HB) : PD) + ((size_t)S.x * NT + (S.wq + i * S.nwq)) * 128 + 2 * lane; *(f32x2*)pd = (f32x2){(float)v2[0] * hsc, (float)v2[1] * hsc}; }
        }
    }
#undef PU_TOK
#undef PU_LOADID
#undef PU_LOADH
#undef PU_GATHER
#undef PU_G1
#undef PU_MATH
}

__device__ __forceinline__ void ph_peer_r2(const Prm& p, const Ctx& C, int l, unsigned char* lds) {
    const unsigned* IDX = (const unsigned*)(p.ws + WS_VV); const f32x2* PW = (const f32x2*)(p.ws + WS_VV + 16 * MiB); const f32x2* PD = (const f32x2*)(p.ws + WS_PD);
    unsigned char* CQ2 = p.ws + WS_VV + 32 * MiB; float* CSC = (float*)(p.ws + WS_VV + 40 * MiB);
    const float* SU = (const float*)(p.ws + WS_SC8) + (size_t)(l * 2) * NEXP; const float* SV = SU + NEXP;
    const size_t n2 = (size_t)NT * 64; const int lane = C.lane;
    const int bidx = 64 * (lane & 1) + 8 * ((lane >> 1) & 3) + (lane >> 3);
    LAS unsigned char* wl = (LAS unsigned char*)lds + C.wave * 256;
    for (int t = C.gw; t < NT; t += C.ngw) {
        f32x2 pd0 = PD[(size_t)t * 64 + lane], pd1 = PD[n2 + (size_t)t * 64 + lane], pd2 = PD[2 * n2 + (size_t)t * 64 + lane], pd3 = PD[3 * n2 + (size_t)t * 64 + lane];
        float r = ((const float*)(p.ws + WS_FC))[t];
        unsigned idw = IDX[(size_t)t * 64 + lane];
        f32x2 pw = PW[(size_t)t * 64 + lane];
        asm volatile("" : "+v"(pd0), "+v"(pd1), "+v"(pd2), "+v"(pd3), "+v"(r), "+v"(idw), "+v"(pw));
        const f32x2 sa = (pd0 + pd1) + (pd2 + pd3);
        const int id0 = (int)(idw & 0xffffu), id1 = (int)(idw >> 16);
        const f32x4* REC = (const f32x4*)(p.ws + WS_T8 + ((size_t)(l * 2 + 0) * 8 + 4) * NEXP * 128) + (size_t)(t / SEQ) * NEXP;
        f32x4 rc0 = REC[id0], rc1 = REC[id1];
        asm volatile("" : "+v"(rc0), "+v"(rc1));
        const float us0 = rc0.x, su0 = rc0.y, sv0 = rc0.z, us1 = rc1.x, su1 = rc1.y, sv1 = rc1.z;
        const float d0 = sa.x * r * su0 + us0, d1 = sa.y * r * su1 + us1;
        const float cf0 = pw.x * (0.5f * d0 * (1.0f + erff(d0 * 0.70710678118654752f))) * sv0;
        const float cf1 = pw.y * (0.5f * d1 * (1.0f + erff(d1 * 0.70710678118654752f))) * sv1;
        float cmx = fmaxf(fabsf(cf0), fabsf(cf1));
        cmx = fmaxf(cmx, dpp_f<0xB1>(cmx)); cmx = fmaxf(cmx, dpp_f<0x4E>(cmx)); cmx = fmaxf(cmx, dpp_f<0x141>(cmx)); cmx = fmaxf(cmx, dpp_f<0x140>(cmx));
        cmx = fmaxf(cmx, __shfl_xor(cmx, 16)); cmx = fmaxf(cmx, __shfl_xor(cmx, 32));
        const float inv = cmx > 0.f ? 16383.0f / cmx : 0.f;
        const int q0 = (int)rintf(cf0 * inv), q1 = (int)rintf(cf1 * inv);
        wl[bidx] = (unsigned char)(q0 >> 7); wl[bidx + 128] = (unsigned char)(q0 & 127); wl[bidx + 32] = (unsigned char)(q1 >> 7); wl[bidx + 160] = (unsigned char)(q1 & 127);
        int qs = q0 + q1;
        qs += dpp_i<0xB1>(qs); qs += dpp_i<0x4E>(qs); qs += dpp_i<0x141>(qs); qs += dpp_i<0x140>(qs); qs += __shfl_xor(qs, 16); qs += __shfl_xor(qs, 32);
        ((unsigned*)(CQ2 + (size_t)t * 256))[lane] = ((LAS unsigned*)wl)[lane];
        if (lane == 0) { const float sc = cmx * (1.0f / 16383.0f); *(f32x2*)(CSC + 2 * (size_t)t) = (f32x2){sc, 8.0f * sc * (float)qs}; }
    }
}
__device__ __forceinline__ void ph_peer_v2(const Prm& p, const Ctx& C, int l, unsigned char* lds) {
    SliceCtx S; S.x = blockIdx.x & 3; S.wq = (blockIdx.x >> 2) * NWAVES + C.wave; S.nwq = (((int)gridDim.x - S.x + 3) >> 2) * NWAVES;
    const unsigned short* IDX = (const unsigned short*)(p.ws + WS_VV); const unsigned char* CQ2 = p.ws + WS_VV + 32 * MiB; const f32x2* CSC = (const f32x2*)(p.ws + WS_VV + 40 * MiB);
    const float* MOD = (const float*)(p.ws + WS_MOD) + (size_t)l * NB * MODW;
    const unsigned char* V8 = p.ws + WS_T8 + ((size_t)(l * 2 + 1) * 8 + S.x) * NEXP * 128;
    const int lane = C.lane, j = lane & 7, k = lane >> 3, jq = (lane >> 2) & 1, n16 = lane & 15, q4 = lane >> 4;
    LAS unsigned* il = (LAS unsigned*)((LAS unsigned char*)lds + 131072 + C.wave * 256); unsigned idr[8];
    LAS unsigned char* wl = (LAS unsigned char*)lds + C.wave * 16384;
    const int wb_e = 128 * k + 32 * ((j >> 1) ^ ((k >> 1) & 1)) + 16 * (j & 1), wb_o = 128 * k + 32 * ((j >> 1) ^ ((k >> 1) & 1) ^ 2) + 16 * (j & 1);
    const int rr = (lane >> 2) & 3, pp = lane & 3, fr = ((rr >> 1) & 1) | ((q4 & 1) << 1);
    int rb[4];
#pragma unroll
    for (int nt = 0; nt < 4; ++nt) rb[nt] = 128 * (8 * q4 + rr) + 32 * (nt ^ fr) + 8 * pp;
    const unsigned selA0 = (lane & 1) ? 0x010c000cu : 0x0c010c00u, selB0 = (lane & 1) ? 0x030c020cu : 0x0c030c02u;
    const unsigned selAL = (lane & 4) ? 0x0c0c0c0cu : selA0, selBL = (lane & 4) ? 0x0c0c0c0cu : selB0, selAH = (lane & 4) ? selA0 : 0x0c0c0c0cu, selBH = (lane & 4) ? selB0 : 0x0c0c0c0cu;
    const int cqo = 128 * ((lane >> 1) & 1) + 32 * q4;
    const int ocol = 256 * S.x + 128 * (q4 & 1) + 64 * (q4 >> 1) + 2 * n16;
    u32x4 vq[2][16]; unsigned idw[2]; u32x4 cqa[2][2]; f32x2 csv[2]; unsigned xvb[2][2]; f32x2 gvv[2][2];
    const bf16_t* XR1 = (const bf16_t*)(p.ws + WS_XR1); bf16_t* XR2 = (bf16_t*)p.out;
    const int nit = (NT - S.wq + S.nwq - 1) / S.nwq;
#define PV_TOK(i) (S.wq + ((i) < nit ? (i) : nit - 1) * S.nwq)
#define PV_LOADID(s_, i) do { idw[s_] = ((const unsigned*)IDX)[(size_t)PV_TOK(i) * 64 + lane]; } while (0)
#define PV_LOADC(s_, i) do { const int t_ = PV_TOK(i); const unsigned char* cp_ = CQ2 + (size_t)t_ * 256 + cqo; cqa[s_][0] = *(const u32x4*)cp_; cqa[s_][1] = *(const u32x4*)(cp_ + 16); csv[s_] = CSC[t_]; \
        xvb[s_][0] = *(const unsigned*)(XR1 + (size_t)t_ * DM + ocol); xvb[s_][1] = *(const unsigned*)(XR1 + (size_t)t_ * DM + ocol + 32); gvv[s_][0] = *(const f32x2*)(MOD + (size_t)(t_ / SEQ) * MODW + 5 * DM + ocol); gvv[s_][1] = *(const f32x2*)(MOD + (size_t)(t_ / SEQ) * MODW + 5 * DM + ocol + 32); } while (0)
#define PV_IDS(s_) do { il[lane] = idw[s_]; const u32x4 i0_ = *(LAS u32x4*)(il + 8 * k), i1_ = *(LAS u32x4*)(il + 8 * k + 4); idr[0] = i0_.x; idr[1] = i0_.y; idr[2] = i0_.z; idr[3] = i0_.w; idr[4] = i1_.x; idr[5] = i1_.y; idr[6] = i1_.z; idr[7] = i1_.w; } while (0)
#define PV_G1(s_, BB) vq[s_][BB] = *(const u32x4*)(V8 + (size_t)((((BB) & 1) ? (idr[(BB) >> 1] >> 16) : (idr[(BB) >> 1] & 0xffffu)) * 128u + 16u * (unsigned)j))
#define PV_GATHER(s_, h_) do { PV_G1(s_, 8 * (h_) + 0); PV_G1(s_, 8 * (h_) + 1); PV_G1(s_, 8 * (h_) + 2); PV_G1(s_, 8 * (h_) + 3); PV_G1(s_, 8 * (h_) + 4); PV_G1(s_, 8 * (h_) + 5); PV_G1(s_, 8 * (h_) + 6); PV_G1(s_, 8 * (h_) + 7); } while (0)
#define PV_W1(s_, h_, B_) *(LAS u32x4*)(wl + 8192 * (h_) + 1024 * (B_) + (((B_) & 1) ? wb_o : wb_e)) = vq[s_][8 * (h_) + (B_)]
#define PV_WRITE(s_, h_) do { PV_W1(s_, h_, 0); PV_W1(s_, h_, 1); PV_W1(s_, h_, 2); PV_W1(s_, h_, 3); PV_W1(s_, h_, 4); PV_W1(s_, h_, 5); PV_W1(s_, h_, 6); PV_W1(s_, h_, 7); } while (0)
#define PV_TR(h_, ksl_, nt_, rd_) __builtin_amdgcn_ds_read_tr16_b64_v4i16((LAS s16x4*)(wl + 8192 * (h_) + 4096 * (ksl_) + 512 * (rd_) + rb[nt_]))
#define PV_MMA(h_) do { _Pragma("unroll") for (int ksl_ = 0; ksl_ < 2; ++ksl_) { const int ks_ = 2 * (h_) + ksl_; const unsigned w0_ = cw[2 * ks_], w1_ = cw[2 * ks_ + 1]; \
        const i32x4 AL_ = {(int)__builtin_amdgcn_perm(w0_, w0_, selAL), (int)__builtin_amdgcn_perm(w0_, w0_, selBL), (int)__builtin_amdgcn_perm(w1_, w1_, selAL), (int)__builtin_amdgcn_perm(w1_, w1_, selBL)}; \
        const i32x4 AH_ = {(int)__builtin_amdgcn_perm(w0_, w0_, selAH), (int)__builtin_amdgcn_perm(w0_, w0_, selBH), (int)__builtin_amdgcn_perm(w1_, w1_, selAH), (int)__builtin_amdgcn_perm(w1_, w1_, selBH)}; \
        _Pragma("unroll") for (int nt_ = 0; nt_ < 4; ++nt_) { const s16x4 b0_ = PV_TR(h_, ksl_, nt_, 0), b1_ = PV_TR(h_, ksl_, nt_, 1); const i32x2 c0_ = __builtin_bit_cast(i32x2, b0_), c1_ = __builtin_bit_cast(i32x2, b1_); \
            const i32x4 BL_ = {c0_.x & 0x0f0f0f0f, c0_.y & 0x0f0f0f0f, c1_.x & 0x0f0f0f0f, c1_.y & 0x0f0f0f0f}, BH_ = {c0_.x, c0_.y, c1_.x, c1_.y};     \
            acc[nt_] = __builtin_amdgcn_mfma_i32_16x16x64_i8(AL_, BL_, acc[nt_], 0, 0, 0); acc[nt_] = __builtin_amdgcn_mfma_i32_16x16x64_i8(AH_, BH_, acc[nt_], 0, 0, 0); } } } while (0)
    PV_LOADID(0, 0); PV_LOADID(1, 1); PV_LOADC(0, 0);
    PV_IDS(0); PV_GATHER(0, 0); PV_GATHER(0, 1); PV_IDS(1); PV_GATHER(1, 0); PV_GATHER(1, 1);
    PV_LOADID(0, 2);
    __builtin_amdgcn_s_waitcnt(0x0F70);
#pragma unroll 1
    for (int it = 0; it < nit; it += 2) {
#pragma unroll
        for (int a = 0; a < 2; ++a) {
            const int i = it + a, bq = 1 - a;
            const unsigned cw[8] = {cqa[a][0].x, cqa[a][0].y, cqa[a][0].z, cqa[a][0].w, cqa[a][1].x, cqa[a][1].y, cqa[a][1].z, cqa[a][1].w}; const f32x2 cback = csv[a]; const f32x2 xv0 = {__uint_as_float(xvb[a][0] << 16), __uint_as_float(xvb[a][0] & 0xffff0000u)}, xv1 = {__uint_as_float(xvb[a][1] << 16), __uint_as_float(xvb[a][1] & 0xffff0000u)}, gv0 = gvv[a][0], gv1 = gvv[a][1];
            PV_LOADC(bq, i + 1); PV_LOADID(bq, i + 3);
            i32x4 acc[4];
#pragma unroll
            for (int nt = 0; nt < 4; ++nt) acc[nt] = (i32x4){0, 0, 0, 0};
            PV_IDS(a); PV_WRITE(a, 0); PV_GATHER(a, 0); PV_MMA(0);
            PV_WRITE(a, 1); PV_GATHER(a, 1); PV_MMA(1);
            const i32x4 a0 = (q4 >> 1) ? acc[2] : acc[0], a1 = (q4 >> 1) ? acc[3] : acc[1];
            const float mf = (q4 & 1) ? cback.x * 0.0625f : cback.x, sb = (q4 & 1) ? 0.f : cback.y;
            int v00 = a0.x * 128 + a0.z, v01 = a0.y * 128 + a0.w, v10 = a1.x * 128 + a1.z, v11 = a1.y * 128 + a1.w;
            { const int p00 = __shfl_xor(v00, 16), p01 = __shfl_xor(v01, 16), p10 = __shfl_xor(v10, 16), p11 = __shfl_xor(v11, 16);
              if (q4 & 1) { v00 -= p00; v01 -= p01; v10 -= p10; v11 -= p11; } }
            const f32x2 y0 = {(float)v00 * mf - sb, (float)v01 * mf - sb}, y1 = {(float)v10 * mf - sb, (float)v11 * mf - sb};
            if (i < nit) {
                const int t = S.wq + i * S.nwq;
                const f32x2 o0 = xv0 + gv0 * y0, o1 = xv1 + gv1 * y1;
                if (l == 0) { *(unsigned*)(XR2 + (size_t)t * DM + ocol) = pg8::cvt_pk_bf16(o0.x, o0.y); *(unsigned*)(XR2 + (size_t)t * DM + ocol + 32) = pg8::cvt_pk_bf16(o1.x, o1.y); }
                else { *(f32x2*)(p.out + (size_t)t * DM + ocol) = o0; *(f32x2*)(p.out + (size_t)t * DM + ocol + 32) = o1; }
            }
        }
    }
#undef PV_TOK
#undef PV_LOADID
#undef PV_LOADC
#undef PV_GATHER
#undef PV_G1
#undef PV_W1
#undef PV_WRITE
#undef PV_TR
#undef PV_MMA
}

constexpr int PH_PER_LAYER = 11, NPH = 1 + 2 * PH_PER_LAYER;

__global__ void __launch_bounds__(NTHREADS, 2) mega(Prm p0) {
    extern __shared__ __attribute__((aligned(16))) unsigned char lds[];
    const int ph_lo = p0.ph_lo, ph_hi = p0.ph_hi;
    volatile LAS unsigned* bst = (volatile LAS unsigned*)((LAS unsigned char*)lds + (LDS_BYTES - 64));
    if (threadIdx.x < 16) bst[threadIdx.x] = 0u;
    __syncthreads();
    XcdBarrier bar = xcd_barrier_post((unsigned*)(p0.ws + WS_CTL), bst);
#define PHASE_BEGIN(k) if (ph_lo <= (k) && (k) < ph_hi) { Prm p = p0; Ctx C; \
        { size_t z_ = 0; asm volatile("" : "+s"(z_));     \
          p.x = (const float*)((const char*)p0.x + z_); p.c = (const float*)((const char*)p0.c + z_); p.ada_w = (const float*)((const char*)p0.ada_w + z_); p.ada_b = (const float*)((const char*)p0.ada_b + z_); \
          p.attn_norm = (const float*)((const char*)p0.attn_norm + z_); p.ffn_norm = (const float*)((const char*)p0.ffn_norm + z_); p.w_in = (const float*)((const char*)p0.w_in + z_); p.fox_bf = (const float*)((const char*)p0.fox_bf + z_); \
          p.gq = (const float*)((const char*)p0.gq + z_); p.gk = (const float*)((const char*)p0.gk + z_); p.w_branch = (const float*)((const char*)p0.w_branch + z_); p.w_out = (const float*)((const char*)p0.w_out + z_); \
          p.wq = (const float*)((const char*)p0.wq + z_); p.k1 = (const float*)((const char*)p0.k1 + z_); p.k2 = (const float*)((const char*)p0.k2 + z_); p.pu = (const float*)((const char*)p0.pu + z_); p.pv = (const float*)((const char*)p0.pv + z_); \
          p.out = (float*)((char*)p0.out + z_); p.ws = p0.ws + z_; } \
        C.tid = threadIdx.x; asm volatile("" : "+v"(C.tid)); C.lane = C.tid & 63; C.wave = __builtin_amdgcn_readfirstlane(C.tid >> 6); \
        C.gw = blockIdx.x * NWAVES + C.wave; C.ngw = gridDim.x * NWAVES;
#define PHASE_END(k) if ((k) + 1 < ph_hi) { xcd_barrier(bar); } }
    PHASE_BEGIN(0) ph_mod(p, C); ph_weights(p, C, lds); ph_convert_tables8s(p, C); PHASE_END(0)
#pragma unroll 1
    for (int l = 0; l < 2; ++l) {
        const int k0 = 1 + l * PH_PER_LAYER;
        PHASE_BEGIN(k0 + 0) ph_norm<true>(p, C, l, p.x, l == 0 ? (const bf16_t*)nullptr : (const bf16_t*)p.out, p.attn_norm + l * DM, 0, 1, lds); ph_peer_pre(p, C, l); PHASE_END(k0 + 0)
        PHASE_BEGIN(k0 + 1) ph_gemm1(p, l, lds); PHASE_END(k0 + 1)
        PHASE_BEGIN(k0 + 2) ph_attn<3>(p, C, l, lds); PHASE_END(k0 + 2)
        PHASE_BEGIN(k0 + 3) ph_merge(p, l, lds); PHASE_END(k0 + 3)
        PHASE_BEGIN(k0 + 4) ph_out(p, l, lds); PHASE_END(k0 + 4)
        PHASE_BEGIN(k0 + 6) ph_q(p, l, lds); PHASE_END(k0 + 6)
        PHASE_BEGIN(k0 + 7) ph_topk(p, C, l, lds); PHASE_END(k0 + 7)
        PHASE_BEGIN(k0 + 8) ph_peer_u4(p, C, l, lds); PHASE_END(k0 + 8)
        PHASE_BEGIN(k0 + 9) ph_peer_r2(p, C, l, lds); PHASE_END(k0 + 9)
        PHASE_BEGIN(k0 + 10) ph_peer_v2(p, C, l, lds); PHASE_END(k0 + 10)
    }
}

extern "C" void kernel_launch(void* const* d_in, const int* in_sizes, int n_in, void* d_out, int out_size, void* d_ws, size_t ws_size, hipStream_t stream) {
    static int grid = 0;
    if (grid == 0) {
        if (n_in != 17 || out_size != NT * DM || ws_size < WS_END) { fprintf(stderr, "kernel_launch: unexpected shapes (n_in %d out %d ws %zu)\n", n_in, out_size, ws_size); grid = -1; return; }
        int dev = 0, cus = 0, per_cu = 0;
        hipGetDevice(&dev); hipDeviceGetAttribute(&cus, hipDeviceAttributeMultiprocessorCount, dev);
        hipFuncSetAttribute((const void*)mega, hipFuncAttributeMaxDynamicSharedMemorySize, LDS_BYTES);
        hipOccupancyMaxActiveBlocksPerMultiprocessor(&per_cu, (const void*)mega, NTHREADS, LDS_BYTES);
        if (per_cu < 1) { fprintf(stderr, "kernel_launch: occupancy query says %d blocks per CU\n", per_cu); per_cu = 1; }
        (void)hipGetLastError();
        grid = cus;
    }
    if (grid < 0) return;
    if (hipMemsetAsync((char*)d_ws + WS_CTL, 0, 32768, stream) != hipSuccess) { fprintf(stderr, "kernel_launch: memset of the barrier words failed\n"); return; }
    Prm p{};
    const float** pp = (const float**)&p;
    for (int i = 0; i < 17; ++i) pp[i] = (const float*)d_in[i];
    p.out = (float*)d_out; p.ws = (unsigned char*)d_ws;
#if MK_MULTI
    for (int ph = 0; ph < NPH; ++ph) { p.ph_lo = ph; p.ph_hi = ph + 1; hipLaunchKernelGGL(mega, dim3(grid), dim3(NTHREADS), LDS_BYTES, stream, p); }
#else
    p.ph_lo = 0; p.ph_hi = NPH;
    void* args[] = {&p};
    hipError_t e = hipLaunchCooperativeKernel((const void*)mega, dim3(grid), dim3(NTHREADS), args, LDS_BYTES, stream);
    if (e != hipSuccess) fprintf(stderr, "cooperative launch failed: %s (grid %d)\n", hipGetErrorString(e), grid);
#endif
}
```

```cpp
#include <hip/hip_runtime.h>
#include <hip/hip_cooperative_groups.h>
#include <hip/hip_bf16.h>
#include <cstdio>
#include <cstdint>
namespace cg = cooperative_groups;

#ifndef MK_MULTI
#define MK_MULTI 0
#endif

constexpr int NB = 8, SEQ = 4096, DM = 1024, NT = NB * SEQ, NH = 8, HD = 64, INW = 5128, NEXP = 16384, NKEYS = 128, TOPK = 16;
constexpr int MODW = 6 * DM;
constexpr float EPS = 1e-6f;
constexpr float LOG2E = 1.4426950408889634f, LN2 = 0.6931471805599453f;
constexpr float C2 = 0.125f * LOG2E;
constexpr int NWAVES = 8, NTHREADS = 512;
constexpr int LDS_BYTES = 147456;

constexpr size_t MiB = 1u << 20;
constexpr size_t WS_CTL = 0;
constexpr size_t WS_MOD = 1 * MiB;
constexpr size_t WS_FA = 2 * MiB;
constexpr size_t WS_FC = 3 * MiB;
constexpr size_t WS_WIN = 4 * MiB;
constexpr size_t WS_WBR = 24 * MiB;
constexpr size_t WS_WOUT = 28 * MiB;
constexpr size_t WS_WQ = 32 * MiB;
constexpr size_t WS_K12 = 36 * MiB;
constexpr size_t WS_UB = 37 * MiB;
constexpr size_t WS_VB = 69 * MiB;
constexpr size_t WS_HB = 101 * MiB;
constexpr size_t WS_QQ = 165 * MiB;
constexpr size_t WS_KK = 229 * MiB;
constexpr size_t WS_VV = 293 * MiB;
constexpr size_t WS_GT = 357 * MiB;
constexpr size_t WS_SSQ = 485 * MiB;
constexpr size_t WS_BQ = 487 * MiB;
constexpr size_t WS_USH = 488 * MiB;
constexpr size_t WS_END = 490 * MiB;
constexpr size_t WS_XR1 = WS_GT + 64 * MiB;

typedef unsigned short bf16_t;
typedef float f32x4 __attribute__((ext_vector_type(4)));
typedef unsigned u32x4 __attribute__((ext_vector_type(4))); typedef unsigned u32x2 __attribute__((ext_vector_type(2)));

struct Prm {
    const float *x, *c, *ada_w, *ada_b, *attn_norm, *ffn_norm, *w_in, *fox_bf, *gq, *gk, *w_branch, *w_out, *wq, *k1, *k2, *pu, *pv;
    float* out; unsigned char* ws; int ph_lo, ph_hi;
};

__device__ __forceinline__ float bf2f(bf16_t v) { return __uint_as_float((unsigned)v << 16); }
__device__ __forceinline__ unsigned f2bf(float f) { unsigned u = __float_as_uint(f); return (u + 0x7fffu + ((u >> 16) & 1u)) >> 16; }
__device__ __forceinline__ unsigned pk2(float lo, float hi) { return f2bf(lo) | (f2bf(hi) << 16); }
template <int CTRL> __device__ __forceinline__ int dpp_i(int v) { return __builtin_amdgcn_update_dpp(0, v, CTRL, 0xF, 0xF, true); }
template <int CTRL> __device__ __forceinline__ float dpp_f(float v) { return __int_as_float(__builtin_amdgcn_update_dpp(0, __float_as_int(v), CTRL, 0xF, 0xF, true)); }
__device__ __forceinline__ float xsum32(float a, float b) { const auto r = __builtin_amdgcn_permlane32_swap(__float_as_uint(a), __float_as_uint(b), false, false); return __uint_as_float(r[0]) + __uint_as_float(r[1]); }
__device__ __forceinline__ float xsum16(float a, float b) { const auto r = __builtin_amdgcn_permlane16_swap(__float_as_uint(a), __float_as_uint(b), false, false); return __uint_as_float(r[0]) + __uint_as_float(r[1]); }
__device__ __forceinline__ float wave_sum(float v) {
    v += dpp_f<0xB1>(v); v += dpp_f<0x4E>(v); v += dpp_f<0x141>(v); v += dpp_f<0x140>(v);
    v = xsum16(v, v); v = xsum32(v, v);
    return v;
}
__device__ __forceinline__ float sigmoidf_(float a) { return 1.0f / (1.0f + __expf(-a)); }
__device__ __forceinline__ float log_sigmoidf_(float a) { return fminf(a, 0.f) - log1pf(expf(-fabsf(a))); }
__device__ __forceinline__ float softplus2(float z2) { return fmaxf(z2, 0.f) + __log2f(1.0f + exp2f(-fabsf(z2))); }

struct Ctx { int tid, lane, wave, gw, ngw; };

__device__ __forceinline__ void ph_mod(const Prm& p, const Ctx& C) {
    float* MOD = (float*)(p.ws + WS_MOD);
    for (int item = C.gw; item < 2 * (MODW / 8); item += C.ngw) {
        const int l = item / (MODW / 8), cb = (item % (MODW / 8)) * 8;
        float acc[8][8];
#pragma unroll
        for (int b = 0; b < 8; ++b)
#pragma unroll
            for (int j = 0; j < 8; ++j) acc[b][j] = 0.f;
        for (int i = 0; i < 16; ++i) {
            const int k = C.lane + 64 * i;
            const float* wp = p.ada_w + ((size_t)l * DM + k) * MODW + cb;
            const f32x4 w0 = *(const f32x4*)wp, w1 = *(const f32x4*)(wp + 4);
            const float w[8] = {w0.x, w0.y, w0.z, w0.w, w1.x, w1.y, w1.z, w1.w};
#pragma unroll
            for (int b = 0; b < 8; ++b) {
                const float cv = p.c[b * DM + k]; const float sv = cv * sigmoidf_(cv);
#pragma unroll
                for (int j = 0; j < 8; ++j) acc[b][j] += sv * w[j];
            }
        }
        float res = 0.f;
#pragma unroll
        for (int b = 0; b < 8; ++b)
#pragma unroll
            for (int j = 0; j < 8; ++j) { const float s = wave_sum(acc[b][j]); if (C.lane == b * 8 + j) res = s; }
        const int b = C.lane >> 3, j = C.lane & 7;
        MOD[((size_t)l * NB + b) * MODW + cb + j] = res + p.ada_b[l * MODW + cb + j];
    }
}

template <bool WITH_FA>
__device__ __forceinline__ void ph_norm(const Prm& p, const Ctx& C, int l, const float* xin, const bf16_t* xinb, const float* gain, int ch_sh, int ch_sc, unsigned char* lds) {
    const float* MOD = (const float*)(p.ws + WS_MOD) + (size_t)l * NB * MODW;
    bf16_t* HB = (bf16_t*)(p.ws + WS_HB);
    float* FA = (float*)(p.ws + WS_FA);
    f32x4 g4[4];
#pragma unroll
    for (int j = 0; j < 4; ++j) g4[j] = *(const f32x4*)(gain + 4 * C.lane + 256 * j);
    float* wfl = (float*)lds;
    if (WITH_FA) {
        for (int i = C.tid; i < DM * 8; i += NTHREADS) wfl[i] = p.w_in[((size_t)l * DM + (i >> 3)) * INW + 1536 + (i & 7)];
        __syncthreads();
    }
    for (int m0 = C.gw; m0 < NT; m0 += 2 * C.ngw) {
      f32x4 vv[2][4];
#pragma unroll
      for (int rr = 0; rr < 2; ++rr) { const size_t xo = (size_t)min(m0 + rr * C.ngw, NT - 1) * DM + 4 * C.lane;
        if (xinb == nullptr) {
#pragma unroll
            for (int j = 0; j < 4; ++j) vv[rr][j] = *(const f32x4*)(xin + xo + 256 * j);
        } else {
#pragma unroll
            for (int j = 0; j < 4; ++j) { const u32x2 w = *(const u32x2*)(xinb + xo + 256 * j); vv[rr][j] = (f32x4){__uint_as_float(w.x << 16), __uint_as_float(w.x & 0xffff0000u), __uint_as_float(w.y << 16), __uint_as_float(w.y & 0xffff0000u)}; } } }
      f32x4 shv[4], scv[4];
      { const int b0_ = m0 / SEQ;
#pragma unroll
        for (int j = 0; j < 4; ++j) { shv[j] = *(const f32x4*)(MOD + (size_t)b0_ * MODW + ch_sh * DM + 4 * C.lane + 256 * j); scv[j] = *(const f32x4*)(MOD + (size_t)b0_ * MODW + ch_sc * DM + 4 * C.lane + 256 * j); } }
#pragma unroll
      for (int rr = 0; rr < 2; ++rr) {
        const int m = m0 + rr * C.ngw; if (m >= NT) break;
        const int b = m / SEQ; const bool sameb = (b == m0 / SEQ);
        f32x4 v[4]; float s = 0.f;
#pragma unroll
        for (int j = 0; j < 4; ++j) { v[j] = vv[rr][j]; s += (v[j].x * v[j].x + v[j].y * v[j].y) + (v[j].z * v[j].z + v[j].w * v[j].w); }
        const float r = 1.0f / sqrtf(wave_sum(s) * (1.0f / DM) + EPS);
        const float* shp = MOD + (size_t)b * MODW + ch_sh * DM + 4 * C.lane;
        const float* scp = MOD + (size_t)b * MODW + ch_sc * DM + 4 * C.lane;
        float fa[8];
#pragma unroll
        for (int q = 0; q < 8; ++q) fa[q] = 0.f;
#pragma unroll
        for (int j = 0; j < 4; ++j) {
            const f32x4 sh = sameb ? shv[j] : *(const f32x4*)(shp + 256 * j), sc = sameb ? scv[j] : *(const f32x4*)(scp + 256 * j);
            f32x4 h = (v[j] * r) * g4[j] * (sc + 1.0f) + sh;
            unsigned long long o = (unsigned long long)pk2(h.x, h.y) | ((unsigned long long)pk2(h.z, h.w) << 32);
            *(unsigned long long*)(HB + (size_t)m * DM + 4 * C.lane + 256 * j) = o;
            if (WITH_FA) {
                const float hh[4] = {h.x, h.y, h.z, h.w};
#pragma unroll
                for (int e = 0; e < 4; ++e) {
                    const f32x4 wa = *(const f32x4*)(wfl + (4 * C.lane + 256 * j + e) * 8), wb = *(const f32x4*)(wfl + (4 * C.lane + 256 * j + e) * 8 + 4);
                    fa[0] += hh[e] * wa.x; fa[1] += hh[e] * wa.y; fa[2] += hh[e] * wa.z; fa[3] += hh[e] * wa.w;
                    fa[4] += hh[e] * wb.x; fa[5] += hh[e] * wb.y; fa[6] += hh[e] * wb.z; fa[7] += hh[e] * wb.w;
                }
            }
        }
        if (WITH_FA) {
            float res = 0.f;
#pragma unroll
            for (int q = 0; q < 8; ++q) { const float t = wave_sum(fa[q]); if (C.lane == q) res = t; }
            if (C.lane < 8) FA[(size_t)m * 8 + C.lane] = log_sigmoidf_(res + p.fox_bf[l * NH + C.lane]);
        }
      }
    }
    if (WITH_FA) __syncthreads();
}

namespace pg8 {
#define PG8_LAS __attribute__((address_space(3)))
typedef short bf16x8 __attribute__((ext_vector_type(8)));
constexpr int BM = 256, BK = 64, HALF = 128, HTB = HALF * BK * 2  , STAGE_BYTES = 8 * HTB, NXCD = 8, WGM = 8;
__host__ __device__ __forceinline__ int lds_byte(int r, int c) { const int st = (r >> 4) * 2 + (c >> 5), rr = r & 15, cc = c & 31, ob = rr * 64 + cc * 2; return st * 1024 + (ob ^ (((ob >> 9) & 1) << 5)); }
__host__ __device__ __forceinline__ void stage_rc(int b, int& R, int& C) { const int st = b / 1024, sb = b % 1024, swz = sb ^ (((sb >> 9) & 1) << 5); R = (st >> 1) * 16 + swz / 64; C = (st & 1) * 32 + (swz % 64) / 2; }
__host__ __device__ __forceinline__ int perm32(int rho) { const int n = rho >> 4, i = rho & 15; return 8 * (i >> 2) + 4 * n + (i & 3); }

struct Unit { int pm, pn, ka, kb, br; };
struct Gemm { const bf16_t* A; const bf16_t* Bt; int lda, ldb, K; };

struct Order {
    int nM, nN, nwg, G, c, pair;
    __device__ void init(int M, int N, int G_, int c_, int pair_) { nM = M / BM; nN = N / BM; nwg = nM * nN; G = G_; c = c_; pair = pair_; }
    __device__ bool next(int i, Unit& u) const {
        const int ii = pair ? (i >> 1) : i;
        const long L = (long)ii * G + c; if (L >= nwg) return false;
        int wgid = (int)L; { const int q = nwg / NXCD, r = nwg % NXCD, xcd = wgid % NXCD, off = wgid / NXCD; wgid = (xcd < r ? xcd * (q + 1) : r * (q + 1) + (xcd - r) * q) + off; }
        const int nig = WGM * nN, gid = wgid / nig, fm = gid * WGM, gsz = (nM - fm) < WGM ? (nM - fm) : WGM;
        u.pm = fm + ((wgid % nig) % gsz); u.pn = (wgid % nig) / gsz;
        u.br = pair ? (i & 1) : 0; u.ka = u.br * 512; u.kb = u.br * (1024 * 512);
        return true;
    }
    __device__ __forceinline__ void a_ready(const Unit&) const {}
    __device__ __forceinline__ void done(const Unit&) const {}
};

__device__ __forceinline__ unsigned cvt_pk_bf16(float lo, float hi) { unsigned r; asm volatile("v_cvt_pk_bf16_f32 %0, %1, %2" : "=v"(r) : "v"(lo), "v"(hi)); return r; }
__device__ __forceinline__ u32x4 pack8(const f32x4 a, const f32x4 b) { u32x4 w; w.x = cvt_pk_bf16(a[0], a[1]); w.y = cvt_pk_bf16(a[2], a[3]); w.z = cvt_pk_bf16(b[0], b[1]); w.w = cvt_pk_bf16(b[2], b[3]); return w; }
__device__ __forceinline__ void unpack8(const u32x4 w, f32x4& a, f32x4& b) {
    a = (f32x4){__uint_as_float(w.x << 16), __uint_as_float(w.x & 0xffff0000u), __uint_as_float(w.y << 16), __uint_as_float(w.y & 0xffff0000u)};
    b = (f32x4){__uint_as_float(w.z << 16), __uint_as_float(w.z & 0xffff0000u), __uint_as_float(w.w << 16), __uint_as_float(w.w & 0xffff0000u)};
}

struct Epi1 {
    static constexpr bool PERM = true, AFTER_DRAIN = false;
    bf16_t *QQ, *KK, *VV, *GT; const float *gq, *gk;
    __device__ __forceinline__ void operator()(const f32x4 (&acc)[2][2][4][2], const Unit& u, int wr, int wc, int fr, int fq) const {
        const int row0 = u.pm * BM + wr * 64 + fr;
        if (u.pn >= 12) {
            const int col0 = (u.pn - 12) * 256 + wc * 32 + 8 * fq;
#pragma unroll
            for (int ai = 0; ai < 2; ++ai)
#pragma unroll
                for (int m = 0; m < 4; ++m) { unsigned char* rowp = (unsigned char*)GT + (size_t)(row0 + ai * HALF + m * 16) * 2048 + col0;
#pragma unroll
                    for (int bj = 0; bj < 2; ++bj) { const f32x4 a0 = acc[ai][bj][m][0], a1 = acc[ai][bj][m][1];
                        u32x2 w; unsigned t_ = __builtin_amdgcn_cvt_pk_u8_f32(rintf(255.0f * sigmoidf_(a0[0])), 0, 0u); t_ = __builtin_amdgcn_cvt_pk_u8_f32(rintf(255.0f * sigmoidf_(a0[1])), 1, t_); t_ = __builtin_amdgcn_cvt_pk_u8_f32(rintf(255.0f * sigmoidf_(a0[2])), 2, t_); w.x = __builtin_amdgcn_cvt_pk_u8_f32(rintf(255.0f * sigmoidf_(a0[3])), 3, t_);
                        t_ = __builtin_amdgcn_cvt_pk_u8_f32(rintf(255.0f * sigmoidf_(a1[0])), 0, 0u); t_ = __builtin_amdgcn_cvt_pk_u8_f32(rintf(255.0f * sigmoidf_(a1[1])), 1, t_); t_ = __builtin_amdgcn_cvt_pk_u8_f32(rintf(255.0f * sigmoidf_(a1[2])), 2, t_); w.y = __builtin_amdgcn_cvt_pk_u8_f32(rintf(255.0f * sigmoidf_(a1[3])), 3, t_);
                        *(u32x2*)(rowp + bj * HALF) = w; } }
        } else {
            const int kind = u.pn >> 1, head = (u.pn & 1) * 4 + wc, k3 = kind % 3;
            bf16_t* base = (k3 == 0 ? QQ : (k3 == 1 ? KK : VV)) + (kind >= 3 ? 512 : 0) + head * 64 + 8 * fq;
            const bool nrm = kind < 2; const float qs = (k3 == 0) ? C2 : 1.0f;
            f32x4 gn[2][2];
#pragma unroll
            for (int bj = 0; bj < 2; ++bj)
#pragma unroll
                for (int n = 0; n < 2; ++n) gn[bj][n] = nrm ? *(const f32x4*)((kind == 0 ? gq : gk) + bj * 32 + 8 * fq + 4 * n) : (f32x4){1.f, 1.f, 1.f, 1.f};
#pragma unroll
            for (int ai = 0; ai < 2; ++ai)
#pragma unroll
                for (int m = 0; m < 4; ++m) {
                    float r = qs;
                    if (nrm) { float ss = 0.f;
#pragma unroll
                        for (int bj = 0; bj < 2; ++bj)
#pragma unroll
                            for (int n = 0; n < 2; ++n) { const f32x4 x = acc[ai][bj][m][n]; ss += (x[0] * x[0] + x[1] * x[1]) + (x[2] * x[2] + x[3] * x[3]); }
                        ss = xsum16(ss, ss); ss = xsum32(ss, ss);
                        r = qs * __builtin_amdgcn_rsqf(ss * (1.0f / 64.0f) + EPS); }
                    bf16_t* rowp = base + (size_t)(row0 + ai * HALF + m * 16) * DM;
#pragma unroll
                    for (int bj = 0; bj < 2; ++bj) *(u32x4*)(rowp + bj * 32) = pack8(acc[ai][bj][m][0] * r * gn[bj][0], acc[ai][bj][m][1] * r * gn[bj][1]);
                }
        }
    }
};
struct EpiGate {
    static constexpr bool PERM = true, AFTER_DRAIN = false;
    const bf16_t* GT; bf16_t* MG;
    __device__ __forceinline__ void operator()(const f32x4 (&acc)[2][2][4][2], const Unit& u, int wr, int wc, int fr, int fq) const {
        const int row0 = u.pm * BM + wr * 64 + fr, col0 = u.pn * BM + wc * 32 + 8 * fq;
#pragma unroll
        for (int ai = 0; ai < 2; ++ai)
#pragma unroll
            for (int m = 0; m < 4; ++m) { const size_t row = (size_t)(row0 + ai * HALF + m * 16);
#pragma unroll
                for (int bj = 0; bj < 2; ++bj) { const int c = col0 + bj * HALF;
                    f32x4 g0, g1; unpack8(*(const u32x4*)(GT + row * 2048 + u.br * 1024 + c), g0, g1);
                    f32x4 v0 = g0 * acc[ai][bj][m][0], v1 = g1 * acc[ai][bj][m][1];
                    if (u.br) { f32x4 o0, o1; unpack8(*(const u32x4*)(MG + row * DM + c), o0, o1); v0 += o0; v1 += o1; }
                    *(u32x4*)(MG + row * DM + c) = pack8(v0, v1); } }
    }
};
struct EpiMerge {
    static constexpr bool PERM = true, AFTER_DRAIN = false, MIDHOOK = true;
    const unsigned char* GT; bf16_t* MG;
    static __device__ __forceinline__ void unpackb(const u32x2 w, f32x4& a, f32x4& b) {
        a = (f32x4){(float)(w.x & 255u), (float)((w.x >> 8) & 255u), (float)((w.x >> 16) & 255u), (float)(w.x >> 24)};
        b = (f32x4){(float)(w.y & 255u), (float)((w.y >> 8) & 255u), (float)((w.y >> 16) & 255u), (float)(w.y >> 24)}; }
    static constexpr float TINY = 255.0f * 9.094947e-13f;
    __device__ __forceinline__ void mid(f32x4 (&acc)[2][2][4][2], const Unit& u, int wr, int wc, int fr_, int fq_) const {
        int fr = fr_, fq = fq_; asm volatile("" : "+v"(fr), "+v"(fq));
        const int row0 = u.pm * BM + wr * 64 + fr, col0 = u.pn * BM + wc * 32 + 8 * fq;
#pragma unroll
        for (int ai = 0; ai < 2; ++ai) {
            u32x2 ga[4][2], gb[4][2];
#pragma unroll
            for (int m = 0; m < 4; ++m) { const size_t row = (size_t)(row0 + ai * HALF + m * 16);
#pragma unroll
                for (int bj = 0; bj < 2; ++bj) { const int c = col0 + bj * HALF; ga[m][bj] = *(const u32x2*)(GT + row * 2048 + c); gb[m][bj] = *(const u32x2*)(GT + row * 2048 + 1024 + c); } }
#pragma unroll
            for (int m = 0; m < 4; ++m) {
#pragma unroll
                for (int bj = 0; bj < 2; ++bj) { f32x4 a0, a1, b0, b1; unpackb(ga[m][bj], a0, a1); unpackb(gb[m][bj], b0, b1);
#pragma unroll
                    for (int e = 0; e < 4; ++e) { acc[ai][bj][m][0][e] *= a0[e] * __builtin_amdgcn_rcpf(fmaxf(b0[e], TINY)); acc[ai][bj][m][1][e] *= a1[e] * __builtin_amdgcn_rcpf(fmaxf(b1[e], TINY)); } } }
            asm volatile("" ::: "memory"); __builtin_amdgcn_sched_barrier(0); }
    }
    __device__ __forceinline__ void operator()(const f32x4 (&acc)[2][2][4][2], const Unit& u, int wr, int wc, int fr, int fq) const {
        const int row0 = u.pm * BM + wr * 64 + fr, col0 = u.pn * BM + wc * 32 + 8 * fq;
#pragma unroll
        for (int ai = 0; ai < 2; ++ai) {
            u32x2 gb[4][2];
#pragma unroll
            for (int m = 0; m < 4; ++m)
#pragma unroll
                for (int bj = 0; bj < 2; ++bj) gb[m][bj] = *(const u32x2*)(GT + (size_t)(row0 + ai * HALF + m * 16) * 2048 + 1024 + col0 + bj * HALF);
#pragma unroll
            for (int m = 0; m < 4; ++m) { const size_t row = (size_t)(row0 + ai * HALF + m * 16);
#pragma unroll
                for (int bj = 0; bj < 2; ++bj) { const int c = col0 + bj * HALF;
                    f32x4 b0, b1; unpackb(gb[m][bj], b0, b1);
                    f32x4 v0, v1;
#pragma unroll
                    for (int e = 0; e < 4; ++e) { v0[e] = acc[ai][bj][m][0][e] * (fmaxf(b0[e], TINY) * (1.0f / 255.0f)); v1[e] = acc[ai][bj][m][1][e] * (fmaxf(b1[e], TINY) * (1.0f / 255.0f)); }
                    *(u32x4*)(MG + row * DM + c) = pack8(v0, v1); } } }
    }
};
struct EpiOut {
    static constexpr bool PERM = true, AFTER_DRAIN = false;
    const float* xin; const bf16_t* xinb; bf16_t* xr1; const float* g1;
    const float* gain; bf16_t* XA; float* SSQ;
    __device__ __forceinline__ void operator()(const f32x4 (&acc)[2][2][4][2], const Unit& u, int wr, int wc, int fr, int fq) const {
        const int row0 = u.pm * BM + wr * 64 + fr, col0 = u.pn * BM + wc * 32 + 8 * fq; const int b = (u.pm * BM) / SEQ;
        f32x4 gv[2][2], gs[2][2];
#pragma unroll
        for (int bj = 0; bj < 2; ++bj)
#pragma unroll
            for (int n = 0; n < 2; ++n) { gv[bj][n] = *(const f32x4*)(g1 + (size_t)b * MODW + col0 + bj * HALF + 4 * n);
                gs[bj][n] = *(const f32x4*)(gain + col0 + bj * HALF + 4 * n) * (*(const f32x4*)(g1 + (size_t)b * MODW + 2 * DM + col0 + bj * HALF + 4 * n) + 1.0f); }
#pragma unroll
        for (int ai = 0; ai < 2; ++ai)
#pragma unroll
          for (int mp = 0; mp < 2; ++mp) {
            f32x4 xr[2][2][2];
#pragma unroll
            for (int mm = 0; mm < 2; ++mm)
#pragma unroll
                for (int bj = 0; bj < 2; ++bj)
#pragma unroll
                    for (int n = 0; n < 2; ++n) { if (xinb == nullptr) xr[mm][bj][n] = *(const f32x4*)(xin + (size_t)(row0 + ai * HALF + (2 * mp + mm) * 16) * DM + col0 + bj * HALF + 4 * n); }
            if (xinb != nullptr) {
#pragma unroll
                for (int mm = 0; mm < 2; ++mm)
#pragma unroll
                    for (int bj = 0; bj < 2; ++bj) unpack8(*(const u32x4*)(xinb + (size_t)(row0 + ai * HALF + (2 * mp + mm) * 16) * DM + col0 + bj * HALF), xr[mm][bj][0], xr[mm][bj][1]); }
#pragma unroll
            for (int mm = 0; mm < 2; ++mm) { const int m = 2 * mp + mm; const size_t row = (size_t)(row0 + ai * HALF + m * 16), off = row * DM + col0; float ss = 0.f;
#pragma unroll
                for (int bj = 0; bj < 2; ++bj) { f32x4 x1[2];
#pragma unroll
                    for (int n = 0; n < 2; ++n) { const f32x4 xv = xr[mm][bj][n]; x1[n] = xv + gv[bj][n] * acc[ai][bj][m][n];
                        ss += (x1[n][0] * x1[n][0] + x1[n][1] * x1[n][1]) + (x1[n][2] * x1[n][2] + x1[n][3] * x1[n][3]); }
                    *(u32x4*)(xr1 + off + bj * HALF) = pack8(x1[0], x1[1]);
                    *(u32x4*)(XA + off + bj * HALF) = pack8(x1[0] * gs[bj][0], x1[1] * gs[bj][1]); }
                ss = xsum16(ss, ss); ss = xsum32(ss, ss);
                if (fq == 0) SSQ[row * 16 + u.pn * 4 + wc] = ss; } }
    }
};
struct EpiQ {
    static constexpr bool PERM = true, AFTER_DRAIN = false;
    bf16_t* O; const float* SSQ; const float* bq; float* RT;
    __device__ __forceinline__ void operator()(const f32x4 (&acc)[2][2][4][2], const Unit& u, int wr, int wc, int fr, int fq) const {
        const int row0 = u.pm * BM + wr * 64 + fr, col0 = u.pn * BM + wc * 32 + 8 * fq; const int b = (u.pm * BM) / SEQ;
        f32x4 bv[2][2];
#pragma unroll
        for (int bj = 0; bj < 2; ++bj)
#pragma unroll
            for (int n = 0; n < 2; ++n) bv[bj][n] = *(const f32x4*)(bq + (size_t)b * DM + col0 + bj * HALF + 4 * n);
        float rr[2][4];
#pragma unroll
        for (int ai = 0; ai < 2; ++ai)
#pragma unroll
            for (int m = 0; m < 4; ++m) { const size_t row = (size_t)(row0 + ai * HALF + m * 16);
                const f32x4 sq = *(const f32x4*)(SSQ + row * 16 + 4 * fq);
                float st = (sq[0] + sq[1]) + (sq[2] + sq[3]); st = xsum16(st, st); st = xsum32(st, st);
                rr[ai][m] = __builtin_amdgcn_rsqf(st * (1.0f / DM) + EPS); }
#pragma unroll
        for (int ai = 0; ai < 2; ++ai)
#pragma unroll
            for (int m = 0; m < 4; ++m) { const size_t row = (size_t)(row0 + ai * HALF + m * 16); const float r = rr[ai][m];
                bf16_t* rowp = O + row * DM + col0;
                if (u.pn == 0 && wc == 0 && fq == 0) RT[row] = r;
#pragma unroll
                for (int bj = 0; bj < 2; ++bj) *(u32x4*)(rowp + bj * HALF) = pack8(acc[ai][bj][m][0] * r + bv[bj][0], acc[ai][bj][m][1] * r + bv[bj][1]); }
    }
};
struct EpiBf {
    static constexpr bool PERM = true, AFTER_DRAIN = false;
    bf16_t* O; int ldc;
    __device__ __forceinline__ void operator()(const f32x4 (&acc)[2][2][4][2], const Unit& u, int wr, int wc, int fr, int fq) const {
        const int row0 = u.pm * BM + wr * 64 + fr, col0 = u.pn * BM + wc * 32 + 8 * fq;
#pragma unroll
        for (int ai = 0; ai < 2; ++ai)
#pragma unroll
            for (int m = 0; m < 4; ++m) { bf16_t* rowp = O + (size_t)(row0 + ai * HALF + m * 16) * ldc + col0;
#pragma unroll
                for (int bj = 0; bj < 2; ++bj) *(u32x4*)(rowp + bj * HALF) = pack8(acc[ai][bj][m][0], acc[ai][bj][m][1]); }
    }
};

template <class E_, class = void> struct has_midhook { static constexpr bool value = false; };
template <class E_> struct has_midhook<E_, decltype((void)E_::MIDHOOK)> { static constexpr bool value = true; };
template <class Epi, class Sched, bool ALIGN_EPI = false, bool SP2 = false>
__device__ __forceinline__ void gemm_phase(PG8_LAS unsigned char* lds, const Gemm g, const Sched& S, const Epi& E) {
    int tid_ = threadIdx.x; asm volatile("" : "+v"(tid_));
    const int tid = tid_, wid = __builtin_amdgcn_readfirstlane(tid >> 6), lane = tid & 63, wr = wid >> 2, wc = wid & 3, fr = lane & 15, fq = lane >> 4;
    const int K = g.K, nt = K / BK;
    unsigned voffA[2], voffB[2];
#pragma unroll
    for (int i = 0; i < 2; ++i) { int R, C; stage_rc(tid * 16 + i * 8192, R, C); const int Rb = Epi::PERM ? ((R & ~31) + perm32(R & 31)) : R;
        voffA[i] = (unsigned)(R * g.lda + C) * 2u; voffB[i] = (unsigned)(Rb * g.ldb + C) * 2u; }
    const size_t kstep = (size_t)(BK * 2);
    const size_t hsA = (size_t)HALF * g.lda * 2, hsB = (size_t)HALF * g.ldb * 2;
    const size_t tsA = 2 * hsA, tsB = 2 * hsB;
    const unsigned ldsw = (unsigned)wid * 1024u;
    const int aoff = lds_byte(wr * 64 + fr, fq * 8), boff = lds_byte(wc * 32 + fr, fq * 8);
#define PG8_SA(b, h) (((b) * 2 + (h)) * HTB)
#define PG8_SB(b, h) ((4 + (b) * 2 + (h)) * HTB)
#define PG8_STAGE(bufoff, gbase, voff) do { _Pragma("unroll") for (int _i = 0; _i < 2; ++_i) \
        __builtin_amdgcn_global_load_lds((const unsigned*)((const char*)(gbase) + (voff)[_i]), (PG8_LAS unsigned*)(lds + (bufoff) + ldsw + _i * 8192), 16, 0, 0); } while (0)
#define PG8_LDA(dst, b, h) do { _Pragma("unroll") for (int m = 0; m < 4; ++m) _Pragma("unroll") for (int k = 0; k < 2; ++k) dst[m][k] = *(const PG8_LAS bf16x8*)(lds + PG8_SA(b, h) + aoff + m * 2048 + k * 1024); } while (0)
#define PG8_LDB(dst, b, h) do { _Pragma("unroll") for (int n = 0; n < 2; ++n) _Pragma("unroll") for (int k = 0; k < 2; ++k) dst[n][k] = *(const PG8_LAS bf16x8*)(lds + PG8_SB(b, h) + boff + n * 2048 + k * 1024); } while (0)
#define PG8_MMA(ai, bj, At, Bt) do { __builtin_amdgcn_s_setprio(1); _Pragma("unroll") for (int m = 0; m < 4; ++m) _Pragma("unroll") for (int n = 0; n < 2; ++n) _Pragma("unroll") for (int k = 0; k < 2; ++k) \
        acc[ai][bj][m][n] = __builtin_amdgcn_mfma_f32_16x16x32_bf16(Bt[n][k], At[m][k], acc[ai][bj][m][n], 0, 0, 0); __builtin_amdgcn_s_setprio(0); } while (0)
#define PG8_WAIT_V(n) asm volatile("s_waitcnt vmcnt(" #n ")" ::: "memory")
#define PG8_WAIT_L(n) asm volatile("s_waitcnt lgkmcnt(" #n ")" ::: "memory")
#define PG8_BAR __builtin_amdgcn_s_barrier()
#define PG8_SCHED __builtin_amdgcn_sched_barrier(0)
    Unit cur, nxt; int ui = 0;
    if (!S.next(0, cur)) return;
    f32x4 acc[2][2][4][2];
#pragma unroll
    for (int a = 0; a < 2; ++a)
#pragma unroll
        for (int b = 0; b < 2; ++b)
#pragma unroll
            for (int m = 0; m < 4; ++m)
#pragma unroll
                for (int n = 0; n < 2; ++n) acc[a][b][m][n] = (f32x4){0.f, 0.f, 0.f, 0.f};
    bf16x8 At[4][2], B0[2][2], B1[2][2];
    const char* cA = (const char*)g.A + (size_t)cur.pm * tsA + (size_t)cur.ka * 2; const char* cB = (const char*)g.Bt + (size_t)cur.pn * tsB + (size_t)cur.kb * 2;
    S.a_ready(cur);
    if constexpr (SP2) {
        PG8_STAGE(PG8_SB(0, 0), cB, voffB); PG8_STAGE(PG8_SB(0, 1), cB + hsB, voffB); PG8_STAGE(PG8_SA(0, 0), cA, voffA); PG8_STAGE(PG8_SA(0, 1), cA + hsA, voffA);
        if (wr == 1) PG8_BAR;
        PG8_WAIT_V(2); PG8_BAR;
        PG8_STAGE(PG8_SB(1, 0), cB + kstep, voffB); PG8_STAGE(PG8_SA(1, 0), cA + kstep, voffA); PG8_STAGE(PG8_SB(1, 1), cB + hsB + kstep, voffB);
        PG8_WAIT_V(6); PG8_BAR;
    } else {
        PG8_STAGE(PG8_SB(0, 0), cB, voffB); PG8_STAGE(PG8_SA(0, 0), cA, voffA); PG8_STAGE(PG8_SB(0, 1), cB + hsB, voffB); PG8_STAGE(PG8_SA(0, 1), cA + hsA, voffA);
        if (wr == 1) PG8_BAR;
        PG8_WAIT_V(4); PG8_BAR;
        PG8_STAGE(PG8_SB(1, 0), cB + kstep, voffB); PG8_STAGE(PG8_SA(1, 0), cA + kstep, voffA); PG8_STAGE(PG8_SB(1, 1), cB + hsB + kstep, voffB);
        PG8_WAIT_V(6); PG8_BAR;
    }
    for (;;) {
        const bool has_next = S.next(ui + 1, nxt);
        const char* nA = has_next ? (const char*)g.A + (size_t)nxt.pm * tsA + (size_t)nxt.ka * 2 : cA; const char* nB = has_next ? (const char*)g.Bt + (size_t)nxt.pn * tsB + (size_t)nxt.kb * 2 : cB;
        for (int t = 0; t < nt; t += 2) {
            if constexpr (has_midhook<Epi>::value) { if (t == nt / 2) E.mid(acc, cur, wr, wc, fr, fq); }
            const bool last = (t == nt - 2);
            const char* a1 = cA + (size_t)(t + 1) * kstep;
            const char* a2 = last ? nA : cA + (size_t)(t + 2) * kstep; const char* b2 = last ? nB : cB + (size_t)(t + 2) * kstep;
            const char* a3 = a2 + kstep; const char* b3 = b2 + kstep;
            if (last && has_next) S.a_ready(nxt);
            if constexpr (SP2) {
            PG8_LDB(B0, 0, 0); PG8_LDB(B1, 0, 1); PG8_SCHED; PG8_LDA(At, 0, 0); PG8_STAGE(PG8_SA(1, 1), a1 + hsA, voffA);
            PG8_WAIT_V(8); PG8_WAIT_L(0); PG8_BAR; PG8_MMA(0, 0, At, B0); PG8_MMA(0, 1, At, B1); PG8_BAR; PG8_SCHED;
            PG8_LDA(At, 0, 1); PG8_STAGE(PG8_SB(0, 0), b2, voffB); PG8_STAGE(PG8_SB(0, 1), b2 + hsB, voffB); PG8_STAGE(PG8_SA(0, 0), a2, voffA);
            PG8_WAIT_V(8); PG8_WAIT_L(0); PG8_BAR; PG8_MMA(1, 0, At, B0); PG8_MMA(1, 1, At, B1); PG8_BAR; PG8_SCHED;
            PG8_LDB(B0, 1, 0); PG8_LDB(B1, 1, 1); PG8_SCHED; PG8_LDA(At, 1, 0); PG8_STAGE(PG8_SA(0, 1), a2 + hsA, voffA);
            PG8_WAIT_V(8); PG8_WAIT_L(0); PG8_BAR; PG8_MMA(0, 0, At, B0); PG8_MMA(0, 1, At, B1); PG8_BAR; PG8_SCHED;
            PG8_LDA(At, 1, 1); PG8_STAGE(PG8_SB(1, 0), b3, voffB); PG8_STAGE(PG8_SB(1, 1), b3 + hsB, voffB); PG8_STAGE(PG8_SA(1, 0), a3, voffA);
            PG8_WAIT_V(8); PG8_WAIT_L(0); PG8_BAR; PG8_MMA(1, 0, At, B0); PG8_MMA(1, 1, At, B1); PG8_BAR; PG8_SCHED;
            } else {
            PG8_LDB(B0, 0, 0); PG8_SCHED; PG8_LDA(At, 0, 0); PG8_STAGE(PG8_SA(1, 1), a1 + hsA, voffA);
            PG8_WAIT_L(8); PG8_BAR; PG8_WAIT_L(0); PG8_MMA(0, 0, At, B0); PG8_BAR; PG8_SCHED;
            PG8_LDB(B1, 0, 1); PG8_STAGE(PG8_SB(0, 0), b2, voffB);
            PG8_BAR; PG8_WAIT_L(0); PG8_MMA(0, 1, At, B1); PG8_BAR;
            PG8_LDA(At, 0, 1); PG8_STAGE(PG8_SA(0, 0), a2, voffA);
            PG8_BAR; PG8_WAIT_L(0); PG8_MMA(1, 0, At, B0); PG8_BAR; PG8_SCHED;
            PG8_STAGE(PG8_SB(0, 1), b2 + hsB, voffB);
            PG8_WAIT_V(6); PG8_BAR; PG8_MMA(1, 1, At, B1); PG8_BAR;
            PG8_LDB(B0, 1, 0); PG8_SCHED; PG8_LDA(At, 1, 0); PG8_STAGE(PG8_SA(0, 1), a2 + hsA, voffA);
            PG8_WAIT_L(8); PG8_BAR; PG8_WAIT_L(0); PG8_MMA(0, 0, At, B0); PG8_BAR; PG8_SCHED;
            PG8_LDB(B1, 1, 1); PG8_STAGE(PG8_SB(1, 0), b3, voffB);
            PG8_BAR; PG8_WAIT_L(0); PG8_MMA(0, 1, At, B1); PG8_BAR;
            PG8_LDA(At, 1, 1); PG8_STAGE(PG8_SA(1, 0), a3, voffA);
            PG8_BAR; PG8_WAIT_L(0); PG8_MMA(1, 0, At, B0); PG8_BAR; PG8_SCHED;
            PG8_STAGE(PG8_SB(1, 1), b3 + hsB, voffB);
            PG8_WAIT_V(6); PG8_BAR; PG8_MMA(1, 1, At, B1); PG8_BAR;
            }
        }
        if constexpr (ALIGN_EPI) { if (wr == 0) PG8_BAR; }
        if constexpr (!Epi::AFTER_DRAIN) { E(acc, cur, wr, wc, fr, fq); S.done(cur); }
        if (!has_next) break;
#pragma unroll
        for (int a = 0; a < 2; ++a)
#pragma unroll
            for (int b = 0; b < 2; ++b)
#pragma unroll
                for (int m = 0; m < 4; ++m)
#pragma unroll
                    for (int n = 0; n < 2; ++n) acc[a][b][m][n] = (f32x4){0.f, 0.f, 0.f, 0.f};
        cur = nxt; cA = nA; cB = nB; ++ui;
        if constexpr (ALIGN_EPI) { if (wr == 1) PG8_BAR; }
    }
    PG8_WAIT_V(0);
    if constexpr (!ALIGN_EPI) { if (wr == 0) PG8_BAR; }
    PG8_BAR;
    if constexpr (Epi::AFTER_DRAIN) { E.fused(acc, cur, wr, wc, fr, fq, lds, wid, lane); S.done(cur); }
#undef PG8_SA
#undef PG8_SB
#undef PG8_STAGE
#undef PG8_LDA
#undef PG8_LDB
#undef PG8_MMA
#undef PG8_WAIT_V
#undef PG8_WAIT_L
#undef PG8_BAR
#undef PG8_SCHED
}
}

__device__ __forceinline__ int win_logical_col(int n) {
    const int pn = n >> 8, tc = n & 255;
    if (pn >= 12) return 3080 + (pn - 12) * 256 + tc;
    const int kind = pn >> 1, bj = tc >> 7, wc = (tc >> 5) & 3, i = tc & 31;
    const int base = (kind < 3) ? kind * 512 : 1544 + (kind - 3) * 512;
    return base + ((pn & 1) * 4 + wc) * 64 + bj * 32 + i;
}
__device__ __forceinline__ void transpose_item(const float* W, int ldw, int src_c0, int k0, bf16_t* WT, int K, int dst_row0, float* scr, int lane) {
#pragma unroll 8
    for (int i = 0; i < 32; ++i) { const int kk = 2 * i + (lane >> 5); scr[kk * 33 + (lane & 31)] = W[(size_t)(k0 + kk) * ldw + src_c0 + (lane & 31)]; }
    __builtin_amdgcn_s_waitcnt(0xc07f); asm volatile("" ::: "memory");
    const int c = lane & 7;
#pragma unroll
    for (int j = 0; j < 4; ++j) { const int n = (lane >> 3) + 8 * j; const float* s = scr + (8 * c) * 33 + n;
        u32x4 o; o.x = pk2(s[0 * 33], s[1 * 33]); o.y = pk2(s[2 * 33], s[3 * 33]); o.z = pk2(s[4 * 33], s[5 * 33]); o.w = pk2(s[6 * 33], s[7 * 33]);
        *(u32x4*)(WT + (size_t)(dst_row0 + n) * K + k0 + 8 * c) = o; }
    __builtin_amdgcn_s_waitcnt(0xc07f); asm volatile("" ::: "memory");
}
__device__ __forceinline__ void ph_weights(const Prm& p, const Ctx& C, unsigned char* lds) {
    float* scr = (float*)(lds + C.wave * 16384);
    bf16_t* WIN = (bf16_t*)(p.ws + WS_WIN); bf16_t* WBR = (bf16_t*)(p.ws + WS_WBR); bf16_t* WOUT = (bf16_t*)(p.ws + WS_WOUT); bf16_t* WQT = (bf16_t*)(p.ws + WS_WQ);
    constexpr int I_IN = 16 * 160, I_BR = 8 * 32, I_SQ = 16 * 32;
    constexpr int NITEMS = 2 * I_IN + 4 * I_BR + 2 * I_SQ + 2 * I_SQ;
    for (int it = C.gw; it < NITEMS; it += C.ngw) {
        int r = it;
        if (r < 2 * I_IN) { const int l = r / I_IN, q = r % I_IN, kb = q / 160, nb = q % 160;
            transpose_item(p.w_in + (size_t)l * DM * INW, INW, win_logical_col(32 * nb), 64 * kb, WIN + (size_t)l * 5120 * DM, DM, 32 * nb, scr, C.lane); continue; }
        r -= 2 * I_IN;
        if (r < 4 * I_BR) { const int lg = r / I_BR, q = r % I_BR, kb = q / 32, nb = q % 32;
            transpose_item(p.w_branch + (size_t)lg * 512 * DM, DM, 32 * nb, 64 * kb, WBR + (size_t)(lg >> 1) * DM * DM + (lg & 1) * 512, DM, 32 * nb, scr, C.lane); continue; }
        r -= 4 * I_BR;
        if (r < 2 * I_SQ) { const int l = r / I_SQ, q = r % I_SQ, kb = q / 32, nb = q % 32;
            transpose_item(p.w_out + (size_t)l * DM * DM, DM, 32 * nb, 64 * kb, WOUT + (size_t)l * DM * DM, DM, 32 * nb, scr, C.lane); continue; }
        r -= 2 * I_SQ;
        { const int l = r / I_SQ, q = r % I_SQ, kb = q / 32, nb = q % 32;
            transpose_item(p.wq + (size_t)l * DM * DM, DM, 32 * nb, 64 * kb, WQT + (size_t)l * DM * DM, DM, 32 * nb, scr, C.lane); }
    }
}
#define LDSP(p) ((PG8_LAS unsigned char*)(p))
__device__ __forceinline__ void ph_gemm1(const Prm& p, int l, unsigned char* lds) {
    pg8::Gemm g{(const bf16_t*)(p.ws + WS_HB), (const bf16_t*)(p.ws + WS_WIN) + (size_t)l * 5120 * DM, DM, DM, DM};
    pg8::Order S; S.init(NT, 5120, gridDim.x, blockIdx.x, 0);
    pg8::Epi1 E{(bf16_t*)(p.ws + WS_QQ), (bf16_t*)(p.ws + WS_KK), (bf16_t*)(p.ws + WS_VV), (bf16_t*)(p.ws + WS_GT), p.gq + l * HD, p.gk + l * HD};
    pg8::gemm_phase<pg8::Epi1, pg8::Order, true, true>(LDSP(lds), g, S, E);
}
__device__ __forceinline__ void ph_merge(const Prm& p, int l, unsigned char* lds) {
    pg8::Gemm g{(const bf16_t*)(p.ws + WS_QQ), (const bf16_t*)(p.ws + WS_WBR) + (size_t)l * DM * DM, DM, DM, DM};
    pg8::Order S; S.init(NT, DM, gridDim.x, blockIdx.x, 0);
    pg8::EpiMerge E{(const unsigned char*)(p.ws + WS_GT), (bf16_t*)(p.ws + WS_HB)};
    pg8::gemm_phase<pg8::EpiMerge, pg8::Order, true, true>(LDSP(lds), g, S, E);
}
__device__ __forceinline__ void ph_out(const Prm& p, int l, unsigned char* lds) {
    pg8::Gemm g{(const bf16_t*)(p.ws + WS_HB), (const bf16_t*)(p.ws + WS_WOUT) + (size_t)l * DM * DM, DM, DM, DM};
    pg8::Order S; S.init(NT, DM, gridDim.x, blockIdx.x, 0);
    pg8::EpiOut E{p.x, l == 0 ? (const bf16_t*)nullptr : (const bf16_t*)p.out, (bf16_t*)(p.ws + WS_XR1), (const float*)(p.ws + WS_MOD) + (size_t)l * NB * MODW + 2 * DM, p.ffn_norm + l * DM, (bf16_t*)(p.ws + WS_QQ), (float*)(p.ws + WS_SSQ)};
    pg8::gemm_phase<pg8::EpiOut, pg8::Order, true, true>(LDSP(lds), g, S, E);
}
__device__ __forceinline__ void ph_q(const Prm& p, int l, unsigned char* lds) {
    pg8::Gemm g{(const bf16_t*)(p.ws + WS_QQ), (const bf16_t*)(p.ws + WS_WQ) + (size_t)l * DM * DM, DM, DM, DM};
    pg8::Order S; S.init(NT, DM, gridDim.x, blockIdx.x, 0);
    pg8::EpiQ E{(bf16_t*)(p.ws + WS_KK), (const float*)(p.ws + WS_SSQ), (const float*)(p.ws + WS_BQ) + (size_t)l * NB * DM, (float*)(p.ws + WS_FC)};
    pg8::gemm_phase<pg8::EpiQ, pg8::Order, true, true>(LDSP(lds), g, S, E);
}

namespace attn_body {
using bf16=__hip_bfloat16;
using bf16x8=__attribute__((ext_vector_type(8)))short;
using s16x4=__attribute__((ext_vector_type(4)))short;
using f32x16=__attribute__((ext_vector_type(16)))float;
using u32x4=__attribute__((ext_vector_type(4)))unsigned;
using f32x4_t=__attribute__((ext_vector_type(4)))float;
constexpr int BATCH=8,NHEAD=8,SEQ=4096,D=64,DM=1024;
constexpr int NW=8,QBLK=32,QB=QBLK*NW,KVBLK=64,NQB=SEQ/QB;
constexpr int ATTN_PITCH=DM, ATTN_UNIT_ROWS=QB;
__device__ __forceinline__ int crow(int r,int hi){return (r&3)+8*(r>>2)+4*hi;}
#define SBAR() __builtin_amdgcn_sched_barrier(0)
__device__ __forceinline__ void cmask(f32x16&p0,f32x16&p1,int jb,int qrel,int hi){
  const float NEG=-INFINITY; int d=qrel-(64*jb+4*hi); asm volatile("":"+v"(d));
  #pragma unroll
  for(int r=0;r<16;++r){const int c=(r&3)+8*(r>>2); if(c>d)p0[r]=NEG; if(c+32>d)p1[r]=NEG;}
}

constexpr int NSLOT=3, SLOTB=8192;
constexpr int LDS_K=0, LDS_V=NSLOT*SLOTB, LDS_WS=2*NSLOT*SLOTB, LDS_OST=LDS_WS+NW*64*4, LDS_BYTES=LDS_OST+NW*4096;
constexpr float C2=0.125f*1.4426950408889634f;
__device__ __forceinline__ void glds16(const void*gsrc,unsigned lds_dst){unsigned keep;
  asm volatile("s_mov_b32 %0, m0\n\ts_mov_b32 m0, %2\n\ts_nop 0\n\tglobal_load_lds_dwordx4 %1, off\n\ts_mov_b32 m0, %0":"=&s"(keep):"v"(gsrc),"s"(lds_dst):"memory");}
__device__ __forceinline__ float max3f(float a,float b,float c){float r;asm("v_max3_f32 %0, %1, %2, %3":"=v"(r):"v"(a),"v"(b),"v"(c));return r;}
__device__ __forceinline__ float max2f(float a,float b){float r;asm("v_max_f32_e32 %0, %1, %2":"=v"(r):"v"(a),"v"(b));return r;}
__device__ __forceinline__ float fadd_s(float a,float b){float r;asm("v_add_f32_e32 %0, %1, %2":"=v"(r):"v"(a),"v"(b));return r;}
__device__ __forceinline__ float fsub_s(float a,float b){float r;asm("v_sub_f32_e32 %0, %1, %2":"=v"(r):"v"(a),"v"(b));return r;}
typedef float f32x2_t __attribute__((ext_vector_type(2))); typedef __bf16 bf16x2_t __attribute__((ext_vector_type(2)));
__device__ __forceinline__ unsigned cvtpk_s(float lo,float hi){f32x2_t v={lo,hi};bf16x2_t b=__builtin_convertvector(v,bf16x2_t);return __builtin_bit_cast(unsigned,b);}
#define WAIT_BAR(N) asm volatile("s_waitcnt vmcnt(" #N ") lgkmcnt(0)\n\ts_barrier":::"memory")

__device__ __forceinline__ void qkt(f32x16&p0,f32x16&p1,const char*Kslot,const bf16x8*qr,const f32x16&negm,int r32,int hi){
  const char*kb=Kslot+hi*1024+r32*16;
  #pragma unroll
  for(int d0=0;d0<4;++d0){
    const bf16x8 b0=*reinterpret_cast<const bf16x8*>(kb+d0*2048);
    const bf16x8 b1=*reinterpret_cast<const bf16x8*>(kb+d0*2048+512);
    if(d0==0){p0=__builtin_amdgcn_mfma_f32_32x32x16_bf16(b0,qr[0],negm,0,0,0);p1=__builtin_amdgcn_mfma_f32_32x32x16_bf16(b1,qr[0],negm,0,0,0);}
    else{p0=__builtin_amdgcn_mfma_f32_32x32x16_bf16(b0,qr[d0],p0,0,0,0);p1=__builtin_amdgcn_mfma_f32_32x32x16_bf16(b1,qr[d0],p1,0,0,0);}}
}
typedef __attribute__((address_space(3))) const char* lds_cptr;
typedef short v4i16_t __attribute__((ext_vector_type(4)));
__device__ __forceinline__ void kload8(bf16x8*kf,lds_cptr kp){
  kf[0]=*(const __attribute__((address_space(3))) bf16x8*)(kp);      kf[1]=*(const __attribute__((address_space(3))) bf16x8*)(kp+512);
  kf[2]=*(const __attribute__((address_space(3))) bf16x8*)(kp+2048); kf[3]=*(const __attribute__((address_space(3))) bf16x8*)(kp+2560);
  kf[4]=*(const __attribute__((address_space(3))) bf16x8*)(kp+4096); kf[5]=*(const __attribute__((address_space(3))) bf16x8*)(kp+4608);
  kf[6]=*(const __attribute__((address_space(3))) bf16x8*)(kp+6144); kf[7]=*(const __attribute__((address_space(3))) bf16x8*)(kp+6656);
}
__device__ __forceinline__ void kload2(bf16x8*kf,lds_cptr kp,int j){ kf[2*j]=*(const __attribute__((address_space(3))) bf16x8*)(kp+j*2048); kf[2*j+1]=*(const __attribute__((address_space(3))) bf16x8*)(kp+j*2048+512); }
__device__ __forceinline__ s16x4 vtr(lds_cptr p){ return __builtin_bit_cast(s16x4,__builtin_amdgcn_ds_read_tr16_b64_v4i16((__attribute__((address_space(3))) v4i16_t*)p)); }
__device__ __forceinline__ float rowmax(const f32x16&p0,const f32x16&p1){
  float a=max3f(p0[0],p0[1],p1[0]),b=max3f(p0[2],p0[3],p1[1]);a=max3f(a,p1[2],p1[3]);
  #pragma unroll
  for(int r=4;r<16;r+=4){a=max3f(a,p0[r],p0[r+1]);b=max3f(b,p0[r+2],p0[r+3]);a=max3f(a,p1[r],p1[r+1]);b=max3f(b,p1[r+2],p1[r+3]);}
  const float m=max2f(a,b);
  auto rr=__builtin_amdgcn_permlane32_swap(__float_as_uint(m),__float_as_uint(m),false,false);
  return max2f(__uint_as_float(rr[0]),__uint_as_float(rr[1]));
}
__device__ __forceinline__ void pv(f32x16*o,int vb,bf16x8 pa0,bf16x8 pa1,bf16x8 pa2,bf16x8 pa3){
  #pragma unroll
  for(int d0=0;d0<2;++d0){s16x4 lo[4],hi[4];
    #pragma unroll
    for(int ks=0;ks<4;++ks){
      asm volatile("ds_read_b64_tr_b16 %0,%1 offset:%c2":"=&v"(lo[ks]):"v"(vb),"i"(d0*4096+ks*1024):"memory");
      asm volatile("ds_read_b64_tr_b16 %0,%1 offset:%c2":"=&v"(hi[ks]):"v"(vb),"i"(d0*4096+ks*1024+512):"memory");}
    asm volatile("s_waitcnt lgkmcnt(0)":::"memory");SBAR();
    #define PK(k) (bf16x8){lo[k][0],lo[k][1],lo[k][2],lo[k][3],hi[k][0],hi[k][1],hi[k][2],hi[k][3]}
    o[d0]=__builtin_amdgcn_mfma_f32_32x32x16_bf16(pa0,PK(0),o[d0],0,0,0);
    o[d0]=__builtin_amdgcn_mfma_f32_32x32x16_bf16(pa1,PK(1),o[d0],0,0,0);
    o[d0]=__builtin_amdgcn_mfma_f32_32x32x16_bf16(pa2,PK(2),o[d0],0,0,0);
    o[d0]=__builtin_amdgcn_mfma_f32_32x32x16_bf16(pa3,PK(3),o[d0],0,0,0);
    #undef PK
  }
}

#ifndef ATTN_STORE16
#define ATTN_STORE16(p,v) (*(u32x4*)(p)=(v))
#endif
template<int THRL> __device__ __forceinline__ void attn_unit(int b,int h,int qb,const bf16*Q,const bf16*__restrict__ K,const bf16*__restrict__ V,bf16*O,char*shm,const float*Gl,int j0){
  int tid_=threadIdx.x; asm volatile("":"+v"(tid_));
  const int tid=tid_,lane=tid&63,r32=lane&31,hi=lane>>5; const int wid=__builtin_amdgcn_readfirstlane(tid>>6);
  const long rowbase=(long)b*SEQ; const int q0=qb*QB;
  const bf16*Qw=Q+(rowbase+q0+wid*QBLK)*DM+h*D;
  const bf16*Kh=K+(rowbase+(long)j0*KVBLK)*DM+h*D,*Vh=V+(rowbase+(long)j0*KVBLK)*DM+h*D; const float*Glt=Gl+j0*KVBLK;
  const unsigned lds0=(unsigned)(uintptr_t)shm;
  float*wsf=(float*)(shm+LDS_WS)+wid*64;
  const bf16*ksrc=Kh+(long)lane*DM+wid*8;
  const bf16*vsrc=Vh+(long)(16*(wid&3)+(lane>>2))*DM+(wid>>2)*32+(lane&3)*8;
  const unsigned kdst=lds0+LDS_K+wid*1024, vdst=lds0+LDS_V+wid*1024;
  #define DMA_K(t,slot) glds16(ksrc+(long)(t)*KVBLK*DM,(unsigned)__builtin_amdgcn_readfirstlane(kdst+(slot)))
  #define DMA_V(t,slot) glds16(vsrc+(long)(t)*KVBLK*DM,(unsigned)__builtin_amdgcn_readfirstlane(vdst+(slot)))
  const int vb0=(int)(lds0+LDS_V)+((lane>>4)&1)*32+(lane&3)*8+(4*hi+((lane&15)>>2))*64;
  const char*Kbase=shm+LDS_K; bf16x8 kf[8];
  const lds_cptr shm3=(lds_cptr)shm; const lds_cptr kp0=shm3+LDS_K+hi*1024+r32*16; const lds_cptr vp0=shm3+LDS_V+((lane>>4)&1)*32+(lane&3)*8+(4*hi+((lane&15)>>2))*64;
  const int NT=(q0+QB)/KVBLK-j0;
  DMA_K(0,0);DMA_V(0,0);DMA_K(1,SLOTB);
  bf16x8 qr[4];
  #pragma unroll
  for(int d0=0;d0<4;++d0)qr[d0]=*reinterpret_cast<const bf16x8*>(&Qw[(long)r32*DM+d0*16+hi*8]);
  typedef __attribute__((address_space(3))) bf16x8* qst_ptr; const qst_ptr qst=(qst_ptr)(((__attribute__((address_space(3))) char*)shm)+LDS_OST+wid*4096)+lane;
  #pragma unroll
  for(int d0=0;d0<4;++d0)qst[d0*64]=qr[d0];
  const int qrel=wid*QBLK+r32; const float Gq=Gl[q0+qrel];
  float mhat=0.f,l_reg=0.f;f32x16 o[2];o[0]=f32x16{};o[1]=f32x16{};const f32x16 negm=f32x16{}; float base=Gq;
  #define BIAS(C0,C1,t) do{ const float*gk_=Glt+(t)*64+4*hi; _Pragma("unroll") for(int g_=0;g_<4;++g_){ SBAR(); const f32x4_t a_=*(const f32x4_t*)(gk_+8*g_), b_=*(const f32x4_t*)(gk_+32+8*g_); \
    _Pragma("unroll") for(int e_=0;e_<4;++e_){ C0[4*g_+e_]+=base-a_[e_]; C1[4*g_+e_]+=base-b_[e_]; } } SBAR(); }while(0)
  #define CMASK(P0,P1,t) do{int jb_=(t)-(NT-4); if(jb_>=0)cmask(P0,P1,jb_,qrel,hi);}while(0)
  bool resc=false;
  #define START(P0,P1) do{ const float rm=rowmax(P0,P1); resc=false; \
    { const float dl=rm; mhat=fadd_s(mhat,dl); \
      _Pragma("unroll") for(int r=0;r<16;++r){P0[r]=fsub_s(P0[r],dl);P1[r]=fsub_s(P1[r],dl);} \
      base=Gq-mhat; } \
    _Pragma("unroll") for(int r=0;r<16;++r)P0[r]=__builtin_amdgcn_exp2f(P0[r]); }while(0)
  #define RESC() do{ if(resc){ asm volatile("s_waitcnt lgkmcnt(0)":::"memory"); \
      _Pragma("unroll") for(int d_=0;d_<2;++d_) _Pragma("unroll") for(int r=0;r<16;++r)o[d_][r]*=wsf[crow(r,hi)]; } }while(0)
  f32x16 pA0,pA1,pB0,pB1;
  int sl_prev=0,sl_cur=0,sl_next=SLOTB;
  #define ROT() do{sl_prev=sl_cur;sl_cur=sl_next;sl_next=(sl_next==(NSLOT-1)*SLOTB)?0:sl_next+SLOTB;}while(0)
  DMA_K(2,2*SLOTB);
  WAIT_BAR(3);
  qkt(pA0,pA1,Kbase,qr,negm,r32,hi);BIAS(pA0,pA1,0);asm volatile("s_nop 15\n\ts_nop 7":"+v"(pA0),"+v"(pA1));CMASK(pA0,pA1,0);
  START(pA0,pA1);
  _Pragma("unroll") for(int r=0;r<16;++r)pA1[r]=__builtin_amdgcn_exp2f(pA1[r]);
  WAIT_BAR(0);
  DMA_K(3,0);DMA_V(1,SLOTB);
  ROT();
  kload8(kf,kp0+sl_cur);
  WAIT_BAR(2);
  s16x4 vlo[8],vhi[8]; u32x4 pw0,pw1,pw2,pw3;
  #define PKW(P,B) cvtpk_s(P[B],P[B+1])
  #define PAF(k) __builtin_bit_cast(bf16x8,pw##k)
  #define VFR(i) (bf16x8){vlo[i][0],vlo[i][1],vlo[i][2],vlo[i][3],vhi[i][0],vhi[i][1],vhi[i][2],vhi[i][3]}
  #define PIN(x) asm volatile("":"+v"(x))
  #define MX3(a,b,c) __builtin_fmaxf(__builtin_fmaxf((a),(b)),(c))
  #define GAPA(MF,A0,A1,A2,A3,W0,W1,PW) do{ MF; sacc+=A0; sacc+=A1; sacc+=A2; sacc+=A3; PIN(sacc); W0; W1; PIN(PW); SBAR(); }while(0)
  #define EX(v) __builtin_amdgcn_exp2f(v)
  #define GAPB(MF,X,B) do{ MF; X[B]=EX(X[B]); X[B+1]=EX(X[B+1]); X[B+2]=EX(X[B+2]); X[B+3]=EX(X[B+3]); PIN(X); SBAR(); }while(0)
  #define VRD(i) do{ vlo[i]=vtr(vp_+(((i)>>2)*4096+((i)&3)*1024)); vhi[i]=vtr(vp_+(((i)>>2)*4096+((i)&3)*1024+512)); }while(0)
  #define KRD(G,j) do{ if(G){ kload2(kf,kp0+sl_next,j); SBAR(); } }while(0)
  #define STEP(C0,C1,P0,P1,t,GK,GV,GL) do{ SBAR(); \
    const lds_cptr vp_=vp0+sl_prev; const bf16x8 q0_=qst[0],q1_=qst[64],q2_=qst[128],q3_=qst[192]; \
    VRD(0); SBAR(); float sacc=(P0[0]+P0[1]); \
    GAPA(C0=__builtin_amdgcn_mfma_f32_32x32x16_bf16(kf[0],q0_,negm,0,0,0), P0[2],P0[3],P0[4],P0[5],     pw0[0]=PKW(P0,0), pw0[1]=PKW(P0,2), pw0); \
    VRD(4); SBAR(); GAPA(C1=__builtin_amdgcn_mfma_f32_32x32x16_bf16(kf[1],q0_,negm,0,0,0), P0[6],P0[7],P0[8],P0[9],     pw0[2]=PKW(P0,4), pw0[3]=PKW(P0,6), pw0); \
    VRD(1); SBAR(); GAPA(C0=__builtin_amdgcn_mfma_f32_32x32x16_bf16(kf[2],q1_,C0,0,0,0),   P0[10],P0[11],P0[12],P0[13], pw1[0]=PKW(P0,8), pw1[1]=PKW(P0,10), pw1); \
    VRD(5); SBAR(); GAPA(C1=__builtin_amdgcn_mfma_f32_32x32x16_bf16(kf[3],q1_,C1,0,0,0),   P0[14],P0[15],P1[0],P1[1],   pw1[2]=PKW(P0,12),pw1[3]=PKW(P0,14), pw1); \
    VRD(2); SBAR(); GAPA(C0=__builtin_amdgcn_mfma_f32_32x32x16_bf16(kf[4],q2_,C0,0,0,0),   P1[2],P1[3],P1[4],P1[5],     pw2[0]=PKW(P1,0), pw2[1]=PKW(P1,2), pw2); \
    VRD(6); SBAR(); GAPA(C1=__builtin_amdgcn_mfma_f32_32x32x16_bf16(kf[5],q2_,C1,0,0,0),   P1[6],P1[7],P1[8],P1[9],     pw2[2]=PKW(P1,4), pw2[3]=PKW(P1,6), pw2); \
    VRD(3); SBAR(); GAPA(C0=__builtin_amdgcn_mfma_f32_32x32x16_bf16(kf[6],q3_,C0,0,0,0),   P1[10],P1[11],P1[12],P1[13], pw3[0]=PKW(P1,8), pw3[1]=PKW(P1,10), pw3); \
    VRD(7); SBAR(); GAPA(C1=__builtin_amdgcn_mfma_f32_32x32x16_bf16(kf[7],q3_,C1,0,0,0),   P1[14],P1[15],0.f,0.f,       pw3[2]=PKW(P1,12),pw3[3]=PKW(P1,14), pw3); \
    l_reg+=sacc; \
    if(GK){DMA_K((t)+3,sl_cur);} if(GV){DMA_V((t)+1,sl_next);} \
    BIAS(C0,C1,t); CMASK(C0,C1,t); \
    { float a=MX3(C0[0],C0[1],C1[0]),b=MX3(C0[2],C0[3],C1[1]); a=MX3(a,C1[2],C1[3]); \
      _Pragma("unroll") for(int r=4;r<16;r+=4){a=MX3(a,C0[r],C0[r+1]);b=MX3(b,C0[r+2],C0[r+3]);a=MX3(a,C1[r],C1[r+1]);b=MX3(b,C1[r+2],C1[r+3]);} \
      float rm=__builtin_fmaxf(a,b); { auto rr=__builtin_amdgcn_permlane32_swap(__float_as_uint(rm),__float_as_uint(rm),false,false); rm=__builtin_fmaxf(__uint_as_float(rr[0]),__uint_as_float(rr[1])); } \
      resc=false; \
      if(__builtin_expect(__any(rm>(float)THRL),0)){ const float dl=__builtin_fmaxf(rm,0.f); mhat+=dl; \
        _Pragma("unroll") for(int r=0;r<16;++r){C0[r]-=dl;C1[r]-=dl;} \
        base=Gq-mhat; \
        const float f=__builtin_amdgcn_exp2f(-dl); l_reg*=f; if(hi==0)wsf[r32]=f; resc=true; } } \
    SBAR(); \
    GAPB(o[0]=__builtin_amdgcn_mfma_f32_32x32x16_bf16(PAF(0),VFR(0),o[0],0,0,0), C0,0); \
    GAPB(o[1]=__builtin_amdgcn_mfma_f32_32x32x16_bf16(PAF(0),VFR(4),o[1],0,0,0), C0,4); \
    KRD(GL,0); GAPB(o[0]=__builtin_amdgcn_mfma_f32_32x32x16_bf16(PAF(1),VFR(1),o[0],0,0,0), C0,8); \
    KRD(GL,1); GAPB(o[1]=__builtin_amdgcn_mfma_f32_32x32x16_bf16(PAF(1),VFR(5),o[1],0,0,0), C0,12); \
    KRD(GL,2); GAPB(o[0]=__builtin_amdgcn_mfma_f32_32x32x16_bf16(PAF(2),VFR(2),o[0],0,0,0), C1,0); \
    KRD(GL,3); GAPB(o[1]=__builtin_amdgcn_mfma_f32_32x32x16_bf16(PAF(2),VFR(6),o[1],0,0,0), C1,4); \
    GAPB(o[0]=__builtin_amdgcn_mfma_f32_32x32x16_bf16(PAF(3),VFR(3),o[0],0,0,0), C1,8); \
    GAPB(o[1]=__builtin_amdgcn_mfma_f32_32x32x16_bf16(PAF(3),VFR(7),o[1],0,0,0), C1,12); \
    }while(0)
  int t=1;
  #undef CMASK
  #define CMASK(P0,P1,t) do{}while(0)
  for(;t+5<NT;t+=2){
    STEP(pB0,pB1,pA0,pA1,t,true,true,true);     WAIT_BAR(2); RESC(); ROT();
    STEP(pA0,pA1,pB0,pB1,t+1,true,true,true);   WAIT_BAR(2); RESC(); ROT();
  }
  #undef CMASK
  #define CMASK(P0,P1,t) do{int jb_=(t)-(NT-4); if(jb_>=0)cmask(P0,P1,jb_,qrel,hi);}while(0)
  #define ENDW(tt) do{ if((tt)+3<NT){WAIT_BAR(2);} else if((tt)+2<NT){WAIT_BAR(1);} else {WAIT_BAR(0);} }while(0)
  for(;t+1<NT;t+=2){
    STEP(pB0,pB1,pA0,pA1,t,(t+3<NT),(t+1<NT),(t+1<NT));       ENDW(t);   RESC(); ROT();
    STEP(pA0,pA1,pB0,pB1,t+1,(t+4<NT),(t+2<NT),(t+2<NT));     ENDW(t+1); RESC(); ROT();
  }
  STEP(pB0,pB1,pA0,pA1,NT-1,false,false,false); RESC();
  { float sacc=pB0[0]+pB0[1]; _Pragma("unroll") for(int r=2;r<16;++r)sacc+=pB0[r]; _Pragma("unroll") for(int r=0;r<16;++r)sacc+=pB1[r]; l_reg+=sacc;
    pw0=(u32x4){PKW(pB0,0),PKW(pB0,2),PKW(pB0,4),PKW(pB0,6)};pw1=(u32x4){PKW(pB0,8),PKW(pB0,10),PKW(pB0,12),PKW(pB0,14)};pw2=(u32x4){PKW(pB1,0),PKW(pB1,2),PKW(pB1,4),PKW(pB1,6)};pw3=(u32x4){PKW(pB1,8),PKW(pB1,10),PKW(pB1,12),PKW(pB1,14)};
    SBAR(); pv(o,vb0+sl_cur,PAF(0),PAF(1),PAF(2),PAF(3)); }
  #undef PKW
  #undef PAF
  #undef VFR
  #undef PIN
  #undef MX3
  #undef GAPA
  #undef GAPB
  #undef EX
  #undef VRD
  #undef KRD
  #undef STEP
  #undef ENDW
  {auto rr=__builtin_amdgcn_permlane32_swap(__float_as_uint(l_reg),__float_as_uint(l_reg),false,false);l_reg=__uint_as_float(rr[0])+__uint_as_float(rr[1]);}
  if(hi==0)wsf[32+r32]=l_reg;asm volatile("s_waitcnt lgkmcnt(0)":::"memory");
  float rli[16];
  #pragma unroll
  for(int r=0;r<16;++r)rli[r]=__builtin_amdgcn_rcpf(wsf[32+crow(r,hi)]);
  bf16*Ow=O+(rowbase+q0+wid*QBLK)*DM+h*D;
  { bf16*stg=(bf16*)(shm+LDS_OST)+wid*2048;
    #pragma unroll
    for(int r=0;r<16;++r){const int orow=crow(r,hi);
      #pragma unroll
      for(int d0=0;d0<2;++d0)stg[orow*64+d0*32+r32]=__float2bfloat16(o[d0][r]*rli[r]);}
    asm volatile("s_waitcnt lgkmcnt(0)":::"memory");
    #pragma unroll
    for(int i=0;i<4;++i){const int row=i*8+(lane>>3),ch=lane&7; const u32x4 v=*(const u32x4*)(stg+row*64+ch*8); ATTN_STORE16(Ow+(long)row*DM+ch*8,v);} }
  asm volatile("s_waitcnt lgkmcnt(0)\n\ts_barrier":::"memory");
  #undef DMA_K
  #undef DMA_V
  #undef CMASK
  #undef BIAS
  #undef START
  #undef RESC
  #undef ROT
}
constexpr int ATTN_LDS_BYTES=LDS_BYTES;
#undef SBAR
#undef WAIT_BAR
}

namespace sbk {
using bf16x8=__attribute__((ext_vector_type(8)))short;
using s16x4=__attribute__((ext_vector_type(4)))short;
using f32x16=__attribute__((ext_vector_type(16)))float;
constexpr int WLDS=12288;
constexpr float R_STOP=48.0f;
__device__ __forceinline__ int crow(int r,int hi){return (r&3)+8*(r>>2)+4*hi;}
__device__ __forceinline__ unsigned cvtpk(float lo,float hi){typedef float f2 __attribute__((ext_vector_type(2)));typedef __bf16 b2 __attribute__((ext_vector_type(2)));f2 v={lo,hi};b2 b=__builtin_convertvector(v,b2);return __builtin_bit_cast(unsigned,b);}
__device__ __forceinline__ void pv(f32x16*o,int vb,bf16x8 pa0,bf16x8 pa1,bf16x8 pa2,bf16x8 pa3){
  #pragma unroll
  for(int d0=0;d0<2;++d0){s16x4 lo[4],hi[4];
    #pragma unroll
    for(int ks=0;ks<4;++ks){
      asm volatile("ds_read_b64_tr_b16 %0,%1 offset:%c2":"=&v"(lo[ks]):"v"(vb),"i"(d0*4096+ks*1024):"memory");
      asm volatile("ds_read_b64_tr_b16 %0,%1 offset:%c2":"=&v"(hi[ks]):"v"(vb),"i"(d0*4096+ks*1024+512):"memory");}
    asm volatile("s_waitcnt lgkmcnt(0)":::"memory");__builtin_amdgcn_sched_barrier(0);
    #define PK(k) (bf16x8){lo[k][0],lo[k][1],lo[k][2],lo[k][3],hi[k][0],hi[k][1],hi[k][2],hi[k][3]}
    o[d0]=__builtin_amdgcn_mfma_f32_32x32x16_bf16(pa0,PK(0),o[d0],0,0,0);
    o[d0]=__builtin_amdgcn_mfma_f32_32x32x16_bf16(pa1,PK(1),o[d0],0,0,0);
    o[d0]=__builtin_amdgcn_mfma_f32_32x32x16_bf16(pa2,PK(2),o[d0],0,0,0);
    o[d0]=__builtin_amdgcn_mfma_f32_32x32x16_bf16(pa3,PK(3),o[d0],0,0,0);
    #undef PK
  }
}
__device__ __forceinline__ float sp2(float z){ return fmaxf(z,0.f)+__builtin_amdgcn_logf(1.0f+__builtin_amdgcn_exp2f(-fabsf(z))); }
__device__ __forceinline__ void sb_unit(int b,int h,int tb,const bf16_t*Q,const bf16_t*K,const bf16_t*V,bf16_t*O,char*wl,int lane){
  const int r32=lane&31,hi=lane>>5,t0=tb*32; const long rowbase=(long)b*SEQ; const int co=512+h*64;
  const bf16_t*Qw=Q+(rowbase+t0)*DM+co;
  bf16x8 qr[4];
  #pragma unroll
  for(int d0=0;d0<4;++d0)qr[d0]=*reinterpret_cast<const bf16x8*>(Qw+(long)r32*DM+d0*16+hi*8);
  f32x16 o[2];o[0]=f32x16{};o[1]=f32x16{};float R=0.f;
  const int vb=(int)(unsigned)(uintptr_t)wl+((lane>>4)&1)*32+(lane&3)*8+(4*hi+((lane&15)>>2))*64;
  bf16x8 kf[8]; u32x4 vr[8];
  #define SB_LOADK(jj) do{ const int s0_=(jj)*64; const bf16_t*Kp=K+(rowbase+s0_+r32)*DM+co+hi*8; \
    _Pragma("unroll") for(int d0=0;d0<4;++d0){kf[2*d0]=*reinterpret_cast<const bf16x8*>(Kp+d0*16);kf[2*d0+1]=*reinterpret_cast<const bf16x8*>(Kp+(long)32*DM+d0*16);} }while(0)
  #define SB_LOADV(jj) do{ const int s0_=(jj)*64; \
    _Pragma("unroll") for(int p=0;p<8;++p)vr[p]=*reinterpret_cast<const u32x4*>(V+(rowbase+s0_+16*(p&3)+(lane>>2))*DM+co+(p>>2)*32+(lane&3)*8); }while(0)
  SB_LOADK(t0>>6);
  for(int j=t0>>6;j>=0;--j){
    const int s0=j*64;
    SB_LOADV(j);
    f32x16 z0=f32x16{},z1=f32x16{};
    #pragma unroll
    for(int d0=0;d0<4;++d0){z0=__builtin_amdgcn_mfma_f32_32x32x16_bf16(kf[2*d0],qr[d0],z0,0,0,0);z1=__builtin_amdgcn_mfma_f32_32x32x16_bf16(kf[2*d0+1],qr[d0],z1,0,0,0);}
    #pragma unroll
    for(int p=0;p<8;++p)*reinterpret_cast<u32x4*>(wl+p*1024+lane*16)=vr[p];
    int rel=((j==(t0>>6))?(t0-s0+r32):1000)-4*hi; asm volatile("":"+v"(rel));
    f32x16 L0,L1;
    #pragma unroll
    for(int r=0;r<16;++r){const int kv=(r&3)+8*(r>>2); L0[r]=(kv<rel)?sp2(z0[r]):0.f; L1[r]=(kv+32<rel)?sp2(z1[r]):0.f;}
    float T[8]; f32x16 E0,E1;
    #pragma unroll
    for(int i=0;i<4;++i){
      E0[4*i+3]=0.f;E0[4*i+2]=L0[4*i+3];E0[4*i+1]=E0[4*i+2]+L0[4*i+2];E0[4*i]=E0[4*i+1]+L0[4*i+1];T[i]=E0[4*i]+L0[4*i];
      E1[4*i+3]=0.f;E1[4*i+2]=L1[4*i+3];E1[4*i+1]=E1[4*i+2]+L1[4*i+2];E1[4*i]=E1[4*i+1]+L1[4*i+1];T[4+i]=E1[4*i]+L1[4*i];}
    float X[8];
    #pragma unroll
    for(int i=0;i<8;++i)X[i]=__shfl_xor(T[i],32);
    float S[8]; float run=0.f;
    #pragma unroll
    for(int i=7;i>=0;--i){
      const float g_hi=hi?T[i]:X[i];
      const float g_lo=hi?X[i]:T[i];
      S[i]=hi?run:(run+g_hi);
      run+=g_hi+g_lo; }
    const float Ttot=run;
    #pragma unroll
    for(int i=0;i<4;++i){
      #pragma unroll
      for(int e=0;e<4;++e){E0[4*i+e]+=S[i];E1[4*i+e]+=S[4+i];}}
    f32x16 P0,P1;
    #pragma unroll
    for(int r=0;r<16;++r){const int kv=(r&3)+8*(r>>2);
      P0[r]=(kv<rel)?__builtin_amdgcn_exp2f(z0[r]-L0[r]-E0[r]-R):0.f;
      P1[r]=(kv+32<rel)?__builtin_amdgcn_exp2f(z1[r]-L1[r]-E1[r]-R):0.f;}
    R+=Ttot;
    u32x4 pw0,pw1,pw2,pw3;
    pw0=(u32x4){cvtpk(P0[0],P0[1]),cvtpk(P0[2],P0[3]),cvtpk(P0[4],P0[5]),cvtpk(P0[6],P0[7])};
    pw1=(u32x4){cvtpk(P0[8],P0[9]),cvtpk(P0[10],P0[11]),cvtpk(P0[12],P0[13]),cvtpk(P0[14],P0[15])};
    pw2=(u32x4){cvtpk(P1[0],P1[1]),cvtpk(P1[2],P1[3]),cvtpk(P1[4],P1[5]),cvtpk(P1[6],P1[7])};
    pw3=(u32x4){cvtpk(P1[8],P1[9]),cvtpk(P1[10],P1[11]),cvtpk(P1[12],P1[13]),cvtpk(P1[14],P1[15])};
    asm volatile("s_waitcnt lgkmcnt(0)":::"memory");
    if(j>0)SB_LOADK(j-1);
    pv(o,vb,__builtin_bit_cast(bf16x8,pw0),__builtin_bit_cast(bf16x8,pw1),__builtin_bit_cast(bf16x8,pw2),__builtin_bit_cast(bf16x8,pw3));
    if(__all(R>R_STOP))break;
  }
  #undef SB_LOADK
  #undef SB_LOADV
  bf16_t*Ow=O+(rowbase+t0)*DM+co;
  { bf16_t*stg=(bf16_t*)(wl+8192);
    #pragma unroll
    for(int r=0;r<16;++r){const int orow=crow(r,hi);
      #pragma unroll
      for(int d0=0;d0<2;++d0)stg[orow*64+d0*32+r32]=(bf16_t)f2bf(o[d0][r]);}
    asm volatile("s_waitcnt lgkmcnt(0)":::"memory");
    #pragma unroll
    for(int i=0;i<4;++i){const int row=i*8+(lane>>3),ch=lane&7; const u32x4 v=*(const u32x4*)(stg+row*64+ch*8); *(u32x4*)(Ow+(long)row*DM+ch*8)=v;}
    asm volatile("s_waitcnt lgkmcnt(0)":::"memory"); }
}
}

constexpr int ATT_G_OFF = attn_body::ATTN_LDS_BYTES, ATT_RED_OFF = ATT_G_OFF + SEQ * 4;
__device__ __forceinline__ void fox_scan_G(const float* FA, int b, int h, float* Gl, float* red, int tid, int lane, int wave) {
    float v[8]; float run = 0.f;
#pragma unroll
    for (int j = 0; j < 8; ++j) { run += FA[((size_t)b * SEQ + 8 * tid + j) * 8 + h] * LOG2E; v[j] = run; }
    float inc = run;
#pragma unroll
    for (int o = 1; o < 64; o <<= 1) { const float n = __shfl_up(inc, o); if (lane >= o) inc += n; }
    if (lane == 63) red[wave] = inc;
    __syncthreads();
    float off = inc - run;
    for (int w = 0; w < wave; ++w) off += red[w];
#pragma unroll
    for (int j = 0; j < 8; ++j) Gl[8 * tid + j] = off + v[j];
    __syncthreads();
}
template <int PARTS = 3>
__device__ __forceinline__ void ph_attn(const Prm& p, const Ctx& C, int l, unsigned char* lds, size_t o_off = WS_QQ) {
    const int G = gridDim.x, bx = blockIdx.x; const int vcu = (G % 8 == 0) ? (bx % 8) * (G / 8) + bx / 8 : bx;
    const attn_body::bf16* Q = (const attn_body::bf16*)(p.ws + WS_QQ); const attn_body::bf16* K = (const attn_body::bf16*)(p.ws + WS_KK); const attn_body::bf16* V = (const attn_body::bf16*)(p.ws + WS_VV);
    float* Gl = (float*)(lds + ATT_G_OFF); float* red = (float*)(lds + ATT_RED_OFF);
    int cur_bh = -1;
    float Bq;
    { float mq = fabsf(p.gq[l * HD + C.lane]), mk = fabsf(p.gk[l * HD + C.lane]);
#pragma unroll
      for (int o = 1; o < 64; o <<= 1) { mq = fmaxf(mq, __shfl_xor(mq, o)); mk = fmaxf(mk, __shfl_xor(mk, o)); }
      Bq = 1.02f * C2 * 64.0f * mq * mk; }
    unsigned* qcnt = (unsigned*)(p.ws + WS_CTL) + 3584 + l * 8 * 64;
    unsigned* uslot = (unsigned*)(lds + ATT_RED_OFF + 64);
    for (int qi = 0; qi < 8; ++qi) {
        const int qx = (bx + qi) & 7;
        for (;;) {
            __syncthreads();
            if (C.tid == 0) *uslot = __hip_atomic_fetch_add(qcnt + 64 * qx, 1u, __ATOMIC_RELAXED, __HIP_MEMORY_SCOPE_AGENT);
            __syncthreads();
            const unsigned u = *uslot;
            if (u >= 256u) break;
            if (u < 128u) {
                if (!(PARTS & 1)) continue;
                const int qb = 15 - (int)(u >> 3), bh = qx * NH + (int)(u & 7);
                if (bh != cur_bh) { __syncthreads(); fox_scan_G((const float*)(p.ws + WS_FA), bh / NH, bh % NH, Gl, red, C.tid, C.lane, C.wave); cur_bh = bh; }
                const int ntf = 4 * qb + 4; const float thr = Gl[qb * 256] + 2.0f * Bq + 48.0f;
                const bool skp = (C.lane < ntf - 4) && (Gl[64 * C.lane + 63] > thr);
                const int j0 = __builtin_popcountll(__ballot(skp)) & ~1;
                attn_body::attn_unit<8>(bh / NH, bh % NH, qb, Q, K, V, (attn_body::bf16*)(p.ws + o_off), (char*)lds, Gl, j0);
            } else {
                if (!(PARTS & 2)) continue;
                const int v = (int)u - 128, h = v & 7, g = 15 - (v >> 3);
                cur_bh = -1;
                int lane_ = C.lane; asm volatile("" : "+v"(lane_));
                sbk::sb_unit(qx, h, 8 * g + C.wave, (const bf16_t*)(p.ws + WS_QQ), (const bf16_t*)(p.ws + WS_KK), (const bf16_t*)(p.ws + WS_VV), (bf16_t*)(p.ws + o_off), (char*)lds + C.wave * sbk::WLDS, lane_);
            }
        }
    }
    __syncthreads();
}

namespace pgk {
typedef __bf16 bf16x2 __attribute__((ext_vector_type(2)));
__device__ __forceinline__ float dot2(unsigned a, unsigned b, float c) { return __builtin_amdgcn_fdot2_f32_bf16(__builtin_bit_cast(bf16x2, a), __builtin_bit_cast(bf16x2, b), c, false); }
__device__ __forceinline__ unsigned cvtpk(float lo, float hi) { typedef float f2 __attribute__((ext_vector_type(2))); f2 v = {lo, hi}; bf16x2 b = __builtin_convertvector(v, bf16x2); return __builtin_bit_cast(unsigned, b); }
}
namespace tk {
using bf16x8 = __attribute__((ext_vector_type(8))) short;
using f32x16 = __attribute__((ext_vector_type(16))) float;
constexpr int NCAND = 50;
__device__ __forceinline__ unsigned f2key(float f) { const unsigned u = __float_as_uint(f); return u ^ ((unsigned)((int)u >> 31) | 0x80000000u); }
__device__ __forceinline__ float key2f(unsigned k) { return __uint_as_float(k ^ ~((unsigned)((int)k >> 31) >> 1)); }
#define TK_CE(a, b) do { const unsigned mx_ = (a) > (b) ? (a) : (b), mn_ = (a) > (b) ? (b) : (a); (a) = mx_; (b) = mn_; } while (0)
template <int N> __device__ __forceinline__ void sort_desc(unsigned (&k)[N]) {
#pragma unroll
    for (int size = 2; size <= N; size <<= 1) {
#pragma unroll
        for (int stride = size >> 1; stride > 0; stride >>= 1) {
#pragma unroll
            for (int i = 0; i < N; ++i) { const int j = i ^ stride; if (j > i) { if ((i & size) == 0 || size == N) TK_CE(k[i], k[j]); else TK_CE(k[j], k[i]); } }
        }
    }
}
__device__ __forceinline__ void merge_desc16(unsigned (&k)[16]) {
#pragma unroll
    for (int stride = 8; stride > 0; stride >>= 1) {
#pragma unroll
        for (int i = 0; i < 16; ++i) { const int j = i ^ stride; if (j > i) TK_CE(k[i], k[j]); }
    }
}
__device__ __forceinline__ void top16_merge(unsigned (&a)[16], const unsigned (&b)[16]) {
#pragma unroll
    for (int i = 0; i < 16; ++i) a[i] = a[i] > b[15 - i] ? a[i] : b[15 - i];
    merge_desc16(a);
}
__device__ __forceinline__ void xlane_merge(unsigned (&a)[16]) {
    unsigned o[16];
#pragma unroll
    for (int i = 0; i < 16; ++i) o[i] = (unsigned)__shfl_xor((int)a[i], 32);
    top16_merge(a, o);
}
__device__ __forceinline__ void half_top16(const f32x16 (&z)[4], int c4, unsigned (&out)[16]) {
    unsigned k[4][16];
#pragma unroll
    for (int blk = 0; blk < 4; ++blk)
#pragma unroll
        for (int r = 0; r < 16; ++r) k[blk][r] = (f2key(z[blk][r]) & ~127u) | (unsigned)((127 - 32 * blk - (r & 3) - 8 * (r >> 2)) - c4);
#pragma unroll
    for (int blk = 0; blk < 4; ++blk) sort_desc<16>(k[blk]);
    top16_merge(k[0], k[1]); top16_merge(k[2], k[3]); top16_merge(k[0], k[2]);
    xlane_merge(k[0]);
#pragma unroll
    for (int i = 0; i < 16; ++i) out[i] = k[0][i];
}
}

__device__ __forceinline__ void ph_topk(const Prm& p, const Ctx& C, int l, unsigned char* lds) {
    constexpr int TA[64] = {0,0,0,0,0,0,0,0,0,0,0,0,0,0,0,0,1,1,1,1,1,1,1,1,2,2,2,2,2,3,3,3,3,4,4,4,5,5,6,6,7,7,8,9,10,11,12,13,14,15,0,0,0,0,0,0,0,0,0,0,0,0,0,0};
    constexpr int TB[64] = {0,1,2,3,4,5,6,7,8,9,10,11,12,13,14,15,0,1,2,3,4,5,6,7,0,1,2,3,4,0,1,2,3,0,1,2,0,1,0,1,0,1,0,0,0,0,0,0,0,0,0,0,0,0,0,0,0,0,0,0,0,0,0,0};
    const bf16_t* QP = (const bf16_t*)(p.ws + WS_KK); unsigned short* IDX = (unsigned short*)(p.ws + WS_VV); float* PW = (float*)(p.ws + WS_VV + 16 * MiB);
    const int lane = C.lane, r32 = lane & 31, hi = lane >> 5;
    int c4 = 4 * hi; asm volatile("" : "+v"(c4));
    unsigned char* wtab = lds + 32768 + C.wave * 1024 + r32 * 32;
    for (int item = blockIdx.x; item < 256; item += gridDim.x) {
        const int h = item & 7, tg = item >> 3;
        __syncthreads();
        for (int c = C.tid; c < 2048; c += NTHREADS) {
            const int tbl = c >> 10, row = (c >> 3) & 127, ch = c & 7;
            const float* src = (tbl ? p.k2 : p.k1) + ((size_t)(l * NH + h) * NKEYS + row) * 64 + ch * 8;
            const f32x4 a = *(const f32x4*)src, b = *(const f32x4*)(src + 4);
            u32x4 o; o.x = pgk::cvtpk(a.x, a.y); o.y = pgk::cvtpk(a.z, a.w); o.z = pgk::cvtpk(b.x, b.y); o.w = pgk::cvtpk(b.z, b.w);
            *(u32x4*)(lds + tbl * 16384 + row * 128 + ((ch ^ (row & 7)) << 4)) = o;
        }
        __syncthreads();
#pragma unroll 1
        for (int i = 0; i < 4; ++i) {
            const int tile = tg * 32 + C.wave * 4 + i, t = tile * 32 + r32;
            const bf16_t* qrow = QP + (size_t)t * DM + h * 128 + 8 * hi;
            unsigned V1[16], V2[16];
#pragma unroll
            for (int half = 0; half < 2; ++half) {
                tk::bf16x8 qf[4];
#pragma unroll
                for (int ks = 0; ks < 4; ++ks) qf[ks] = *(const tk::bf16x8*)(qrow + half * 64 + 16 * ks);
                tk::f32x16 z[4];
#pragma unroll
                for (int blk = 0; blk < 4; ++blk) {
                    z[blk] = tk::f32x16{};
                    const int row = 32 * blk + r32;
#pragma unroll
                    for (int ks = 0; ks < 4; ++ks) {
                        const tk::bf16x8 kfr = *(const tk::bf16x8*)(lds + half * 16384 + row * 128 + (((2 * ks + hi) ^ (row & 7)) << 4));
                        z[blk] = __builtin_amdgcn_mfma_f32_32x32x16_bf16(kfr, qf[ks], z[blk], 0, 0, 0);
                    }
                }
                if (half == 0) tk::half_top16(z, c4, V1); else tk::half_top16(z, c4, V2);
            }
            { u32x4 w;
              unsigned n[16];
#pragma unroll
              for (int q = 0; q < 16; ++q) n[q] = 127u - ((hi ? V2[q] : V1[q]) & 127u);
              w.x = n[0] | (n[1] << 8) | (n[2] << 16) | (n[3] << 24); w.y = n[4] | (n[5] << 8) | (n[6] << 16) | (n[7] << 24);
              w.z = n[8] | (n[9] << 8) | (n[10] << 16) | (n[11] << 24); w.w = n[12] | (n[13] << 8) | (n[14] << 16) | (n[15] << 24);
              *(u32x4*)(wtab + 16 * hi) = w; }
            float f1[16], f2[16];
#pragma unroll
            for (int q = 0; q < 16; ++q) { f1[q] = tk::key2f(V1[q] & ~127u); f2[q] = tk::key2f(V2[q] & ~127u); }
            unsigned ca[16], cb[16];
#pragma unroll
            for (int s = 0; s < 32; ++s) {
                const float v0 = f1[TA[s]] + f2[TB[s]];
                const float v1 = (32 + s < tk::NCAND) ? f1[TA[32 + s]] + f2[TB[32 + s]] : -INFINITY;
                const unsigned j0 = 255u - (unsigned)(TA[s] * 16 + TB[s]), j1 = 255u - (unsigned)(TA[32 + s] * 16 + TB[32 + s]);
                const unsigned key = (tk::f2key(hi ? v1 : v0) & ~255u) | (hi ? j1 : j0);
                if (s < 16) ca[s] = key; else cb[s - 16] = key;
            }
            tk::sort_desc<16>(ca); tk::sort_desc<16>(cb); tk::top16_merge(ca, cb); tk::xlane_merge(ca);
            float e[16]; float sum = 0.f; const float mx = tk::key2f(ca[0] & ~255u);
#pragma unroll
            for (int q = 0; q < 16; ++q) { e[q] = __builtin_amdgcn_exp2f((tk::key2f(ca[q] & ~255u) - mx) * LOG2E); sum += e[q]; }
            const float inv = 1.0f / sum;
            int eo[8]; float go[8];
            asm volatile("s_waitcnt lgkmcnt(0)" ::: "memory");
#pragma unroll
            for (int q = 0; q < 8; ++q) {
                const unsigned kq = hi ? ca[8 + q] : ca[q]; const unsigned j = 255u - (kq & 255u);
                const unsigned n1 = wtab[j >> 4], n2 = wtab[16 + (j & 15)];
                eo[q] = (int)(n1 * NKEYS + n2); go[q] = (hi ? e[8 + q] : e[q]) * inv;
            }
            unsigned short* ip = IDX + (size_t)t * 128 + h * 16 + 8 * hi; float* gp = PW + (size_t)t * 128 + h * 16 + 8 * hi;
            *(u32x4*)ip = (u32x4){(unsigned)eo[0] | ((unsigned)eo[1] << 16), (unsigned)eo[2] | ((unsigned)eo[3] << 16), (unsigned)eo[4] | ((unsigned)eo[5] << 16), (unsigned)eo[6] | ((unsigned)eo[7] << 16)};
            *(f32x4*)gp = (f32x4){go[0], go[1], go[2], go[3]}; *(f32x4*)(gp + 4) = (f32x4){go[4], go[5], go[6], go[7]};
            asm volatile("s_waitcnt lgkmcnt(0)" ::: "memory");
        }
    }
    __syncthreads();
}


constexpr size_t WS_T8 = WS_UB;
constexpr size_t WS_SC8 = WS_K12;
typedef float f32x2 __attribute__((ext_vector_type(2)));
typedef short s16x4 __attribute__((ext_vector_type(4))); typedef int i32x4 __attribute__((ext_vector_type(4))); typedef int i32x2 __attribute__((ext_vector_type(2)));
#define GAS __attribute__((address_space(1)))
#define LAS __attribute__((address_space(3)))
#define XB_TMO      128
#define XB_XCNT(j)  (256  + 64 * (j))
#define XB_XSUB(j)  (1280 + 64 * (j))
#define XB_XGEN(j)  (2304 + 64 * (j))
#define XB_TOP      3328
#define XB_TOPGEN   3392
#define XCD_BAR_WORDS 3456
#define XB_SPIN_CAP (1u << 18)

__device__ __forceinline__ unsigned xb_ld(unsigned* p)              { return __hip_atomic_load(p, __ATOMIC_RELAXED, __HIP_MEMORY_SCOPE_AGENT); }
__device__ __forceinline__ unsigned xb_add(unsigned* p, unsigned v) { return __hip_atomic_fetch_add(p, v, __ATOMIC_RELAXED, __HIP_MEMORY_SCOPE_AGENT); }
__device__ __forceinline__ unsigned xb_xcc_id() { return (unsigned)__builtin_amdgcn_s_getreg((3 << 11) | 20) & 0xFu; }
#define XB_SPIN(cond, bar) do { unsigned _sp = 0; while (cond) { __builtin_amdgcn_s_sleep(1); \
    if ((++_sp & 255u) == 0u) { if (xb_ld(&(bar)[XB_TMO])) break; if (_sp > XB_SPIN_CAP) { atomicAdd(&(bar)[XB_TMO], 1u); break; } } } } while (0)

struct XcdBarrier {
    unsigned* bar; unsigned x;
    volatile LAS unsigned* st;
};

__device__ __forceinline__ XcdBarrier xcd_barrier_post(unsigned* bar, volatile LAS unsigned* st) {
    XcdBarrier b; b.bar = bar; b.x = xb_xcc_id(); b.st = st;
    if (threadIdx.x == 0) st[2] = xb_add(&bar[XB_XCNT(b.x)], 1u);
    return b;
}
__device__ __forceinline__ void xcd_barrier_complete(unsigned* bar, unsigned x, unsigned& nloc, unsigned& nx) {
    const unsigned G = gridDim.x * gridDim.y * gridDim.z;
    unsigned sum, cnt, mine, sp = 0u;
    for (;;) {
        sum = 0u; cnt = 0u; mine = 0u;
#pragma unroll
        for (unsigned j = 0; j < 16; ++j) { const unsigned c = xb_ld(&bar[XB_XCNT(j)]); sum += c; cnt += (c > 0u) ? 1u : 0u; mine = (j == x) ? c : mine; }
        if (sum == G) break;
        __builtin_amdgcn_s_sleep(1);
        if ((++sp & 255u) == 0u) { if (xb_ld(&bar[XB_TMO])) break; if (sp > XB_SPIN_CAP) { atomicAdd(&bar[XB_TMO], 1u); break; } }
    }
    nloc = mine > 0u ? mine : 1u; nx = cnt > 0u ? cnt : 1u;
}

__device__ __forceinline__ void xcd_barrier(const XcdBarrier& b) {
    asm volatile("s_waitcnt vmcnt(0)" ::: "memory");
    __syncthreads();
    if (threadIdx.x == 0) {
        unsigned* bar = b.bar;
        __builtin_amdgcn_s_waitcnt(0);
        unsigned nloc = b.st[0], nx = b.st[1];
        if (nloc == 0u) { xcd_barrier_complete(bar, b.x, nloc, nx); b.st[0] = nloc; b.st[1] = nx; }
        const unsigned old = xb_add(&bar[XB_XSUB(b.x)], 1u);
        const unsigned gen = old / nloc;
        if (old + 1u == (gen + 1u) * nloc) {
            __builtin_amdgcn_fence(__ATOMIC_RELEASE, "agent");
            asm volatile("s_waitcnt vmcnt(0)" ::: "memory");
            const unsigned og = xb_add(&bar[XB_TOP], 1u);
            const unsigned tg = og / nx;
            if (og + 1u == (tg + 1u) * nx) xb_add(&bar[XB_TOPGEN], 1u);
            else XB_SPIN(xb_ld(&bar[XB_TOPGEN]) == tg, bar);
            __builtin_amdgcn_fence(__ATOMIC_ACQUIRE, "agent");
            xb_add(&bar[XB_XGEN(b.x)], 1u);
            asm volatile("s_waitcnt vmcnt(0)" ::: "memory");
        } else {
            XB_SPIN(xb_ld(&bar[XB_XGEN(b.x)]) == gen, bar);
            __builtin_amdgcn_fence(__ATOMIC_ACQUIRE, "agent");
            asm volatile("s_waitcnt vmcnt(0)" ::: "memory");
        }
    }
    __syncthreads();
}


constexpr size_t WS_PD = WS_GT;
__device__ __forceinline__ void ph_convert_tables8s(const Prm& p, const Ctx& C) {
    unsigned char* T8 = p.ws + WS_T8; float* SC = (float*)(p.ws + WS_SC8);
    constexpr int NR = 2 * 2 * NEXP;
    f32x4 v[2][2][4];
#define CV_LOAD(s_, row0_) do { _Pragma("unroll") for (int r = 0; r < 2; ++r) { const int row = min((row0_) + r * C.ngw, NR - 1); const int lt = row >> 14, e = row & (NEXP - 1), l = lt >> 1, tbl = lt & 1; \
        const float* src = (tbl ? p.pv : p.pu) + ((size_t)l * NEXP + e) * DM + 4 * C.lane; _Pragma("unroll") for (int j = 0; j < 4; ++j) v[s_][r][j] = *(const f32x4*)(src + 256 * j); } } while (0)
#define CV_PROC(s_, row0_) do { _Pragma("unroll") for (int r = 0; r < 2; ++r) { const int row = (row0_) + r * C.ngw; if (row >= NR) break; const int lt = row >> 14, e = row & (NEXP - 1); \
        float am = 0.f; _Pragma("unroll") for (int j = 0; j < 4; ++j) am = fmaxf(am, fmaxf(fmaxf(fabsf(v[s_][r][j].x), fabsf(v[s_][r][j].y)), fmaxf(fabsf(v[s_][r][j].z), fabsf(v[s_][r][j].w)))); \
        am = fmaxf(am, dpp_f<0xB1>(am)); am = fmaxf(am, dpp_f<0x4E>(am)); am = fmaxf(am, dpp_f<0x141>(am)); am = fmaxf(am, dpp_f<0x140>(am)); am = fmaxf(am, __shfl_xor(am, 16)); am = fmaxf(am, __shfl_xor(am, 32)); \
          \
        const float qm = 7.0f / 0.75f, sc = am > 0.f ? am / qm : 1.0f, inv = am > 0.f ? qm / am : 0.f; \
        const int o8 = (lt & 1) ? 8 : 0;     \
        _Pragma("unroll") for (int j = 0; j < 4; ++j) {     \
            const int q0 = (int)fminf(fmaxf(rintf(v[s_][r][j].x * inv), -8.0f), 7.0f), q1 = (int)fminf(fmaxf(rintf(v[s_][r][j].y * inv), -8.0f), 7.0f), q2 = (int)fminf(fmaxf(rintf(v[s_][r][j].z * inv), -8.0f), 7.0f), q3 = (int)fminf(fmaxf(rintf(v[s_][r][j].w * inv), -8.0f), 7.0f); \
            const int o_ = C.lane < 32 ? o8 : 0; const unsigned mine = (unsigned)(((q0 + o_) & 15) | (((q1 + o_) & 15) << 8) | (((q2 + o_) & 15) << 16) | (((q3 + o_) & 15) << 24)); \
            const unsigned other = (unsigned)__shfl_xor((int)mine, 32); \
            if (C.lane < 32) *(unsigned*)(T8 + (((size_t)lt * 8 + j) * NEXP + e) * 128 + 4 * C.lane) = mine | (other << 4); } \
        if (C.lane == 0) SC[row] = sc; } } while (0)
    CV_LOAD(0, C.gw);
    __builtin_amdgcn_s_waitcnt(0x0F70);
#pragma unroll 1
    for (int row0 = C.gw; row0 < NR; row0 += 4 * C.ngw) {
        CV_LOAD(1, row0 + 2 * C.ngw); CV_PROC(0, row0);
        CV_LOAD(0, row0 + 4 * C.ngw); CV_PROC(1, row0 + 2 * C.ngw);
    }
#undef CV_LOAD
#undef CV_PROC
}
__device__ __forceinline__ float sum8(float v) { v += dpp_f<0xB1>(v); v += dpp_f<0x4E>(v); v += dpp_f<0x141>(v); return v; }
template <int JS> __device__ __forceinline__ unsigned bcast8(unsigned v, int jq) {
    constexpr int c = JS & 3, ctrl = c | (c << 2) | (c << 4) | (c << 6);
    const unsigned v1 = (unsigned)__builtin_amdgcn_update_dpp(0, (int)v, ctrl, 0xF, 0xF, true);
    const unsigned v2 = (unsigned)__builtin_amdgcn_update_dpp(0, (int)v1, 0x141, 0xF, 0xF, true);
    return (jq == (JS >> 2)) ? v1 : v2;
}
template <int BB> __device__ __forceinline__ unsigned pick_id(unsigned idw, int jq) { const unsigned w = bcast8<(BB >> 1)>(idw, jq); return (BB & 1) ? (w >> 16) : (w & 0xffffu); }
template <int G4> __device__ __forceinline__ int bcast4(unsigned v) { constexpr int ctrl = G4 | (G4 << 2) | (G4 << 4) | (G4 << 6); return __builtin_amdgcn_update_dpp(0, (int)v, ctrl, 0xF, 0xF, true); }
struct SliceCtx { int x, wq, nwq; };
#ifndef SLICE_BY_XCC
#define SLICE_BY_XCC 0
#endif
__device__ __forceinline__ SliceCtx slice_ctx(const Ctx& C, const Prm& p, unsigned char* lds) { SliceCtx s; const int G = gridDim.x;
    if (SLICE_BY_XCC) { const unsigned x = xb_xcc_id() & 7u; const unsigned* bar = (const unsigned*)(p.ws + WS_CTL); const volatile LAS unsigned* st = (const volatile LAS unsigned*)((LAS unsigned char*)lds + (LDS_BYTES - 64));
        s.x = (int)x; s.wq = (int)st[2] * NWAVES + C.wave; s.nwq = (int)xb_ld((unsigned*)&bar[XB_XCNT(x)]) * NWAVES; return s; }
    s.x = blockIdx.x & 7; s.wq = (blockIdx.x >> 3) * NWAVES + C.wave; s.nwq = ((G - s.x + 7) >> 3) * NWAVES; return s; }
__device__ __forceinline__ void ph_peer_u(const Prm& p, const Ctx& C, int l, unsigned char* lds) {
    const SliceCtx S = slice_ctx(C, p, lds);
    const bf16_t* HB = (const bf16_t*)(p.ws + WS_QQ);     const unsigned short* IDX = (const unsigned short*)(p.ws + WS_VV); float* PD = (float*)(p.ws + WS_PD);
    const unsigned char* U8 = p.ws + WS_T8 + ((size_t)(l * 2 + 0) * 8 + S.x) * NEXP * 128;
    const int lane = C.lane, j = lane & 7, k = lane >> 3, jq = (lane >> 2) & 1;
    u32x4 uq[2][16]; unsigned idw[2]; u32x4 hr0[2], hr1[2];
    const int nit = (NT - S.wq + S.nwq - 1) / S.nwq;
#define PU_TOK(i) (S.wq + ((i) < nit ? (i) : nit - 1) * S.nwq)
#define PU_LOADID(s_, i) do { idw[s_] = ((const unsigned*)IDX)[(size_t)PU_TOK(i) * 64 + lane]; } while (0)
#define PU_LOADH(s_, i) do { const bf16_t* hp_ = HB + (size_t)PU_TOK(i) * DM + 128 * S.x + 16 * j; hr0[s_] = *(const u32x4*)hp_; hr1[s_] = *(const u32x4*)(hp_ + 8); } while (0)
#define PU_G1(s_, BB) uq[s_][BB] = *(const u32x4*)(U8 + (size_t)pick_id<BB>(idw[s_], jq) * 128 + 16 * j)
#define PU_GATHER(s_, h_) do { PU_G1(s_, 8 * (h_) + 0); PU_G1(s_, 8 * (h_) + 1); PU_G1(s_, 8 * (h_) + 2); PU_G1(s_, 8 * (h_) + 3); PU_G1(s_, 8 * (h_) + 4); PU_G1(s_, 8 * (h_) + 5); PU_G1(s_, 8 * (h_) + 6); PU_G1(s_, 8 * (h_) + 7); } while (0)
#define PU_MATH(s_, h_, pd_) do { _Pragma("unroll") for (int b_ = 0; b_ < 8; ++b_) { const int bb = 8 * (h_) + b_; int ai = __builtin_amdgcn_sdot4((int)uq[s_][bb].x, hq[0], 0, false); \
        ai = __builtin_amdgcn_sdot4((int)uq[s_][bb].y, hq[1], ai, false); ai = __builtin_amdgcn_sdot4((int)uq[s_][bb].z, hq[2], ai, false); ai = __builtin_amdgcn_sdot4((int)uq[s_][bb].w, hq[3], ai, false); \
        ai += dpp_i<0xB1>(ai); ai += dpp_i<0x4E>(ai); ai += dpp_i<0x141>(ai); if (b_ == j) pd_ = ai; } } while (0)
    PU_LOADID(0, 0); PU_LOADID(1, 1); PU_LOADH(0, 0); PU_LOADH(1, 1);
    PU_GATHER(0, 0); PU_GATHER(0, 1); PU_GATHER(1, 0); PU_GATHER(1, 1);
    PU_LOADID(0, 2);
#pragma unroll 1
    for (int it = 0; it < nit; it += 2) {
#pragma unroll
        for (int a = 0; a < 2; ++a) {
            const int i = it + a, bq = 1 - a;
            int hq[4]; float hsc;
            { const unsigned hw[8] = {hr0[a].x, hr0[a].y, hr0[a].z, hr0[a].w, hr1[a].x, hr1[a].y, hr1[a].z, hr1[a].w};
              float hv[16]; float am = 0.f;
#pragma unroll
              for (int q = 0; q < 8; ++q) { hv[2 * q] = __uint_as_float(hw[q] << 16); hv[2 * q + 1] = __uint_as_float(hw[q] & 0xffff0000u); am = fmaxf(am, fmaxf(fabsf(hv[2 * q]), fabsf(hv[2 * q + 1]))); }
              am = fmaxf(am, dpp_f<0xB1>(am)); am = fmaxf(am, dpp_f<0x4E>(am)); am = fmaxf(am, dpp_f<0x141>(am));
              hsc = am > 0.f ? am * (1.0f / 127.0f) : 1.0f; const float inv = am > 0.f ? 127.0f / am : 0.f;
#pragma unroll
              for (int q = 0; q < 4; ++q) { unsigned u0 = __builtin_amdgcn_cvt_pk_u8_f32(hv[4 * q] * inv + 128.0f, 0, 0u); u0 = __builtin_amdgcn_cvt_pk_u8_f32(hv[4 * q + 1] * inv + 128.0f, 1, u0);
                  u0 = __builtin_amdgcn_cvt_pk_u8_f32(hv[4 * q + 2] * inv + 128.0f, 2, u0); u0 = __builtin_amdgcn_cvt_pk_u8_f32(hv[4 * q + 3] * inv + 128.0f, 3, u0); hq[q] = (int)(u0 ^ 0x80808080u); } }
            PU_LOADH(a, i + 2); PU_LOADID(bq, i + 3);
            int pd0 = 0, pd1 = 0;
            PU_MATH(a, 0, pd0); PU_GATHER(a, 0);
            PU_MATH(a, 1, pd1); PU_GATHER(a, 1);
            if (i < nit) { float* pd = PD + ((size_t)S.x * NT + (S.wq + i * S.nwq)) * 128 + 16 * k + j; pd[0] = (float)pd0 * hsc; pd[8] = (float)pd1 * hsc; }
        }
    }
#undef PU_TOK
#undef PU_LOADID
#undef PU_LOADH
#undef PU_GATHER
#undef PU_G1
#undef PU_MATH
}
__device__ __forceinline__ void ph_peer_pre(const Prm& p, const Ctx& C, int l) {
    const float* MOD = (const float*)(p.ws + WS_MOD) + (size_t)l * NB * MODW + 3 * DM;
    const bf16_t* WQT = (const bf16_t*)(p.ws + WS_WQ) + (size_t)l * DM * DM; float* BQ = (float*)(p.ws + WS_BQ) + (size_t)l * NB * DM;
    for (int item = C.gw; item < (DM / 8) * NB; item += C.ngw) {
        const int b = item & 7, c0 = (item >> 3) * 8;
        float sh[16];
#pragma unroll
        for (int q = 0; q < 4; ++q) { const f32x4 v = *(const f32x4*)(MOD + (size_t)b * MODW + 16 * C.lane + 4 * q); sh[4 * q] = v.x; sh[4 * q + 1] = v.y; sh[4 * q + 2] = v.z; sh[4 * q + 3] = v.w; }
        float res = 0.f;
#pragma unroll
        for (int c = 0; c < 8; ++c) { const u32x4 w0 = *(const u32x4*)(WQT + (size_t)(c0 + c) * DM + 16 * C.lane), w1 = *(const u32x4*)(WQT + (size_t)(c0 + c) * DM + 16 * C.lane + 8);
            const unsigned ww[8] = {w0.x, w0.y, w0.z, w0.w, w1.x, w1.y, w1.z, w1.w}; float a = 0.f;
#pragma unroll
            for (int q = 0; q < 8; ++q) a += __uint_as_float(ww[q] << 16) * sh[2 * q] + __uint_as_float(ww[q] & 0xffff0000u) * sh[2 * q + 1];
            a = wave_sum(a); if (C.lane == c) res = a; }
        if (C.lane < 8) BQ[(size_t)b * DM + c0 + C.lane] = res;
    }
    const unsigned char* U8 = p.ws + WS_T8 + (size_t)(l * 2 + 0) * 8 * NEXP * 128; const float* SU = (const float*)(p.ws + WS_SC8) + (size_t)(l * 2) * NEXP; float* USH = (float*)(p.ws + WS_USH) + (size_t)l * NB * NEXP;
    float shb[8][16];
    const int cl = 256 * (C.lane >> 4) + 8 * (C.lane & 15);
#pragma unroll
    for (int b = 0; b < 8; ++b)
#pragma unroll
        for (int q = 0; q < 4; ++q) { const f32x4 v = *(const f32x4*)(MOD + (size_t)b * MODW + cl + 128 * (q >> 1) + 4 * (q & 1)); shb[b][4 * q] = v.x; shb[b][4 * q + 1] = v.y; shb[b][4 * q + 2] = v.z; shb[b][4 * q + 3] = v.w; }
    const int hi5 = C.lane >> 5, b4 = (C.lane >> 4) & 1;
    for (int e0 = C.gw; e0 < NEXP; e0 += 2 * C.ngw) {
        u32x2 uq[2];
#pragma unroll
        for (int r = 0; r < 2; ++r) uq[r] = *(const u32x2*)(U8 + ((size_t)(C.lane >> 4) * NEXP + min(e0 + r * C.ngw, NEXP - 1)) * 128 + 8 * (C.lane & 15));
#pragma unroll
        for (int r = 0; r < 2; ++r) { const int e = e0 + r * C.ngw; if (e >= NEXP) break;
            const unsigned w[2] = {uq[r].x, uq[r].y}; float uf[16];
#pragma unroll
            for (int q = 0; q < 8; ++q) { uf[q] = (float)(((int)(w[q >> 2] << (28 - 8 * (q & 3)))) >> 28); uf[8 + q] = (float)(((int)(w[q >> 2] << (24 - 8 * (q & 3)))) >> 28); }
            float a[8];
#pragma unroll
            for (int b = 0; b < 8; ++b) { float t = 0.f;
#pragma unroll
                for (int q = 0; q < 16; ++q) t += uf[q] * shb[b][q];
                a[b] = t; }
            float r4[4], r2[2];
#pragma unroll
            for (int q = 0; q < 4; ++q) r4[q] = xsum32(a[q], a[4 + q]);
#pragma unroll
            for (int q = 0; q < 2; ++q) r2[q] = xsum16(r4[q], r4[2 + q]);
#pragma unroll
            for (int q = 0; q < 2; ++q) { float v = r2[q]; v += dpp_f<0xB1>(v); v += dpp_f<0x4E>(v); v += dpp_f<0x141>(v); v += dpp_f<0x128>(v); r2[q] = v; }
            if ((C.lane & 15) == 0) { const float su = SU[e], sv = SU[NEXP + e]; const int b0 = 4 * hi5 + 2 * b4;
                f32x4* REC = (f32x4*)(p.ws + WS_T8 + ((size_t)(l * 2 + 0) * 8 + 4) * NEXP * 128); REC[(size_t)b0 * NEXP + e] = (f32x4){r2[0] * su, su, sv, 0.f}; REC[(size_t)(b0 + 1) * NEXP + e] = (f32x4){r2[1] * su, su, sv, 0.f}; }
        }
    }
}
__device__ __forceinline__ void ph_peer_r(const Prm& p, const Ctx& C, int l) {
    const unsigned short* IDX = (const unsigned short*)(p.ws + WS_VV); float* PW = (float*)(p.ws + WS_VV + 16 * MiB); const float* PD = (const float*)(p.ws + WS_PD);
    const float* SU = (const float*)(p.ws + WS_SC8) + (size_t)(l * 2) * NEXP; const float* SV = SU + NEXP;
    const size_t n = (size_t)NT * 128, stride = (size_t)gridDim.x * NTHREADS;
    for (size_t i = (size_t)blockIdx.x * NTHREADS + C.tid; i < n; i += stride) {
        float s = 0.f;
#pragma unroll
        for (int x = 0; x < 8; ++x) s += PD[(size_t)x * n + i];
        const size_t t = i >> 7; const float r = ((const float*)(p.ws + WS_FC))[t];
        const int id = IDX[i]; const float d = s * r * SU[id] + ((const float*)(p.ws + WS_USH))[((size_t)l * NB + t / SEQ) * NEXP + id];
        const float cf = PW[i] * (0.5f * d * (1.0f + erff(d * 0.70710678118654752f))) * SV[id];
        float cmx = fabsf(cf); cmx = fmaxf(cmx, dpp_f<0xB1>(cmx)); cmx = fmaxf(cmx, dpp_f<0x4E>(cmx)); cmx = fmaxf(cmx, dpp_f<0x141>(cmx)); cmx = fmaxf(cmx, dpp_f<0x128>(cmx));
        const float inv = cmx > 0.f ? 127.0f / cmx : 0.f;
        ((unsigned char*)(p.ws + WS_VV + 32 * MiB))[i] = (unsigned char)((__builtin_amdgcn_cvt_pk_u8_f32(cf * inv + 128.0f, 0, 0u) ^ 0x80u) & 0xffu);
        if ((C.lane & 15) == 0) ((float*)(p.ws + WS_VV + 40 * MiB))[i >> 4] = cmx * (1.0f / 127.0f);
    }
}
__device__ __forceinline__ void ph_peer_v(const Prm& p, const Ctx& C, int l, unsigned char* lds) {
    const SliceCtx S = slice_ctx(C, p, lds);
    const unsigned short* IDX = (const unsigned short*)(p.ws + WS_VV); const unsigned char* CQ = p.ws + WS_VV + 32 * MiB; const float* CSC = (const float*)(p.ws + WS_VV + 40 * MiB);
    const float* MOD = (const float*)(p.ws + WS_MOD) + (size_t)l * NB * MODW;
    const unsigned char* V8 = p.ws + WS_T8 + ((size_t)(l * 2 + 1) * 8 + S.x) * NEXP * 128;
    const int lane = C.lane, j = lane & 7, k = lane >> 3, b3 = (lane >> 3) & 1, jq = (lane >> 2) & 1;
    u32x4 vq[2][16]; unsigned idw[2]; unsigned cqw[2]; float csv[2]; f32x2 xvv[2], gvv[2];
    const int ocol = 128 * S.x + 16 * j + 2 * k;
    const int nit = (NT - S.wq + S.nwq - 1) / S.nwq;
#define PV_TOK(i) (S.wq + ((i) < nit ? (i) : nit - 1) * S.nwq)
#define PV_LOADID(s_, i) do { idw[s_] = ((const unsigned*)IDX)[(size_t)PV_TOK(i) * 64 + lane]; } while (0)
#define PV_LOADC(s_, i) do { const int t_ = PV_TOK(i); cqw[s_] = ((const unsigned*)CQ)[(size_t)t_ * 32 + 4 * k + (j & 3)]; csv[s_] = CSC[(size_t)t_ * 8 + k]; \
        xvv[s_] = *(const f32x2*)(p.out + (size_t)t_ * DM + ocol); gvv[s_] = *(const f32x2*)(MOD + (size_t)(t_ / SEQ) * MODW + 5 * DM + ocol); } while (0)
#define PV_G1(s_, BB) vq[s_][BB] = *(const u32x4*)(V8 + (size_t)pick_id<BB>(idw[s_], jq) * 128 + 16 * j)
#define PV_GATHER(s_, h_) do { PV_G1(s_, 8 * (h_) + 0); PV_G1(s_, 8 * (h_) + 1); PV_G1(s_, 8 * (h_) + 2); PV_G1(s_, 8 * (h_) + 3); PV_G1(s_, 8 * (h_) + 4); PV_G1(s_, 8 * (h_) + 5); PV_G1(s_, 8 * (h_) + 6); PV_G1(s_, 8 * (h_) + 7); } while (0)
#define PV_MATH(s_, h_) do { _Pragma("unroll") for (int g_ = 2 * (h_); g_ < 2 * (h_) + 2; ++g_) { const unsigned r0_[4] = {vq[s_][4 * g_].x, vq[s_][4 * g_].y, vq[s_][4 * g_].z, vq[s_][4 * g_].w}, r1_[4] = {vq[s_][4 * g_ + 1].x, vq[s_][4 * g_ + 1].y, vq[s_][4 * g_ + 1].z, vq[s_][4 * g_ + 1].w}, \
        r2_[4] = {vq[s_][4 * g_ + 2].x, vq[s_][4 * g_ + 2].y, vq[s_][4 * g_ + 2].z, vq[s_][4 * g_ + 2].w}, r3_[4] = {vq[s_][4 * g_ + 3].x, vq[s_][4 * g_ + 3].y, vq[s_][4 * g_ + 3].z, vq[s_][4 * g_ + 3].w}; \
        _Pragma("unroll") for (int w = 0; w < 4; ++w) { const unsigned p01l = __builtin_amdgcn_perm(r1_[w], r0_[w], 0x05010400u), p01h = __builtin_amdgcn_perm(r1_[w], r0_[w], 0x07030602u), p23l = __builtin_amdgcn_perm(r3_[w], r2_[w], 0x05010400u), p23h = __builtin_amdgcn_perm(r3_[w], r2_[w], 0x07030602u); \
            yi[4 * w + 0] = __builtin_amdgcn_sdot4((int)__builtin_amdgcn_perm(p23l, p01l, 0x05040100u), cq[g_], yi[4 * w + 0], false); yi[4 * w + 1] = __builtin_amdgcn_sdot4((int)__builtin_amdgcn_perm(p23l, p01l, 0x07060302u), cq[g_], yi[4 * w + 1], false); \
            yi[4 * w + 2] = __builtin_amdgcn_sdot4((int)__builtin_amdgcn_perm(p23h, p01h, 0x05040100u), cq[g_], yi[4 * w + 2], false); yi[4 * w + 3] = __builtin_amdgcn_sdot4((int)__builtin_amdgcn_perm(p23h, p01h, 0x07060302u), cq[g_], yi[4 * w + 3], false); } } } while (0)
    PV_LOADID(0, 0); PV_LOADID(1, 1); PV_LOADC(0, 0); PV_LOADC(1, 1);
    PV_GATHER(0, 0); PV_GATHER(0, 1); PV_GATHER(1, 0); PV_GATHER(1, 1);
    PV_LOADID(0, 2);
#pragma unroll 1
    for (int it = 0; it < nit; it += 2) {
#pragma unroll
        for (int a = 0; a < 2; ++a) {
            const int i = it + a, bq = 1 - a;
            const int cq[4] = {bcast4<0>(cqw[a]), bcast4<1>(cqw[a]), bcast4<2>(cqw[a]), bcast4<3>(cqw[a])}; const float cback = csv[a]; const f32x2 xv = xvv[a], gv = gvv[a];
            PV_LOADC(a, i + 2); PV_LOADID(bq, i + 3);
            int yi[16];
#pragma unroll
            for (int q = 0; q < 16; ++q) yi[q] = 0;
            PV_MATH(a, 0); PV_GATHER(a, 0);
            PV_MATH(a, 1); PV_GATHER(a, 1);
            f32x2 y[8];
#pragma unroll
            for (int q = 0; q < 8; ++q) y[q] = (f32x2){(float)yi[2 * q] * cback, (float)yi[2 * q + 1] * cback};
            f32x2 r4[4], r2[2], r1;
#pragma unroll
            for (int q = 0; q < 4; ++q) r4[q] = (f32x2){xsum32(y[q].x, y[4 + q].x), xsum32(y[q].y, y[4 + q].y)};
#pragma unroll
            for (int q = 0; q < 2; ++q) r2[q] = (f32x2){xsum16(r4[q].x, r4[2 + q].x), xsum16(r4[q].y, r4[2 + q].y)};
            { const f32x2 snd = b3 ? r2[0] : r2[1], kp = b3 ? r2[1] : r2[0]; r1 = (f32x2){kp.x + dpp_f<0x128>(snd.x), kp.y + dpp_f<0x128>(snd.y)}; }
            if (i < nit) {
                const int t = S.wq + i * S.nwq;
                *(f32x2*)(p.out + (size_t)t * DM + ocol) = xv + gv * r1;
            }
        }
    }
#undef PV_TOK
#undef PV_LOADID
#undef PV_LOADC
#undef PV_GATHER
#undef PV_G1
#undef PV_MATH
}

template <int MODE = 0> __device__ __forceinline__ void ph_peer_u4(const Prm& p, const Ctx& C, int l, unsigned char* lds) {
    SliceCtx S; S.x = blockIdx.x & 3; S.wq = (blockIdx.x >> 2) * NWAVES + C.wave; S.nwq = (((int)gridDim.x - S.x + 3) >> 2) * NWAVES;
    const bf16_t* HB = (const bf16_t*)(p.ws + WS_QQ); float* PD = (float*)(p.ws + WS_PD);
    const unsigned short* IDX = (const unsigned short*)(p.ws + WS_VV);
    const unsigned char* U8 = p.ws + WS_T8 + ((size_t)(l * 2 + 0) * 8 + S.x) * NEXP * 128;
    const int lane = C.lane, j = lane & 7, k = lane >> 3, jq = (lane >> 2) & 1;
    u32x4 uq[2][16]; unsigned idw[2]; u32x2 hr[2];
    LAS unsigned* il = (LAS unsigned*)((LAS unsigned char*)lds + 131072 + C.wave * 256);
    unsigned idr[8];
    LAS unsigned* hl = (LAS unsigned*)((LAS unsigned char*)lds + C.wave * 256);
    const int nit = (NT - S.wq + S.nwq - 1) / S.nwq;
#define PU_TOK(i) (S.wq + ((i) < nit ? (i) : nit - 1) * S.nwq)
#define PU_LOADID(s_, i) do { idw[s_] = ((const unsigned*)IDX)[(size_t)PU_TOK(i) * 64 + lane]; } while (0)
#define PU_LOADH(s_, i) do { hr[s_] = *(const u32x2*)(HB + (size_t)PU_TOK(i) * DM + 256 * S.x + 4 * lane); } while (0)
#define PU_IDS(s_) do { il[lane] = idw[s_]; const u32x4 i0_ = *(LAS u32x4*)(il + 8 * k), i1_ = *(LAS u32x4*)(il + 8 * k + 4); idr[0] = i0_.x; idr[1] = i0_.y; idr[2] = i0_.z; idr[3] = i0_.w; idr[4] = i1_.x; idr[5] = i1_.y; idr[6] = i1_.z; idr[7] = i1_.w; } while (0)
#define PU_G1(s_, BB) uq[s_][BB] = *(const u32x4*)(U8 + (size_t)((((BB) & 1) ? (idr[(BB) >> 1] >> 16) : (idr[(BB) >> 1] & 0xffffu)) * 128u + 16u * (unsigned)j))
#define PU_GATHER(s_, h_) do { PU_G1(s_, 8 * (h_) + 0); PU_G1(s_, 8 * (h_) + 1); PU_G1(s_, 8 * (h_) + 2); PU_G1(s_, 8 * (h_) + 3); PU_G1(s_, 8 * (h_) + 4); PU_G1(s_, 8 * (h_) + 5); PU_G1(s_, 8 * (h_) + 6); PU_G1(s_, 8 * (h_) + 7); } while (0)
#define PU_MATH(s_, h_, pd_) do { _Pragma("unroll") for (int b_ = 0; b_ < 8; ++b_) { const int bb = 8 * (h_) + b_; const unsigned x_[4] = {uq[s_][bb].x, uq[s_][bb].y, uq[s_][bb].z, uq[s_][bb].w}; int a0_ = 0, a1_ = 0; \
        _Pragma("unroll") for (int w_ = 0; w_ < 4; ++w_) { a0_ = __builtin_amdgcn_sdot8((int)x_[w_], hp0[w_], a0_, false); a1_ = __builtin_amdgcn_sdot8((int)x_[w_], hp1[w_], a1_, false); } \
        pd_[bb] = a1_ * 16 + a0_; } } while (0)
    PU_LOADID(0, 0); PU_LOADID(1, 1); PU_LOADH(0, 0); PU_LOADH(1, 1);
    PU_IDS(0); PU_GATHER(0, 0); PU_GATHER(0, 1); PU_IDS(1); PU_GATHER(1, 0); PU_GATHER(1, 1);
    PU_LOADID(0, 2);
    __builtin_amdgcn_s_waitcnt(0x0F70);
#pragma unroll 1
    for (int it = 0; it < nit; it += 2) {
#pragma unroll
        for (int a = 0; a < 2; ++a) {
            const int i = it + a, bq = 1 - a;
            int hp0[4], hp1[4]; float hsc;
            { const float h0_ = __uint_as_float(hr[a].x << 16), h1_ = __uint_as_float(hr[a].x & 0xffff0000u), h2_ = __uint_as_float(hr[a].y << 16), h3_ = __uint_as_float(hr[a].y & 0xffff0000u);
              float am = fmaxf(fmaxf(fabsf(h0_), fabsf(h1_)), fmaxf(fabsf(h2_), fabsf(h3_)));
              am = fmaxf(am, dpp_f<0xB1>(am)); am = fmaxf(am, dpp_f<0x4E>(am)); am = fmaxf(am, dpp_f<0x141>(am)); am = fmaxf(am, dpp_f<0x140>(am)); am = fmaxf(am, __shfl_xor(am, 16)); am = fmaxf(am, __shfl_xor(am, 32));
              hsc = am > 0.f ? am * (1.0f / 119.0f) : 1.0f; const float inv = am > 0.f ? 119.0f / am : 0.f;
              unsigned u0 = __builtin_amdgcn_cvt_pk_u8_f32(h0_ * inv + 136.0f, 0, 0u); u0 = __builtin_amdgcn_cvt_pk_u8_f32(h1_ * inv + 136.0f, 1, u0); u0 = __builtin_amdgcn_cvt_pk_u8_f32(h2_ * inv + 136.0f, 2, u0); u0 = __builtin_amdgcn_cvt_pk_u8_f32(h3_ * inv + 136.0f, 3, u0);
              hl[lane] = u0;
              const u32x4 lo4 = *(LAS u32x4*)(hl + 4 * j), hi4 = *(LAS u32x4*)(hl + 32 + 4 * j);
              const unsigned L8_[4] = {lo4.x, lo4.y, lo4.z, lo4.w}, H8_[4] = {hi4.x, hi4.y, hi4.z, hi4.w};
#pragma unroll
              for (int w = 0; w < 4; ++w) { const unsigned L8 = L8_[w], H8 = H8_[w];
                  hp0[w] = (int)(((L8 & 0x0f0f0f0fu) | ((H8 & 0x0f0f0f0fu) << 4)) ^ 0x88888888u);
                  hp1[w] = (int)((((L8 >> 4) & 0x0f0f0f0fu) | (H8 & 0xf0f0f0f0u)) ^ 0x88888888u); } }
            PU_LOADH(a, i + 2); PU_LOADID(bq, i + 3);
            int v16[16];
            PU_IDS(a); PU_MATH(a, 0, v16); PU_GATHER(a, 0);
            PU_MATH(a, 1, v16); PU_GATHER(a, 1);
            int v8[8], v4[4], v2[2];
#pragma unroll
            for (int m = 0; m < 8; ++m) { const int kp = (j & 4) ? v16[8 + m] : v16[m], sd = (j & 4) ? v16[m] : v16[8 + m]; v8[m] = kp + dpp_i<0x141>(sd); }
#pragma unroll
            for (int m = 0; m < 4; ++m) { const int kp = (j & 2) ? v8[4 + m] : v8[m], sd = (j & 2) ? v8[m] : v8[4 + m]; v4[m] = kp + dpp_i<0x4E>(sd); }
#pragma unroll
            for (int m = 0; m < 2; ++m) { const int kp = (j & 1) ? v4[2 + m] : v4[m], sd = (j & 1) ? v4[m] : v4[2 + m]; v2[m] = kp + dpp_i<0xB1>(sd); }
            if (i < nit) { float* pd = (MODE == 1 ? (float*)(p.ws + WS_HB) : PD) + ((size_t)S.x * NT + (S.wq + i * S.nwq)) * 128 + 2 * lane; *(f32x2*)pd = (f32x2){(float)v2[0] * hsc, (float)v2[1] * hsc}; }
        }
    }
#undef PU_TOK
#undef PU_LOADID
#undef PU_LOADH
#undef PU_GATHER
#undef PU_G1
#undef PU_MATH
}

__device__ __forceinline__ void ph_peer_r2(const Prm& p, const Ctx& C, int l, unsigned char* lds) {
    const unsigned* IDX = (const unsigned*)(p.ws + WS_VV); const f32x2* PW = (const f32x2*)(p.ws + WS_VV + 16 * MiB); const f32x2* PD = (const f32x2*)(p.ws + WS_PD);
    unsigned char* CQ2 = p.ws + WS_VV + 32 * MiB; float* CSC = (float*)(p.ws + WS_VV + 40 * MiB);
    const float* SU = (const float*)(p.ws + WS_SC8) + (size_t)(l * 2) * NEXP; const float* SV = SU + NEXP;
    const size_t n2 = (size_t)NT * 64; const int lane = C.lane;
    const int bidx = 64 * (lane & 1) + 8 * ((lane >> 1) & 3) + (lane >> 3);
    LAS unsigned char* wl = (LAS unsigned char*)lds + C.wave * 256;
    for (int t = C.gw; t < NT; t += C.ngw) {
        f32x2 pd0 = PD[(size_t)t * 64 + lane], pd1 = PD[n2 + (size_t)t * 64 + lane], pd2 = PD[2 * n2 + (size_t)t * 64 + lane], pd3 = PD[3 * n2 + (size_t)t * 64 + lane];
        float r = ((const float*)(p.ws + WS_FC))[t];
        unsigned idw = IDX[(size_t)t * 64 + lane];
        f32x2 pw = PW[(size_t)t * 64 + lane];
        asm volatile("" : "+v"(pd0), "+v"(pd1), "+v"(pd2), "+v"(pd3), "+v"(r), "+v"(idw), "+v"(pw));
        const f32x2 sa = (pd0 + pd1) + (pd2 + pd3);
        const int id0 = (int)(idw & 0xffffu), id1 = (int)(idw >> 16);
        const f32x4* REC = (const f32x4*)(p.ws + WS_T8 + ((size_t)(l * 2 + 0) * 8 + 4) * NEXP * 128) + (size_t)(t / SEQ) * NEXP;
        f32x4 rc0 = REC[id0], rc1 = REC[id1];
        asm volatile("" : "+v"(rc0), "+v"(rc1));
        const float us0 = rc0.x, su0 = rc0.y, sv0 = rc0.z, us1 = rc1.x, su1 = rc1.y, sv1 = rc1.z;
        const float d0 = sa.x * r * su0 + us0, d1 = sa.y * r * su1 + us1;
        const float cf0 = pw.x * (0.5f * d0 * (1.0f + erff(d0 * 0.70710678118654752f))) * sv0;
        const float cf1 = pw.y * (0.5f * d1 * (1.0f + erff(d1 * 0.70710678118654752f))) * sv1;
        float cmx = fmaxf(fabsf(cf0), fabsf(cf1));
        cmx = fmaxf(cmx, dpp_f<0xB1>(cmx)); cmx = fmaxf(cmx, dpp_f<0x4E>(cmx)); cmx = fmaxf(cmx, dpp_f<0x141>(cmx)); cmx = fmaxf(cmx, dpp_f<0x140>(cmx));
        cmx = fmaxf(cmx, __shfl_xor(cmx, 16)); cmx = fmaxf(cmx, __shfl_xor(cmx, 32));
        const float inv = cmx > 0.f ? 16383.0f / cmx : 0.f;
        const int q0 = (int)rintf(cf0 * inv), q1 = (int)rintf(cf1 * inv);
        wl[bidx] = (unsigned char)(q0 >> 7); wl[bidx + 128] = (unsigned char)(q0 & 127); wl[bidx + 32] = (unsigned char)(q1 >> 7); wl[bidx + 160] = (unsigned char)(q1 & 127);
        int qs = q0 + q1;
        qs += dpp_i<0xB1>(qs); qs += dpp_i<0x4E>(qs); qs += dpp_i<0x141>(qs); qs += dpp_i<0x140>(qs); qs += __shfl_xor(qs, 16); qs += __shfl_xor(qs, 32);
        ((unsigned*)(CQ2 + (size_t)t * 256))[lane] = ((LAS unsigned*)wl)[lane];
        if (lane == 0) { const float sc = cmx * (1.0f / 16383.0f); *(f32x2*)(CSC + 2 * (size_t)t) = (f32x2){sc, 8.0f * sc * (float)qs}; }
    }
}
__device__ __forceinline__ void ph_peer_v2(const Prm& p, const Ctx& C, int l, unsigned char* lds) {
    SliceCtx S; S.x = blockIdx.x & 3; S.wq = (blockIdx.x >> 2) * NWAVES + C.wave; S.nwq = (((int)gridDim.x - S.x + 3) >> 2) * NWAVES;
    const unsigned short* IDX = (const unsigned short*)(p.ws + WS_VV); const unsigned char* CQ2 = p.ws + WS_VV + 32 * MiB; const f32x2* CSC = (const f32x2*)(p.ws + WS_VV + 40 * MiB);
    const float* MOD = (const float*)(p.ws + WS_MOD) + (size_t)l * NB * MODW;
    const unsigned char* V8 = p.ws + WS_T8 + ((size_t)(l * 2 + 1) * 8 + S.x) * NEXP * 128;
    const int lane = C.lane, j = lane & 7, k = lane >> 3, jq = (lane >> 2) & 1, n16 = lane & 15, q4 = lane >> 4;
    LAS unsigned* il = (LAS unsigned*)((LAS unsigned char*)lds + 131072 + C.wave * 256); unsigned idr[8];
    LAS unsigned char* wl = (LAS unsigned char*)lds + C.wave * 16384;
    const int wb_e = 128 * k + 32 * ((j >> 1) ^ ((k >> 1) & 1)) + 16 * (j & 1), wb_o = 128 * k + 32 * ((j >> 1) ^ ((k >> 1) & 1) ^ 2) + 16 * (j & 1);
    const int rr = (lane >> 2) & 3, pp = lane & 3, fr = ((rr >> 1) & 1) | ((q4 & 1) << 1);
    int rb[4];
#pragma unroll
    for (int nt = 0; nt < 4; ++nt) rb[nt] = 128 * (8 * q4 + rr) + 32 * (nt ^ fr) + 8 * pp;
    const unsigned selA0 = (lane & 1) ? 0x010c000cu : 0x0c010c00u, selB0 = (lane & 1) ? 0x030c020cu : 0x0c030c02u;
    const unsigned selAL = (lane & 4) ? 0x0c0c0c0cu : selA0, selBL = (lane & 4) ? 0x0c0c0c0cu : selB0, selAH = (lane & 4) ? selA0 : 0x0c0c0c0cu, selBH = (lane & 4) ? selB0 : 0x0c0c0c0cu;
    const int cqo = 128 * ((lane >> 1) & 1) + 32 * q4;
    const int ocol = 256 * S.x + 128 * (q4 & 1) + 64 * (q4 >> 1) + 2 * n16;
    u32x4 vq[2][16]; unsigned idw[2]; u32x4 cqa[2][2]; f32x2 csv[2]; unsigned xvb[2][2]; f32x2 gvv[2][2];
    const bf16_t* XR1 = (const bf16_t*)(p.ws + WS_XR1); bf16_t* XR2 = (bf16_t*)p.out;
    const int nit = (NT - S.wq + S.nwq - 1) / S.nwq;
#define PV_TOK(i) (S.wq + ((i) < nit ? (i) : nit - 1) * S.nwq)
#define PV_LOADID(s_, i) do { idw[s_] = ((const unsigned*)IDX)[(size_t)PV_TOK(i) * 64 + lane]; } while (0)
#define PV_LOADC(s_, i) do { const int t_ = PV_TOK(i); const unsigned char* cp_ = CQ2 + (size_t)t_ * 256 + cqo; cqa[s_][0] = *(const u32x4*)cp_; cqa[s_][1] = *(const u32x4*)(cp_ + 16); csv[s_] = CSC[t_]; \
        xvb[s_][0] = *(const unsigned*)(XR1 + (size_t)t_ * DM + ocol); xvb[s_][1] = *(const unsigned*)(XR1 + (size_t)t_ * DM + ocol + 32); gvv[s_][0] = *(const f32x2*)(MOD + (size_t)(t_ / SEQ) * MODW + 5 * DM + ocol); gvv[s_][1] = *(const f32x2*)(MOD + (size_t)(t_ / SEQ) * MODW + 5 * DM + ocol + 32); } while (0)
#define PV_IDS(s_) do { il[lane] = idw[s_]; const u32x4 i0_ = *(LAS u32x4*)(il + 8 * k), i1_ = *(LAS u32x4*)(il + 8 * k + 4); idr[0] = i0_.x; idr[1] = i0_.y; idr[2] = i0_.z; idr[3] = i0_.w; idr[4] = i1_.x; idr[5] = i1_.y; idr[6] = i1_.z; idr[7] = i1_.w; } while (0)
#define PV_G1(s_, BB) vq[s_][BB] = *(const u32x4*)(V8 + (size_t)((((BB) & 1) ? (idr[(BB) >> 1] >> 16) : (idr[(BB) >> 1] & 0xffffu)) * 128u + 16u * (unsigned)j))
#define PV_GATHER(s_, h_) do { PV_G1(s_, 8 * (h_) + 0); PV_G1(s_, 8 * (h_) + 1); PV_G1(s_, 8 * (h_) + 2); PV_G1(s_, 8 * (h_) + 3); PV_G1(s_, 8 * (h_) + 4); PV_G1(s_, 8 * (h_) + 5); PV_G1(s_, 8 * (h_) + 6); PV_G1(s_, 8 * (h_) + 7); } while (0)
#define PV_W1(s_, h_, B_) *(LAS u32x4*)(wl + 8192 * (h_) + 1024 * (B_) + (((B_) & 1) ? wb_o : wb_e)) = vq[s_][8 * (h_) + (B_)]
#define PV_WRITE(s_, h_) do { PV_W1(s_, h_, 0); PV_W1(s_, h_, 1); PV_W1(s_, h_, 2); PV_W1(s_, h_, 3); PV_W1(s_, h_, 4); PV_W1(s_, h_, 5); PV_W1(s_, h_, 6); PV_W1(s_, h_, 7); } while (0)
#define PV_TR(h_, ksl_, nt_, rd_) __builtin_amdgcn_ds_read_tr16_b64_v4i16((LAS s16x4*)(wl + 8192 * (h_) + 4096 * (ksl_) + 512 * (rd_) + rb[nt_]))
#define PV_MMA(h_) do { _Pragma("unroll") for (int ksl_ = 0; ksl_ < 2; ++ksl_) { const int ks_ = 2 * (h_) + ksl_; const unsigned w0_ = cw[2 * ks_], w1_ = cw[2 * ks_ + 1]; \
        const i32x4 AL_ = {(int)__builtin_amdgcn_perm(w0_, w0_, selAL), (int)__builtin_amdgcn_perm(w0_, w0_, selBL), (int)__builtin_amdgcn_perm(w1_, w1_, selAL), (int)__builtin_amdgcn_perm(w1_, w1_, selBL)}; \
        const i32x4 AH_ = {(int)__builtin_amdgcn_perm(w0_, w0_, selAH), (int)__builtin_amdgcn_perm(w0_, w0_, selBH), (int)__builtin_amdgcn_perm(w1_, w1_, selAH), (int)__builtin_amdgcn_perm(w1_, w1_, selBH)}; \
        _Pragma("unroll") for (int nt_ = 0; nt_ < 4; ++nt_) { const s16x4 b0_ = PV_TR(h_, ksl_, nt_, 0), b1_ = PV_TR(h_, ksl_, nt_, 1); const i32x2 c0_ = __builtin_bit_cast(i32x2, b0_), c1_ = __builtin_bit_cast(i32x2, b1_); \
            const i32x4 BL_ = {c0_.x & 0x0f0f0f0f, c0_.y & 0x0f0f0f0f, c1_.x & 0x0f0f0f0f, c1_.y & 0x0f0f0f0f}, BH_ = {c0_.x, c0_.y, c1_.x, c1_.y};     \
            acc[nt_] = __builtin_amdgcn_mfma_i32_16x16x64_i8(AL_, BL_, acc[nt_], 0, 0, 0); acc[nt_] = __builtin_amdgcn_mfma_i32_16x16x64_i8(AH_, BH_, acc[nt_], 0, 0, 0); } } } while (0)
    PV_LOADID(0, 0); PV_LOADID(1, 1); PV_LOADC(0, 0);
    PV_IDS(0); PV_GATHER(0, 0); PV_GATHER(0, 1); PV_IDS(1); PV_GATHER(1, 0); PV_GATHER(1, 1);
    PV_LOADID(0, 2);
    __builtin_amdgcn_s_waitcnt(0x0F70);
#pragma unroll 1
    for (int it = 0; it < nit; it += 2) {
#pragma unroll
        for (int a = 0; a < 2; ++a) {
            const int i = it + a, bq = 1 - a;
            const unsigned cw[8] = {cqa[a][0].x, cqa[a][0].y, cqa[a][0].z, cqa[a][0].w, cqa[a][1].x, cqa[a][1].y, cqa[a][1].z, cqa[a][1].w}; const f32x2 cback = csv[a]; const f32x2 xv0 = {__uint_as_float(xvb[a][0] << 16), __uint_as_float(xvb[a][0] & 0xffff0000u)}, xv1 = {__uint_as_float(xvb[a][1] << 16), __uint_as_float(xvb[a][1] & 0xffff0000u)}, gv0 = gvv[a][0], gv1 = gvv[a][1];
            PV_LOADC(bq, i + 1); PV_LOADID(bq, i + 3);
            i32x4 acc[4];
#pragma unroll
            for (int nt = 0; nt < 4; ++nt) acc[nt] = (i32x4){0, 0, 0, 0};
            PV_IDS(a); PV_WRITE(a, 0); PV_GATHER(a, 0); PV_MMA(0);
            PV_WRITE(a, 1); PV_GATHER(a, 1); PV_MMA(1);
            const i32x4 a0 = (q4 >> 1) ? acc[2] : acc[0], a1 = (q4 >> 1) ? acc[3] : acc[1];
            const float mf = (q4 & 1) ? cback.x * 0.0625f : cback.x, sb = (q4 & 1) ? 0.f : cback.y;
            int v00 = a0.x * 128 + a0.z, v01 = a0.y * 128 + a0.w, v10 = a1.x * 128 + a1.z, v11 = a1.y * 128 + a1.w;
            { const int p00 = __shfl_xor(v00, 16), p01 = __shfl_xor(v01, 16), p10 = __shfl_xor(v10, 16), p11 = __shfl_xor(v11, 16);
              if (q4 & 1) { v00 -= p00; v01 -= p01; v10 -= p10; v11 -= p11; } }
            const f32x2 y0 = {(float)v00 * mf - sb, (float)v01 * mf - sb}, y1 = {(float)v10 * mf - sb, (float)v11 * mf - sb};
            if (i < nit) {
                const int t = S.wq + i * S.nwq;
                const f32x2 o0 = xv0 + gv0 * y0, o1 = xv1 + gv1 * y1;
                if (l == 0) { *(unsigned*)(XR2 + (size_t)t * DM + ocol) = pg8::cvt_pk_bf16(o0.x, o0.y); *(unsigned*)(XR2 + (size_t)t * DM + ocol + 32) = pg8::cvt_pk_bf16(o1.x, o1.y); }
                else { *(f32x2*)(p.out + (size_t)t * DM + ocol) = o0; *(f32x2*)(p.out + (size_t)t * DM + ocol + 32) = o1; }
            }
        }
    }
#undef PV_TOK
#undef PV_LOADID
#undef PV_LOADC
#undef PV_GATHER
#undef PV_G1
#undef PV_W1
#undef PV_WRITE
#undef PV_TR
#undef PV_MMA
}

constexpr int PH_PER_LAYER = 11, NPH = 1 + 2 * PH_PER_LAYER;

__global__ void __launch_bounds__(NTHREADS, 2) mega(Prm p0) {
    extern __shared__ __attribute__((aligned(16))) unsigned char lds[];
    const int ph_lo = p0.ph_lo, ph_hi = p0.ph_hi;
    volatile LAS unsigned* bst = (volatile LAS unsigned*)((LAS unsigned char*)lds + (LDS_BYTES - 64));
    if (threadIdx.x < 16) bst[threadIdx.x] = 0u;
    __syncthreads();
    XcdBarrier bar = xcd_barrier_post((unsigned*)(p0.ws + WS_CTL), bst);
#define PHASE_BEGIN(k) if (ph_lo <= (k) && (k) < ph_hi) { Prm p = p0; Ctx C; \
        { size_t z_ = 0; asm volatile("" : "+s"(z_));     \
          p.x = (const float*)((const char*)p0.x + z_); p.c = (const float*)((const char*)p0.c + z_); p.ada_w = (const float*)((const char*)p0.ada_w + z_); p.ada_b = (const float*)((const char*)p0.ada_b + z_); \
          p.attn_norm = (const float*)((const char*)p0.attn_norm + z_); p.ffn_norm = (const float*)((const char*)p0.ffn_norm + z_); p.w_in = (const float*)((const char*)p0.w_in + z_); p.fox_bf = (const float*)((const char*)p0.fox_bf + z_); \
          p.gq = (const float*)((const char*)p0.gq + z_); p.gk = (const float*)((const char*)p0.gk + z_); p.w_branch = (const float*)((const char*)p0.w_branch + z_); p.w_out = (const float*)((const char*)p0.w_out + z_); \
          p.wq = (const float*)((const char*)p0.wq + z_); p.k1 = (const float*)((const char*)p0.k1 + z_); p.k2 = (const float*)((const char*)p0.k2 + z_); p.pu = (const float*)((const char*)p0.pu + z_); p.pv = (const float*)((const char*)p0.pv + z_); \
          p.out = (float*)((char*)p0.out + z_); p.ws = p0.ws + z_; } \
        C.tid = threadIdx.x; asm volatile("" : "+v"(C.tid)); C.lane = C.tid & 63; C.wave = __builtin_amdgcn_readfirstlane(C.tid >> 6); \
        C.gw = blockIdx.x * NWAVES + C.wave; C.ngw = gridDim.x * NWAVES;
#define PHASE_END(k) if ((k) + 1 < ph_hi) { xcd_barrier(bar); } }
    PHASE_BEGIN(0) ph_mod(p, C); ph_weights(p, C, lds); ph_convert_tables8s(p, C); PHASE_END(0)
#pragma unroll 1
    for (int l = 0; l < 2; ++l) {
        const int k0 = 1 + l * PH_PER_LAYER;
        PHASE_BEGIN(k0 + 0) ph_norm<true>(p, C, l, p.x, l == 0 ? (const bf16_t*)nullptr : (const bf16_t*)p.out, p.attn_norm + l * DM, 0, 1, lds); ph_peer_pre(p, C, l); PHASE_END(k0 + 0)
        PHASE_BEGIN(k0 + 1) ph_gemm1(p, l, lds); PHASE_END(k0 + 1)
        PHASE_BEGIN(k0 + 2) ph_attn<3>(p, C, l, lds); PHASE_END(k0 + 2)
        PHASE_BEGIN(k0 + 3) ph_merge(p, l, lds); PHASE_END(k0 + 3)
        PHASE_BEGIN(k0 + 4) ph_out(p, l, lds); PHASE_END(k0 + 4)
        PHASE_BEGIN(k0 + 6) ph_q(p, l, lds); PHASE_END(k0 + 6)
        PHASE_BEGIN(k0 + 7) ph_topk(p, C, l, lds); PHASE_END(k0 + 7)
        PHASE_BEGIN(k0 + 8) ph_peer_u4(p, C, l, lds); PHASE_END(k0 + 8)
        PHASE_BEGIN(k0 + 9) ph_peer_r2(p, C, l, lds); PHASE_END(k0 + 9)
        PHASE_BEGIN(k0 + 10) ph_peer_v2(p, C, l, lds); PHASE_END(k0 + 10)
    }
}

extern "C" void kernel_launch(void* const* d_in, const int* in_sizes, int n_in, void* d_out, int out_size, void* d_ws, size_t ws_size, hipStream_t stream) {
    static int grid = 0;
    if (grid == 0) {
        if (n_in != 17 || out_size != NT * DM || ws_size < WS_END) { fprintf(stderr, "kernel_launch: unexpected shapes (n_in %d out %d ws %zu)\n", n_in, out_size, ws_size); grid = -1; return; }
        int dev = 0, cus = 0, per_cu = 0;
        hipGetDevice(&dev); hipDeviceGetAttribute(&cus, hipDeviceAttributeMultiprocessorCount, dev);
        hipFuncSetAttribute((const void*)mega, hipFuncAttributeMaxDynamicSharedMemorySize, LDS_BYTES);
        hipOccupancyMaxActiveBlocksPerMultiprocessor(&per_cu, (const void*)mega, NTHREADS, LDS_BYTES);
        if (per_cu < 1) { fprintf(stderr, "kernel_launch: occupancy query says %d blocks per CU\n", per_cu); per_cu = 1; }
        (void)hipGetLastError();
        grid = cus;
    }
    if (grid < 0) return;
    if (hipMemsetAsync((char*)d_ws + WS_CTL, 0, 32768, stream) != hipSuccess) { fprintf(stderr, "kernel_launch: memset of the barrier words failed\n"); return; }
    Prm p{};
    const float** pp = (const float**)&p;
    for (int i = 0; i < 17; ++i) pp[i] = (const float*)d_in[i];
    p.out = (float*)d_out; p.ws = (unsigned char*)d_ws;
#if MK_MULTI
    for (int ph = 0; ph < NPH; ++ph) { p.ph_lo = ph; p.ph_hi = ph + 1; hipLaunchKernelGGL(mega, dim3(grid), dim3(NTHREADS), LDS_BYTES, stream, p); }
#else
    p.ph_lo = 0; p.ph_hi = NPH;
    void* args[] = {&p};
    hipError_t e = hipLaunchCooperativeKernel((const void*)mega, dim3(grid), dim3(NTHREADS), args, LDS_BYTES, stream);
    if (e != hipSuccess) fprintf(stderr, "cooperative launch failed: %s (grid %d)\n", hipGetErrorString(e), grid);
#endif
}
```

```cpp
#include <hip/hip_runtime.h>
#include <hip/hip_cooperative_groups.h>
#include <hip/hip_bf16.h>
#include <cstdio>
#include <cstdint>
namespace cg = cooperative_groups;

#ifndef MK_MULTI
#define MK_MULTI 0
#endif

constexpr int NB = 8, SEQ = 4096, DM = 1024, NT = NB * SEQ, NH = 8, HD = 64, INW = 5128, NEXP = 16384, NKEYS = 128, TOPK = 16;
constexpr int MODW = 6 * DM;
constexpr float EPS = 1e-6f;
constexpr float LOG2E = 1.4426950408889634f, LN2 = 0.6931471805599453f;
constexpr float C2 = 0.125f * LOG2E;
constexpr int NWAVES = 8, NTHREADS = 512;
constexpr int LDS_BYTES = 147456;

constexpr size_t MiB = 1u << 20;
constexpr size_t WS_CTL = 0;
constexpr size_t WS_MOD = 1 * MiB;
constexpr size_t WS_FA = 2 * MiB;
constexpr size_t WS_FC = 3 * MiB;
constexpr size_t WS_WIN = 4 * MiB;
constexpr size_t WS_WBR = 24 * MiB;
constexpr size_t WS_WOUT = 28 * MiB;
constexpr size_t WS_WQ = 32 * MiB;
constexpr size_t WS_K12 = 36 * MiB;
constexpr size_t WS_UB = 37 * MiB;
constexpr size_t WS_VB = 69 * MiB;
constexpr size_t WS_HB = 101 * MiB;
constexpr size_t WS_QQ = 165 * MiB;
constexpr size_t WS_KK = 229 * MiB;
constexpr size_t WS_VV = 293 * MiB;
constexpr size_t WS_GT = 357 * MiB;
constexpr size_t WS_SSQ = 485 * MiB;
constexpr size_t WS_BQ = 487 * MiB;
constexpr size_t WS_USH = 488 * MiB;
constexpr size_t WS_END = 490 * MiB;
constexpr size_t WS_XR1 = WS_GT + 64 * MiB;

typedef unsigned short bf16_t;
typedef float f32x4 __attribute__((ext_vector_type(4)));
typedef unsigned u32x4 __attribute__((ext_vector_type(4))); typedef unsigned u32x2 __attribute__((ext_vector_type(2)));

struct Prm {
    const float *x, *c, *ada_w, *ada_b, *attn_norm, *ffn_norm, *w_in, *fox_bf, *gq, *gk, *w_branch, *w_out, *wq, *k1, *k2, *pu, *pv;
    float* out; unsigned char* ws; int ph_lo, ph_hi;
};

__device__ __forceinline__ float bf2f(bf16_t v) { return __uint_as_float((unsigned)v << 16); }
__device__ __forceinline__ unsigned f2bf(float f) { unsigned u = __float_as_uint(f); return (u + 0x7fffu + ((u >> 16) & 1u)) >> 16; }
__device__ __forceinline__ unsigned pk2(float lo, float hi) { return f2bf(lo) | (f2bf(hi) << 16); }
template <int CTRL> __device__ __forceinline__ int dpp_i(int v) { return __builtin_amdgcn_update_dpp(0, v, CTRL, 0xF, 0xF, true); }
template <int CTRL> __device__ __forceinline__ float dpp_f(float v) { return __int_as_float(__builtin_amdgcn_update_dpp(0, __float_as_int(v), CTRL, 0xF, 0xF, true)); }
__device__ __forceinline__ float xsum32(float a, float b) { const auto r = __builtin_amdgcn_permlane32_swap(__float_as_uint(a), __float_as_uint(b), false, false); return __uint_as_float(r[0]) + __uint_as_float(r[1]); }
__device__ __forceinline__ float xsum16(float a, float b) { const auto r = __builtin_amdgcn_permlane16_swap(__float_as_uint(a), __float_as_uint(b), false, false); return __uint_as_float(r[0]) + __uint_as_float(r[1]); }
__device__ __forceinline__ float wave_sum(float v) {
    v += dpp_f<0xB1>(v); v += dpp_f<0x4E>(v); v += dpp_f<0x141>(v); v += dpp_f<0x140>(v);
    v = xsum16(v, v); v = xsum32(v, v);
    return v;
}
__device__ __forceinline__ float sigmoidf_(float a) { return 1.0f / (1.0f + __expf(-a)); }
__device__ __forceinline__ float log_sigmoidf_(float a) { return fminf(a, 0.f) - log1pf(expf(-fabsf(a))); }
__device__ __forceinline__ float softplus2(float z2) { return fmaxf(z2, 0.f) + __log2f(1.0f + exp2f(-fabsf(z2))); }

struct Ctx { int tid, lane, wave, gw, ngw; };

__device__ __forceinline__ void ph_mod(const Prm& p, const Ctx& C) {
    float* MOD = (float*)(p.ws + WS_MOD);
    for (int item = C.gw; item < 2 * (MODW / 8); item += C.ngw) {
        const int l = item / (MODW / 8), cb = (item % (MODW / 8)) * 8;
        float acc[8][8];
#pragma unroll
        for (int b = 0; b < 8; ++b)
#pragma unroll
            for (int j = 0; j < 8; ++j) acc[b][j] = 0.f;
        for (int i = 0; i < 16; ++i) {
            const int k = C.lane + 64 * i;
            const float* wp = p.ada_w + ((size_t)l * DM + k) * MODW + cb;
            const f32x4 w0 = *(const f32x4*)wp, w1 = *(const f32x4*)(wp + 4);
            const float w[8] = {w0.x, w0.y, w0.z, w0.w, w1.x, w1.y, w1.z, w1.w};
#pragma unroll
            for (int b = 0; b < 8; ++b) {
                const float cv = p.c[b * DM + k]; const float sv = cv * sigmoidf_(cv);
#pragma unroll
                for (int j = 0; j < 8; ++j) acc[b][j] += sv * w[j];
            }
        }
        float res = 0.f;
#pragma unroll
        for (int b = 0; b < 8; ++b)
#pragma unroll
            for (int j = 0; j < 8; ++j) { const float s = wave_sum(acc[b][j]); if (C.lane == b * 8 + j) res = s; }
        const int b = C.lane >> 3, j = C.lane & 7;
        MOD[((size_t)l * NB + b) * MODW + cb + j] = res + p.ada_b[l * MODW + cb + j];
    }
}

template <bool WITH_FA>
__device__ __forceinline__ void ph_norm(const Prm& p, const Ctx& C, int l, const float* xin, const bf16_t* xinb, const float* gain, int ch_sh, int ch_sc, unsigned char* lds) {
    const float* MOD = (const float*)(p.ws + WS_MOD) + (size_t)l * NB * MODW;
    bf16_t* HB = (bf16_t*)(p.ws + WS_HB);
    float* FA = (float*)(p.ws + WS_FA);
    f32x4 g4[4];
#pragma unroll
    for (int j = 0; j < 4; ++j) g4[j] = *(const f32x4*)(gain + 4 * C.lane + 256 * j);
    float* wfl = (float*)lds;
    if (WITH_FA) {
        for (int i = C.tid; i < DM * 8; i += NTHREADS) wfl[i] = p.w_in[((size_t)l * DM + (i >> 3)) * INW + 1536 + (i & 7)];
        __syncthreads();
    }
    for (int m0 = C.gw; m0 < NT; m0 += 2 * C.ngw) {
      f32x4 vv[2][4];
#pragma unroll
      for (int rr = 0; rr < 2; ++rr) { const size_t xo = (size_t)min(m0 + rr * C.ngw, NT - 1) * DM + 4 * C.lane;
        if (xinb == nullptr) {
#pragma unroll
            for (int j = 0; j < 4; ++j) vv[rr][j] = *(const f32x4*)(xin + xo + 256 * j);
        } else {
#pragma unroll
            for (int j = 0; j < 4; ++j) { const u32x2 w = *(const u32x2*)(xinb + xo + 256 * j); vv[rr][j] = (f32x4){__uint_as_float(w.x << 16), __uint_as_float(w.x & 0xffff0000u), __uint_as_float(w.y << 16), __uint_as_float(w.y & 0xffff0000u)}; } } }
      f32x4 shv[4], scv[4];
      { const int b0_ = m0 / SEQ;
#pragma unroll
        for (int j = 0; j < 4; ++j) { shv[j] = *(const f32x4*)(MOD + (size_t)b0_ * MODW + ch_sh * DM + 4 * C.lane + 256 * j); scv[j] = *(const f32x4*)(MOD + (size_t)b0_ * MODW + ch_sc * DM + 4 * C.lane + 256 * j); } }
#pragma unroll
      for (int rr = 0; rr < 2; ++rr) {
        const int m = m0 + rr * C.ngw; if (m >= NT) break;
        const int b = m / SEQ; const bool sameb = (b == m0 / SEQ);
        f32x4 v[4]; float s = 0.f;
#pragma unroll
        for (int j = 0; j < 4; ++j) { v[j] = vv[rr][j]; s += (v[j].x * v[j].x + v[j].y * v[j].y) + (v[j].z * v[j].z + v[j].w * v[j].w); }
        const float r = 1.0f / sqrtf(wave_sum(s) * (1.0f / DM) + EPS);
        const float* shp = MOD + (size_t)b * MODW + ch_sh * DM + 4 * C.lane;
        const float* scp = MOD + (size_t)b * MODW + ch_sc * DM + 4 * C.lane;
        float fa[8];
#pragma unroll
        for (int q = 0; q < 8; ++q) fa[q] = 0.f;
#pragma unroll
        for (int j = 0; j < 4; ++j) {
            const f32x4 sh = sameb ? shv[j] : *(const f32x4*)(shp + 256 * j), sc = sameb ? scv[j] : *(const f32x4*)(scp + 256 * j);
            f32x4 h = (v[j] * r) * g4[j] * (sc + 1.0f) + sh;
            unsigned long long o = (unsigned long long)pk2(h.x, h.y) | ((unsigned long long)pk2(h.z, h.w) << 32);
            *(unsigned long long*)(HB + (size_t)m * DM + 4 * C.lane + 256 * j) = o;
            if (WITH_FA) {
                const float hh[4] = {h.x, h.y, h.z, h.w};
#pragma unroll
                for (int e = 0; e < 4; ++e) {
                    const f32x4 wa = *(const f32x4*)(wfl + (4 * C.lane + 256 * j + e) * 8), wb = *(const f32x4*)(wfl + (4 * C.lane + 256 * j + e) * 8 + 4);
                    fa[0] += hh[e] * wa.x; fa[1] += hh[e] * wa.y; fa[2] += hh[e] * wa.z; fa[3] += hh[e] * wa.w;
                    fa[4] += hh[e] * wb.x; fa[5] += hh[e] * wb.y; fa[6] += hh[e] * wb.z; fa[7] += hh[e] * wb.w;
                }
            }
        }
        if (WITH_FA) {
            float res = 0.f;
#pragma unroll
            for (int q = 0; q < 8; ++q) { const float t = wave_sum(fa[q]); if (C.lane == q) res = t; }
            if (C.lane < 8) FA[(size_t)m * 8 + C.lane] = log_sigmoidf_(res + p.fox_bf[l * NH + C.lane]);
        }
      }
    }
    if (WITH_FA) __syncthreads();
}

namespace pg8 {
#define PG8_LAS __attribute__((address_space(3)))
typedef short bf16x8 __attribute__((ext_vector_type(8)));
constexpr int BM = 256, BK = 64, HALF = 128, HTB = HALF * BK * 2  , STAGE_BYTES = 8 * HTB, NXCD = 8, WGM = 8;
__host__ __device__ __forceinline__ int lds_byte(int r, int c) { const int st = (r >> 4) * 2 + (c >> 5), rr = r & 15, cc = c & 31, ob = rr * 64 + cc * 2; return st * 1024 + (ob ^ (((ob >> 9) & 1) << 5)); }
__host__ __device__ __forceinline__ void stage_rc(int b, int& R, int& C) { const int st = b / 1024, sb = b % 1024, swz = sb ^ (((sb >> 9) & 1) << 5); R = (st >> 1) * 16 + swz / 64; C = (st & 1) * 32 + (swz % 64) / 2; }
__host__ __device__ __forceinline__ int perm32(int rho) { const int n = rho >> 4, i = rho & 15; return 8 * (i >> 2) + 4 * n + (i & 3); }

struct Unit { int pm, pn, ka, kb, br; };
struct Gemm { const bf16_t* A; const bf16_t* Bt; int lda, ldb, K; };

struct Order {
    int nM, nN, nwg, G, c, pair;
    __device__ void init(int M, int N, int G_, int c_, int pair_) { nM = M / BM; nN = N / BM; nwg = nM * nN; G = G_; c = c_; pair = pair_; }
    __device__ bool next(int i, Unit& u) const {
        const int ii = pair ? (i >> 1) : i;
        const long L = (long)ii * G + c; if (L >= nwg) return false;
        int wgid = (int)L; { const int q = nwg / NXCD, r = nwg % NXCD, xcd = wgid % NXCD, off = wgid / NXCD; wgid = (xcd < r ? xcd * (q + 1) : r * (q + 1) + (xcd - r) * q) + off; }
        const int nig = WGM * nN, gid = wgid / nig, fm = gid * WGM, gsz = (nM - fm) < WGM ? (nM - fm) : WGM;
        u.pm = fm + ((wgid % nig) % gsz); u.pn = (wgid % nig) / gsz;
        u.br = pair ? (i & 1) : 0; u.ka = u.br * 512; u.kb = u.br * (1024 * 512);
        return true;
    }
    __device__ __forceinline__ void a_ready(const Unit&) const {}
    __device__ __forceinline__ void done(const Unit&) const {}
};

__device__ __forceinline__ unsigned cvt_pk_bf16(float lo, float hi) { unsigned r; asm volatile("v_cvt_pk_bf16_f32 %0, %1, %2" : "=v"(r) : "v"(lo), "v"(hi)); return r; }
__device__ __forceinline__ u32x4 pack8(const f32x4 a, const f32x4 b) { u32x4 w; w.x = cvt_pk_bf16(a[0], a[1]); w.y = cvt_pk_bf16(a[2], a[3]); w.z = cvt_pk_bf16(b[0], b[1]); w.w = cvt_pk_bf16(b[2], b[3]); return w; }
__device__ __forceinline__ void unpack8(const u32x4 w, f32x4& a, f32x4& b) {
    a = (f32x4){__uint_as_float(w.x << 16), __uint_as_float(w.x & 0xffff0000u), __uint_as_float(w.y << 16), __uint_as_float(w.y & 0xffff0000u)};
    b = (f32x4){__uint_as_float(w.z << 16), __uint_as_float(w.z & 0xffff0000u), __uint_as_float(w.w << 16), __uint_as_float(w.w & 0xffff0000u)};
}

struct Epi1 {
    static constexpr bool PERM = true, AFTER_DRAIN = false;
    bf16_t *QQ, *KK, *VV, *GT; const float *gq, *gk;
    __device__ __forceinline__ void operator()(const f32x4 (&acc)[2][2][4][2], const Unit& u, int wr, int wc, int fr, int fq) const {
        const int row0 = u.pm * BM + wr * 64 + fr;
        if (u.pn >= 12) {
            const int col0 = (u.pn - 12) * 256 + wc * 32 + 8 * fq;
#pragma unroll
            for (int ai = 0; ai < 2; ++ai)
#pragma unroll
                for (int m = 0; m < 4; ++m) { unsigned char* rowp = (unsigned char*)GT + (size_t)(row0 + ai * HALF + m * 16) * 2048 + col0;
#pragma unroll
                    for (int bj = 0; bj < 2; ++bj) { const f32x4 a0 = acc[ai][bj][m][0], a1 = acc[ai][bj][m][1];
                        u32x2 w; unsigned t_ = __builtin_amdgcn_cvt_pk_u8_f32(rintf(255.0f * sigmoidf_(a0[0])), 0, 0u); t_ = __builtin_amdgcn_cvt_pk_u8_f32(rintf(255.0f * sigmoidf_(a0[1])), 1, t_); t_ = __builtin_amdgcn_cvt_pk_u8_f32(rintf(255.0f * sigmoidf_(a0[2])), 2, t_); w.x = __builtin_amdgcn_cvt_pk_u8_f32(rintf(255.0f * sigmoidf_(a0[3])), 3, t_);
                        t_ = __builtin_amdgcn_cvt_pk_u8_f32(rintf(255.0f * sigmoidf_(a1[0])), 0, 0u); t_ = __builtin_amdgcn_cvt_pk_u8_f32(rintf(255.0f * sigmoidf_(a1[1])), 1, t_); t_ = __builtin_amdgcn_cvt_pk_u8_f32(rintf(255.0f * sigmoidf_(a1[2])), 2, t_); w.y = __builtin_amdgcn_cvt_pk_u8_f32(rintf(255.0f * sigmoidf_(a1[3])), 3, t_);
                        *(u32x2*)(rowp + bj * HALF) = w; } }
        } else {
            const int kind = u.pn >> 1, head = (u.pn & 1) * 4 + wc, k3 = kind % 3;
            bf16_t* base = (k3 == 0 ? QQ : (k3 == 1 ? KK : VV)) + (kind >= 3 ? 512 : 0) + head * 64 + 8 * fq;
            const bool nrm = kind < 2; const float qs = (k3 == 0) ? C2 : 1.0f;
            f32x4 gn[2][2];
#pragma unroll
            for (int bj = 0; bj < 2; ++bj)
#pragma unroll
                for (int n = 0; n < 2; ++n) gn[bj][n] = nrm ? *(const f32x4*)((kind == 0 ? gq : gk) + bj * 32 + 8 * fq + 4 * n) : (f32x4){1.f, 1.f, 1.f, 1.f};
#pragma unroll
            for (int ai = 0; ai < 2; ++ai)
#pragma unroll
                for (int m = 0; m < 4; ++m) {
                    float r = qs;
                    if (nrm) { float ss = 0.f;
#pragma unroll
                        for (int bj = 0; bj < 2; ++bj)
#pragma unroll
                            for (int n = 0; n < 2; ++n) { const f32x4 x = acc[ai][bj][m][n]; ss += (x[0] * x[0] + x[1] * x[1]) + (x[2] * x[2] + x[3] * x[3]); }
                        ss = xsum16(ss, ss); ss = xsum32(ss, ss);
                        r = qs * __builtin_amdgcn_rsqf(ss * (1.0f / 64.0f) + EPS); }
                    bf16_t* rowp = base + (size_t)(row0 + ai * HALF + m * 16) * DM;
#pragma unroll
                    for (int bj = 0; bj < 2; ++bj) *(u32x4*)(rowp + bj * 32) = pack8(acc[ai][bj][m][0] * r * gn[bj][0], acc[ai][bj][m][1] * r * gn[bj][1]);
                }
        }
    }
};
struct EpiGate {
    static constexpr bool PERM = true, AFTER_DRAIN = false;
    const bf16_t* GT; bf16_t* MG;
    __device__ __forceinline__ void operator()(const f32x4 (&acc)[2][2][4][2], const Unit& u, int wr, int wc, int fr, int fq) const {
        const int row0 = u.pm * BM + wr * 64 + fr, col0 = u.pn * BM + wc * 32 + 8 * fq;
#pragma unroll
        for (int ai = 0; ai < 2; ++ai)
#pragma unroll
            for (int m = 0; m < 4; ++m) { const size_t row = (size_t)(row0 + ai * HALF + m * 16);
#pragma unroll
                for (int bj = 0; bj < 2; ++bj) { const int c = col0 + bj * HALF;
                    f32x4 g0, g1; unpack8(*(const u32x4*)(GT + row * 2048 + u.br * 1024 + c), g0, g1);
                    f32x4 v0 = g0 * acc[ai][bj][m][0], v1 = g1 * acc[ai][bj][m][1];
                    if (u.br) { f32x4 o0, o1; unpack8(*(const u32x4*)(MG + row * DM + c), o0, o1); v0 += o0; v1 += o1; }
                    *(u32x4*)(MG + row * DM + c) = pack8(v0, v1); } }
    }
};
struct EpiMerge {
    static constexpr bool PERM = true, AFTER_DRAIN = false, MIDHOOK = true;
    const unsigned char* GT; bf16_t* MG;
    static __device__ __forceinline__ void unpackb(const u32x2 w, f32x4& a, f32x4& b) {
        a = (f32x4){(float)(w.x & 255u), (float)((w.x >> 8) & 255u), (float)((w.x >> 16) & 255u), (float)(w.x >> 24)};
        b = (f32x4){(float)(w.y & 255u), (float)((w.y >> 8) & 255u), (float)((w.y >> 16) & 255u), (float)(w.y >> 24)}; }
    static constexpr float TINY = 255.0f * 9.094947e-13f;
    __device__ __forceinline__ void mid(f32x4 (&acc)[2][2][4][2], const Unit& u, int wr, int wc, int fr_, int fq_) const {
        int fr = fr_, fq = fq_; asm volatile("" : "+v"(fr), "+v"(fq));
        const int row0 = u.pm * BM + wr * 64 + fr, col0 = u.pn * BM + wc * 32 + 8 * fq;
#pragma unroll
        for (int ai = 0; ai < 2; ++ai) {
            u32x2 ga[4][2], gb[4][2];
#pragma unroll
            for (int m = 0; m < 4; ++m) { const size_t row = (size_t)(row0 + ai * HALF + m * 16);
#pragma unroll
                for (int bj = 0; bj < 2; ++bj) { const int c = col0 + bj * HALF; ga[m][bj] = *(const u32x2*)(GT + row * 2048 + c); gb[m][bj] = *(const u32x2*)(GT + row * 2048 + 1024 + c); } }
#pragma unroll
            for (int m = 0; m < 4; ++m) {
#pragma unroll
                for (int bj = 0; bj < 2; ++bj) { f32x4 a0, a1, b0, b1; unpackb(ga[m][bj], a0, a1); unpackb(gb[m][bj], b0, b1);
#pragma unroll
                    for (int e = 0; e < 4; ++e) { acc[ai][bj][m][0][e] *= a0[e] * __builtin_amdgcn_rcpf(fmaxf(b0[e], TINY)); acc[ai][bj][m][1][e] *= a1[e] * __builtin_amdgcn_rcpf(fmaxf(b1[e], TINY)); } } }
            asm volatile("" ::: "memory"); __builtin_amdgcn_sched_barrier(0); }
    }
    __device__ __forceinline__ void operator()(const f32x4 (&acc)[2][2][4][2], const Unit& u, int wr, int wc, int fr, int fq) const {
        const int row0 = u.pm * BM + wr * 64 + fr, col0 = u.pn * BM + wc * 32 + 8 * fq;
#pragma unroll
        for (int ai = 0; ai < 2; ++ai) {
            u32x2 gb[4][2];
#pragma unroll
            for (int m = 0; m < 4; ++m)
#pragma unroll
                for (int bj = 0; bj < 2; ++bj) gb[m][bj] = *(const u32x2*)(GT + (size_t)(row0 + ai * HALF + m * 16) * 2048 + 1024 + col0 + bj * HALF);
#pragma unroll
            for (int m = 0; m < 4; ++m) { const size_t row = (size_t)(row0 + ai * HALF + m * 16);
#pragma unroll
                for (int bj = 0; bj < 2; ++bj) { const int c = col0 + bj * HALF;
                    f32x4 b0, b1; unpackb(gb[m][bj], b0, b1);
                    f32x4 v0, v1;
#pragma unroll
                    for (int e = 0; e < 4; ++e) { v0[e] = acc[ai][bj][m][0][e] * (fmaxf(b0[e], TINY) * (1.0f / 255.0f)); v1[e] = acc[ai][bj][m][1][e] * (fmaxf(b1[e], TINY) * (1.0f / 255.0f)); }
                    *(u32x4*)(MG + row * DM + c) = pack8(v0, v1); } } }
    }
};
template <bool XBF>
struct EpiOut {
    static constexpr bool PERM = true, AFTER_DRAIN = false;
    const float* xin; const bf16_t* xinb; bf16_t* xr1; const float* g1;
    const float* gain; bf16_t* XA; float* SSQ;
    __device__ __forceinline__ void operator()(const f32x4 (&acc)[2][2][4][2], const Unit& u, int wr, int wc, int fr, int fq) const {
        const int row0 = u.pm * BM + wr * 64 + fr, col0 = u.pn * BM + wc * 32 + 8 * fq; const int b = (u.pm * BM) / SEQ;
        f32x4 gv[2][2], gs[2][2];
#pragma unroll
        for (int bj = 0; bj < 2; ++bj)
#pragma unroll
            for (int n = 0; n < 2; ++n) { gv[bj][n] = *(const f32x4*)(g1 + (size_t)b * MODW + col0 + bj * HALF + 4 * n);
                gs[bj][n] = *(const f32x4*)(gain + col0 + bj * HALF + 4 * n) * (*(const f32x4*)(g1 + (size_t)b * MODW + 2 * DM + col0 + bj * HALF + 4 * n) + 1.0f); }
#pragma unroll
        for (int ai = 0; ai < 2; ++ai)
#pragma unroll
          for (int mp = 0; mp < 2; ++mp) {
            f32x4 xr[2][2][2];
#pragma unroll
            for (int mm = 0; mm < 2; ++mm)
#pragma unroll
                for (int bj = 0; bj < 2; ++bj)
#pragma unroll
                    for (int n = 0; n < 2; ++n) { if constexpr (!XBF) xr[mm][bj][n] = *(const f32x4*)(xin + (size_t)(row0 + ai * HALF + (2 * mp + mm) * 16) * DM + col0 + bj * HALF + 4 * n); }
            if constexpr (XBF) {
#pragma unroll
                for (int mm = 0; mm < 2; ++mm)
#pragma unroll
                    for (int bj = 0; bj < 2; ++bj) unpack8(*(const u32x4*)(xinb + (size_t)(row0 + ai * HALF + (2 * mp + mm) * 16) * DM + col0 + bj * HALF), xr[mm][bj][0], xr[mm][bj][1]); }
#pragma unroll
            for (int mm = 0; mm < 2; ++mm) { const int m = 2 * mp + mm; const size_t row = (size_t)(row0 + ai * HALF + m * 16), off = row * DM + col0; float ss = 0.f;
#pragma unroll
                for (int bj = 0; bj < 2; ++bj) { f32x4 x1[2];
#pragma unroll
                    for (int n = 0; n < 2; ++n) { const f32x4 xv = xr[mm][bj][n]; x1[n] = xv + gv[bj][n] * acc[ai][bj][m][n];
                        ss += (x1[n][0] * x1[n][0] + x1[n][1] * x1[n][1]) + (x1[n][2] * x1[n][2] + x1[n][3] * x1[n][3]); }
                    *(u32x4*)(xr1 + off + bj * HALF) = pack8(x1[0], x1[1]);
                    *(u32x4*)(XA + off + bj * HALF) = pack8(x1[0] * gs[bj][0], x1[1] * gs[bj][1]); }
                ss = xsum16(ss, ss); ss = xsum32(ss, ss);
                if (fq == 0) SSQ[row * 16 + u.pn * 4 + wc] = ss; } }
    }
};
struct EpiQ {
    static constexpr bool PERM = true, AFTER_DRAIN = false;
    bf16_t* O; const float* SSQ; const float* bq; float* RT;
    __device__ __forceinline__ void operator()(const f32x4 (&acc)[2][2][4][2], const Unit& u, int wr, int wc, int fr, int fq) const {
        const int row0 = u.pm * BM + wr * 64 + fr, col0 = u.pn * BM + wc * 32 + 8 * fq; const int b = (u.pm * BM) / SEQ;
        f32x4 bv[2][2];
#pragma unroll
        for (int bj = 0; bj < 2; ++bj)
#pragma unroll
            for (int n = 0; n < 2; ++n) bv[bj][n] = *(const f32x4*)(bq + (size_t)b * DM + col0 + bj * HALF + 4 * n);
        float rr[2][4];
#pragma unroll
        for (int ai = 0; ai < 2; ++ai)
#pragma unroll
            for (int m = 0; m < 4; ++m) { const size_t row = (size_t)(row0 + ai * HALF + m * 16);
                const f32x4 sq = *(const f32x4*)(SSQ + row * 16 + 4 * fq);
                float st = (sq[0] + sq[1]) + (sq[2] + sq[3]); st = xsum16(st, st); st = xsum32(st, st);
                rr[ai][m] = __builtin_amdgcn_rsqf(st * (1.0f / DM) + EPS); }
#pragma unroll
        for (int ai = 0; ai < 2; ++ai)
#pragma unroll
            for (int m = 0; m < 4; ++m) { const size_t row = (size_t)(row0 + ai * HALF + m * 16); const float r = rr[ai][m];
                bf16_t* rowp = O + row * DM + col0;
                if (u.pn == 0 && wc == 0 && fq == 0) RT[row] = r;
#pragma unroll
                for (int bj = 0; bj < 2; ++bj) *(u32x4*)(rowp + bj * HALF) = pack8(acc[ai][bj][m][0] * r + bv[bj][0], acc[ai][bj][m][1] * r + bv[bj][1]); }
    }
};
struct EpiBf {
    static constexpr bool PERM = true, AFTER_DRAIN = false;
    bf16_t* O; int ldc;
    __device__ __forceinline__ void operator()(const f32x4 (&acc)[2][2][4][2], const Unit& u, int wr, int wc, int fr, int fq) const {
        const int row0 = u.pm * BM + wr * 64 + fr, col0 = u.pn * BM + wc * 32 + 8 * fq;
#pragma unroll
        for (int ai = 0; ai < 2; ++ai)
#pragma unroll
            for (int m = 0; m < 4; ++m) { bf16_t* rowp = O + (size_t)(row0 + ai * HALF + m * 16) * ldc + col0;
#pragma unroll
                for (int bj = 0; bj < 2; ++bj) *(u32x4*)(rowp + bj * HALF) = pack8(acc[ai][bj][m][0], acc[ai][bj][m][1]); }
    }
};

template <class E_, class = void> struct has_midhook { static constexpr bool value = false; };
template <class E_> struct has_midhook<E_, decltype((void)E_::MIDHOOK)> { static constexpr bool value = true; };
template <class Epi, class Sched, bool ALIGN_EPI = false, bool SP2 = false>
__device__ __forceinline__ void gemm_phase(PG8_LAS unsigned char* lds, const Gemm g, const Sched& S, const Epi& E) {
    int tid_ = threadIdx.x; asm volatile("" : "+v"(tid_));
    const int tid = tid_, wid = __builtin_amdgcn_readfirstlane(tid >> 6), lane = tid & 63, wr = wid >> 2, wc = wid & 3, fr = lane & 15, fq = lane >> 4;
    const int K = g.K, nt = K / BK;
    unsigned voffA[2], voffB[2];
#pragma unroll
    for (int i = 0; i < 2; ++i) { int R, C; stage_rc(tid * 16 + i * 8192, R, C); const int Rb = Epi::PERM ? ((R & ~31) + perm32(R & 31)) : R;
        voffA[i] = (unsigned)(R * g.lda + C) * 2u; voffB[i] = (unsigned)(Rb * g.ldb + C) * 2u; }
    const size_t kstep = (size_t)(BK * 2);
    const size_t hsA = (size_t)HALF * g.lda * 2, hsB = (size_t)HALF * g.ldb * 2;
    const size_t tsA = 2 * hsA, tsB = 2 * hsB;
    const unsigned ldsw = (unsigned)wid * 1024u;
    const int aoff = lds_byte(wr * 64 + fr, fq * 8), boff = lds_byte(wc * 32 + fr, fq * 8);
#define PG8_SA(b, h) (((b) * 2 + (h)) * HTB)
#define PG8_SB(b, h) ((4 + (b) * 2 + (h)) * HTB)
#define PG8_STAGE(bufoff, gbase, voff) do { _Pragma("unroll") for (int _i = 0; _i < 2; ++_i) \
        __builtin_amdgcn_global_load_lds((const unsigned*)((const char*)(gbase) + (voff)[_i]), (PG8_LAS unsigned*)(lds + (bufoff) + ldsw + _i * 8192), 16, 0, 0); } while (0)
#define PG8_LDA(dst, b, h) do { _Pragma("unroll") for (int m = 0; m < 4; ++m) _Pragma("unroll") for (int k = 0; k < 2; ++k) dst[m][k] = *(const PG8_LAS bf16x8*)(lds + PG8_SA(b, h) + aoff + m * 2048 + k * 1024); } while (0)
#define PG8_LDB(dst, b, h) do { _Pragma("unroll") for (int n = 0; n < 2; ++n) _Pragma("unroll") for (int k = 0; k < 2; ++k) dst[n][k] = *(const PG8_LAS bf16x8*)(lds + PG8_SB(b, h) + boff + n * 2048 + k * 1024); } while (0)
#define PG8_MMA(ai, bj, At, Bt) do { __builtin_amdgcn_s_setprio(1); _Pragma("unroll") for (int m = 0; m < 4; ++m) _Pragma("unroll") for (int n = 0; n < 2; ++n) _Pragma("unroll") for (int k = 0; k < 2; ++k) \
        acc[ai][bj][m][n] = __builtin_amdgcn_mfma_f32_16x16x32_bf16(Bt[n][k], At[m][k], acc[ai][bj][m][n], 0, 0, 0); __builtin_amdgcn_s_setprio(0); } while (0)
#define PG8_WAIT_V(n) asm volatile("s_waitcnt vmcnt(" #n ")" ::: "memory")
#define PG8_WAIT_L(n) asm volatile("s_waitcnt lgkmcnt(" #n ")" ::: "memory")
#define PG8_BAR __builtin_amdgcn_s_barrier()
#define PG8_SCHED __builtin_amdgcn_sched_barrier(0)
    Unit cur, nxt; int ui = 0;
    if (!S.next(0, cur)) return;
    f32x4 acc[2][2][4][2];
#pragma unroll
    for (int a = 0; a < 2; ++a)
#pragma unroll
        for (int b = 0; b < 2; ++b)
#pragma unroll
            for (int m = 0; m < 4; ++m)
#pragma unroll
                for (int n = 0; n < 2; ++n) acc[a][b][m][n] = (f32x4){0.f, 0.f, 0.f, 0.f};
    bf16x8 At[4][2], B0[2][2], B1[2][2];
    const char* cA = (const char*)g.A + (size_t)cur.pm * tsA + (size_t)cur.ka * 2; const char* cB = (const char*)g.Bt + (size_t)cur.pn * tsB + (size_t)cur.kb * 2;
    S.a_ready(cur);
    if constexpr (SP2) {
        PG8_STAGE(PG8_SB(0, 0), cB, voffB); PG8_STAGE(PG8_SB(0, 1), cB + hsB, voffB); PG8_STAGE(PG8_SA(0, 0), cA, voffA); PG8_STAGE(PG8_SA(0, 1), cA + hsA, voffA);
        if (wr == 1) PG8_BAR;
        PG8_WAIT_V(2); PG8_BAR;
        PG8_STAGE(PG8_SB(1, 0), cB + kstep, voffB); PG8_STAGE(PG8_SA(1, 0), cA + kstep, voffA); PG8_STAGE(PG8_SB(1, 1), cB + hsB + kstep, voffB);
        PG8_WAIT_V(6); PG8_BAR;
    } else {
        PG8_STAGE(PG8_SB(0, 0), cB, voffB); PG8_STAGE(PG8_SA(0, 0), cA, voffA); PG8_STAGE(PG8_SB(0, 1), cB + hsB, voffB); PG8_STAGE(PG8_SA(0, 1), cA + hsA, voffA);
        if (wr == 1) PG8_BAR;
        PG8_WAIT_V(4); PG8_BAR;
        PG8_STAGE(PG8_SB(1, 0), cB + kstep, voffB); PG8_STAGE(PG8_SA(1, 0), cA + kstep, voffA); PG8_STAGE(PG8_SB(1, 1), cB + hsB + kstep, voffB);
        PG8_WAIT_V(6); PG8_BAR;
    }
    for (;;) {
        const bool has_next = S.next(ui + 1, nxt);
        const char* nA = has_next ? (const char*)g.A + (size_t)nxt.pm * tsA + (size_t)nxt.ka * 2 : cA; const char* nB = has_next ? (const char*)g.Bt + (size_t)nxt.pn * tsB + (size_t)nxt.kb * 2 : cB;
        for (int t = 0; t < nt; t += 2) {
            if constexpr (has_midhook<Epi>::value) { if (t == nt / 2) E.mid(acc, cur, wr, wc, fr, fq); }
            const bool last = (t == nt - 2);
            const char* a1 = cA + (size_t)(t + 1) * kstep;
            const char* a2 = last ? nA : cA + (size_t)(t + 2) * kstep; const char* b2 = last ? nB : cB + (size_t)(t + 2) * kstep;
            const char* a3 = a2 + kstep; const char* b3 = b2 + kstep;
            if (last && has_next) S.a_ready(nxt);
            if constexpr (SP2) {
            PG8_LDB(B0, 0, 0); PG8_LDB(B1, 0, 1); PG8_SCHED; PG8_LDA(At, 0, 0); PG8_STAGE(PG8_SA(1, 1), a1 + hsA, voffA);
            PG8_WAIT_V(8); PG8_WAIT_L(0); PG8_BAR; PG8_MMA(0, 0, At, B0); PG8_MMA(0, 1, At, B1); PG8_BAR; PG8_SCHED;
            PG8_LDA(At, 0, 1); PG8_STAGE(PG8_SB(0, 0), b2, voffB); PG8_STAGE(PG8_SB(0, 1), b2 + hsB, voffB); PG8_STAGE(PG8_SA(0, 0), a2, voffA);
            PG8_WAIT_V(8); PG8_WAIT_L(0); PG8_BAR; PG8_MMA(1, 0, At, B0); PG8_MMA(1, 1, At, B1); PG8_BAR; PG8_SCHED;
            PG8_LDB(B0, 1, 0); PG8_LDB(B1, 1, 1); PG8_SCHED; PG8_LDA(At, 1, 0); PG8_STAGE(PG8_SA(0, 1), a2 + hsA, voffA);
            PG8_WAIT_V(8); PG8_WAIT_L(0); PG8_BAR; PG8_MMA(0, 0, At, B0); PG8_MMA(0, 1, At, B1); PG8_BAR; PG8_SCHED;
            PG8_LDA(At, 1, 1); PG8_STAGE(PG8_SB(1, 0), b3, voffB); PG8_STAGE(PG8_SB(1, 1), b3 + hsB, voffB); PG8_STAGE(PG8_SA(1, 0), a3, voffA);
            PG8_WAIT_V(8); PG8_WAIT_L(0); PG8_BAR; PG8_MMA(1, 0, At, B0); PG8_MMA(1, 1, At, B1); PG8_BAR; PG8_SCHED;
            } else {
            PG8_LDB(B0, 0, 0); PG8_SCHED; PG8_LDA(At, 0, 0); PG8_STAGE(PG8_SA(1, 1), a1 + hsA, voffA);
            PG8_WAIT_L(8); PG8_BAR; PG8_WAIT_L(0); PG8_MMA(0, 0, At, B0); PG8_BAR; PG8_SCHED;
            PG8_LDB(B1, 0, 1); PG8_STAGE(PG8_SB(0, 0), b2, voffB);
            PG8_BAR; PG8_WAIT_L(0); PG8_MMA(0, 1, At, B1); PG8_BAR;
            PG8_LDA(At, 0, 1); PG8_STAGE(PG8_SA(0, 0), a2, voffA);
            PG8_BAR; PG8_WAIT_L(0); PG8_MMA(1, 0, At, B0); PG8_BAR; PG8_SCHED;
            PG8_STAGE(PG8_SB(0, 1), b2 + hsB, voffB);
            PG8_WAIT_V(6); PG8_BAR; PG8_MMA(1, 1, At, B1); PG8_BAR;
            PG8_LDB(B0, 1, 0); PG8_SCHED; PG8_LDA(At, 1, 0); PG8_STAGE(PG8_SA(0, 1), a2 + hsA, voffA);
            PG8_WAIT_L(8); PG8_BAR; PG8_WAIT_L(0); PG8_MMA(0, 0, At, B0); PG8_BAR; PG8_SCHED;
            PG8_LDB(B1, 1, 1); PG8_STAGE(PG8_SB(1, 0), b3, voffB);
            PG8_BAR; PG8_WAIT_L(0); PG8_MMA(0, 1, At, B1); PG8_BAR;
            PG8_LDA(At, 1, 1); PG8_STAGE(PG8_SA(1, 0), a3, voffA);
            PG8_BAR; PG8_WAIT_L(0); PG8_MMA(1, 0, At, B0); PG8_BAR; PG8_SCHED;
            PG8_STAGE(PG8_SB(1, 1), b3 + hsB, voffB);
            PG8_WAIT_V(6); PG8_BAR; PG8_MMA(1, 1, At, B1); PG8_BAR;
            }
        }
        if constexpr (ALIGN_EPI) { if (wr == 0) PG8_BAR; }
        if constexpr (!Epi::AFTER_DRAIN) { E(acc, cur, wr, wc, fr, fq); S.done(cur); }
        if (!has_next) break;
#pragma unroll
        for (int a = 0; a < 2; ++a)
#pragma unroll
            for (int b = 0; b < 2; ++b)
#pragma unroll
                for (int m = 0; m < 4; ++m)
#pragma unroll
                    for (int n = 0; n < 2; ++n) acc[a][b][m][n] = (f32x4){0.f, 0.f, 0.f, 0.f};
        cur = nxt; cA = nA; cB = nB; ++ui;
        if constexpr (ALIGN_EPI) { if (wr == 1) PG8_BAR; }
    }
    PG8_WAIT_V(0);
    if constexpr (!ALIGN_EPI) { if (wr == 0) PG8_BAR; }
    PG8_BAR;
    if constexpr (Epi::AFTER_DRAIN) { E.fused(acc, cur, wr, wc, fr, fq, lds, wid, lane); S.done(cur); }
#undef PG8_SA
#undef PG8_SB
#undef PG8_STAGE
#undef PG8_LDA
#undef PG8_LDB
#undef PG8_MMA
#undef PG8_WAIT_V
#undef PG8_WAIT_L
#undef PG8_BAR
#undef PG8_SCHED
}
}

__device__ __forceinline__ int win_logical_col(int n) {
    const int pn = n >> 8, tc = n & 255;
    if (pn >= 12) return 3080 + (pn - 12) * 256 + tc;
    const int kind = pn >> 1, bj = tc >> 7, wc = (tc >> 5) & 3, i = tc & 31;
    const int base = (kind < 3) ? kind * 512 : 1544 + (kind - 3) * 512;
    return base + ((pn & 1) * 4 + wc) * 64 + bj * 32 + i;
}
__device__ __forceinline__ void transpose_item(const float* W, int ldw, int src_c0, int k0, bf16_t* WT, int K, int dst_row0, float* scr, int lane) {
#pragma unroll 8
    for (int i = 0; i < 32; ++i) { const int kk = 2 * i + (lane >> 5); scr[kk * 33 + (lane & 31)] = W[(size_t)(k0 + kk) * ldw + src_c0 + (lane & 31)]; }
    __builtin_amdgcn_s_waitcnt(0xc07f); asm volatile("" ::: "memory");
    const int c = lane & 7;
#pragma unroll
    for (int j = 0; j < 4; ++j) { const int n = (lane >> 3) + 8 * j; const float* s = scr + (8 * c) * 33 + n;
        u32x4 o; o.x = pk2(s[0 * 33], s[1 * 33]); o.y = pk2(s[2 * 33], s[3 * 33]); o.z = pk2(s[4 * 33], s[5 * 33]); o.w = pk2(s[6 * 33], s[7 * 33]);
        *(u32x4*)(WT + (size_t)(dst_row0 + n) * K + k0 + 8 * c) = o; }
    __builtin_amdgcn_s_waitcnt(0xc07f); asm volatile("" ::: "memory");
}
__device__ __forceinline__ void ph_weights(const Prm& p, const Ctx& C, unsigned char* lds) {
    float* scr = (float*)(lds + C.wave * 16384);
    bf16_t* WIN = (bf16_t*)(p.ws + WS_WIN); bf16_t* WBR = (bf16_t*)(p.ws + WS_WBR); bf16_t* WOUT = (bf16_t*)(p.ws + WS_WOUT); bf16_t* WQT = (bf16_t*)(p.ws + WS_WQ);
    constexpr int I_IN = 16 * 160, I_BR = 8 * 32, I_SQ = 16 * 32;
    constexpr int NITEMS = 2 * I_IN + 4 * I_BR + 2 * I_SQ + 2 * I_SQ;
    for (int it = C.gw; it < NITEMS; it += C.ngw) {
        int r = it;
        if (r < 2 * I_IN) { const int l = r / I_IN, q = r % I_IN, kb = q / 160, nb = q % 160;
            transpose_item(p.w_in + (size_t)l * DM * INW, INW, win_logical_col(32 * nb), 64 * kb, WIN + (size_t)l * 5120 * DM, DM, 32 * nb, scr, C.lane); continue; }
        r -= 2 * I_IN;
        if (r < 4 * I_BR) { const int lg = r / I_BR, q = r % I_BR, kb = q / 32, nb = q % 32;
            transpose_item(p.w_branch + (size_t)lg * 512 * DM, DM, 32 * nb, 64 * kb, WBR + (size_t)(lg >> 1) * DM * DM + (lg & 1) * 512, DM, 32 * nb, scr, C.lane); continue; }
        r -= 4 * I_BR;
        if (r < 2 * I_SQ) { const int l = r / I_SQ, q = r % I_SQ, kb = q / 32, nb = q % 32;
            transpose_item(p.w_out + (size_t)l * DM * DM, DM, 32 * nb, 64 * kb, WOUT + (size_t)l * DM * DM, DM, 32 * nb, scr, C.lane); continue; }
        r -= 2 * I_SQ;
        { const int l = r / I_SQ, q = r % I_SQ, kb = q / 32, nb = q % 32;
            transpose_item(p.wq + (size_t)l * DM * DM, DM, 32 * nb, 64 * kb, WQT + (size_t)l * DM * DM, DM, 32 * nb, scr, C.lane); }
    }
}
#define LDSP(p) ((PG8_LAS unsigned char*)(p))
__device__ __forceinline__ void ph_gemm1(const Prm& p, int l, unsigned char* lds) {
    pg8::Gemm g{(const bf16_t*)(p.ws + WS_HB), (const bf16_t*)(p.ws + WS_WIN) + (size_t)l * 5120 * DM, DM, DM, DM};
    pg8::Order S; S.init(NT, 5120, gridDim.x, blockIdx.x, 0);
    pg8::Epi1 E{(bf16_t*)(p.ws + WS_QQ), (bf16_t*)(p.ws + WS_KK), (bf16_t*)(p.ws + WS_VV), (bf16_t*)(p.ws + WS_GT), p.gq + l * HD, p.gk + l * HD};
    pg8::gemm_phase<pg8::Epi1, pg8::Order, true, true>(LDSP(lds), g, S, E);
}
__device__ __forceinline__ void ph_merge(const Prm& p, int l, unsigned char* lds) {
    pg8::Gemm g{(const bf16_t*)(p.ws + WS_QQ), (const bf16_t*)(p.ws + WS_WBR) + (size_t)l * DM * DM, DM, DM, DM};
    pg8::Order S; S.init(NT, DM, gridDim.x, blockIdx.x, 0);
    pg8::EpiMerge E{(const unsigned char*)(p.ws + WS_GT), (bf16_t*)(p.ws + WS_HB)};
    pg8::gemm_phase<pg8::EpiMerge, pg8::Order, true, true>(LDSP(lds), g, S, E);
}
__device__ __forceinline__ void ph_out(const Prm& p, int l, unsigned char* lds) {
    pg8::Gemm g{(const bf16_t*)(p.ws + WS_HB), (const bf16_t*)(p.ws + WS_WOUT) + (size_t)l * DM * DM, DM, DM, DM};
    pg8::Order S; S.init(NT, DM, gridDim.x, blockIdx.x, 0);
    if (l == 0) { pg8::EpiOut<false> E{p.x, (const bf16_t*)nullptr, (bf16_t*)(p.ws + WS_XR1), (const float*)(p.ws + WS_MOD) + (size_t)l * NB * MODW + 2 * DM, p.ffn_norm + l * DM, (bf16_t*)(p.ws + WS_QQ), (float*)(p.ws + WS_SSQ)};
        pg8::gemm_phase<pg8::EpiOut<false>, pg8::Order, true, true>(LDSP(lds), g, S, E); return; }
    pg8::EpiOut<true> E{p.x, (const bf16_t*)p.out, (bf16_t*)(p.ws + WS_XR1), (const float*)(p.ws + WS_MOD) + (size_t)l * NB * MODW + 2 * DM, p.ffn_norm + l * DM, (bf16_t*)(p.ws + WS_QQ), (float*)(p.ws + WS_SSQ)};
    pg8::gemm_phase<pg8::EpiOut<true>, pg8::Order, true, true>(LDSP(lds), g, S, E);
}
__device__ __forceinline__ void ph_q(const Prm& p, int l, unsigned char* lds) {
    pg8::Gemm g{(const bf16_t*)(p.ws + WS_QQ), (const bf16_t*)(p.ws + WS_WQ) + (size_t)l * DM * DM, DM, DM, DM};
    pg8::Order S; S.init(NT, DM, gridDim.x, blockIdx.x, 0);
    pg8::EpiQ E{(bf16_t*)(p.ws + WS_KK), (const float*)(p.ws + WS_SSQ), (const float*)(p.ws + WS_BQ) + (size_t)l * NB * DM, (float*)(p.ws + WS_FC)};
    pg8::gemm_phase<pg8::EpiQ, pg8::Order, true, true>(LDSP(lds), g, S, E);
}

namespace attn_body {
using bf16=__hip_bfloat16;
using bf16x8=__attribute__((ext_vector_type(8)))short;
using s16x4=__attribute__((ext_vector_type(4)))short;
using f32x16=__attribute__((ext_vector_type(16)))float;
using u32x4=__attribute__((ext_vector_type(4)))unsigned;
using f32x4_t=__attribute__((ext_vector_type(4)))float;
constexpr int BATCH=8,NHEAD=8,SEQ=4096,D=64,DM=1024;
constexpr int NW=8,QBLK=32,QB=QBLK*NW,KVBLK=64,NQB=SEQ/QB;
constexpr int ATTN_PITCH=DM, ATTN_UNIT_ROWS=QB;
__device__ __forceinline__ int crow(int r,int hi){return (r&3)+8*(r>>2)+4*hi;}
#define SBAR() __builtin_amdgcn_sched_barrier(0)
__device__ __forceinline__ void cmask(f32x16&p0,f32x16&p1,int jb,int qrel,int hi){
  const float NEG=-INFINITY; int d=qrel-(64*jb+4*hi); asm volatile("":"+v"(d));
  #pragma unroll
  for(int r=0;r<16;++r){const int c=(r&3)+8*(r>>2); if(c>d)p0[r]=NEG; if(c+32>d)p1[r]=NEG;}
}

constexpr int NSLOT=3, SLOTB=8192;
constexpr int LDS_K=0, LDS_V=NSLOT*SLOTB, LDS_WS=2*NSLOT*SLOTB, LDS_OST=LDS_WS+NW*64*4, LDS_BYTES=LDS_OST+NW*4096;
constexpr float C2=0.125f*1.4426950408889634f;
__device__ __forceinline__ void glds16(const void*gsrc,unsigned lds_dst){unsigned keep;
  asm volatile("s_mov_b32 %0, m0\n\ts_mov_b32 m0, %2\n\ts_nop 0\n\tglobal_load_lds_dwordx4 %1, off\n\ts_mov_b32 m0, %0":"=&s"(keep):"v"(gsrc),"s"(lds_dst):"memory");}
__device__ __forceinline__ float max3f(float a,float b,float c){float r;asm("v_max3_f32 %0, %1, %2, %3":"=v"(r):"v"(a),"v"(b),"v"(c));return r;}
__device__ __forceinline__ float max2f(float a,float b){float r;asm("v_max_f32_e32 %0, %1, %2":"=v"(r):"v"(a),"v"(b));return r;}
__device__ __forceinline__ float fadd_s(float a,float b){float r;asm("v_add_f32_e32 %0, %1, %2":"=v"(r):"v"(a),"v"(b));return r;}
__device__ __forceinline__ float fsub_s(float a,float b){float r;asm("v_sub_f32_e32 %0, %1, %2":"=v"(r):"v"(a),"v"(b));return r;}
typedef float f32x2_t __attribute__((ext_vector_type(2))); typedef __bf16 bf16x2_t __attribute__((ext_vector_type(2)));
__device__ __forceinline__ unsigned cvtpk_s(float lo,float hi){f32x2_t v={lo,hi};bf16x2_t b=__builtin_convertvector(v,bf16x2_t);return __builtin_bit_cast(unsigned,b);}
#define WAIT_BAR(N) asm volatile("s_waitcnt vmcnt(" #N ") lgkmcnt(0)\n\ts_barrier":::"memory")

__device__ __forceinline__ void qkt(f32x16&p0,f32x16&p1,const char*Kslot,const bf16x8*qr,const f32x16&negm,int r32,int hi){
  const char*kb=Kslot+hi*1024+r32*16;
  #pragma unroll
  for(int d0=0;d0<4;++d0){
    const bf16x8 b0=*reinterpret_cast<const bf16x8*>(kb+d0*2048);
    const bf16x8 b1=*reinterpret_cast<const bf16x8*>(kb+d0*2048+512);
    if(d0==0){p0=__builtin_amdgcn_mfma_f32_32x32x16_bf16(b0,qr[0],negm,0,0,0);p1=__builtin_amdgcn_mfma_f32_32x32x16_bf16(b1,qr[0],negm,0,0,0);}
    else{p0=__builtin_amdgcn_mfma_f32_32x32x16_bf16(b0,qr[d0],p0,0,0,0);p1=__builtin_amdgcn_mfma_f32_32x32x16_bf16(b1,qr[d0],p1,0,0,0);}}
}
typedef __attribute__((address_space(3))) const char* lds_cptr;
typedef short v4i16_t __attribute__((ext_vector_type(4)));
__device__ __forceinline__ void kload8(bf16x8*kf,lds_cptr kp){
  kf[0]=*(const __attribute__((address_space(3))) bf16x8*)(kp);      kf[1]=*(const __attribute__((address_space(3))) bf16x8*)(kp+512);
  kf[2]=*(const __attribute__((address_space(3))) bf16x8*)(kp+2048); kf[3]=*(const __attribute__((address_space(3))) bf16x8*)(kp+2560);
  kf[4]=*(const __attribute__((address_space(3))) bf16x8*)(kp+4096); kf[5]=*(const __attribute__((address_space(3))) bf16x8*)(kp+4608);
  kf[6]=*(const __attribute__((address_space(3))) bf16x8*)(kp+6144); kf[7]=*(const __attribute__((address_space(3))) bf16x8*)(kp+6656);
}
__device__ __forceinline__ void kload2(bf16x8*kf,lds_cptr kp,int j){ kf[2*j]=*(const __attribute__((address_space(3))) bf16x8*)(kp+j*2048); kf[2*j+1]=*(const __attribute__((address_space(3))) bf16x8*)(kp+j*2048+512); }
__device__ __forceinline__ s16x4 vtr(lds_cptr p){ return __builtin_bit_cast(s16x4,__builtin_amdgcn_ds_read_tr16_b64_v4i16((__attribute__((address_space(3))) v4i16_t*)p)); }
__device__ __forceinline__ float rowmax(const f32x16&p0,const f32x16&p1){
  float a=max3f(p0[0],p0[1],p1[0]),b=max3f(p0[2],p0[3],p1[1]);a=max3f(a,p1[2],p1[3]);
  #pragma unroll
  for(int r=4;r<16;r+=4){a=max3f(a,p0[r],p0[r+1]);b=max3f(b,p0[r+2],p0[r+3]);a=max3f(a,p1[r],p1[r+1]);b=max3f(b,p1[r+2],p1[r+3]);}
  const float m=max2f(a,b);
  auto rr=__builtin_amdgcn_permlane32_swap(__float_as_uint(m),__float_as_uint(m),false,false);
  return max2f(__uint_as_float(rr[0]),__uint_as_float(rr[1]));
}
__device__ __forceinline__ void pv(f32x16*o,int vb,bf16x8 pa0,bf16x8 pa1,bf16x8 pa2,bf16x8 pa3){
  #pragma unroll
  for(int d0=0;d0<2;++d0){s16x4 lo[4],hi[4];
    #pragma unroll
    for(int ks=0;ks<4;++ks){
      asm volatile("ds_read_b64_tr_b16 %0,%1 offset:%c2":"=&v"(lo[ks]):"v"(vb),"i"(d0*4096+ks*1024):"memory");
      asm volatile("ds_read_b64_tr_b16 %0,%1 offset:%c2":"=&v"(hi[ks]):"v"(vb),"i"(d0*4096+ks*1024+512):"memory");}
    asm volatile("s_waitcnt lgkmcnt(0)":::"memory");SBAR();
    #define PK(k) (bf16x8){lo[k][0],lo[k][1],lo[k][2],lo[k][3],hi[k][0],hi[k][1],hi[k][2],hi[k][3]}
    o[d0]=__builtin_amdgcn_mfma_f32_32x32x16_bf16(pa0,PK(0),o[d0],0,0,0);
    o[d0]=__builtin_amdgcn_mfma_f32_32x32x16_bf16(pa1,PK(1),o[d0],0,0,0);
    o[d0]=__builtin_amdgcn_mfma_f32_32x32x16_bf16(pa2,PK(2),o[d0],0,0,0);
    o[d0]=__builtin_amdgcn_mfma_f32_32x32x16_bf16(pa3,PK(3),o[d0],0,0,0);
    #undef PK
  }
}

#ifndef ATTN_STORE16
#define ATTN_STORE16(p,v) (*(u32x4*)(p)=(v))
#endif
template<int THRL> __device__ __forceinline__ void attn_unit(int b,int h,int qb,const bf16*Q,const bf16*__restrict__ K,const bf16*__restrict__ V,bf16*O,char*shm,const float*Gl,int j0){
  int tid_=threadIdx.x; asm volatile("":"+v"(tid_));
  const int tid=tid_,lane=tid&63,r32=lane&31,hi=lane>>5; const int wid=__builtin_amdgcn_readfirstlane(tid>>6);
  const long rowbase=(long)b*SEQ; const int q0=qb*QB;
  const bf16*Qw=Q+(rowbase+q0+wid*QBLK)*DM+h*D;
  const bf16*Kh=K+(rowbase+(long)j0*KVBLK)*DM+h*D,*Vh=V+(rowbase+(long)j0*KVBLK)*DM+h*D; const float*Glt=Gl+j0*KVBLK;
  const unsigned lds0=(unsigned)(uintptr_t)shm;
  float*wsf=(float*)(shm+LDS_WS)+wid*64;
  const bf16*ksrc=Kh+(long)lane*DM+wid*8;
  const bf16*vsrc=Vh+(long)(16*(wid&3)+(lane>>2))*DM+(wid>>2)*32+(lane&3)*8;
  const unsigned kdst=lds0+LDS_K+wid*1024, vdst=lds0+LDS_V+wid*1024;
  #define DMA_K(t,slot) glds16(ksrc+(long)(t)*KVBLK*DM,(unsigned)__builtin_amdgcn_readfirstlane(kdst+(slot)))
  #define DMA_V(t,slot) glds16(vsrc+(long)(t)*KVBLK*DM,(unsigned)__builtin_amdgcn_readfirstlane(vdst+(slot)))
  const int vb0=(int)(lds0+LDS_V)+((lane>>4)&1)*32+(lane&3)*8+(4*hi+((lane&15)>>2))*64;
  const char*Kbase=shm+LDS_K; bf16x8 kf[8];
  const lds_cptr shm3=(lds_cptr)shm; const lds_cptr kp0=shm3+LDS_K+hi*1024+r32*16; const lds_cptr vp0=shm3+LDS_V+((lane>>4)&1)*32+(lane&3)*8+(4*hi+((lane&15)>>2))*64;
  const int NT=(q0+QB)/KVBLK-j0;
  DMA_K(0,0);DMA_V(0,0);DMA_K(1,SLOTB);
  bf16x8 qr[4];
  #pragma unroll
  for(int d0=0;d0<4;++d0)qr[d0]=*reinterpret_cast<const bf16x8*>(&Qw[(long)r32*DM+d0*16+hi*8]);
  typedef __attribute__((address_space(3))) bf16x8* qst_ptr; const qst_ptr qst=(qst_ptr)(((__attribute__((address_space(3))) char*)shm)+LDS_OST+wid*4096)+lane;
  #pragma unroll
  for(int d0=0;d0<4;++d0)qst[d0*64]=qr[d0];
  const int qrel=wid*QBLK+r32; const float Gq=Gl[q0+qrel];
  float mhat=0.f,l_reg=0.f;f32x16 o[2];o[0]=f32x16{};o[1]=f32x16{};const f32x16 negm=f32x16{}; float base=Gq;
  #define BIAS(C0,C1,t) do{ const float*gk_=Glt+(t)*64+4*hi; _Pragma("unroll") for(int g_=0;g_<4;++g_){ SBAR(); const f32x4_t a_=*(const f32x4_t*)(gk_+8*g_), b_=*(const f32x4_t*)(gk_+32+8*g_); \
    _Pragma("unroll") for(int e_=0;e_<4;++e_){ C0[4*g_+e_]+=base-a_[e_]; C1[4*g_+e_]+=base-b_[e_]; } } SBAR(); }while(0)
  #define CMASK(P0,P1,t) do{int jb_=(t)-(NT-4); if(jb_>=0)cmask(P0,P1,jb_,qrel,hi);}while(0)
  bool resc=false;
  #define START(P0,P1) do{ const float rm=rowmax(P0,P1); resc=false; \
    { const float dl=rm; mhat=fadd_s(mhat,dl); \
      _Pragma("unroll") for(int r=0;r<16;++r){P0[r]=fsub_s(P0[r],dl);P1[r]=fsub_s(P1[r],dl);} \
      base=Gq-mhat; } \
    _Pragma("unroll") for(int r=0;r<16;++r)P0[r]=__builtin_amdgcn_exp2f(P0[r]); }while(0)
  #define RESC() do{ if(resc){ asm volatile("s_waitcnt lgkmcnt(0)":::"memory"); \
      _Pragma("unroll") for(int d_=0;d_<2;++d_) _Pragma("unroll") for(int r=0;r<16;++r)o[d_][r]*=wsf[crow(r,hi)]; } }while(0)
  f32x16 pA0,pA1,pB0,pB1;
  int sl_prev=0,sl_cur=0,sl_next=SLOTB;
  #define ROT() do{sl_prev=sl_cur;sl_cur=sl_next;sl_next=(sl_next==(NSLOT-1)*SLOTB)?0:sl_next+SLOTB;}while(0)
  DMA_K(2,2*SLOTB);
  WAIT_BAR(3);
  qkt(pA0,pA1,Kbase,qr,negm,r32,hi);BIAS(pA0,pA1,0);asm volatile("s_nop 15\n\ts_nop 7":"+v"(pA0),"+v"(pA1));CMASK(pA0,pA1,0);
  START(pA0,pA1);
  _Pragma("unroll") for(int r=0;r<16;++r)pA1[r]=__builtin_amdgcn_exp2f(pA1[r]);
  WAIT_BAR(0);
  DMA_K(3,0);DMA_V(1,SLOTB);
  ROT();
  kload8(kf,kp0+sl_cur);
  WAIT_BAR(2);
  s16x4 vlo[8],vhi[8]; u32x4 pw0,pw1,pw2,pw3;
  #define PKW(P,B) cvtpk_s(P[B],P[B+1])
  #define PAF(k) __builtin_bit_cast(bf16x8,pw##k)
  #define VFR(i) (bf16x8){vlo[i][0],vlo[i][1],vlo[i][2],vlo[i][3],vhi[i][0],vhi[i][1],vhi[i][2],vhi[i][3]}
  #define PIN(x) asm volatile("":"+v"(x))
  #define MX3(a,b,c) __builtin_fmaxf(__builtin_fmaxf((a),(b)),(c))
  #define GAPA(MF,A0,A1,A2,A3,W0,W1,PW) do{ MF; sacc+=A0; sacc+=A1; sacc+=A2; sacc+=A3; PIN(sacc); W0; W1; PIN(PW); SBAR(); }while(0)
  #define EX(v) __builtin_amdgcn_exp2f(v)
  #define GAPB(MF,X,B) do{ MF; X[B]=EX(X[B]); X[B+1]=EX(X[B+1]); X[B+2]=EX(X[B+2]); X[B+3]=EX(X[B+3]); PIN(X); SBAR(); }while(0)
  #define VRD(i) do{ vlo[i]=vtr(vp_+(((i)>>2)*4096+((i)&3)*1024)); vhi[i]=vtr(vp_+(((i)>>2)*4096+((i)&3)*1024+512)); }while(0)
  #define KRD(G,j) do{ if(G){ kload2(kf,kp0+sl_next,j); SBAR(); } }while(0)
  #define STEP(C0,C1,P0,P1,t,GK,GV,GL) do{ SBAR(); \
    const lds_cptr vp_=vp0+sl_prev; const bf16x8 q0_=qst[0],q1_=qst[64],q2_=qst[128],q3_=qst[192]; \
    VRD(0); SBAR(); float sacc=(P0[0]+P0[1]); \
    GAPA(C0=__builtin_amdgcn_mfma_f32_32x32x16_bf16(kf[0],q0_,negm,0,0,0), P0[2],P0[3],P0[4],P0[5],     pw0[0]=PKW(P0,0), pw0[1]=PKW(P0,2), pw0); \
    VRD(4); SBAR(); GAPA(C1=__builtin_amdgcn_mfma_f32_32x32x16_bf16(kf[1],q0_,negm,0,0,0), P0[6],P0[7],P0[8],P0[9],     pw0[2]=PKW(P0,4), pw0[3]=PKW(P0,6), pw0); \
    VRD(1); SBAR(); GAPA(C0=__builtin_amdgcn_mfma_f32_32x32x16_bf16(kf[2],q1_,C0,0,0,0),   P0[10],P0[11],P0[12],P0[13], pw1[0]=PKW(P0,8), pw1[1]=PKW(P0,10), pw1); \
    VRD(5); SBAR(); GAPA(C1=__builtin_amdgcn_mfma_f32_32x32x16_bf16(kf[3],q1_,C1,0,0,0),   P0[14],P0[15],P1[0],P1[1],   pw1[2]=PKW(P0,12),pw1[3]=PKW(P0,14), pw1); \
    VRD(2); SBAR(); GAPA(C0=__builtin_amdgcn_mfma_f32_32x32x16_bf16(kf[4],q2_,C0,0,0,0),   P1[2],P1[3],P1[4],P1[5],     pw2[0]=PKW(P1,0), pw2[1]=PKW(P1,2), pw2); \
    VRD(6); SBAR(); GAPA(C1=__builtin_amdgcn_mfma_f32_32x32x16_bf16(kf[5],q2_,C1,0,0,0),   P1[6],P1[7],P1[8],P1[9],     pw2[2]=PKW(P1,4), pw2[3]=PKW(P1,6), pw2); \
    VRD(3); SBAR(); GAPA(C0=__builtin_amdgcn_mfma_f32_32x32x16_bf16(kf[6],q3_,C0,0,0,0),   P1[10],P1[11],P1[12],P1[13], pw3[0]=PKW(P1,8), pw3[1]=PKW(P1,10), pw3); \
    VRD(7); SBAR(); GAPA(C1=__builtin_amdgcn_mfma_f32_32x32x16_bf16(kf[7],q3_,C1,0,0,0),   P1[14],P1[15],0.f,0.f,       pw3[2]=PKW(P1,12),pw3[3]=PKW(P1,14), pw3); \
    l_reg+=sacc; \
    if(GK){DMA_K((t)+3,sl_cur);} if(GV){DMA_V((t)+1,sl_next);} \
    BIAS(C0,C1,t); CMASK(C0,C1,t); \
    { float a=MX3(C0[0],C0[1],C1[0]),b=MX3(C0[2],C0[3],C1[1]); a=MX3(a,C1[2],C1[3]); \
      _Pragma("unroll") for(int r=4;r<16;r+=4){a=MX3(a,C0[r],C0[r+1]);b=MX3(b,C0[r+2],C0[r+3]);a=MX3(a,C1[r],C1[r+1]);b=MX3(b,C1[r+2],C1[r+3]);} \
      float rm=__builtin_fmaxf(a,b); { auto rr=__builtin_amdgcn_permlane32_swap(__float_as_uint(rm),__float_as_uint(rm),false,false); rm=__builtin_fmaxf(__uint_as_float(rr[0]),__uint_as_float(rr[1])); } \
      resc=false; \
      if(__builtin_expect(__any(rm>(float)THRL),0)){ const float dl=__builtin_fmaxf(rm,0.f); mhat+=dl; \
        _Pragma("unroll") for(int r=0;r<16;++r){C0[r]-=dl;C1[r]-=dl;} \
        base=Gq-mhat; \
        const float f=__builtin_amdgcn_exp2f(-dl); l_reg*=f; if(hi==0)wsf[r32]=f; resc=true; } } \
    SBAR(); \
    GAPB(o[0]=__builtin_amdgcn_mfma_f32_32x32x16_bf16(PAF(0),VFR(0),o[0],0,0,0), C0,0); \
    GAPB(o[1]=__builtin_amdgcn_mfma_f32_32x32x16_bf16(PAF(0),VFR(4),o[1],0,0,0), C0,4); \
    KRD(GL,0); GAPB(o[0]=__builtin_amdgcn_mfma_f32_32x32x16_bf16(PAF(1),VFR(1),o[0],0,0,0), C0,8); \
    KRD(GL,1); GAPB(o[1]=__builtin_amdgcn_mfma_f32_32x32x16_bf16(PAF(1),VFR(5),o[1],0,0,0), C0,12); \
    KRD(GL,2); GAPB(o[0]=__builtin_amdgcn_mfma_f32_32x32x16_bf16(PAF(2),VFR(2),o[0],0,0,0), C1,0); \
    KRD(GL,3); GAPB(o[1]=__builtin_amdgcn_mfma_f32_32x32x16_bf16(PAF(2),VFR(6),o[1],0,0,0), C1,4); \
    GAPB(o[0]=__builtin_amdgcn_mfma_f32_32x32x16_bf16(PAF(3),VFR(3),o[0],0,0,0), C1,8); \
    GAPB(o[1]=__builtin_amdgcn_mfma_f32_32x32x16_bf16(PAF(3),VFR(7),o[1],0,0,0), C1,12); \
    }while(0)
  int t=1;
  #undef CMASK
  #define CMASK(P0,P1,t) do{}while(0)
  for(;t+5<NT;t+=2){
    STEP(pB0,pB1,pA0,pA1,t,true,true,true);     WAIT_BAR(2); RESC(); ROT();
    STEP(pA0,pA1,pB0,pB1,t+1,true,true,true);   WAIT_BAR(2); RESC(); ROT();
  }
  #undef CMASK
  #define CMASK(P0,P1,t) do{int jb_=(t)-(NT-4); if(jb_>=0)cmask(P0,P1,jb_,qrel,hi);}while(0)
  #define ENDW(tt) do{ if((tt)+3<NT){WAIT_BAR(2);} else if((tt)+2<NT){WAIT_BAR(1);} else {WAIT_BAR(0);} }while(0)
  for(;t+1<NT;t+=2){
    STEP(pB0,pB1,pA0,pA1,t,(t+3<NT),(t+1<NT),(t+1<NT));       ENDW(t);   RESC(); ROT();
    STEP(pA0,pA1,pB0,pB1,t+1,(t+4<NT),(t+2<NT),(t+2<NT));     ENDW(t+1); RESC(); ROT();
  }
  STEP(pB0,pB1,pA0,pA1,NT-1,false,false,false); RESC();
  { float sacc=pB0[0]+pB0[1]; _Pragma("unroll") for(int r=2;r<16;++r)sacc+=pB0[r]; _Pragma("unroll") for(int r=0;r<16;++r)sacc+=pB1[r]; l_reg+=sacc;
    pw0=(u32x4){PKW(pB0,0),PKW(pB0,2),PKW(pB0,4),PKW(pB0,6)};pw1=(u32x4){PKW(pB0,8),PKW(pB0,10),PKW(pB0,12),PKW(pB0,14)};pw2=(u32x4){PKW(pB1,0),PKW(pB1,2),PKW(pB1,4),PKW(pB1,6)};pw3=(u32x4){PKW(pB1,8),PKW(pB1,10),PKW(pB1,12),PKW(pB1,14)};
    SBAR(); pv(o,vb0+sl_cur,PAF(0),PAF(1),PAF(2),PAF(3)); }
  #undef PKW
  #undef PAF
  #undef VFR
  #undef PIN
  #undef MX3
  #undef GAPA
  #undef GAPB
  #undef EX
  #undef VRD
  #undef KRD
  #undef STEP
  #undef ENDW
  {auto rr=__builtin_amdgcn_permlane32_swap(__float_as_uint(l_reg),__float_as_uint(l_reg),false,false);l_reg=__uint_as_float(rr[0])+__uint_as_float(rr[1]);}
  if(hi==0)wsf[32+r32]=l_reg;asm volatile("s_waitcnt lgkmcnt(0)":::"memory");
  float rli[16];
  #pragma unroll
  for(int r=0;r<16;++r)rli[r]=__builtin_amdgcn_rcpf(wsf[32+crow(r,hi)]);
  bf16*Ow=O+(rowbase+q0+wid*QBLK)*DM+h*D;
  { bf16*stg=(bf16*)(shm+LDS_OST)+wid*2048;
    #pragma unroll
    for(int r=0;r<16;++r){const int orow=crow(r,hi);
      #pragma unroll
      for(int d0=0;d0<2;++d0)stg[orow*64+d0*32+r32]=__float2bfloat16(o[d0][r]*rli[r]);}
    asm volatile("s_waitcnt lgkmcnt(0)":::"memory");
    #pragma unroll
    for(int i=0;i<4;++i){const int row=i*8+(lane>>3),ch=lane&7; const u32x4 v=*(const u32x4*)(stg+row*64+ch*8); ATTN_STORE16(Ow+(long)row*DM+ch*8,v);} }
  asm volatile("s_waitcnt lgkmcnt(0)\n\ts_barrier":::"memory");
  #undef DMA_K
  #undef DMA_V
  #undef CMASK
  #undef BIAS
  #undef START
  #undef RESC
  #undef ROT
}
constexpr int ATTN_LDS_BYTES=LDS_BYTES;
#undef SBAR
#undef WAIT_BAR
}

namespace sbk {
using bf16x8=__attribute__((ext_vector_type(8)))short;
using s16x4=__attribute__((ext_vector_type(4)))short;
using f32x16=__attribute__((ext_vector_type(16)))float;
constexpr int WLDS=12288;
constexpr float R_STOP=48.0f;
__device__ __forceinline__ int crow(int r,int hi){return (r&3)+8*(r>>2)+4*hi;}
__device__ __forceinline__ unsigned cvtpk(float lo,float hi){typedef float f2 __attribute__((ext_vector_type(2)));typedef __bf16 b2 __attribute__((ext_vector_type(2)));f2 v={lo,hi};b2 b=__builtin_convertvector(v,b2);return __builtin_bit_cast(unsigned,b);}
__device__ __forceinline__ void pv(f32x16*o,int vb,bf16x8 pa0,bf16x8 pa1,bf16x8 pa2,bf16x8 pa3){
  #pragma unroll
  for(int d0=0;d0<2;++d0){s16x4 lo[4],hi[4];
    #pragma unroll
    for(int ks=0;ks<4;++ks){
      asm volatile("ds_read_b64_tr_b16 %0,%1 offset:%c2":"=&v"(lo[ks]):"v"(vb),"i"(d0*4096+ks*1024):"memory");
      asm volatile("ds_read_b64_tr_b16 %0,%1 offset:%c2":"=&v"(hi[ks]):"v"(vb),"i"(d0*4096+ks*1024+512):"memory");}
    asm volatile("s_waitcnt lgkmcnt(0)":::"memory");__builtin_amdgcn_sched_barrier(0);
    #define PK(k) (bf16x8){lo[k][0],lo[k][1],lo[k][2],lo[k][3],hi[k][0],hi[k][1],hi[k][2],hi[k][3]}
    o[d0]=__builtin_amdgcn_mfma_f32_32x32x16_bf16(pa0,PK(0),o[d0],0,0,0);
    o[d0]=__builtin_amdgcn_mfma_f32_32x32x16_bf16(pa1,PK(1),o[d0],0,0,0);
    o[d0]=__builtin_amdgcn_mfma_f32_32x32x16_bf16(pa2,PK(2),o[d0],0,0,0);
    o[d0]=__builtin_amdgcn_mfma_f32_32x32x16_bf16(pa3,PK(3),o[d0],0,0,0);
    #undef PK
  }
}
__device__ __forceinline__ float sp2(float z){ return fmaxf(z,0.f)+__builtin_amdgcn_logf(1.0f+__builtin_amdgcn_exp2f(-fabsf(z))); }
__device__ __forceinline__ void sb_unit(int b,int h,int tb,const bf16_t*Q,const bf16_t*K,const bf16_t*V,bf16_t*O,char*wl,int lane){
  const int r32=lane&31,hi=lane>>5,t0=tb*32; const long rowbase=(long)b*SEQ; const int co=512+h*64;
  const bf16_t*Qw=Q+(rowbase+t0)*DM+co;
  bf16x8 qr[4];
  #pragma unroll
  for(int d0=0;d0<4;++d0)qr[d0]=*reinterpret_cast<const bf16x8*>(Qw+(long)r32*DM+d0*16+hi*8);
  f32x16 o[2];o[0]=f32x16{};o[1]=f32x16{};float R=0.f;
  const int vb=(int)(unsigned)(uintptr_t)wl+((lane>>4)&1)*32+(lane&3)*8+(4*hi+((lane&15)>>2))*64;
  bf16x8 kf[8]; u32x4 vr[8];
  #define SB_LOADK(jj) do{ const int s0_=(jj)*64; const bf16_t*Kp=K+(rowbase+s0_+r32)*DM+co+hi*8; \
    _Pragma("unroll") for(int d0=0;d0<4;++d0){kf[2*d0]=*reinterpret_cast<const bf16x8*>(Kp+d0*16);kf[2*d0+1]=*reinterpret_cast<const bf16x8*>(Kp+(long)32*DM+d0*16);} }while(0)
  #define SB_LOADV(jj) do{ const int s0_=(jj)*64; \
    _Pragma("unroll") for(int p=0;p<8;++p)vr[p]=*reinterpret_cast<const u32x4*>(V+(rowbase+s0_+16*(p&3)+(lane>>2))*DM+co+(p>>2)*32+(lane&3)*8); }while(0)
  SB_LOADK(t0>>6);
  for(int j=t0>>6;j>=0;--j){
    const int s0=j*64;
    SB_LOADV(j);
    f32x16 z0=f32x16{},z1=f32x16{};
    #pragma unroll
    for(int d0=0;d0<4;++d0){z0=__builtin_amdgcn_mfma_f32_32x32x16_bf16(kf[2*d0],qr[d0],z0,0,0,0);z1=__builtin_amdgcn_mfma_f32_32x32x16_bf16(kf[2*d0+1],qr[d0],z1,0,0,0);}
    #pragma unroll
    for(int p=0;p<8;++p)*reinterpret_cast<u32x4*>(wl+p*1024+lane*16)=vr[p];
    int rel=((j==(t0>>6))?(t0-s0+r32):1000)-4*hi; asm volatile("":"+v"(rel));
    f32x16 L0,L1;
    #pragma unroll
    for(int r=0;r<16;++r){const int kv=(r&3)+8*(r>>2); L0[r]=(kv<rel)?sp2(z0[r]):0.f; L1[r]=(kv+32<rel)?sp2(z1[r]):0.f;}
    float T[8]; f32x16 E0,E1;
    #pragma unroll
    for(int i=0;i<4;++i){
      E0[4*i+3]=0.f;E0[4*i+2]=L0[4*i+3];E0[4*i+1]=E0[4*i+2]+L0[4*i+2];E0[4*i]=E0[4*i+1]+L0[4*i+1];T[i]=E0[4*i]+L0[4*i];
      E1[4*i+3]=0.f;E1[4*i+2]=L1[4*i+3];E1[4*i+1]=E1[4*i+2]+L1[4*i+2];E1[4*i]=E1[4*i+1]+L1[4*i+1];T[4+i]=E1[4*i]+L1[4*i];}
    float X[8];
    #pragma unroll
    for(int i=0;i<8;++i)X[i]=__shfl_xor(T[i],32);
    float S[8]; float run=0.f;
    #pragma unroll
    for(int i=7;i>=0;--i){
      const float g_hi=hi?T[i]:X[i];
      const float g_lo=hi?X[i]:T[i];
      S[i]=hi?run:(run+g_hi);
      run+=g_hi+g_lo; }
    const float Ttot=run;
    #pragma unroll
    for(int i=0;i<4;++i){
      #pragma unroll
      for(int e=0;e<4;++e){E0[4*i+e]+=S[i];E1[4*i+e]+=S[4+i];}}
    f32x16 P0,P1;
    #pragma unroll
    for(int r=0;r<16;++r){const int kv=(r&3)+8*(r>>2);
      P0[r]=(kv<rel)?__builtin_amdgcn_exp2f(z0[r]-L0[r]-E0[r]-R):0.f;
      P1[r]=(kv+32<rel)?__builtin_amdgcn_exp2f(z1[r]-L1[r]-E1[r]-R):0.f;}
    R+=Ttot;
    u32x4 pw0,pw1,pw2,pw3;
    pw0=(u32x4){cvtpk(P0[0],P0[1]),cvtpk(P0[2],P0[3]),cvtpk(P0[4],P0[5]),cvtpk(P0[6],P0[7])};
    pw1=(u32x4){cvtpk(P0[8],P0[9]),cvtpk(P0[10],P0[11]),cvtpk(P0[12],P0[13]),cvtpk(P0[14],P0[15])};
    pw2=(u32x4){cvtpk(P1[0],P1[1]),cvtpk(P1[2],P1[3]),cvtpk(P1[4],P1[5]),cvtpk(P1[6],P1[7])};
    pw3=(u32x4){cvtpk(P1[8],P1[9]),cvtpk(P1[10],P1[11]),cvtpk(P1[12],P1[13]),cvtpk(P1[14],P1[15])};
    asm volatile("s_waitcnt lgkmcnt(0)":::"memory");
    if(j>0)SB_LOADK(j-1);
    pv(o,vb,__builtin_bit_cast(bf16x8,pw0),__builtin_bit_cast(bf16x8,pw1),__builtin_bit_cast(bf16x8,pw2),__builtin_bit_cast(bf16x8,pw3));
    if(__all(R>R_STOP))break;
  }
  #undef SB_LOADK
  #undef SB_LOADV
  bf16_t*Ow=O+(rowbase+t0)*DM+co;
  { bf16_t*stg=(bf16_t*)(wl+8192);
    #pragma unroll
    for(int r=0;r<16;++r){const int orow=crow(r,hi);
      #pragma unroll
      for(int d0=0;d0<2;++d0)stg[orow*64+d0*32+r32]=(bf16_t)f2bf(o[d0][r]);}
    asm volatile("s_waitcnt lgkmcnt(0)":::"memory");
    #pragma unroll
    for(int i=0;i<4;++i){const int row=i*8+(lane>>3),ch=lane&7; const u32x4 v=*(const u32x4*)(stg+row*64+ch*8); *(u32x4*)(Ow+(long)row*DM+ch*8)=v;}
    asm volatile("s_waitcnt lgkmcnt(0)":::"memory"); }
}
}

constexpr int ATT_G_OFF = attn_body::ATTN_LDS_BYTES, ATT_RED_OFF = ATT_G_OFF + SEQ * 4;
__device__ __forceinline__ void fox_scan_G(const float* FA, int b, int h, float* Gl, float* red, int tid, int lane, int wave) {
    float v[8]; float run = 0.f;
#pragma unroll
    for (int j = 0; j < 8; ++j) { run += FA[((size_t)b * SEQ + 8 * tid + j) * 8 + h] * LOG2E; v[j] = run; }
    float inc = run;
#pragma unroll
    for (int o = 1; o < 64; o <<= 1) { const float n = __shfl_up(inc, o); if (lane >= o) inc += n; }
    if (lane == 63) red[wave] = inc;
    __syncthreads();
    float off = inc - run;
    for (int w = 0; w < wave; ++w) off += red[w];
#pragma unroll
    for (int j = 0; j < 8; ++j) Gl[8 * tid + j] = off + v[j];
    __syncthreads();
}
template <int PARTS = 3>
__device__ __forceinline__ void ph_attn(const Prm& p, const Ctx& C, int l, unsigned char* lds, size_t o_off = WS_QQ) {
    const int G = gridDim.x, bx = blockIdx.x; const int vcu = (G % 8 == 0) ? (bx % 8) * (G / 8) + bx / 8 : bx;
    const attn_body::bf16* Q = (const attn_body::bf16*)(p.ws + WS_QQ); const attn_body::bf16* K = (const attn_body::bf16*)(p.ws + WS_KK); const attn_body::bf16* V = (const attn_body::bf16*)(p.ws + WS_VV);
    float* Gl = (float*)(lds + ATT_G_OFF); float* red = (float*)(lds + ATT_RED_OFF);
    int cur_bh = -1;
    float Bq;
    { float mq = fabsf(p.gq[l * HD + C.lane]), mk = fabsf(p.gk[l * HD + C.lane]);
#pragma unroll
      for (int o = 1; o < 64; o <<= 1) { mq = fmaxf(mq, __shfl_xor(mq, o)); mk = fmaxf(mk, __shfl_xor(mk, o)); }
      Bq = 1.02f * C2 * 64.0f * mq * mk; }
    unsigned* qcnt = (unsigned*)(p.ws + WS_CTL) + 3584 + l * 8 * 64;
    unsigned* uslot = (unsigned*)(lds + ATT_RED_OFF + 64);
    for (int qi = 0; qi < 8; ++qi) {
        const int qx = (bx + qi) & 7;
        for (;;) {
            __syncthreads();
            if (C.tid == 0) *uslot = __hip_atomic_fetch_add(qcnt + 64 * qx, 1u, __ATOMIC_RELAXED, __HIP_MEMORY_SCOPE_AGENT);
            __syncthreads();
            const unsigned u = *uslot;
            if (u >= 256u) break;
            if (u < 128u) {
                if (!(PARTS & 1)) continue;
                const int qb = 15 - (int)(u >> 3), bh = qx * NH + (int)(u & 7);
                if (bh != cur_bh) { __syncthreads(); fox_scan_G((const float*)(p.ws + WS_FA), bh / NH, bh % NH, Gl, red, C.tid, C.lane, C.wave); cur_bh = bh; }
                const int ntf = 4 * qb + 4; const float thr = Gl[qb * 256] + 2.0f * Bq + 48.0f;
                const bool skp = (C.lane < ntf - 4) && (Gl[64 * C.lane + 63] > thr);
                const int j0 = __builtin_popcountll(__ballot(skp)) & ~1;
                attn_body::attn_unit<8>(bh / NH, bh % NH, qb, Q, K, V, (attn_body::bf16*)(p.ws + o_off), (char*)lds, Gl, j0);
            } else {
                if (!(PARTS & 2)) continue;
                const int v = (int)u - 128, h = v & 7, g = 15 - (v >> 3);
                cur_bh = -1;
                int lane_ = C.lane; asm volatile("" : "+v"(lane_));
                sbk::sb_unit(qx, h, 8 * g + C.wave, (const bf16_t*)(p.ws + WS_QQ), (const bf16_t*)(p.ws + WS_KK), (const bf16_t*)(p.ws + WS_VV), (bf16_t*)(p.ws + o_off), (char*)lds + C.wave * sbk::WLDS, lane_);
            }
        }
    }
    __syncthreads();
}

namespace pgk {
typedef __bf16 bf16x2 __attribute__((ext_vector_type(2)));
__device__ __forceinline__ float dot2(unsigned a, unsigned b, float c) { return __builtin_amdgcn_fdot2_f32_bf16(__builtin_bit_cast(bf16x2, a), __builtin_bit_cast(bf16x2, b), c, false); }
__device__ __forceinline__ unsigned cvtpk(float lo, float hi) { typedef float f2 __attribute__((ext_vector_type(2))); f2 v = {lo, hi}; bf16x2 b = __builtin_convertvector(v, bf16x2); return __builtin_bit_cast(unsigned, b); }
}
namespace tk {
using bf16x8 = __attribute__((ext_vector_type(8))) short;
using f32x16 = __attribute__((ext_vector_type(16))) float;
constexpr int NCAND = 50;
__device__ __forceinline__ unsigned f2key(float f) { const unsigned u = __float_as_uint(f); return u ^ ((unsigned)((int)u >> 31) | 0x80000000u); }
__device__ __forceinline__ float key2f(unsigned k) { return __uint_as_float(k ^ ~((unsigned)((int)k >> 31) >> 1)); }
#define TK_CE(a, b) do { const unsigned mx_ = (a) > (b) ? (a) : (b), mn_ = (a) > (b) ? (b) : (a); (a) = mx_; (b) = mn_; } while (0)
template <int N> __device__ __forceinline__ void sort_desc(unsigned (&k)[N]) {
#pragma unroll
    for (int size = 2; size <= N; size <<= 1) {
#pragma unroll
        for (int stride = size >> 1; stride > 0; stride >>= 1) {
#pragma unroll
            for (int i = 0; i < N; ++i) { const int j = i ^ stride; if (j > i) { if ((i & size) == 0 || size == N) TK_CE(k[i], k[j]); else TK_CE(k[j], k[i]); } }
        }
    }
}
__device__ __forceinline__ void merge_desc16(unsigned (&k)[16]) {
#pragma unroll
    for (int stride = 8; stride > 0; stride >>= 1) {
#pragma unroll
        for (int i = 0; i < 16; ++i) { const int j = i ^ stride; if (j > i) TK_CE(k[i], k[j]); }
    }
}
__device__ __forceinline__ void top16_merge(unsigned (&a)[16], const unsigned (&b)[16]) {
#pragma unroll
    for (int i = 0; i < 16; ++i) a[i] = a[i] > b[15 - i] ? a[i] : b[15 - i];
    merge_desc16(a);
}
__device__ __forceinline__ void xlane_merge(unsigned (&a)[16]) {
    unsigned o[16];
#pragma unroll
    for (int i = 0; i < 16; ++i) o[i] = (unsigned)__shfl_xor((int)a[i], 32);
    top16_merge(a, o);
}
__device__ __forceinline__ void half_top16(const f32x16 (&z)[4], int c4, unsigned (&out)[16]) {
    unsigned k[4][16];
#pragma unroll
    for (int blk = 0; blk < 4; ++blk)
#pragma unroll
        for (int r = 0; r < 16; ++r) k[blk][r] = (f2key(z[blk][r]) & ~127u) | (unsigned)((127 - 32 * blk - (r & 3) - 8 * (r >> 2)) - c4);
#pragma unroll
    for (int blk = 0; blk < 4; ++blk) sort_desc<16>(k[blk]);
    top16_merge(k[0], k[1]); top16_merge(k[2], k[3]); top16_merge(k[0], k[2]);
    xlane_merge(k[0]);
#pragma unroll
    for (int i = 0; i < 16; ++i) out[i] = k[0][i];
}
}

__device__ __forceinline__ void ph_topk(const Prm& p, const Ctx& C, int l, unsigned char* lds) {
    constexpr int TA[64] = {0,0,0,0,0,0,0,0,0,0,0,0,0,0,0,0,1,1,1,1,1,1,1,1,2,2,2,2,2,3,3,3,3,4,4,4,5,5,6,6,7,7,8,9,10,11,12,13,14,15,0,0,0,0,0,0,0,0,0,0,0,0,0,0};
    constexpr int TB[64] = {0,1,2,3,4,5,6,7,8,9,10,11,12,13,14,15,0,1,2,3,4,5,6,7,0,1,2,3,4,0,1,2,3,0,1,2,0,1,0,1,0,1,0,0,0,0,0,0,0,0,0,0,0,0,0,0,0,0,0,0,0,0,0,0};
    const bf16_t* QP = (const bf16_t*)(p.ws + WS_KK); unsigned short* IDX = (unsigned short*)(p.ws + WS_VV); float* PW = (float*)(p.ws + WS_VV + 16 * MiB);
    const int lane = C.lane, r32 = lane & 31, hi = lane >> 5;
    int c4 = 4 * hi; asm volatile("" : "+v"(c4));
    unsigned char* wtab = lds + 32768 + C.wave * 1024 + r32 * 32;
    for (int item = blockIdx.x; item < 256; item += gridDim.x) {
        const int h = item & 7, tg = item >> 3;
        __syncthreads();
        for (int c = C.tid; c < 2048; c += NTHREADS) {
            const int tbl = c >> 10, row = (c >> 3) & 127, ch = c & 7;
            const float* src = (tbl ? p.k2 : p.k1) + ((size_t)(l * NH + h) * NKEYS + row) * 64 + ch * 8;
            const f32x4 a = *(const f32x4*)src, b = *(const f32x4*)(src + 4);
            u32x4 o; o.x = pgk::cvtpk(a.x, a.y); o.y = pgk::cvtpk(a.z, a.w); o.z = pgk::cvtpk(b.x, b.y); o.w = pgk::cvtpk(b.z, b.w);
            *(u32x4*)(lds + tbl * 16384 + row * 128 + ((ch ^ (row & 7)) << 4)) = o;
        }
        __syncthreads();
#pragma unroll 1
        for (int i = 0; i < 4; ++i) {
            const int tile = tg * 32 + C.wave * 4 + i, t = tile * 32 + r32;
            const bf16_t* qrow = QP + (size_t)t * DM + h * 128 + 8 * hi;
            unsigned V1[16], V2[16];
#pragma unroll
            for (int half = 0; half < 2; ++half) {
                tk::bf16x8 qf[4];
#pragma unroll
                for (int ks = 0; ks < 4; ++ks) qf[ks] = *(const tk::bf16x8*)(qrow + half * 64 + 16 * ks);
                tk::f32x16 z[4];
#pragma unroll
                for (int blk = 0; blk < 4; ++blk) {
                    z[blk] = tk::f32x16{};
                    const int row = 32 * blk + r32;
#pragma unroll
                    for (int ks = 0; ks < 4; ++ks) {
                        const tk::bf16x8 kfr = *(const tk::bf16x8*)(lds + half * 16384 + row * 128 + (((2 * ks + hi) ^ (row & 7)) << 4));
                        z[blk] = __builtin_amdgcn_mfma_f32_32x32x16_bf16(kfr, qf[ks], z[blk], 0, 0, 0);
                    }
                }
                if (half == 0) tk::half_top16(z, c4, V1); else tk::half_top16(z, c4, V2);
            }
            { u32x4 w;
              unsigned n[16];
#pragma unroll
              for (int q = 0; q < 16; ++q) n[q] = 127u - ((hi ? V2[q] : V1[q]) & 127u);
              w.x = n[0] | (n[1] << 8) | (n[2] << 16) | (n[3] << 24); w.y = n[4] | (n[5] << 8) | (n[6] << 16) | (n[7] << 24);
              w.z = n[8] | (n[9] << 8) | (n[10] << 16) | (n[11] << 24); w.w = n[12] | (n[13] << 8) | (n[14] << 16) | (n[15] << 24);
              *(u32x4*)(wtab + 16 * hi) = w; }
            float f1[16], f2[16];
#pragma unroll
            for (int q = 0; q < 16; ++q) { f1[q] = tk::key2f(V1[q] & ~127u); f2[q] = tk::key2f(V2[q] & ~127u); }
            unsigned ca[16], cb[16];
#pragma unroll
            for (int s = 0; s < 32; ++s) {
                const float v0 = f1[TA[s]] + f2[TB[s]];
                const float v1 = (32 + s < tk::NCAND) ? f1[TA[32 + s]] + f2[TB[32 + s]] : -INFINITY;
                const unsigned j0 = 255u - (unsigned)(TA[s] * 16 + TB[s]), j1 = 255u - (unsigned)(TA[32 + s] * 16 + TB[32 + s]);
                const unsigned key = (tk::f2key(hi ? v1 : v0) & ~255u) | (hi ? j1 : j0);
                if (s < 16) ca[s] = key; else cb[s - 16] = key;
            }
            tk::sort_desc<16>(ca); tk::sort_desc<16>(cb); tk::top16_merge(ca, cb); tk::xlane_merge(ca);
            float e[16]; float sum = 0.f; const float mx = tk::key2f(ca[0] & ~255u);
#pragma unroll
            for (int q = 0; q < 16; ++q) { e[q] = __builtin_amdgcn_exp2f((tk::key2f(ca[q] & ~255u) - mx) * LOG2E); sum += e[q]; }
            const float inv = 1.0f / sum;
            int eo[8]; float go[8];
            asm volatile("s_waitcnt lgkmcnt(0)" ::: "memory");
#pragma unroll
            for (int q = 0; q < 8; ++q) {
                const unsigned kq = hi ? ca[8 + q] : ca[q]; const unsigned j = 255u - (kq & 255u);
                const unsigned n1 = wtab[j >> 4], n2 = wtab[16 + (j & 15)];
                eo[q] = (int)(n1 * NKEYS + n2); go[q] = (hi ? e[8 + q] : e[q]) * inv;
            }
            unsigned short* ip = IDX + (size_t)t * 128 + h * 16 + 8 * hi; float* gp = PW + (size_t)t * 128 + h * 16 + 8 * hi;
            *(u32x4*)ip = (u32x4){(unsigned)eo[0] | ((unsigned)eo[1] << 16), (unsigned)eo[2] | ((unsigned)eo[3] << 16), (unsigned)eo[4] | ((unsigned)eo[5] << 16), (unsigned)eo[6] | ((unsigned)eo[7] << 16)};
            *(f32x4*)gp = (f32x4){go[0], go[1], go[2], go[3]}; *(f32x4*)(gp + 4) = (f32x4){go[4], go[5], go[6], go[7]};
            asm volatile("s_waitcnt lgkmcnt(0)" ::: "memory");
        }
    }
    __syncthreads();
}


constexpr size_t WS_T8 = WS_UB;
constexpr size_t WS_SC8 = WS_K12;
typedef float f32x2 __attribute__((ext_vector_type(2)));
typedef short s16x4 __attribute__((ext_vector_type(4))); typedef int i32x4 __attribute__((ext_vector_type(4))); typedef int i32x2 __attribute__((ext_vector_type(2)));
#define GAS __attribute__((address_space(1)))
#define LAS __attribute__((address_space(3)))
#define XB_TMO      128
#define XB_XCNT(j)  (256  + 64 * (j))
#define XB_XSUB(j)  (1280 + 64 * (j))
#define XB_XGEN(j)  (2304 + 64 * (j))
#define XB_TOP      3328
#define XB_TOPGEN   3392
#define XCD_BAR_WORDS 3456
#define XB_SPIN_CAP (1u << 18)

__device__ __forceinline__ unsigned xb_ld(unsigned* p)              { return __hip_atomic_load(p, __ATOMIC_RELAXED, __HIP_MEMORY_SCOPE_AGENT); }
__device__ __forceinline__ unsigned xb_add(unsigned* p, unsigned v) { return __hip_atomic_fetch_add(p, v, __ATOMIC_RELAXED, __HIP_MEMORY_SCOPE_AGENT); }
__device__ __forceinline__ unsigned xb_xcc_id() { return (unsigned)__builtin_amdgcn_s_getreg((3 << 11) | 20) & 0xFu; }
#define XB_SPIN(cond, bar) do { unsigned _sp = 0; while (cond) { __builtin_amdgcn_s_sleep(1); \
    if ((++_sp & 255u) == 0u) { if (xb_ld(&(bar)[XB_TMO])) break; if (_sp > XB_SPIN_CAP) { atomicAdd(&(bar)[XB_TMO], 1u); break; } } } } while (0)

struct XcdBarrier {
    unsigned* bar; unsigned x;
    volatile LAS unsigned* st;
};

__device__ __forceinline__ XcdBarrier xcd_barrier_post(unsigned* bar, volatile LAS unsigned* st) {
    XcdBarrier b; b.bar = bar; b.x = xb_xcc_id(); b.st = st;
    if (threadIdx.x == 0) st[2] = xb_add(&bar[XB_XCNT(b.x)], 1u);
    return b;
}
__device__ __forceinline__ void xcd_barrier_complete(unsigned* bar, unsigned x, unsigned& nloc, unsigned& nx) {
    const unsigned G = gridDim.x * gridDim.y * gridDim.z;
    unsigned sum, cnt, mine, sp = 0u;
    for (;;) {
        sum = 0u; cnt = 0u; mine = 0u;
#pragma unroll
        for (unsigned j = 0; j < 16; ++j) { const unsigned c = xb_ld(&bar[XB_XCNT(j)]); sum += c; cnt += (c > 0u) ? 1u : 0u; mine = (j == x) ? c : mine; }
        if (sum == G) break;
        __builtin_amdgcn_s_sleep(1);
        if ((++sp & 255u) == 0u) { if (xb_ld(&bar[XB_TMO])) break; if (sp > XB_SPIN_CAP) { atomicAdd(&bar[XB_TMO], 1u); break; } }
    }
    nloc = mine > 0u ? mine : 1u; nx = cnt > 0u ? cnt : 1u;
}

__device__ __forceinline__ void xcd_barrier(const XcdBarrier& b) {
    asm volatile("s_waitcnt vmcnt(0)" ::: "memory");
    __syncthreads();
    if (threadIdx.x == 0) {
        unsigned* bar = b.bar;
        __builtin_amdgcn_s_waitcnt(0);
        unsigned nloc = b.st[0], nx = b.st[1];
        if (nloc == 0u) { xcd_barrier_complete(bar, b.x, nloc, nx); b.st[0] = nloc; b.st[1] = nx; }
        const unsigned old = xb_add(&bar[XB_XSUB(b.x)], 1u);
        const unsigned gen = old / nloc;
        if (old + 1u == (gen + 1u) * nloc) {
            __builtin_amdgcn_fence(__ATOMIC_RELEASE, "agent");
            asm volatile("s_waitcnt vmcnt(0)" ::: "memory");
            const unsigned og = xb_add(&bar[XB_TOP], 1u);
            const unsigned tg = og / nx;
            if (og + 1u == (tg + 1u) * nx) xb_add(&bar[XB_TOPGEN], 1u);
            else XB_SPIN(xb_ld(&bar[XB_TOPGEN]) == tg, bar);
            __builtin_amdgcn_fence(__ATOMIC_ACQUIRE, "agent");
            xb_add(&bar[XB_XGEN(b.x)], 1u);
            asm volatile("s_waitcnt vmcnt(0)" ::: "memory");
        } else {
            XB_SPIN(xb_ld(&bar[XB_XGEN(b.x)]) == gen, bar);
            __builtin_amdgcn_fence(__ATOMIC_ACQUIRE, "agent");
            asm volatile("s_waitcnt vmcnt(0)" ::: "memory");
        }
    }
    __syncthreads();
}


constexpr size_t WS_PD = WS_GT;
__device__ __forceinline__ void ph_convert_tables8s(const Prm& p, const Ctx& C) {
    unsigned char* T8 = p.ws + WS_T8; float* SC = (float*)(p.ws + WS_SC8);
    constexpr int NR = 2 * 2 * NEXP;
    f32x4 v[2][2][4];
#define CV_LOAD(s_, row0_) do { _Pragma("unroll") for (int r = 0; r < 2; ++r) { const int row = min((row0_) + r * C.ngw, NR - 1); const int lt = row >> 14, e = row & (NEXP - 1), l = lt >> 1, tbl = lt & 1; \
        const float* src = (tbl ? p.pv : p.pu) + ((size_t)l * NEXP + e) * DM + 4 * C.lane; _Pragma("unroll") for (int j = 0; j < 4; ++j) v[s_][r][j] = *(const f32x4*)(src + 256 * j); } } while (0)
#define CV_PROC(s_, row0_) do { _Pragma("unroll") for (int r = 0; r < 2; ++r) { const int row = (row0_) + r * C.ngw; if (row >= NR) break; const int lt = row >> 14, e = row & (NEXP - 1); \
        float am = 0.f; _Pragma("unroll") for (int j = 0; j < 4; ++j) am = fmaxf(am, fmaxf(fmaxf(fabsf(v[s_][r][j].x), fabsf(v[s_][r][j].y)), fmaxf(fabsf(v[s_][r][j].z), fabsf(v[s_][r][j].w)))); \
        am = fmaxf(am, dpp_f<0xB1>(am)); am = fmaxf(am, dpp_f<0x4E>(am)); am = fmaxf(am, dpp_f<0x141>(am)); am = fmaxf(am, dpp_f<0x140>(am)); am = fmaxf(am, __shfl_xor(am, 16)); am = fmaxf(am, __shfl_xor(am, 32)); \
          \
        const float qm = 7.0f / 0.75f, sc = am > 0.f ? am / qm : 1.0f, inv = am > 0.f ? qm / am : 0.f; \
        const int o8 = (lt & 1) ? 8 : 0;     \
        _Pragma("unroll") for (int j = 0; j < 4; ++j) {     \
            const int q0 = (int)fminf(fmaxf(rintf(v[s_][r][j].x * inv), -8.0f), 7.0f), q1 = (int)fminf(fmaxf(rintf(v[s_][r][j].y * inv), -8.0f), 7.0f), q2 = (int)fminf(fmaxf(rintf(v[s_][r][j].z * inv), -8.0f), 7.0f), q3 = (int)fminf(fmaxf(rintf(v[s_][r][j].w * inv), -8.0f), 7.0f); \
            const int o_ = C.lane < 32 ? o8 : 0; const unsigned mine = (unsigned)(((q0 + o_) & 15) | (((q1 + o_) & 15) << 8) | (((q2 + o_) & 15) << 16) | (((q3 + o_) & 15) << 24)); \
            const unsigned other = (unsigned)__shfl_xor((int)mine, 32); \
            if (C.lane < 32) *(unsigned*)(T8 + (((size_t)lt * 8 + j) * NEXP + e) * 128 + 4 * C.lane) = mine | (other << 4); } \
        if (C.lane == 0) SC[row] = sc; } } while (0)
    CV_LOAD(0, C.gw);
    __builtin_amdgcn_s_waitcnt(0x0F70);
#pragma unroll 1
    for (int row0 = C.gw; row0 < NR; row0 += 4 * C.ngw) {
        CV_LOAD(1, row0 + 2 * C.ngw); CV_PROC(0, row0);
        CV_LOAD(0, row0 + 4 * C.ngw); CV_PROC(1, row0 + 2 * C.ngw);
    }
#undef CV_LOAD
#undef CV_PROC
}
__device__ __forceinline__ float sum8(float v) { v += dpp_f<0xB1>(v); v += dpp_f<0x4E>(v); v += dpp_f<0x141>(v); return v; }
template <int JS> __device__ __forceinline__ unsigned bcast8(unsigned v, int jq) {
    constexpr int c = JS & 3, ctrl = c | (c << 2) | (c << 4) | (c << 6);
    const unsigned v1 = (unsigned)__builtin_amdgcn_update_dpp(0, (int)v, ctrl, 0xF, 0xF, true);
    const unsigned v2 = (unsigned)__builtin_amdgcn_update_dpp(0, (int)v1, 0x141, 0xF, 0xF, true);
    return (jq == (JS >> 2)) ? v1 : v2;
}
template <int BB> __device__ __forceinline__ unsigned pick_id(unsigned idw, int jq) { const unsigned w = bcast8<(BB >> 1)>(idw, jq); return (BB & 1) ? (w >> 16) : (w & 0xffffu); }
template <int G4> __device__ __forceinline__ int bcast4(unsigned v) { constexpr int ctrl = G4 | (G4 << 2) | (G4 << 4) | (G4 << 6); return __builtin_amdgcn_update_dpp(0, (int)v, ctrl, 0xF, 0xF, true); }
struct SliceCtx { int x, wq, nwq; };
#ifndef SLICE_BY_XCC
#define SLICE_BY_XCC 0
#endif
__device__ __forceinline__ SliceCtx slice_ctx(const Ctx& C, const Prm& p, unsigned char* lds) { SliceCtx s; const int G = gridDim.x;
    if (SLICE_BY_XCC) { const unsigned x = xb_xcc_id() & 7u; const unsigned* bar = (const unsigned*)(p.ws + WS_CTL); const volatile LAS unsigned* st = (const volatile LAS unsigned*)((LAS unsigned char*)lds + (LDS_BYTES - 64));
        s.x = (int)x; s.wq = (int)st[2] * NWAVES + C.wave; s.nwq = (int)xb_ld((unsigned*)&bar[XB_XCNT(x)]) * NWAVES; return s; }
    s.x = blockIdx.x & 7; s.wq = (blockIdx.x >> 3) * NWAVES + C.wave; s.nwq = ((G - s.x + 7) >> 3) * NWAVES; return s; }
__device__ __forceinline__ void ph_peer_u(const Prm& p, const Ctx& C, int l, unsigned char* lds) {
    const SliceCtx S = slice_ctx(C, p, lds);
    const bf16_t* HB = (const bf16_t*)(p.ws + WS_QQ);     const unsigned short* IDX = (const unsigned short*)(p.ws + WS_VV); float* PD = (float*)(p.ws + WS_PD);
    const unsigned char* U8 = p.ws + WS_T8 + ((size_t)(l * 2 + 0) * 8 + S.x) * NEXP * 128;
    const int lane = C.lane, j = lane & 7, k = lane >> 3, jq = (lane >> 2) & 1;
    u32x4 uq[2][16]; unsigned idw[2]; u32x4 hr0[2], hr1[2];
    const int nit = (NT - S.wq + S.nwq - 1) / S.nwq;
#define PU_TOK(i) (S.wq + ((i) < nit ? (i) : nit - 1) * S.nwq)
#define PU_LOADID(s_, i) do { idw[s_] = ((const unsigned*)IDX)[(size_t)PU_TOK(i) * 64 + lane]; } while (0)
#define PU_LOADH(s_, i) do { const bf16_t* hp_ = HB + (size_t)PU_TOK(i) * DM + 128 * S.x + 16 * j; hr0[s_] = *(const u32x4*)hp_; hr1[s_] = *(const u32x4*)(hp_ + 8); } while (0)
#define PU_G1(s_, BB) uq[s_][BB] = *(const u32x4*)(U8 + (size_t)pick_id<BB>(idw[s_], jq) * 128 + 16 * j)
#define PU_GATHER(s_, h_) do { PU_G1(s_, 8 * (h_) + 0); PU_G1(s_, 8 * (h_) + 1); PU_G1(s_, 8 * (h_) + 2); PU_G1(s_, 8 * (h_) + 3); PU_G1(s_, 8 * (h_) + 4); PU_G1(s_, 8 * (h_) + 5); PU_G1(s_, 8 * (h_) + 6); PU_G1(s_, 8 * (h_) + 7); } while (0)
#define PU_MATH(s_, h_, pd_) do { _Pragma("unroll") for (int b_ = 0; b_ < 8; ++b_) { const int bb = 8 * (h_) + b_; int ai = __builtin_amdgcn_sdot4((int)uq[s_][bb].x, hq[0], 0, false); \
        ai = __builtin_amdgcn_sdot4((int)uq[s_][bb].y, hq[1], ai, false); ai = __builtin_amdgcn_sdot4((int)uq[s_][bb].z, hq[2], ai, false); ai = __builtin_amdgcn_sdot4((int)uq[s_][bb].w, hq[3], ai, false); \
        ai += dpp_i<0xB1>(ai); ai += dpp_i<0x4E>(ai); ai += dpp_i<0x141>(ai); if (b_ == j) pd_ = ai; } } while (0)
    PU_LOADID(0, 0); PU_LOADID(1, 1); PU_LOADH(0, 0); PU_LOADH(1, 1);
    PU_GATHER(0, 0); PU_GATHER(0, 1); PU_GATHER(1, 0); PU_GATHER(1, 1);
    PU_LOADID(0, 2);
#pragma unroll 1
    for (int it = 0; it < nit; it += 2) {
#pragma unroll
        for (int a = 0; a < 2; ++a) {
            const int i = it + a, bq = 1 - a;
            int hq[4]; float hsc;
            { const unsigned hw[8] = {hr0[a].x, hr0[a].y, hr0[a].z, hr0[a].w, hr1[a].x, hr1[a].y, hr1[a].z, hr1[a].w};
              float hv[16]; float am = 0.f;
#pragma unroll
              for (int q = 0; q < 8; ++q) { hv[2 * q] = __uint_as_float(hw[q] << 16); hv[2 * q + 1] = __uint_as_float(hw[q] & 0xffff0000u); am = fmaxf(am, fmaxf(fabsf(hv[2 * q]), fabsf(hv[2 * q + 1]))); }
              am = fmaxf(am, dpp_f<0xB1>(am)); am = fmaxf(am, dpp_f<0x4E>(am)); am = fmaxf(am, dpp_f<0x141>(am));
              hsc = am > 0.f ? am * (1.0f / 127.0f) : 1.0f; const float inv = am > 0.f ? 127.0f / am : 0.f;
#pragma unroll
              for (int q = 0; q < 4; ++q) { unsigned u0 = __builtin_amdgcn_cvt_pk_u8_f32(hv[4 * q] * inv + 128.0f, 0, 0u); u0 = __builtin_amdgcn_cvt_pk_u8_f32(hv[4 * q + 1] * inv + 128.0f, 1, u0);
                  u0 = __builtin_amdgcn_cvt_pk_u8_f32(hv[4 * q + 2] * inv + 128.0f, 2, u0); u0 = __builtin_amdgcn_cvt_pk_u8_f32(hv[4 * q + 3] * inv + 128.0f, 3, u0); hq[q] = (int)(u0 ^ 0x80808080u); } }
            PU_LOADH(a, i + 2); PU_LOADID(bq, i + 3);
            int pd0 = 0, pd1 = 0;
            PU_MATH(a, 0, pd0); PU_GATHER(a, 0);
            PU_MATH(a, 1, pd1); PU_GATHER(a, 1);
            if (i < nit) { float* pd = PD + ((size_t)S.x * NT + (S.wq + i * S.nwq)) * 128 + 16 * k + j; pd[0] = (float)pd0 * hsc; pd[8] = (float)pd1 * hsc; }
        }
    }
#undef PU_TOK
#undef PU_LOADID
#undef PU_LOADH
#undef PU_GATHER
#undef PU_G1
#undef PU_MATH
}
__device__ __forceinline__ void ph_peer_pre(const Prm& p, const Ctx& C, int l) {
    const float* MOD = (const float*)(p.ws + WS_MOD) + (size_t)l * NB * MODW + 3 * DM;
    const bf16_t* WQT = (const bf16_t*)(p.ws + WS_WQ) + (size_t)l * DM * DM; float* BQ = (float*)(p.ws + WS_BQ) + (size_t)l * NB * DM;
    for (int item = C.gw; item < (DM / 8) * NB; item += C.ngw) {
        const int b = item & 7, c0 = (item >> 3) * 8;
        float sh[16];
#pragma unroll
        for (int q = 0; q < 4; ++q) { const f32x4 v = *(const f32x4*)(MOD + (size_t)b * MODW + 16 * C.lane + 4 * q); sh[4 * q] = v.x; sh[4 * q + 1] = v.y; sh[4 * q + 2] = v.z; sh[4 * q + 3] = v.w; }
        float res = 0.f;
#pragma unroll
        for (int c = 0; c < 8; ++c) { const u32x4 w0 = *(const u32x4*)(WQT + (size_t)(c0 + c) * DM + 16 * C.lane), w1 = *(const u32x4*)(WQT + (size_t)(c0 + c) * DM + 16 * C.lane + 8);
            const unsigned ww[8] = {w0.x, w0.y, w0.z, w0.w, w1.x, w1.y, w1.z, w1.w}; float a = 0.f;
#pragma unroll
            for (int q = 0; q < 8; ++q) a += __uint_as_float(ww[q] << 16) * sh[2 * q] + __uint_as_float(ww[q] & 0xffff0000u) * sh[2 * q + 1];
            a = wave_sum(a); if (C.lane == c) res = a; }
        if (C.lane < 8) BQ[(size_t)b * DM + c0 + C.lane] = res;
    }
    const unsigned char* U8 = p.ws + WS_T8 + (size_t)(l * 2 + 0) * 8 * NEXP * 128; const float* SU = (const float*)(p.ws + WS_SC8) + (size_t)(l * 2) * NEXP; float* USH = (float*)(p.ws + WS_USH) + (size_t)l * NB * NEXP;
    float shb[8][16];
    const int cl = 256 * (C.lane >> 4) + 8 * (C.lane & 15);
#pragma unroll
    for (int b = 0; b < 8; ++b)
#pragma unroll
        for (int q = 0; q < 4; ++q) { const f32x4 v = *(const f32x4*)(MOD + (size_t)b * MODW + cl + 128 * (q >> 1) + 4 * (q & 1)); shb[b][4 * q] = v.x; shb[b][4 * q + 1] = v.y; shb[b][4 * q + 2] = v.z; shb[b][4 * q + 3] = v.w; }
    const int hi5 = C.lane >> 5, b4 = (C.lane >> 4) & 1;
    for (int e0 = C.gw; e0 < NEXP; e0 += 2 * C.ngw) {
        u32x2 uq[2];
#pragma unroll
        for (int r = 0; r < 2; ++r) uq[r] = *(const u32x2*)(U8 + ((size_t)(C.lane >> 4) * NEXP + min(e0 + r * C.ngw, NEXP - 1)) * 128 + 8 * (C.lane & 15));
#pragma unroll
        for (int r = 0; r < 2; ++r) { const int e = e0 + r * C.ngw; if (e >= NEXP) break;
            const unsigned w[2] = {uq[r].x, uq[r].y}; float uf[16];
#pragma unroll
            for (int q = 0; q < 8; ++q) { uf[q] = (float)(((int)(w[q >> 2] << (28 - 8 * (q & 3)))) >> 28); uf[8 + q] = (float)(((int)(w[q >> 2] << (24 - 8 * (q & 3)))) >> 28); }
            float a[8];
#pragma unroll
            for (int b = 0; b < 8; ++b) { float t = 0.f;
#pragma unroll
                for (int q = 0; q < 16; ++q) t += uf[q] * shb[b][q];
                a[b] = t; }
            float r4[4], r2[2];
#pragma unroll
            for (int q = 0; q < 4; ++q) r4[q] = xsum32(a[q], a[4 + q]);
#pragma unroll
            for (int q = 0; q < 2; ++q) r2[q] = xsum16(r4[q], r4[2 + q]);
#pragma unroll
            for (int q = 0; q < 2; ++q) { float v = r2[q]; v += dpp_f<0xB1>(v); v += dpp_f<0x4E>(v); v += dpp_f<0x141>(v); v += dpp_f<0x128>(v); r2[q] = v; }
            if ((C.lane & 15) == 0) { const float su = SU[e], sv = SU[NEXP + e]; const int b0 = 4 * hi5 + 2 * b4;
                f32x4* REC = (f32x4*)(p.ws + WS_T8 + ((size_t)(l * 2 + 0) * 8 + 4) * NEXP * 128); REC[(size_t)b0 * NEXP + e] = (f32x4){r2[0] * su, su, sv, 0.f}; REC[(size_t)(b0 + 1) * NEXP + e] = (f32x4){r2[1] * su, su, sv, 0.f}; }
        }
    }
}
__device__ __forceinline__ void ph_peer_r(const Prm& p, const Ctx& C, int l) {
    const unsigned short* IDX = (const unsigned short*)(p.ws + WS_VV); float* PW = (float*)(p.ws + WS_VV + 16 * MiB); const float* PD = (const float*)(p.ws + WS_PD);
    const float* SU = (const float*)(p.ws + WS_SC8) + (size_t)(l * 2) * NEXP; const float* SV = SU + NEXP;
    const size_t n = (size_t)NT * 128, stride = (size_t)gridDim.x * NTHREADS;
    for (size_t i = (size_t)blockIdx.x * NTHREADS + C.tid; i < n; i += stride) {
        float s = 0.f;
#pragma unroll
        for (int x = 0; x < 8; ++x) s += PD[(size_t)x * n + i];
        const size_t t = i >> 7; const float r = ((const float*)(p.ws + WS_FC))[t];
        const int id = IDX[i]; const float d = s * r * SU[id] + ((const float*)(p.ws + WS_USH))[((size_t)l * NB + t / SEQ) * NEXP + id];
        const float cf = PW[i] * (0.5f * d * (1.0f + erff(d * 0.70710678118654752f))) * SV[id];
        float cmx = fabsf(cf); cmx = fmaxf(cmx, dpp_f<0xB1>(cmx)); cmx = fmaxf(cmx, dpp_f<0x4E>(cmx)); cmx = fmaxf(cmx, dpp_f<0x141>(cmx)); cmx = fmaxf(cmx, dpp_f<0x128>(cmx));
        const float inv = cmx > 0.f ? 127.0f / cmx : 0.f;
        ((unsigned char*)(p.ws + WS_VV + 32 * MiB))[i] = (unsigned char)((__builtin_amdgcn_cvt_pk_u8_f32(cf * inv + 128.0f, 0, 0u) ^ 0x80u) & 0xffu);
        if ((C.lane & 15) == 0) ((float*)(p.ws + WS_VV + 40 * MiB))[i >> 4] = cmx * (1.0f / 127.0f);
    }
}
__device__ __forceinline__ void ph_peer_v(const Prm& p, const Ctx& C, int l, unsigned char* lds) {
    const SliceCtx S = slice_ctx(C, p, lds);
    const unsigned short* IDX = (const unsigned short*)(p.ws + WS_VV); const unsigned char* CQ = p.ws + WS_VV + 32 * MiB; const float* CSC = (const float*)(p.ws + WS_VV + 40 * MiB);
    const float* MOD = (const float*)(p.ws + WS_MOD) + (size_t)l * NB * MODW;
    const unsigned char* V8 = p.ws + WS_T8 + ((size_t)(l * 2 + 1) * 8 + S.x) * NEXP * 128;
    const int lane = C.lane, j = lane & 7, k = lane >> 3, b3 = (lane >> 3) & 1, jq = (lane >> 2) & 1;
    u32x4 vq[2][16]; unsigned idw[2]; unsigned cqw[2]; float csv[2]; f32x2 xvv[2], gvv[2];
    const int ocol = 128 * S.x + 16 * j + 2 * k;
    const int nit = (NT - S.wq + S.nwq - 1) / S.nwq;
#define PV_TOK(i) (S.wq + ((i) < nit ? (i) : nit - 1) * S.nwq)
#define PV_LOADID(s_, i) do { idw[s_] = ((const unsigned*)IDX)[(size_t)PV_TOK(i) * 64 + lane]; } while (0)
#define PV_LOADC(s_, i) do { const int t_ = PV_TOK(i); cqw[s_] = ((const unsigned*)CQ)[(size_t)t_ * 32 + 4 * k + (j & 3)]; csv[s_] = CSC[(size_t)t_ * 8 + k]; \
        xvv[s_] = *(const f32x2*)(p.out + (size_t)t_ * DM + ocol); gvv[s_] = *(const f32x2*)(MOD + (size_t)(t_ / SEQ) * MODW + 5 * DM + ocol); } while (0)
#define PV_G1(s_, BB) vq[s_][BB] = *(const u32x4*)(V8 + (size_t)pick_id<BB>(idw[s_], jq) * 128 + 16 * j)
#define PV_GATHER(s_, h_) do { PV_G1(s_, 8 * (h_) + 0); PV_G1(s_, 8 * (h_) + 1); PV_G1(s_, 8 * (h_) + 2); PV_G1(s_, 8 * (h_) + 3); PV_G1(s_, 8 * (h_) + 4); PV_G1(s_, 8 * (h_) + 5); PV_G1(s_, 8 * (h_) + 6); PV_G1(s_, 8 * (h_) + 7); } while (0)
#define PV_MATH(s_, h_) do { _Pragma("unroll") for (int g_ = 2 * (h_); g_ < 2 * (h_) + 2; ++g_) { const unsigned r0_[4] = {vq[s_][4 * g_].x, vq[s_][4 * g_].y, vq[s_][4 * g_].z, vq[s_][4 * g_].w}, r1_[4] = {vq[s_][4 * g_ + 1].x, vq[s_][4 * g_ + 1].y, vq[s_][4 * g_ + 1].z, vq[s_][4 * g_ + 1].w}, \
        r2_[4] = {vq[s_][4 * g_ + 2].x, vq[s_][4 * g_ + 2].y, vq[s_][4 * g_ + 2].z, vq[s_][4 * g_ + 2].w}, r3_[4] = {vq[s_][4 * g_ + 3].x, vq[s_][4 * g_ + 3].y, vq[s_][4 * g_ + 3].z, vq[s_][4 * g_ + 3].w}; \
        _Pragma("unroll") for (int w = 0; w < 4; ++w) { const unsigned p01l = __builtin_amdgcn_perm(r1_[w], r0_[w], 0x05010400u), p01h = __builtin_amdgcn_perm(r1_[w], r0_[w], 0x07030602u), p23l = __builtin_amdgcn_perm(r3_[w], r2_[w], 0x05010400u), p23h = __builtin_amdgcn_perm(r3_[w], r2_[w], 0x07030602u); \
            yi[4 * w + 0] = __builtin_amdgcn_sdot4((int)__builtin_amdgcn_perm(p23l, p01l, 0x05040100u), cq[g_], yi[4 * w + 0], false); yi[4 * w + 1] = __builtin_amdgcn_sdot4((int)__builtin_amdgcn_perm(p23l, p01l, 0x07060302u), cq[g_], yi[4 * w + 1], false); \
            yi[4 * w + 2] = __builtin_amdgcn_sdot4((int)__builtin_amdgcn_perm(p23h, p01h, 0x05040100u), cq[g_], yi[4 * w + 2], false); yi[4 * w + 3] = __builtin_amdgcn_sdot4((int)__builtin_amdgcn_perm(p23h, p01h, 0x07060302u), cq[g_], yi[4 * w + 3], false); } } } while (0)
    PV_LOADID(0, 0); PV_LOADID(1, 1); PV_LOADC(0, 0); PV_LOADC(1, 1);
    PV_GATHER(0, 0); PV_GATHER(0, 1); PV_GATHER(1, 0); PV_GATHER(1, 1);
    PV_LOADID(0, 2);
#pragma unroll 1
    for (int it = 0; it < nit; it += 2) {
#pragma unroll
        for (int a = 0; a < 2; ++a) {
            const int i = it + a, bq = 1 - a;
            const int cq[4] = {bcast4<0>(cqw[a]), bcast4<1>(cqw[a]), bcast4<2>(cqw[a]), bcast4<3>(cqw[a])}; const float cback = csv[a]; const f32x2 xv = xvv[a], gv = gvv[a];
            PV_LOADC(a, i + 2); PV_LOADID(bq, i + 3);
            int yi[16];
#pragma unroll
            for (int q = 0; q < 16; ++q) yi[q] = 0;
            PV_MATH(a, 0); PV_GATHER(a, 0);
            PV_MATH(a, 1); PV_GATHER(a, 1);
            f32x2 y[8];
#pragma unroll
            for (int q = 0; q < 8; ++q) y[q] = (f32x2){(float)yi[2 * q] * cback, (float)yi[2 * q + 1] * cback};
            f32x2 r4[4], r2[2], r1;
#pragma unroll
            for (int q = 0; q < 4; ++q) r4[q] = (f32x2){xsum32(y[q].x, y[4 + q].x), xsum32(y[q].y, y[4 + q].y)};
#pragma unroll
            for (int q = 0; q < 2; ++q) r2[q] = (f32x2){xsum16(r4[q].x, r4[2 + q].x), xsum16(r4[q].y, r4[2 + q].y)};
            { const f32x2 snd = b3 ? r2[0] : r2[1], kp = b3 ? r2[1] : r2[0]; r1 = (f32x2){kp.x + dpp_f<0x128>(snd.x), kp.y + dpp_f<0x128>(snd.y)}; }
            if (i < nit) {
                const int t = S.wq + i * S.nwq;
                *(f32x2*)(p.out + (size_t)t * DM + ocol) = xv + gv * r1;
            }
        }
    }
#undef PV_TOK
#undef PV_LOADID
#undef PV_LOADC
#undef PV_GATHER
#undef PV_G1
#undef PV_MATH
}

template <int MODE = 0> __device__ __forceinline__ void ph_peer_u4(const Prm& p, const Ctx& C, int l, unsigned char* lds) {
    SliceCtx S; S.x = blockIdx.x & 3; S.wq = (blockIdx.x >> 2) * NWAVES + C.wave; S.nwq = (((int)gridDim.x - S.x + 3) >> 2) * NWAVES;
    const bf16_t* HB = (const bf16_t*)(p.ws + WS_QQ); float* PD = (float*)(p.ws + WS_PD);
    const unsigned short* IDX = (const unsigned short*)(p.ws + WS_VV);
    const unsigned char* U8 = p.ws + WS_T8 + ((size_t)(l * 2 + 0) * 8 + S.x) * NEXP * 128;
    const int lane = C.lane, j = lane & 7, k = lane >> 3, jq = (lane >> 2) & 1;
    u32x4 uq[2][16]; unsigned idw[2]; u32x2 hr[2];
    LAS unsigned* il = (LAS unsigned*)((LAS unsigned char*)lds + 131072 + C.wave * 256);
    unsigned idr[8];
    LAS unsigned* hl = (LAS unsigned*)((LAS unsigned char*)lds + C.wave * 256);
    const int nit = (NT - S.wq + S.nwq - 1) / S.nwq;
#define PU_TOK(i) (S.wq + ((i) < nit ? (i) : nit - 1) * S.nwq)
#define PU_LOADID(s_, i) do { idw[s_] = ((const unsigned*)IDX)[(size_t)PU_TOK(i) * 64 + lane]; } while (0)
#define PU_LOADH(s_, i) do { hr[s_] = *(const u32x2*)(HB + (size_t)PU_TOK(i) * DM + 256 * S.x + 4 * lane); } while (0)
#define PU_IDS(s_) do { il[lane] = idw[s_]; const u32x4 i0_ = *(LAS u32x4*)(il + 8 * k), i1_ = *(LAS u32x4*)(il + 8 * k + 4); idr[0] = i0_.x; idr[1] = i0_.y; idr[2] = i0_.z; idr[3] = i0_.w; idr[4] = i1_.x; idr[5] = i1_.y; idr[6] = i1_.z; idr[7] = i1_.w; } while (0)
#define PU_G1(s_, BB) uq[s_][BB] = *(const u32x4*)(U8 + (size_t)((((BB) & 1) ? (idr[(BB) >> 1] >> 16) : (idr[(BB) >> 1] & 0xffffu)) * 128u + 16u * (unsigned)j))
#define PU_GATHER(s_, h_) do { PU_G1(s_, 8 * (h_) + 0); PU_G1(s_, 8 * (h_) + 1); PU_G1(s_, 8 * (h_) + 2); PU_G1(s_, 8 * (h_) + 3); PU_G1(s_, 8 * (h_) + 4); PU_G1(s_, 8 * (h_) + 5); PU_G1(s_, 8 * (h_) + 6); PU_G1(s_, 8 * (h_) + 7); } while (0)
#define PU_MATH(s_, h_, pd_) do { _Pragma("unroll") for (int b_ = 0; b_ < 8; ++b_) { const int bb = 8 * (h_) + b_; const unsigned x_[4] = {uq[s_][bb].x, uq[s_][bb].y, uq[s_][bb].z, uq[s_][bb].w}; int a0_ = 0, a1_ = 0; \
        _Pragma("unroll") for (int w_ = 0; w_ < 4; ++w_) { a0_ = __builtin_amdgcn_sdot8((int)x_[w_], hp0[w_], a0_, false); a1_ = __builtin_amdgcn_sdot8((int)x_[w_], hp1[w_], a1_, false); } \
        pd_[bb] = a1_ * 16 + a0_; } } while (0)
    PU_LOADID(0, 0); PU_LOADID(1, 1); PU_LOADH(0, 0); PU_LOADH(1, 1);
    PU_IDS(0); PU_GATHER(0, 0); PU_GATHER(0, 1); PU_IDS(1); PU_GATHER(1, 0); PU_GATHER(1, 1);
    PU_LOADID(0, 2);
    __builtin_amdgcn_s_waitcnt(0x0F70);
#pragma unroll 1
    for (int it = 0; it < nit; it += 2) {
#pragma unroll
        for (int a = 0; a < 2; ++a) {
            const int i = it + a, bq = 1 - a;
            int hp0[4], hp1[4]; float hsc;
            { const float h0_ = __uint_as_float(hr[a].x << 16), h1_ = __uint_as_float(hr[a].x & 0xffff0000u), h2_ = __uint_as_float(hr[a].y << 16), h3_ = __uint_as_float(hr[a].y & 0xffff0000u);
              float am = fmaxf(fmaxf(fabsf(h0_), fabsf(h1_)), fmaxf(fabsf(h2_), fabsf(h3_)));
              am = fmaxf(am, dpp_f<0xB1>(am)); am = fmaxf(am, dpp_f<0x4E>(am)); am = fmaxf(am, dpp_f<0x141>(am)); am = fmaxf(am, dpp_f<0x140>(am)); am = fmaxf(am, __shfl_xor(am, 16)); am = fmaxf(am, __shfl_xor(am, 32));
              hsc = am > 0.f ? am * (1.0f / 119.0f) : 1.0f; const float inv = am > 0.f ? 119.0f / am : 0.f;
              unsigned u0 = __builtin_amdgcn_cvt_pk_u8_f32(h0_ * inv + 136.0f, 0, 0u); u0 = __builtin_amdgcn_cvt_pk_u8_f32(h1_ * inv + 136.0f, 1, u0); u0 = __builtin_amdgcn_cvt_pk_u8_f32(h2_ * inv + 136.0f, 2, u0); u0 = __builtin_amdgcn_cvt_pk_u8_f32(h3_ * inv + 136.0f, 3, u0);
              hl[lane] = u0;
              const u32x4 lo4 = *(LAS u32x4*)(hl + 4 * j), hi4 = *(LAS u32x4*)(hl + 32 + 4 * j);
              const unsigned L8_[4] = {lo4.x, lo4.y, lo4.z, lo4.w}, H8_[4] = {hi4.x, hi4.y, hi4.z, hi4.w};
#pragma unroll
              for (int w = 0; w < 4; ++w) { const unsigned L8 = L8_[w], H8 = H8_[w];
                  hp0[w] = (int)(((L8 & 0x0f0f0f0fu) | ((H8 & 0x0f0f0f0fu) << 4)) ^ 0x88888888u);
                  hp1[w] = (int)((((L8 >> 4) & 0x0f0f0f0fu) | (H8 & 0xf0f0f0f0u)) ^ 0x88888888u); } }
            PU_LOADH(a, i + 2); PU_LOADID(bq, i + 3);
            int v16[16];
            PU_IDS(a); PU_MATH(a, 0, v16); PU_GATHER(a, 0);
            PU_MATH(a, 1, v16); PU_GATHER(a, 1);
            int v8[8], v4[4], v2[2];
#pragma unroll
            for (int m = 0; m < 8; ++m) { const int kp = (j & 4) ? v16[8 + m] : v16[m], sd = (j & 4) ? v16[m] : v16[8 + m]; v8[m] = kp + dpp_i<0x141>(sd); }
#pragma unroll
            for (int m = 0; m < 4; ++m) { const int kp = (j & 2) ? v8[4 + m] : v8[m], sd = (j & 2) ? v8[m] : v8[4 + m]; v4[m] = kp + dpp_i<0x4E>(sd); }
#pragma unroll
            for (int m = 0; m < 2; ++m) { const int kp = (j & 1) ? v4[2 + m] : v4[m], sd = (j & 1) ? v4[m] : v4[2 + m]; v2[m] = kp + dpp_i<0xB1>(sd); }
            if (i < nit) { float* pd = (MODE == 1 ? (float*)(p.ws + WS_HB) : PD) + ((size_t)S.x * NT + (S.wq + i * S.nwq)) * 128 + 2 * lane; *(f32x2*)pd = (f32x2){(float)v2[0] * hsc, (float)v2[1] * hsc}; }
        }
    }
#undef PU_TOK
#undef PU_LOADID
#undef PU_LOADH
#undef PU_GATHER
#undef PU_G1
#undef PU_MATH
}

__device__ __forceinline__ void ph_peer_r2(const Prm& p, const Ctx& C, int l, unsigned char* lds) {
    const unsigned* IDX = (const unsigned*)(p.ws + WS_VV); const f32x2* PW = (const f32x2*)(p.ws + WS_VV + 16 * MiB); const f32x2* PD = (const f32x2*)(p.ws + WS_PD);
    unsigned char* CQ2 = p.ws + WS_VV + 32 * MiB; float* CSC = (float*)(p.ws + WS_VV + 40 * MiB);
    const float* SU = (const float*)(p.ws + WS_SC8) + (size_t)(l * 2) * NEXP; const float* SV = SU + NEXP;
    const size_t n2 = (size_t)NT * 64; const int lane = C.lane;
    const int bidx = 64 * (lane & 1) + 8 * ((lane >> 1) & 3) + (lane >> 3);
    LAS unsigned char* wl = (LAS unsigned char*)lds + C.wave * 256;
    for (int t = C.gw; t < NT; t += C.ngw) {
        f32x2 pd0 = PD[(size_t)t * 64 + lane], pd1 = PD[n2 + (size_t)t * 64 + lane], pd2 = PD[2 * n2 + (size_t)t * 64 + lane], pd3 = PD[3 * n2 + (size_t)t * 64 + lane];
        float r = ((const float*)(p.ws + WS_FC))[t];
        unsigned idw = IDX[(size_t)t * 64 + lane];
        f32x2 pw = PW[(size_t)t * 64 + lane];
        asm volatile("" : "+v"(pd0), "+v"(pd1), "+v"(pd2), "+v"(pd3), "+v"(r), "+v"(idw), "+v"(pw));
        const f32x2 sa = (pd0 + pd1) + (pd2 + pd3);
        const int id0 = (int)(idw & 0xffffu), id1 = (int)(idw >> 16);
        const f32x4* REC = (const f32x4*)(p.ws + WS_T8 + ((size_t)(l * 2 + 0) * 8 + 4) * NEXP * 128) + (size_t)(t / SEQ) * NEXP;
        f32x4 rc0 = REC[id0], rc1 = REC[id1];
        asm volatile("" : "+v"(rc0), "+v"(rc1));
        const float us0 = rc0.x, su0 = rc0.y, sv0 = rc0.z, us1 = rc1.x, su1 = rc1.y, sv1 = rc1.z;
        const float d0 = sa.x * r * su0 + us0, d1 = sa.y * r * su1 + us1;
        const float cf0 = pw.x * (0.5f * d0 * (1.0f + erff(d0 * 0.70710678118654752f))) * sv0;
        const float cf1 = pw.y * (0.5f * d1 * (1.0f + erff(d1 * 0.70710678118654752f))) * sv1;
        float cmx = fmaxf(fabsf(cf0), fabsf(cf1));
        cmx = fmaxf(cmx, dpp_f<0xB1>(cmx)); cmx = fmaxf(cmx, dpp_f<0x4E>(cmx)); cmx = fmaxf(cmx, dpp_f<0x141>(cmx)); cmx = fmaxf(cmx, dpp_f<0x140>(cmx));
        cmx = fmaxf(cmx, __shfl_xor(cmx, 16)); cmx = fmaxf(cmx, __shfl_xor(cmx, 32));
        const float inv = cmx > 0.f ? 16383.0f / cmx : 0.f;
        const int q0 = (int)rintf(cf0 * inv), q1 = (int)rintf(cf1 * inv);
        wl[bidx] = (unsigned char)(q0 >> 7); wl[bidx + 128] = (unsigned char)(q0 & 127); wl[bidx + 32] = (unsigned char)(q1 >> 7); wl[bidx + 160] = (unsigned char)(q1 & 127);
        int qs = q0 + q1;
        qs += dpp_i<0xB1>(qs); qs += dpp_i<0x4E>(qs); qs += dpp_i<0x141>(qs); qs += dpp_i<0x140>(qs); qs += __shfl_xor(qs, 16); qs += __shfl_xor(qs, 32);
        ((unsigned*)(CQ2 + (size_t)t * 256))[lane] = ((LAS unsigned*)wl)[lane];
        if (lane == 0) { const float sc = cmx * (1.0f / 16383.0f); *(f32x2*)(CSC + 2 * (size_t)t) = (f32x2){sc, 8.0f * sc * (float)qs}; }
    }
}
__device__ __forceinline__ void ph_peer_v2(const Prm& p, const Ctx& C, int l, unsigned char* lds) {
    SliceCtx S; S.x = blockIdx.x & 3; S.wq = (blockIdx.x >> 2) * NWAVES + C.wave; S.nwq = (((int)gridDim.x - S.x + 3) >> 2) * NWAVES;
    const unsigned short* IDX = (const unsigned short*)(p.ws + WS_VV); const unsigned char* CQ2 = p.ws + WS_VV + 32 * MiB; const f32x2* CSC = (const f32x2*)(p.ws + WS_VV + 40 * MiB);
    const float* MOD = (const float*)(p.ws + WS_MOD) + (size_t)l * NB * MODW;
    const unsigned char* V8 = p.ws + WS_T8 + ((size_t)(l * 2 + 1) * 8 + S.x) * NEXP * 128;
    const int lane = C.lane, j = lane & 7, k = lane >> 3, jq = (lane >> 2) & 1, n16 = lane & 15, q4 = lane >> 4;
    LAS unsigned* il = (LAS unsigned*)((LAS unsigned char*)lds + 131072 + C.wave * 256); unsigned idr[8];
    LAS unsigned char* wl = (LAS unsigned char*)lds + C.wave * 16384;
    const int wb_e = 128 * k + 32 * ((j >> 1) ^ ((k >> 1) & 1)) + 16 * (j & 1), wb_o = 128 * k + 32 * ((j >> 1) ^ ((k >> 1) & 1) ^ 2) + 16 * (j & 1);
    const int rr = (lane >> 2) & 3, pp = lane & 3, fr = ((rr >> 1) & 1) | ((q4 & 1) << 1);
    int rb[4];
#pragma unroll
    for (int nt = 0; nt < 4; ++nt) rb[nt] = 128 * (8 * q4 + rr) + 32 * (nt ^ fr) + 8 * pp;
    const unsigned selA0 = (lane & 1) ? 0x010c000cu : 0x0c010c00u, selB0 = (lane & 1) ? 0x030c020cu : 0x0c030c02u;
    const unsigned selAL = (lane & 4) ? 0x0c0c0c0cu : selA0, selBL = (lane & 4) ? 0x0c0c0c0cu : selB0, selAH = (lane & 4) ? selA0 : 0x0c0c0c0cu, selBH = (lane & 4) ? selB0 : 0x0c0c0c0cu;
    const int cqo = 128 * ((lane >> 1) & 1) + 32 * q4;
    const int ocol = 256 * S.x + 128 * (q4 & 1) + 64 * (q4 >> 1) + 2 * n16;
    u32x4 vq[2][16]; unsigned idw[2]; u32x4 cqa[2][2]; f32x2 csv[2]; unsigned xvb[2][2]; f32x2 gvv[2][2];
    const bf16_t* XR1 = (const bf16_t*)(p.ws + WS_XR1); bf16_t* XR2 = (bf16_t*)p.out;
    const int nit = (NT - S.wq + S.nwq - 1) / S.nwq;
#define PV_TOK(i) (S.wq + ((i) < nit ? (i) : nit - 1) * S.nwq)
#define PV_LOADID(s_, i) do { idw[s_] = ((const unsigned*)IDX)[(size_t)PV_TOK(i) * 64 + lane]; } while (0)
#define PV_LOADC(s_, i) do { const int t_ = PV_TOK(i); const unsigned char* cp_ = CQ2 + (size_t)t_ * 256 + cqo; cqa[s_][0] = *(const u32x4*)cp_; cqa[s_][1] = *(const u32x4*)(cp_ + 16); csv[s_] = CSC[t_]; \
        xvb[s_][0] = *(const unsigned*)(XR1 + (size_t)t_ * DM + ocol); xvb[s_][1] = *(const unsigned*)(XR1 + (size_t)t_ * DM + ocol + 32); gvv[s_][0] = *(const f32x2*)(MOD + (size_t)(t_ / SEQ) * MODW + 5 * DM + ocol); gvv[s_][1] = *(const f32x2*)(MOD + (size_t)(t_ / SEQ) * MODW + 5 * DM + ocol + 32); } while (0)
#define PV_IDS(s_) do { il[lane] = idw[s_]; const u32x4 i0_ = *(LAS u32x4*)(il + 8 * k), i1_ = *(LAS u32x4*)(il + 8 * k + 4); idr[0] = i0_.x; idr[1] = i0_.y; idr[2] = i0_.z; idr[3] = i0_.w; idr[4] = i1_.x; idr[5] = i1_.y; idr[6] = i1_.z; idr[7] = i1_.w; } while (0)
#define PV_G1(s_, BB) vq[s_][BB] = *(const u32x4*)(V8 + (size_t)((((BB) & 1) ? (idr[(BB) >> 1] >> 16) : (idr[(BB) >> 1] & 0xffffu)) * 128u + 16u * (unsigned)j))
#define PV_GATHER(s_, h_) do { PV_G1(s_, 8 * (h_) + 0); PV_G1(s_, 8 * (h_) + 1); PV_G1(s_, 8 * (h_) + 2); PV_G1(s_, 8 * (h_) + 3); PV_G1(s_, 8 * (h_) + 4); PV_G1(s_, 8 * (h_) + 5); PV_G1(s_, 8 * (h_) + 6); PV_G1(s_, 8 * (h_) + 7); } while (0)
#define PV_W1(s_, h_, B_) *(LAS u32x4*)(wl + 8192 * (h_) + 1024 * (B_) + (((B_) & 1) ? wb_o : wb_e)) = vq[s_][8 * (h_) + (B_)]
#define PV_WRITE(s_, h_) do { PV_W1(s_, h_, 0); PV_W1(s_, h_, 1); PV_W1(s_, h_, 2); PV_W1(s_, h_, 3); PV_W1(s_, h_, 4); PV_W1(s_, h_, 5); PV_W1(s_, h_, 6); PV_W1(s_, h_, 7); } while (0)
#define PV_TR(h_, ksl_, nt_, rd_) __builtin_amdgcn_ds_read_tr16_b64_v4i16((LAS s16x4*)(wl + 8192 * (h_) + 4096 * (ksl_) + 512 * (rd_) + rb[nt_]))
#define PV_MMA(h_) do { _Pragma("unroll") for (int ksl_ = 0; ksl_ < 2; ++ksl_) { const int ks_ = 2 * (h_) + ksl_; const unsigned w0_ = cw[2 * ks_], w1_ = cw[2 * ks_ + 1]; \
        const i32x4 AL_ = {(int)__builtin_amdgcn_perm(w0_, w0_, selAL), (int)__builtin_amdgcn_perm(w0_, w0_, selBL), (int)__builtin_amdgcn_perm(w1_, w1_, selAL), (int)__builtin_amdgcn_perm(w1_, w1_, selBL)}; \
        const i32x4 AH_ = {(int)__builtin_amdgcn_perm(w0_, w0_, selAH), (int)__builtin_amdgcn_perm(w0_, w0_, selBH), (int)__builtin_amdgcn_perm(w1_, w1_, selAH), (int)__builtin_amdgcn_perm(w1_, w1_, selBH)}; \
        _Pragma("unroll") for (int nt_ = 0; nt_ < 4; ++nt_) { const s16x4 b0_ = PV_TR(h_, ksl_, nt_, 0), b1_ = PV_TR(h_, ksl_, nt_, 1); const i32x2 c0_ = __builtin_bit_cast(i32x2, b0_), c1_ = __builtin_bit_cast(i32x2, b1_); \
            const i32x4 BL_ = {c0_.x & 0x0f0f0f0f, c0_.y & 0x0f0f0f0f, c1_.x & 0x0f0f0f0f, c1_.y & 0x0f0f0f0f}, BH_ = {c0_.x, c0_.y, c1_.x, c1_.y};     \
            acc[nt_] = __builtin_amdgcn_mfma_i32_16x16x64_i8(AL_, BL_, acc[nt_], 0, 0, 0); acc[nt_] = __builtin_amdgcn_mfma_i32_16x16x64_i8(AH_, BH_, acc[nt_], 0, 0, 0); } } } while (0)
    PV_LOADID(0, 0); PV_LOADID(1, 1); PV_LOADC(0, 0);
    PV_IDS(0); PV_GATHER(0, 0); PV_GATHER(0, 1); PV_IDS(1); PV_GATHER(1, 0); PV_GATHER(1, 1);
    PV_LOADID(0, 2);
    __builtin_amdgcn_s_waitcnt(0x0F70);
#pragma unroll 1
    for (int it = 0; it < nit; it += 2) {
#pragma unroll
        for (int a = 0; a < 2; ++a) {
            const int i = it + a, bq = 1 - a;
            const unsigned cw[8] = {cqa[a][0].x, cqa[a][0].y, cqa[a][0].z, cqa[a][0].w, cqa[a][1].x, cqa[a][1].y, cqa[a][1].z, cqa[a][1].w}; const f32x2 cback = csv[a]; const f32x2 xv0 = {__uint_as_float(xvb[a][0] << 16), __uint_as_float(xvb[a][0] & 0xffff0000u)}, xv1 = {__uint_as_float(xvb[a][1] << 16), __uint_as_float(xvb[a][1] & 0xffff0000u)}, gv0 = gvv[a][0], gv1 = gvv[a][1];
            PV_LOADC(bq, i + 1); PV_LOADID(bq, i + 3);
            i32x4 acc[4];
#pragma unroll
            for (int nt = 0; nt < 4; ++nt) acc[nt] = (i32x4){0, 0, 0, 0};
            PV_IDS(a); PV_WRITE(a, 0); PV_GATHER(a, 0); PV_MMA(0);
            PV_WRITE(a, 1); PV_GATHER(a, 1); PV_MMA(1);
            const i32x4 a0 = (q4 >> 1) ? acc[2] : acc[0], a1 = (q4 >> 1) ? acc[3] : acc[1];
            const float mf = (q4 & 1) ? cback.x * 0.0625f : cback.x, sb = (q4 & 1) ? 0.f : cback.y;
            int v00 = a0.x * 128 + a0.z, v01 = a0.y * 128 + a0.w, v10 = a1.x * 128 + a1.z, v11 = a1.y * 128 + a1.w;
            { const int p00 = __shfl_xor(v00, 16), p01 = __shfl_xor(v01, 16), p10 = __shfl_xor(v10, 16), p11 = __shfl_xor(v11, 16);
              if (q4 & 1) { v00 -= p00; v01 -= p01; v10 -= p10; v11 -= p11; } }
            const f32x2 y0 = {(float)v00 * mf - sb, (float)v01 * mf - sb}, y1 = {(float)v10 * mf - sb, (float)v11 * mf - sb};
            if (i < nit) {
                const int t = S.wq + i * S.nwq;
                const f32x2 o0 = xv0 + gv0 * y0, o1 = xv1 + gv1 * y1;
                if (l == 0) { *(unsigned*)(XR2 + (size_t)t * DM + ocol) = pg8::cvt_pk_bf16(o0.x, o0.y); *(unsigned*)(XR2 + (size_t)t * DM + ocol + 32) = pg8::cvt_pk_bf16(o1.x, o1.y); }
                else { *(f32x2*)(p.out + (size_t)t * DM + ocol) = o0; *(f32x2*)(p.out + (size_t)t * DM + ocol + 32) = o1; }
            }
        }
    }
#undef PV_TOK
#undef PV_LOADID
#undef PV_LOADC
#undef PV_GATHER
#undef PV_G1
#undef PV_W1
#undef PV_WRITE
#undef PV_TR
#undef PV_MMA
}

constexpr int PH_PER_LAYER = 11, NPH = 1 + 2 * PH_PER_LAYER;

__global__ void __launch_bounds__(NTHREADS, 2) mega(Prm p0) {
    extern __shared__ __attribute__((aligned(16))) unsigned char lds[];
    const int ph_lo = p0.ph_lo, ph_hi = p0.ph_hi;
    volatile LAS unsigned* bst = (volatile LAS unsigned*)((LAS unsigned char*)lds + (LDS_BYTES - 64));
    if (threadIdx.x < 16) bst[threadIdx.x] = 0u;
    __syncthreads();
    XcdBarrier bar = xcd_barrier_post((unsigned*)(p0.ws + WS_CTL), bst);
#define PHASE_BEGIN(k) if (ph_lo <= (k) && (k) < ph_hi) { Prm p = p0; Ctx C; \
        { size_t z_ = 0; asm volatile("" : "+s"(z_));     \
          p.x = (const float*)((const char*)p0.x + z_); p.c = (const float*)((const char*)p0.c + z_); p.ada_w = (const float*)((const char*)p0.ada_w + z_); p.ada_b = (const float*)((const char*)p0.ada_b + z_); \
          p.attn_norm = (const float*)((const char*)p0.attn_norm + z_); p.ffn_norm = (const float*)((const char*)p0.ffn_norm + z_); p.w_in = (const float*)((const char*)p0.w_in + z_); p.fox_bf = (const float*)((const char*)p0.fox_bf + z_); \
          p.gq = (const float*)((const char*)p0.gq + z_); p.gk = (const float*)((const char*)p0.gk + z_); p.w_branch = (const float*)((const char*)p0.w_branch + z_); p.w_out = (const float*)((const char*)p0.w_out + z_); \
          p.wq = (const float*)((const char*)p0.wq + z_); p.k1 = (const float*)((const char*)p0.k1 + z_); p.k2 = (const float*)((const char*)p0.k2 + z_); p.pu = (const float*)((const char*)p0.pu + z_); p.pv = (const float*)((const char*)p0.pv + z_); \
          p.out = (float*)((char*)p0.out + z_); p.ws = p0.ws + z_; } \
        C.tid = threadIdx.x; asm volatile("" : "+v"(C.tid)); C.lane = C.tid & 63; C.wave = __builtin_amdgcn_readfirstlane(C.tid >> 6); \
        C.gw = blockIdx.x * NWAVES + C.wave; C.ngw = gridDim.x * NWAVES;
#define PHASE_END(k) if ((k) + 1 < ph_hi) { xcd_barrier(bar); } }
    PHASE_BEGIN(0) ph_mod(p, C); ph_weights(p, C, lds); ph_convert_tables8s(p, C); PHASE_END(0)
#pragma unroll 1
    for (int l = 0; l < 2; ++l) {
        const int k0 = 1 + l * PH_PER_LAYER;
        PHASE_BEGIN(k0 + 0) ph_norm<true>(p, C, l, p.x, l == 0 ? (const bf16_t*)nullptr : (const bf16_t*)p.out, p.attn_norm + l * DM, 0, 1, lds); ph_peer_pre(p, C, l); PHASE_END(k0 + 0)
        PHASE_BEGIN(k0 + 1) ph_gemm1(p, l, lds); PHASE_END(k0 + 1)
        PHASE_BEGIN(k0 + 2) ph_attn<3>(p, C, l, lds); PHASE_END(k0 + 2)
        PHASE_BEGIN(k0 + 3) ph_merge(p, l, lds); PHASE_END(k0 + 3)
        PHASE_BEGIN(k0 + 4) ph_out(p, l, lds); PHASE_END(k0 + 4)
        PHASE_BEGIN(k0 + 6) ph_q(p, l, lds); PHASE_END(k0 + 6)
        PHASE_BEGIN(k0 + 7) ph_topk(p, C, l, lds); PHASE_END(k0 + 7)
        PHASE_BEGIN(k0 + 8) ph_peer_u4(p, C, l, lds); PHASE_END(k0 + 8)
        PHASE_BEGIN(k0 + 9) ph_peer_r2(p, C, l, lds); PHASE_END(k0 + 9)
        PHASE_BEGIN(k0 + 10) ph_peer_v2(p, C, l, lds); PHASE_END(k0 + 10)
    }
}

extern "C" void kernel_launch(void* const* d_in, const int* in_sizes, int n_in, void* d_out, int out_size, void* d_ws, size_t ws_size, hipStream_t stream) {
    static int grid = 0;
    if (grid == 0) {
        if (n_in != 17 || out_size != NT * DM || ws_size < WS_END) { fprintf(stderr, "kernel_launch: unexpected shapes (n_in %d out %d ws %zu)\n", n_in, out_size, ws_size); grid = -1; return; }
        int dev = 0, cus = 0, per_cu = 0;
        hipGetDevice(&dev); hipDeviceGetAttribute(&cus, hipDeviceAttributeMultiprocessorCount, dev);
        hipFuncSetAttribute((const void*)mega, hipFuncAttributeMaxDynamicSharedMemorySize, LDS_BYTES);
        hipOccupancyMaxActiveBlocksPerMultiprocessor(&per_cu, (const void*)mega, NTHREADS, LDS_BYTES);
        if (per_cu < 1) { fprintf(stderr, "kernel_launch: occupancy query says %d blocks per CU\n", per_cu); per_cu = 1; }
        (void)hipGetLastError();
        grid = cus;
    }
    if (grid < 0) return;
    if (hipMemsetAsync((char*)d_ws + WS_CTL, 0, 32768, stream) != hipSuccess) { fprintf(stderr, "kernel_launch: memset of the barrier words failed\n"); return; }
    Prm p{};
    const float** pp = (const float**)&p;
    for (int i = 0; i < 17; ++i) pp[i] = (const float*)d_in[i];
    p.out = (float*)d_out; p.ws = (unsigned char*)d_ws;
#if MK_MULTI
    for (int ph = 0; ph < NPH; ++ph) { p.ph_lo = ph; p.ph_hi = ph + 1; hipLaunchKernelGGL(mega, dim3(grid), dim3(NTHREADS), LDS_BYTES, stream, p); }
#else
    p.ph_lo = 0; p.ph_hi = NPH;
    void* args[] = {&p};
    hipError_t e = hipLaunchCooperativeKernel((const void*)mega, dim3(grid), dim3(NTHREADS), args, LDS_BYTES, stream);
    if (e != hipSuccess) fprintf(stderr, "cooperative launch failed: %s (grid %d)\n", hipGetErrorString(e), grid);
#endif
}
```

```cpp
#include <hip/hip_runtime.h>
#include <hip/hip_cooperative_groups.h>
#include <hip/hip_bf16.h>
#include <cstdio>
#include <cstdint>
namespace cg = cooperative_groups;

#ifndef MK_MULTI
#define MK_MULTI 0
#endif

constexpr int NB = 8, SEQ = 4096, DM = 1024, NT = NB * SEQ, NH = 8, HD = 64, INW = 5128, NEXP = 16384, NKEYS = 128, TOPK = 16;
constexpr int MODW = 6 * DM;
constexpr float EPS = 1e-6f;
constexpr float LOG2E = 1.4426950408889634f, LN2 = 0.6931471805599453f;
constexpr float C2 = 0.125f * LOG2E;
constexpr int NWAVES = 8, NTHREADS = 512;
constexpr int LDS_BYTES = 147456;

constexpr size_t MiB = 1u << 20;
constexpr size_t WS_CTL = 0;
constexpr size_t WS_MOD = 1 * MiB;
constexpr size_t WS_FA = 2 * MiB;
constexpr size_t WS_FC = 3 * MiB;
constexpr size_t WS_WIN = 4 * MiB;
constexpr size_t WS_WBR = 24 * MiB;
constexpr size_t WS_WOUT = 28 * MiB;
constexpr size_t WS_WQ = 32 * MiB;
constexpr size_t WS_K12 = 36 * MiB;
constexpr size_t WS_UB = 37 * MiB;
constexpr size_t WS_VB = 69 * MiB;
constexpr size_t WS_HB = 101 * MiB;
constexpr size_t WS_QQ = 165 * MiB;
constexpr size_t WS_KK = 229 * MiB;
constexpr size_t WS_VV = 293 * MiB;
constexpr size_t WS_GT = 357 * MiB;
constexpr size_t WS_SSQ = 485 * MiB;
constexpr size_t WS_BQ = 487 * MiB;
constexpr size_t WS_USH = 488 * MiB;
constexpr size_t WS_END = 490 * MiB;
constexpr size_t WS_XR1 = WS_GT + 64 * MiB;

typedef unsigned short bf16_t;
typedef float f32x4 __attribute__((ext_vector_type(4)));
typedef unsigned u32x4 __attribute__((ext_vector_type(4))); typedef unsigned u32x2 __attribute__((ext_vector_type(2)));

struct Prm {
    const float *x, *c, *ada_w, *ada_b, *attn_norm, *ffn_norm, *w_in, *fox_bf, *gq, *gk, *w_branch, *w_out, *wq, *k1, *k2, *pu, *pv;
    float* out; unsigned char* ws; int ph_lo, ph_hi;
};

__device__ __forceinline__ float bf2f(bf16_t v) { return __uint_as_float((unsigned)v << 16); }
__device__ __forceinline__ unsigned f2bf(float f) { unsigned u = __float_as_uint(f); return (u + 0x7fffu + ((u >> 16) & 1u)) >> 16; }
__device__ __forceinline__ unsigned pk2(float lo, float hi) { return f2bf(lo) | (f2bf(hi) << 16); }
template <int CTRL> __device__ __forceinline__ int dpp_i(int v) { return __builtin_amdgcn_update_dpp(0, v, CTRL, 0xF, 0xF, true); }
template <int CTRL> __device__ __forceinline__ float dpp_f(float v) { return __int_as_float(__builtin_amdgcn_update_dpp(0, __float_as_int(v), CTRL, 0xF, 0xF, true)); }
__device__ __forceinline__ float xsum32(float a, float b) { const auto r = __builtin_amdgcn_permlane32_swap(__float_as_uint(a), __float_as_uint(b), false, false); return __uint_as_float(r[0]) + __uint_as_float(r[1]); }
__device__ __forceinline__ float xsum16(float a, float b) { const auto r = __builtin_amdgcn_permlane16_swap(__float_as_uint(a), __float_as_uint(b), false, false); return __uint_as_float(r[0]) + __uint_as_float(r[1]); }
__device__ __forceinline__ float xmax32(float a) { const auto r = __builtin_amdgcn_permlane32_swap(__float_as_uint(a), __float_as_uint(a), false, false); return fmaxf(__uint_as_float(r[0]), __uint_as_float(r[1])); }
__device__ __forceinline__ float xmax16(float a) { const auto r = __builtin_amdgcn_permlane16_swap(__float_as_uint(a), __float_as_uint(a), false, false); return fmaxf(__uint_as_float(r[0]), __uint_as_float(r[1])); }
__device__ __forceinline__ int xsumi32(int a) { const auto r = __builtin_amdgcn_permlane32_swap((unsigned)a, (unsigned)a, false, false); return (int)(r[0] + r[1]); }
__device__ __forceinline__ int xsumi16(int a) { const auto r = __builtin_amdgcn_permlane16_swap((unsigned)a, (unsigned)a, false, false); return (int)(r[0] + r[1]); }
__device__ __forceinline__ float wave_sum(float v) {
    v += dpp_f<0xB1>(v); v += dpp_f<0x4E>(v); v += dpp_f<0x141>(v); v += dpp_f<0x140>(v);
    v = xsum16(v, v); v = xsum32(v, v);
    return v;
}
__device__ __forceinline__ float sigmoidf_(float a) { return 1.0f / (1.0f + __expf(-a)); }
__device__ __forceinline__ float log_sigmoidf_(float a) { return fminf(a, 0.f) - log1pf(expf(-fabsf(a))); }
__device__ __forceinline__ float softplus2(float z2) { return fmaxf(z2, 0.f) + __log2f(1.0f + exp2f(-fabsf(z2))); }

struct Ctx { int tid, lane, wave, gw, ngw; };

__device__ __forceinline__ void ph_mod(const Prm& p, const Ctx& C) {
    float* MOD = (float*)(p.ws + WS_MOD);
    for (int item = C.gw; item < 2 * (MODW / 8); item += C.ngw) {
        const int l = item / (MODW / 8), cb = (item % (MODW / 8)) * 8;
        float acc[8][8];
#pragma unroll
        for (int b = 0; b < 8; ++b)
#pragma unroll
            for (int j = 0; j < 8; ++j) acc[b][j] = 0.f;
        for (int i = 0; i < 16; ++i) {
            const int k = C.lane + 64 * i;
            const float* wp = p.ada_w + ((size_t)l * DM + k) * MODW + cb;
            const f32x4 w0 = *(const f32x4*)wp, w1 = *(const f32x4*)(wp + 4);
            const float w[8] = {w0.x, w0.y, w0.z, w0.w, w1.x, w1.y, w1.z, w1.w};
#pragma unroll
            for (int b = 0; b < 8; ++b) {
                const float cv = p.c[b * DM + k]; const float sv = cv * sigmoidf_(cv);
#pragma unroll
                for (int j = 0; j < 8; ++j) acc[b][j] += sv * w[j];
            }
        }
        float res = 0.f;
#pragma unroll
        for (int b = 0; b < 8; ++b)
#pragma unroll
            for (int j = 0; j < 8; ++j) { const float s = wave_sum(acc[b][j]); if (C.lane == b * 8 + j) res = s; }
        const int b = C.lane >> 3, j = C.lane & 7;
        MOD[((size_t)l * NB + b) * MODW + cb + j] = res + p.ada_b[l * MODW + cb + j];
    }
}

template <bool WITH_FA>
__device__ __forceinline__ void ph_norm(const Prm& p, const Ctx& C, int l, const float* xin, const bf16_t* xinb, const float* gain, int ch_sh, int ch_sc, unsigned char* lds) {
    const float* MOD = (const float*)(p.ws + WS_MOD) + (size_t)l * NB * MODW;
    bf16_t* HB = (bf16_t*)(p.ws + WS_HB);
    float* FA = (float*)(p.ws + WS_FA);
    f32x4 g4[4];
#pragma unroll
    for (int j = 0; j < 4; ++j) g4[j] = *(const f32x4*)(gain + 4 * C.lane + 256 * j);
    float* wfl = (float*)lds;
    if (WITH_FA) {
        for (int i = C.tid; i < DM * 8; i += NTHREADS) wfl[i] = p.w_in[((size_t)l * DM + (i >> 3)) * INW + 1536 + (i & 7)];
        __syncthreads();
    }
    for (int m0 = C.gw; m0 < NT; m0 += 2 * C.ngw) {
      f32x4 vv[2][4];
#pragma unroll
      for (int rr = 0; rr < 2; ++rr) { const size_t xo = (size_t)min(m0 + rr * C.ngw, NT - 1) * DM + 4 * C.lane;
        if (xinb == nullptr) {
#pragma unroll
            for (int j = 0; j < 4; ++j) vv[rr][j] = *(const f32x4*)(xin + xo + 256 * j);
        } else {
#pragma unroll
            for (int j = 0; j < 4; ++j) { const u32x2 w = *(const u32x2*)(xinb + xo + 256 * j); vv[rr][j] = (f32x4){__uint_as_float(w.x << 16), __uint_as_float(w.x & 0xffff0000u), __uint_as_float(w.y << 16), __uint_as_float(w.y & 0xffff0000u)}; } } }
      f32x4 shv[4], scv[4];
      { const int b0_ = m0 / SEQ;
#pragma unroll
        for (int j = 0; j < 4; ++j) { shv[j] = *(const f32x4*)(MOD + (size_t)b0_ * MODW + ch_sh * DM + 4 * C.lane + 256 * j); scv[j] = *(const f32x4*)(MOD + (size_t)b0_ * MODW + ch_sc * DM + 4 * C.lane + 256 * j); } }
#pragma unroll
      for (int rr = 0; rr < 2; ++rr) {
        const int m = m0 + rr * C.ngw; if (m >= NT) break;
        const int b = m / SEQ; const bool sameb = (b == m0 / SEQ);
        f32x4 v[4]; float s = 0.f;
#pragma unroll
        for (int j = 0; j < 4; ++j) { v[j] = vv[rr][j]; s += (v[j].x * v[j].x + v[j].y * v[j].y) + (v[j].z * v[j].z + v[j].w * v[j].w); }
        const float r = 1.0f / sqrtf(wave_sum(s) * (1.0f / DM) + EPS);
        const float* shp = MOD + (size_t)b * MODW + ch_sh * DM + 4 * C.lane;
        const float* scp = MOD + (size_t)b * MODW + ch_sc * DM + 4 * C.lane;
        float fa[8];
#pragma unroll
        for (int q = 0; q < 8; ++q) fa[q] = 0.f;
#pragma unroll
        for (int j = 0; j < 4; ++j) {
            const f32x4 sh = sameb ? shv[j] : *(const f32x4*)(shp + 256 * j), sc = sameb ? scv[j] : *(const f32x4*)(scp + 256 * j);
            f32x4 h = (v[j] * r) * g4[j] * (sc + 1.0f) + sh;
            unsigned long long o = (unsigned long long)pk2(h.x, h.y) | ((unsigned long long)pk2(h.z, h.w) << 32);
            *(unsigned long long*)(HB + (size_t)m * DM + 4 * C.lane + 256 * j) = o;
            if (WITH_FA) {
                const float hh[4] = {h.x, h.y, h.z, h.w};
#pragma unroll
                for (int e = 0; e < 4; ++e) {
                    const f32x4 wa = *(const f32x4*)(wfl + (4 * C.lane + 256 * j + e) * 8), wb = *(const f32x4*)(wfl + (4 * C.lane + 256 * j + e) * 8 + 4);
                    fa[0] += hh[e] * wa.x; fa[1] += hh[e] * wa.y; fa[2] += hh[e] * wa.z; fa[3] += hh[e] * wa.w;
                    fa[4] += hh[e] * wb.x; fa[5] += hh[e] * wb.y; fa[6] += hh[e] * wb.z; fa[7] += hh[e] * wb.w;
                }
            }
        }
        if (WITH_FA) {
            float res = 0.f;
#pragma unroll
            for (int q = 0; q < 8; ++q) { const float t = wave_sum(fa[q]); if (C.lane == q) res = t; }
            if (C.lane < 8) FA[(size_t)m * 8 + C.lane] = log_sigmoidf_(res + p.fox_bf[l * NH + C.lane]);
        }
      }
    }
    if (WITH_FA) __syncthreads();
}

namespace pg8 {
#define PG8_LAS __attribute__((address_space(3)))
typedef short bf16x8 __attribute__((ext_vector_type(8)));
constexpr int BM = 256, BK = 64, HALF = 128, HTB = HALF * BK * 2  , STAGE_BYTES = 8 * HTB, NXCD = 8, WGM = 8;
__host__ __device__ __forceinline__ int lds_byte(int r, int c) { const int st = (r >> 4) * 2 + (c >> 5), rr = r & 15, cc = c & 31, ob = rr * 64 + cc * 2; return st * 1024 + (ob ^ (((ob >> 9) & 1) << 5)); }
__host__ __device__ __forceinline__ void stage_rc(int b, int& R, int& C) { const int st = b / 1024, sb = b % 1024, swz = sb ^ (((sb >> 9) & 1) << 5); R = (st >> 1) * 16 + swz / 64; C = (st & 1) * 32 + (swz % 64) / 2; }
__host__ __device__ __forceinline__ int perm32(int rho) { const int n = rho >> 4, i = rho & 15; return 8 * (i >> 2) + 4 * n + (i & 3); }

struct Unit { int pm, pn, ka, kb, br; };
struct Gemm { const bf16_t* A; const bf16_t* Bt; int lda, ldb, K; };

struct Order {
    int nM, nN, nwg, G, c, pair, bstride;
    __device__ void init(int M, int N, int G_, int c_, int pair_, int bstride_ = 0) { nM = M / BM; nN = N / BM; nwg = nM * nN; G = G_; c = c_; pair = pair_; bstride = bstride_; }
    __device__ bool next(int i, Unit& u) const {
        const int ii = pair ? (i >> 1) : i;
        const long L = (long)ii * G + c; if (L >= nwg) return false;
        int wgid = (int)L; { const int q = nwg / NXCD, r = nwg % NXCD, xcd = wgid % NXCD, off = wgid / NXCD; wgid = (xcd < r ? xcd * (q + 1) : r * (q + 1) + (xcd - r) * q) + off; }
        const int nig = WGM * nN, gid = wgid / nig, fm = gid * WGM, gsz = (nM - fm) < WGM ? (nM - fm) : WGM;
        u.pm = fm + ((wgid % nig) % gsz); u.pn = (wgid % nig) / gsz;
        u.br = pair ? (i & 1) : 0; u.ka = u.br * 512; u.kb = u.br * (1024 * 512) + (u.pm * BM / SEQ) * bstride;
        return true;
    }
    __device__ __forceinline__ void a_ready(const Unit&) const {}
    __device__ __forceinline__ void done(const Unit&) const {}
};

__device__ __forceinline__ unsigned cvt_pk_bf16(float lo, float hi) { unsigned r; asm volatile("v_cvt_pk_bf16_f32 %0, %1, %2" : "=v"(r) : "v"(lo), "v"(hi)); return r; }
__device__ __forceinline__ u32x4 pack8(const f32x4 a, const f32x4 b) { u32x4 w; w.x = cvt_pk_bf16(a[0], a[1]); w.y = cvt_pk_bf16(a[2], a[3]); w.z = cvt_pk_bf16(b[0], b[1]); w.w = cvt_pk_bf16(b[2], b[3]); return w; }
__device__ __forceinline__ void unpack8(const u32x4 w, f32x4& a, f32x4& b) {
    a = (f32x4){__uint_as_float(w.x << 16), __uint_as_float(w.x & 0xffff0000u), __uint_as_float(w.y << 16), __uint_as_float(w.y & 0xffff0000u)};
    b = (f32x4){__uint_as_float(w.z << 16), __uint_as_float(w.z & 0xffff0000u), __uint_as_float(w.w << 16), __uint_as_float(w.w & 0xffff0000u)};
}

struct Epi1 {
    static constexpr bool PERM = true, AFTER_DRAIN = false;
    bf16_t *QQ, *KK, *VV, *GT; const float *gq, *gk;
    __device__ __forceinline__ void operator()(const f32x4 (&acc)[2][2][4][2], const Unit& u, int wr, int wc, int fr, int fq) const {
        const int row0 = u.pm * BM + wr * 64 + fr;
        if (u.pn >= 12) {
            const int col0 = (u.pn - 12) * 256 + wc * 32 + 8 * fq;
#pragma unroll
            for (int ai = 0; ai < 2; ++ai)
#pragma unroll
                for (int m = 0; m < 4; ++m) { unsigned char* rowp = (unsigned char*)GT + (size_t)(row0 + ai * HALF + m * 16) * 2048 + col0;
#pragma unroll
                    for (int bj = 0; bj < 2; ++bj) { const f32x4 a0 = acc[ai][bj][m][0], a1 = acc[ai][bj][m][1];
                        u32x2 w; unsigned t_ = __builtin_amdgcn_cvt_pk_u8_f32(rintf(255.0f * sigmoidf_(a0[0])), 0, 0u); t_ = __builtin_amdgcn_cvt_pk_u8_f32(rintf(255.0f * sigmoidf_(a0[1])), 1, t_); t_ = __builtin_amdgcn_cvt_pk_u8_f32(rintf(255.0f * sigmoidf_(a0[2])), 2, t_); w.x = __builtin_amdgcn_cvt_pk_u8_f32(rintf(255.0f * sigmoidf_(a0[3])), 3, t_);
                        t_ = __builtin_amdgcn_cvt_pk_u8_f32(rintf(255.0f * sigmoidf_(a1[0])), 0, 0u); t_ = __builtin_amdgcn_cvt_pk_u8_f32(rintf(255.0f * sigmoidf_(a1[1])), 1, t_); t_ = __builtin_amdgcn_cvt_pk_u8_f32(rintf(255.0f * sigmoidf_(a1[2])), 2, t_); w.y = __builtin_amdgcn_cvt_pk_u8_f32(rintf(255.0f * sigmoidf_(a1[3])), 3, t_);
                        *(u32x2*)(rowp + bj * HALF) = w; } }
        } else {
            const int kind = u.pn >> 1, head = (u.pn & 1) * 4 + wc, k3 = kind % 3;
            bf16_t* base = (k3 == 0 ? QQ : (k3 == 1 ? KK : VV)) + (kind >= 3 ? 512 : 0) + head * 64 + 8 * fq;
            const bool nrm = kind < 2; const float qs = (k3 == 0) ? C2 : 1.0f;
            f32x4 gn[2][2];
#pragma unroll
            for (int bj = 0; bj < 2; ++bj)
#pragma unroll
                for (int n = 0; n < 2; ++n) gn[bj][n] = nrm ? *(const f32x4*)((kind == 0 ? gq : gk) + bj * 32 + 8 * fq + 4 * n) : (f32x4){1.f, 1.f, 1.f, 1.f};
#pragma unroll
            for (int ai = 0; ai < 2; ++ai)
#pragma unroll
                for (int m = 0; m < 4; ++m) {
                    float r = qs;
                    if (nrm) { float ss = 0.f;
#pragma unroll
                        for (int bj = 0; bj < 2; ++bj)
#pragma unroll
                            for (int n = 0; n < 2; ++n) { const f32x4 x = acc[ai][bj][m][n]; ss += (x[0] * x[0] + x[1] * x[1]) + (x[2] * x[2] + x[3] * x[3]); }
                        ss = xsum16(ss, ss); ss = xsum32(ss, ss);
                        r = qs * __builtin_amdgcn_rsqf(ss * (1.0f / 64.0f) + EPS); }
                    bf16_t* rowp = base + (size_t)(row0 + ai * HALF + m * 16) * DM;
#pragma unroll
                    for (int bj = 0; bj < 2; ++bj) *(u32x4*)(rowp + bj * 32) = pack8(acc[ai][bj][m][0] * r * gn[bj][0], acc[ai][bj][m][1] * r * gn[bj][1]);
                }
        }
    }
};
struct EpiGate {
    static constexpr bool PERM = true, AFTER_DRAIN = false;
    const bf16_t* GT; bf16_t* MG;
    __device__ __forceinline__ void operator()(const f32x4 (&acc)[2][2][4][2], const Unit& u, int wr, int wc, int fr, int fq) const {
        const int row0 = u.pm * BM + wr * 64 + fr, col0 = u.pn * BM + wc * 32 + 8 * fq;
#pragma unroll
        for (int ai = 0; ai < 2; ++ai)
#pragma unroll
            for (int m = 0; m < 4; ++m) { const size_t row = (size_t)(row0 + ai * HALF + m * 16);
#pragma unroll
                for (int bj = 0; bj < 2; ++bj) { const int c = col0 + bj * HALF;
                    f32x4 g0, g1; unpack8(*(const u32x4*)(GT + row * 2048 + u.br * 1024 + c), g0, g1);
                    f32x4 v0 = g0 * acc[ai][bj][m][0], v1 = g1 * acc[ai][bj][m][1];
                    if (u.br) { f32x4 o0, o1; unpack8(*(const u32x4*)(MG + row * DM + c), o0, o1); v0 += o0; v1 += o1; }
                    *(u32x4*)(MG + row * DM + c) = pack8(v0, v1); } }
    }
};
struct EpiMerge {
    static constexpr bool PERM = true, AFTER_DRAIN = false, MIDHOOK = true;
    const unsigned char* GT; bf16_t* MG;
    static __device__ __forceinline__ void unpackb(const u32x2 w, f32x4& a, f32x4& b) {
        a = (f32x4){(float)(w.x & 255u), (float)((w.x >> 8) & 255u), (float)((w.x >> 16) & 255u), (float)(w.x >> 24)};
        b = (f32x4){(float)(w.y & 255u), (float)((w.y >> 8) & 255u), (float)((w.y >> 16) & 255u), (float)(w.y >> 24)}; }
    static constexpr float TINY = 255.0f * 9.094947e-13f;
    __device__ __forceinline__ void mid(f32x4 (&acc)[2][2][4][2], const Unit& u, int wr, int wc, int fr_, int fq_) const {
        int fr = fr_, fq = fq_; asm volatile("" : "+v"(fr), "+v"(fq));
        const int row0 = u.pm * BM + wr * 64 + fr, col0 = u.pn * BM + wc * 32 + 8 * fq;
#pragma unroll
        for (int ai = 0; ai < 2; ++ai) {
            u32x2 ga[4][2], gb[4][2];
#pragma unroll
            for (int m = 0; m < 4; ++m) { const size_t row = (size_t)(row0 + ai * HALF + m * 16);
#pragma unroll
                for (int bj = 0; bj < 2; ++bj) { const int c = col0 + bj * HALF; ga[m][bj] = *(const u32x2*)(GT + row * 2048 + c); gb[m][bj] = *(const u32x2*)(GT + row * 2048 + 1024 + c); } }
#pragma unroll
            for (int m = 0; m < 4; ++m) {
#pragma unroll
                for (int bj = 0; bj < 2; ++bj) { f32x4 a0, a1, b0, b1; unpackb(ga[m][bj], a0, a1); unpackb(gb[m][bj], b0, b1);
#pragma unroll
                    for (int e = 0; e < 4; ++e) { acc[ai][bj][m][0][e] *= a0[e] * __builtin_amdgcn_rcpf(fmaxf(b0[e], TINY)); acc[ai][bj][m][1][e] *= a1[e] * __builtin_amdgcn_rcpf(fmaxf(b1[e], TINY)); } } }
            asm volatile("" ::: "memory"); __builtin_amdgcn_sched_barrier(0); }
    }
    __device__ __forceinline__ void operator()(const f32x4 (&acc)[2][2][4][2], const Unit& u, int wr, int wc, int fr, int fq) const {
        const int row0 = u.pm * BM + wr * 64 + fr, col0 = u.pn * BM + wc * 32 + 8 * fq;
        u32x2 gn[2];
        auto ldg = [&](int g, u32x2 (&d)[2]) {
#pragma unroll
            for (int bj = 0; bj < 2; ++bj) d[bj] = *(const u32x2*)(GT + (size_t)(row0 + (g >> 2) * HALF + (g & 3) * 16) * 2048 + 1024 + col0 + bj * HALF); };
        ldg(0, gn);
#pragma unroll
        for (int g = 0; g < 8; ++g) { const int ai = g >> 2, m = g & 3; const size_t row = (size_t)(row0 + ai * HALF + m * 16);
            const u32x2 gc[2] = {gn[0], gn[1]};
            if (g < 7) ldg(g + 1, gn);
#pragma unroll
            for (int bj = 0; bj < 2; ++bj) { const int c = col0 + bj * HALF;
                f32x4 b0, b1; unpackb(gc[bj], b0, b1);
                f32x4 v0, v1;
#pragma unroll
                for (int e = 0; e < 4; ++e) { v0[e] = acc[ai][bj][m][0][e] * (fmaxf(b0[e], TINY) * (1.0f / 255.0f)); v1[e] = acc[ai][bj][m][1][e] * (fmaxf(b1[e], TINY) * (1.0f / 255.0f)); }
                *(u32x4*)(MG + row * DM + c) = pack8(v0, v1); } }
    }
};
template <bool XBF>
struct EpiOut {
    static constexpr bool PERM = true, AFTER_DRAIN = false;
    const float* xin; const bf16_t* xinb; bf16_t* xr1; const float* g1;
    float* SSQ;
    __device__ __forceinline__ void operator()(const f32x4 (&acc)[2][2][4][2], const Unit& u, int wr, int wc, int fr, int fq) const {
        const int row0 = u.pm * BM + wr * 64 + fr, col0 = u.pn * BM + wc * 32 + 8 * fq; const int b = (u.pm * BM) / SEQ;
        f32x4 gv[2][2];
#pragma unroll
        for (int bj = 0; bj < 2; ++bj)
#pragma unroll
            for (int n = 0; n < 2; ++n) gv[bj][n] = *(const f32x4*)(g1 + (size_t)b * MODW + col0 + bj * HALF + 4 * n);
        f32x4 xn[2][2];
        auto ldx = [&](int g, f32x4 (&d)[2][2]) {
            const size_t rowb = (size_t)(row0 + (g >> 2) * HALF + (g & 3) * 16) * DM + col0;
#pragma unroll
            for (int bj = 0; bj < 2; ++bj) {
                if constexpr (XBF) unpack8(*(const u32x4*)(xinb + rowb + bj * HALF), d[bj][0], d[bj][1]);
                else { d[bj][0] = *(const f32x4*)(xin + rowb + bj * HALF); d[bj][1] = *(const f32x4*)(xin + rowb + bj * HALF + 4); } } };
        ldx(0, xn);
#pragma unroll
        for (int g = 0; g < 8; ++g) { const int ai = g >> 2, m = g & 3;
            f32x4 xc[2][2];
#pragma unroll
            for (int bj = 0; bj < 2; ++bj) { xc[bj][0] = xn[bj][0]; xc[bj][1] = xn[bj][1]; }
            if (g < 7) ldx(g + 1, xn);
            const size_t row = (size_t)(row0 + ai * HALF + m * 16), off = row * DM + col0; float ss = 0.f;
#pragma unroll
            for (int bj = 0; bj < 2; ++bj) { f32x4 x1[2];
#pragma unroll
                for (int n = 0; n < 2; ++n) { x1[n] = xc[bj][n] + gv[bj][n] * acc[ai][bj][m][n];
                    ss += (x1[n][0] * x1[n][0] + x1[n][1] * x1[n][1]) + (x1[n][2] * x1[n][2] + x1[n][3] * x1[n][3]); }
                *(u32x4*)(xr1 + off + bj * HALF) = pack8(x1[0], x1[1]); }
            ss = xsum16(ss, ss); ss = xsum32(ss, ss);
            if (fq == 0) SSQ[row * 16 + u.pn * 4 + wc] = ss; }
    }
};
struct EpiQ {
    static constexpr bool PERM = true, AFTER_DRAIN = false;
    bf16_t* O; const float* SSQ; const float* bq; float* RT;
    __device__ __forceinline__ void operator()(const f32x4 (&acc)[2][2][4][2], const Unit& u, int wr, int wc, int fr, int fq) const {
        const int row0 = u.pm * BM + wr * 64 + fr, col0 = u.pn * BM + wc * 32 + 8 * fq; const int b = (u.pm * BM) / SEQ;
        f32x4 bv[2][2];
#pragma unroll
        for (int bj = 0; bj < 2; ++bj)
#pragma unroll
            for (int n = 0; n < 2; ++n) bv[bj][n] = *(const f32x4*)(bq + (size_t)b * DM + col0 + bj * HALF + 4 * n);
        float rr[2][4];
#pragma unroll
        for (int ai = 0; ai < 2; ++ai)
#pragma unroll
            for (int m = 0; m < 4; ++m) { const size_t row = (size_t)(row0 + ai * HALF + m * 16);
                const f32x4 sq = *(const f32x4*)(SSQ + row * 16 + 4 * fq);
                float st = (sq[0] + sq[1]) + (sq[2] + sq[3]); st = xsum16(st, st); st = xsum32(st, st);
                rr[ai][m] = __builtin_amdgcn_rsqf(st * (1.0f / DM) + EPS); }
#pragma unroll
        for (int ai = 0; ai < 2; ++ai)
#pragma unroll
            for (int m = 0; m < 4; ++m) { const size_t row = (size_t)(row0 + ai * HALF + m * 16); const float r = rr[ai][m];
                bf16_t* rowp = O + row * DM + col0;
                if (u.pn == 0 && wc == 0 && fq == 0) RT[row] = r;
#pragma unroll
                for (int bj = 0; bj < 2; ++bj) *(u32x4*)(rowp + bj * HALF) = pack8(acc[ai][bj][m][0] * r + bv[bj][0], acc[ai][bj][m][1] * r + bv[bj][1]); }
    }
};
struct EpiBf {
    static constexpr bool PERM = true, AFTER_DRAIN = false;
    bf16_t* O; int ldc;
    __device__ __forceinline__ void operator()(const f32x4 (&acc)[2][2][4][2], const Unit& u, int wr, int wc, int fr, int fq) const {
        const int row0 = u.pm * BM + wr * 64 + fr, col0 = u.pn * BM + wc * 32 + 8 * fq;
#pragma unroll
        for (int ai = 0; ai < 2; ++ai)
#pragma unroll
            for (int m = 0; m < 4; ++m) { bf16_t* rowp = O + (size_t)(row0 + ai * HALF + m * 16) * ldc + col0;
#pragma unroll
                for (int bj = 0; bj < 2; ++bj) *(u32x4*)(rowp + bj * HALF) = pack8(acc[ai][bj][m][0], acc[ai][bj][m][1]); }
    }
};

template <class E_, class = void> struct has_midhook { static constexpr bool value = false; };
template <class E_> struct has_midhook<E_, decltype((void)E_::MIDHOOK)> { static constexpr bool value = true; };
template <class Epi, class Sched, bool ALIGN_EPI = false, bool SP2 = false>
__device__ __forceinline__ void gemm_phase(PG8_LAS unsigned char* lds, const Gemm g, const Sched& S, const Epi& E) {
    int tid_ = threadIdx.x; asm volatile("" : "+v"(tid_));
    const int tid = tid_, wid = __builtin_amdgcn_readfirstlane(tid >> 6), lane = tid & 63, wr = wid >> 2, wc = wid & 3, fr = lane & 15, fq = lane >> 4;
    const int K = g.K, nt = K / BK;
    unsigned voffA[2], voffB[2];
#pragma unroll
    for (int i = 0; i < 2; ++i) { int R, C; stage_rc(tid * 16 + i * 8192, R, C); const int Rb = Epi::PERM ? ((R & ~31) + perm32(R & 31)) : R;
        voffA[i] = (unsigned)(R * g.lda + C) * 2u; voffB[i] = (unsigned)(Rb * g.ldb + C) * 2u; }
    const size_t kstep = (size_t)(BK * 2);
    const size_t hsA = (size_t)HALF * g.lda * 2, hsB = (size_t)HALF * g.ldb * 2;
    const size_t tsA = 2 * hsA, tsB = 2 * hsB;
    const unsigned ldsw = (unsigned)wid * 1024u;
    const int aoff = lds_byte(wr * 64 + fr, fq * 8), boff = lds_byte(wc * 32 + fr, fq * 8);
#define PG8_SA(b, h) (((b) * 2 + (h)) * HTB)
#define PG8_SB(b, h) ((4 + (b) * 2 + (h)) * HTB)
#define PG8_STAGE(bufoff, gbase, voff) do { _Pragma("unroll") for (int _i = 0; _i < 2; ++_i) \
        __builtin_amdgcn_global_load_lds((const unsigned*)((const char*)(gbase) + (voff)[_i]), (PG8_LAS unsigned*)(lds + (bufoff) + ldsw + _i * 8192), 16, 0, 0); } while (0)
#define PG8_LDA(dst, b, h) do { _Pragma("unroll") for (int m = 0; m < 4; ++m) _Pragma("unroll") for (int k = 0; k < 2; ++k) dst[m][k] = *(const PG8_LAS bf16x8*)(lds + PG8_SA(b, h) + aoff + m * 2048 + k * 1024); } while (0)
#define PG8_LDB(dst, b, h) do { _Pragma("unroll") for (int n = 0; n < 2; ++n) _Pragma("unroll") for (int k = 0; k < 2; ++k) dst[n][k] = *(const PG8_LAS bf16x8*)(lds + PG8_SB(b, h) + boff + n * 2048 + k * 1024); } while (0)
#define PG8_MMA(ai, bj, At, Bt) do { __builtin_amdgcn_s_setprio(1); _Pragma("unroll") for (int m = 0; m < 4; ++m) _Pragma("unroll") for (int n = 0; n < 2; ++n) _Pragma("unroll") for (int k = 0; k < 2; ++k) \
        acc[ai][bj][m][n] = __builtin_amdgcn_mfma_f32_16x16x32_bf16(Bt[n][k], At[m][k], acc[ai][bj][m][n], 0, 0, 0); __builtin_amdgcn_s_setprio(0); } while (0)
#define PG8_WAIT_V(n) asm volatile("s_waitcnt vmcnt(" #n ")" ::: "memory")
#define PG8_WAIT_L(n) asm volatile("s_waitcnt lgkmcnt(" #n ")" ::: "memory")
#define PG8_BAR __builtin_amdgcn_s_barrier()
#define PG8_SCHED __builtin_amdgcn_sched_barrier(0)
    Unit cur, nxt; int ui = 0;
    if (!S.next(0, cur)) return;
    f32x4 acc[2][2][4][2];
#pragma unroll
    for (int a = 0; a < 2; ++a)
#pragma unroll
        for (int b = 0; b < 2; ++b)
#pragma unroll
            for (int m = 0; m < 4; ++m)
#pragma unroll
                for (int n = 0; n < 2; ++n) acc[a][b][m][n] = (f32x4){0.f, 0.f, 0.f, 0.f};
    bf16x8 At[4][2], B0[2][2], B1[2][2];
    const char* cA = (const char*)g.A + (size_t)cur.pm * tsA + (size_t)cur.ka * 2; const char* cB = (const char*)g.Bt + (size_t)cur.pn * tsB + (size_t)cur.kb * 2;
    S.a_ready(cur);
    if constexpr (SP2) {
        PG8_STAGE(PG8_SB(0, 0), cB, voffB); PG8_STAGE(PG8_SB(0, 1), cB + hsB, voffB); PG8_STAGE(PG8_SA(0, 0), cA, voffA); PG8_STAGE(PG8_SA(0, 1), cA + hsA, voffA);
        if (wr == 1) PG8_BAR;
        PG8_WAIT_V(2); PG8_BAR;
        PG8_STAGE(PG8_SB(1, 0), cB + kstep, voffB); PG8_STAGE(PG8_SA(1, 0), cA + kstep, voffA); PG8_STAGE(PG8_SB(1, 1), cB + hsB + kstep, voffB);
        PG8_WAIT_V(6); PG8_BAR;
    } else {
        PG8_STAGE(PG8_SB(0, 0), cB, voffB); PG8_STAGE(PG8_SA(0, 0), cA, voffA); PG8_STAGE(PG8_SB(0, 1), cB + hsB, voffB); PG8_STAGE(PG8_SA(0, 1), cA + hsA, voffA);
        if (wr == 1) PG8_BAR;
        PG8_WAIT_V(4); PG8_BAR;
        PG8_STAGE(PG8_SB(1, 0), cB + kstep, voffB); PG8_STAGE(PG8_SA(1, 0), cA + kstep, voffA); PG8_STAGE(PG8_SB(1, 1), cB + hsB + kstep, voffB);
        PG8_WAIT_V(6); PG8_BAR;
    }
    for (;;) {
        const bool has_next = S.next(ui + 1, nxt);
        const char* nA = has_next ? (const char*)g.A + (size_t)nxt.pm * tsA + (size_t)nxt.ka * 2 : cA; const char* nB = has_next ? (const char*)g.Bt + (size_t)nxt.pn * tsB + (size_t)nxt.kb * 2 : cB;
        for (int t = 0; t < nt; t += 2) {
            if constexpr (has_midhook<Epi>::value) { if (t == nt / 2) E.mid(acc, cur, wr, wc, fr, fq); }
            const bool last = (t == nt - 2);
            const char* a1 = cA + (size_t)(t + 1) * kstep;
            const char* a2 = last ? nA : cA + (size_t)(t + 2) * kstep; const char* b2 = last ? nB : cB + (size_t)(t + 2) * kstep;
            const char* a3 = a2 + kstep; const char* b3 = b2 + kstep;
            if (last && has_next) S.a_ready(nxt);
            if constexpr (SP2) {
            PG8_LDB(B0, 0, 0); PG8_LDB(B1, 0, 1); PG8_SCHED; PG8_LDA(At, 0, 0); PG8_STAGE(PG8_SA(1, 1), a1 + hsA, voffA);
            PG8_WAIT_V(8); PG8_WAIT_L(0); PG8_BAR; PG8_MMA(0, 0, At, B0); PG8_MMA(0, 1, At, B1); PG8_BAR; PG8_SCHED;
            PG8_LDA(At, 0, 1); PG8_STAGE(PG8_SB(0, 0), b2, voffB); PG8_STAGE(PG8_SB(0, 1), b2 + hsB, voffB); PG8_STAGE(PG8_SA(0, 0), a2, voffA);
            PG8_WAIT_V(8); PG8_WAIT_L(0); PG8_BAR; PG8_MMA(1, 0, At, B0); PG8_MMA(1, 1, At, B1); PG8_BAR; PG8_SCHED;
            PG8_LDB(B0, 1, 0); PG8_LDB(B1, 1, 1); PG8_SCHED; PG8_LDA(At, 1, 0); PG8_STAGE(PG8_SA(0, 1), a2 + hsA, voffA);
            PG8_WAIT_V(8); PG8_WAIT_L(0); PG8_BAR; PG8_MMA(0, 0, At, B0); PG8_MMA(0, 1, At, B1); PG8_BAR; PG8_SCHED;
            PG8_LDA(At, 1, 1); PG8_STAGE(PG8_SB(1, 0), b3, voffB); PG8_STAGE(PG8_SB(1, 1), b3 + hsB, voffB); PG8_STAGE(PG8_SA(1, 0), a3, voffA);
            PG8_WAIT_V(8); PG8_WAIT_L(0); PG8_BAR; PG8_MMA(1, 0, At, B0); PG8_MMA(1, 1, At, B1); PG8_BAR; PG8_SCHED;
            } else {
            PG8_LDB(B0, 0, 0); PG8_SCHED; PG8_LDA(At, 0, 0); PG8_STAGE(PG8_SA(1, 1), a1 + hsA, voffA);
            PG8_WAIT_L(8); PG8_BAR; PG8_WAIT_L(0); PG8_MMA(0, 0, At, B0); PG8_BAR; PG8_SCHED;
            PG8_LDB(B1, 0, 1); PG8_STAGE(PG8_SB(0, 0), b2, voffB);
            PG8_BAR; PG8_WAIT_L(0); PG8_MMA(0, 1, At, B1); PG8_BAR;
            PG8_LDA(At, 0, 1); PG8_STAGE(PG8_SA(0, 0), a2, voffA);
            PG8_BAR; PG8_WAIT_L(0); PG8_MMA(1, 0, At, B0); PG8_BAR; PG8_SCHED;
            PG8_STAGE(PG8_SB(0, 1), b2 + hsB, voffB);
            PG8_WAIT_V(6); PG8_BAR; PG8_MMA(1, 1, At, B1); PG8_BAR;
            PG8_LDB(B0, 1, 0); PG8_SCHED; PG8_LDA(At, 1, 0); PG8_STAGE(PG8_SA(0, 1), a2 + hsA, voffA);
            PG8_WAIT_L(8); PG8_BAR; PG8_WAIT_L(0); PG8_MMA(0, 0, At, B0); PG8_BAR; PG8_SCHED;
            PG8_LDB(B1, 1, 1); PG8_STAGE(PG8_SB(1, 0), b3, voffB);
            PG8_BAR; PG8_WAIT_L(0); PG8_MMA(0, 1, At, B1); PG8_BAR;
            PG8_LDA(At, 1, 1); PG8_STAGE(PG8_SA(1, 0), a3, voffA);
            PG8_BAR; PG8_WAIT_L(0); PG8_MMA(1, 0, At, B0); PG8_BAR; PG8_SCHED;
            PG8_STAGE(PG8_SB(1, 1), b3 + hsB, voffB);
            PG8_WAIT_V(6); PG8_BAR; PG8_MMA(1, 1, At, B1); PG8_BAR;
            }
        }
        if constexpr (ALIGN_EPI) { if (wr == 0) PG8_BAR; }
        if constexpr (!Epi::AFTER_DRAIN) { E(acc, cur, wr, wc, fr, fq); S.done(cur); }
        if (!has_next) break;
#pragma unroll
        for (int a = 0; a < 2; ++a)
#pragma unroll
            for (int b = 0; b < 2; ++b)
#pragma unroll
                for (int m = 0; m < 4; ++m)
#pragma unroll
                    for (int n = 0; n < 2; ++n) acc[a][b][m][n] = (f32x4){0.f, 0.f, 0.f, 0.f};
        cur = nxt; cA = nA; cB = nB; ++ui;
        if constexpr (ALIGN_EPI) { if (wr == 1) PG8_BAR; }
    }
    PG8_WAIT_V(0);
    if constexpr (!ALIGN_EPI) { if (wr == 0) PG8_BAR; }
    PG8_BAR;
    if constexpr (Epi::AFTER_DRAIN) { E.fused(acc, cur, wr, wc, fr, fq, lds, wid, lane); S.done(cur); }
#undef PG8_SA
#undef PG8_SB
#undef PG8_STAGE
#undef PG8_LDA
#undef PG8_LDB
#undef PG8_MMA
#undef PG8_WAIT_V
#undef PG8_WAIT_L
#undef PG8_BAR
#undef PG8_SCHED
}
}

__device__ __forceinline__ int win_logical_col(int n) {
    const int pn = n >> 8, tc = n & 255;
    if (pn >= 12) return 3080 + (pn - 12) * 256 + tc;
    const int kind = pn >> 1, bj = tc >> 7, wc = (tc >> 5) & 3, i = tc & 31;
    const int base = (kind < 3) ? kind * 512 : 1544 + (kind - 3) * 512;
    return base + ((pn & 1) * 4 + wc) * 64 + bj * 32 + i;
}
__device__ __forceinline__ void transpose_item(const float* W, int ldw, int src_c0, int k0, bf16_t* WT, int K, int dst_row0, float* scr, int lane) {
#pragma unroll 8
    for (int i = 0; i < 32; ++i) { const int kk = 2 * i + (lane >> 5); scr[kk * 33 + (lane & 31)] = W[(size_t)(k0 + kk) * ldw + src_c0 + (lane & 31)]; }
    __builtin_amdgcn_s_waitcnt(0xc07f); asm volatile("" ::: "memory");
    const int c = lane & 7;
#pragma unroll
    for (int j = 0; j < 4; ++j) { const int n = (lane >> 3) + 8 * j; const float* s = scr + (8 * c) * 33 + n;
        u32x4 o; o.x = pk2(s[0 * 33], s[1 * 33]); o.y = pk2(s[2 * 33], s[3 * 33]); o.z = pk2(s[4 * 33], s[5 * 33]); o.w = pk2(s[6 * 33], s[7 * 33]);
        *(u32x4*)(WT + (size_t)(dst_row0 + n) * K + k0 + 8 * c) = o; }
    __builtin_amdgcn_s_waitcnt(0xc07f); asm volatile("" ::: "memory");
}
__device__ __forceinline__ void ph_weights(const Prm& p, const Ctx& C, unsigned char* lds) {
    float* scr = (float*)(lds + C.wave * 16384);
    bf16_t* WIN = (bf16_t*)(p.ws + WS_WIN); bf16_t* WBR = (bf16_t*)(p.ws + WS_WBR); bf16_t* WOUT = (bf16_t*)(p.ws + WS_WOUT); bf16_t* WQT = (bf16_t*)(p.ws + WS_WQ);
    constexpr int I_IN = 16 * 160, I_BR = 8 * 32, I_SQ = 16 * 32;
    constexpr int NITEMS = 2 * I_IN + 4 * I_BR + 2 * I_SQ + 2 * I_SQ;
    for (int it = C.gw; it < NITEMS; it += C.ngw) {
        int r = it;
        if (r < 2 * I_IN) { const int l = r / I_IN, q = r % I_IN, kb = q / 160, nb = q % 160;
            transpose_item(p.w_in + (size_t)l * DM * INW, INW, win_logical_col(32 * nb), 64 * kb, WIN + (size_t)l * 5120 * DM, DM, 32 * nb, scr, C.lane); continue; }
        r -= 2 * I_IN;
        if (r < 4 * I_BR) { const int lg = r / I_BR, q = r % I_BR, kb = q / 32, nb = q % 32;
            transpose_item(p.w_branch + (size_t)lg * 512 * DM, DM, 32 * nb, 64 * kb, WBR + (size_t)(lg >> 1) * DM * DM + (lg & 1) * 512, DM, 32 * nb, scr, C.lane); continue; }
        r -= 4 * I_BR;
        if (r < 2 * I_SQ) { const int l = r / I_SQ, q = r % I_SQ, kb = q / 32, nb = q % 32;
            transpose_item(p.w_out + (size_t)l * DM * DM, DM, 32 * nb, 64 * kb, WOUT + (size_t)l * DM * DM, DM, 32 * nb, scr, C.lane); continue; }
        r -= 2 * I_SQ;
        { const int l = r / I_SQ, q = r % I_SQ, kb = q / 32, nb = q % 32;
            transpose_item(p.wq + (size_t)l * DM * DM, DM, 32 * nb, 64 * kb, WQT + (size_t)l * DM * DM, DM, 32 * nb, scr, C.lane); }
    }
}
#define LDSP(p) ((PG8_LAS unsigned char*)(p))
__device__ __forceinline__ void ph_gemm1(const Prm& p, int l, unsigned char* lds) {
    pg8::Gemm g{(const bf16_t*)(p.ws + WS_HB), (const bf16_t*)(p.ws + WS_WIN) + (size_t)l * 5120 * DM, DM, DM, DM};
    pg8::Order S; S.init(NT, 5120, gridDim.x, blockIdx.x, 0);
    pg8::Epi1 E{(bf16_t*)(p.ws + WS_QQ), (bf16_t*)(p.ws + WS_KK), (bf16_t*)(p.ws + WS_VV), (bf16_t*)(p.ws + WS_GT), p.gq + l * HD, p.gk + l * HD};
    pg8::gemm_phase<pg8::Epi1, pg8::Order, true, true>(LDSP(lds), g, S, E);
}
__device__ __forceinline__ void ph_merge(const Prm& p, int l, unsigned char* lds) {
    pg8::Gemm g{(const bf16_t*)(p.ws + WS_QQ), (const bf16_t*)(p.ws + WS_WBR) + (size_t)l * DM * DM, DM, DM, DM};
    pg8::Order S; S.init(NT, DM, gridDim.x, blockIdx.x, 0);
    pg8::EpiMerge E{(const unsigned char*)(p.ws + WS_GT), (bf16_t*)(p.ws + WS_HB)};
    pg8::gemm_phase<pg8::EpiMerge, pg8::Order, true, true>(LDSP(lds), g, S, E);
}
__device__ __forceinline__ void ph_out(const Prm& p, int l, unsigned char* lds) {
    pg8::Gemm g{(const bf16_t*)(p.ws + WS_HB), (const bf16_t*)(p.ws + WS_WOUT) + (size_t)l * DM * DM, DM, DM, DM};
    pg8::Order S; S.init(NT, DM, gridDim.x, blockIdx.x, 0);
    if (l == 0) { pg8::EpiOut<false> E{p.x, (const bf16_t*)nullptr, (bf16_t*)(p.ws + WS_XR1), (const float*)(p.ws + WS_MOD) + (size_t)l * NB * MODW + 2 * DM, (float*)(p.ws + WS_SSQ)};
        pg8::gemm_phase<pg8::EpiOut<false>, pg8::Order, true, true>(LDSP(lds), g, S, E); return; }
    pg8::EpiOut<true> E{p.x, (const bf16_t*)p.out, (bf16_t*)(p.ws + WS_XR1), (const float*)(p.ws + WS_MOD) + (size_t)l * NB * MODW + 2 * DM, (float*)(p.ws + WS_SSQ)};
    pg8::gemm_phase<pg8::EpiOut<true>, pg8::Order, true, true>(LDSP(lds), g, S, E);
}
__device__ __forceinline__ void ph_q(const Prm& p, int l, unsigned char* lds) {
    pg8::Gemm g{(const bf16_t*)(p.ws + WS_XR1), (const bf16_t*)((const char*)p.out + 64 * MiB) + (size_t)l * NB * DM * DM, DM, DM, DM};
    pg8::Order S; S.init(NT, DM, gridDim.x, blockIdx.x, 0, DM * DM);
    pg8::EpiQ E{(bf16_t*)(p.ws + WS_KK), (const float*)(p.ws + WS_SSQ), (const float*)(p.ws + WS_BQ) + (size_t)l * NB * DM, (float*)(p.ws + WS_FC)};
    pg8::gemm_phase<pg8::EpiQ, pg8::Order, true, true>(LDSP(lds), g, S, E);
}

namespace attn_body {
using bf16=__hip_bfloat16;
using bf16x8=__attribute__((ext_vector_type(8)))short;
using s16x4=__attribute__((ext_vector_type(4)))short;
using f32x16=__attribute__((ext_vector_type(16)))float;
using u32x4=__attribute__((ext_vector_type(4)))unsigned;
using f32x4_t=__attribute__((ext_vector_type(4)))float;
constexpr int BATCH=8,NHEAD=8,SEQ=4096,D=64,DM=1024;
constexpr int NW=8,QBLK=32,QB=QBLK*NW,KVBLK=64,NQB=SEQ/QB;
constexpr int ATTN_PITCH=DM, ATTN_UNIT_ROWS=QB;
__device__ __forceinline__ int crow(int r,int hi){return (r&3)+8*(r>>2)+4*hi;}
#define SBAR() __builtin_amdgcn_sched_barrier(0)
__device__ __forceinline__ void cmask(f32x16&p0,f32x16&p1,int jb,int qrel,int hi){
  const float NEG=-INFINITY; int d=qrel-(64*jb+4*hi); asm volatile("":"+v"(d));
  #pragma unroll
  for(int r=0;r<16;++r){const int c=(r&3)+8*(r>>2); if(c>d)p0[r]=NEG; if(c+32>d)p1[r]=NEG;}
}

constexpr int NSLOT=3, SLOTB=8192;
constexpr int LDS_K=0, LDS_V=NSLOT*SLOTB, LDS_WS=2*NSLOT*SLOTB, LDS_OST=LDS_WS+NW*64*4, LDS_BYTES=LDS_OST+NW*4096;
constexpr float C2=0.125f*1.4426950408889634f;
__device__ __forceinline__ void glds16(const void*gsrc,unsigned lds_dst){unsigned keep;
  asm volatile("s_mov_b32 %0, m0\n\ts_mov_b32 m0, %2\n\ts_nop 0\n\tglobal_load_lds_dwordx4 %1, off\n\ts_mov_b32 m0, %0":"=&s"(keep):"v"(gsrc),"s"(lds_dst):"memory");}
__device__ __forceinline__ float max3f(float a,float b,float c){float r;asm("v_max3_f32 %0, %1, %2, %3":"=v"(r):"v"(a),"v"(b),"v"(c));return r;}
__device__ __forceinline__ float max2f(float a,float b){float r;asm("v_max_f32_e32 %0, %1, %2":"=v"(r):"v"(a),"v"(b));return r;}
__device__ __forceinline__ float fadd_s(float a,float b){float r;asm("v_add_f32_e32 %0, %1, %2":"=v"(r):"v"(a),"v"(b));return r;}
__device__ __forceinline__ float fsub_s(float a,float b){float r;asm("v_sub_f32_e32 %0, %1, %2":"=v"(r):"v"(a),"v"(b));return r;}
typedef float f32x2_t __attribute__((ext_vector_type(2))); typedef __bf16 bf16x2_t __attribute__((ext_vector_type(2)));
__device__ __forceinline__ unsigned cvtpk_s(float lo,float hi){f32x2_t v={lo,hi};bf16x2_t b=__builtin_convertvector(v,bf16x2_t);return __builtin_bit_cast(unsigned,b);}
#define WAIT_BAR(N) asm volatile("s_waitcnt vmcnt(" #N ") lgkmcnt(0)\n\ts_barrier":::"memory")

__device__ __forceinline__ void qkt(f32x16&p0,f32x16&p1,const char*Kslot,const bf16x8*qr,const f32x16&negm,int r32,int hi){
  const char*kb=Kslot+hi*1024+r32*16;
  #pragma unroll
  for(int d0=0;d0<4;++d0){
    const bf16x8 b0=*reinterpret_cast<const bf16x8*>(kb+d0*2048);
    const bf16x8 b1=*reinterpret_cast<const bf16x8*>(kb+d0*2048+512);
    if(d0==0){p0=__builtin_amdgcn_mfma_f32_32x32x16_bf16(b0,qr[0],negm,0,0,0);p1=__builtin_amdgcn_mfma_f32_32x32x16_bf16(b1,qr[0],negm,0,0,0);}
    else{p0=__builtin_amdgcn_mfma_f32_32x32x16_bf16(b0,qr[d0],p0,0,0,0);p1=__builtin_amdgcn_mfma_f32_32x32x16_bf16(b1,qr[d0],p1,0,0,0);}}
}
typedef __attribute__((address_space(3))) const char* lds_cptr;
typedef short v4i16_t __attribute__((ext_vector_type(4)));
__device__ __forceinline__ void kload8(bf16x8*kf,lds_cptr kp){
  kf[0]=*(const __attribute__((address_space(3))) bf16x8*)(kp);      kf[1]=*(const __attribute__((address_space(3))) bf16x8*)(kp+512);
  kf[2]=*(const __attribute__((address_space(3))) bf16x8*)(kp+2048); kf[3]=*(const __attribute__((address_space(3))) bf16x8*)(kp+2560);
  kf[4]=*(const __attribute__((address_space(3))) bf16x8*)(kp+4096); kf[5]=*(const __attribute__((address_space(3))) bf16x8*)(kp+4608);
  kf[6]=*(const __attribute__((address_space(3))) bf16x8*)(kp+6144); kf[7]=*(const __attribute__((address_space(3))) bf16x8*)(kp+6656);
}
__device__ __forceinline__ void kload2(bf16x8*kf,lds_cptr kp,int j){ kf[2*j]=*(const __attribute__((address_space(3))) bf16x8*)(kp+j*2048); kf[2*j+1]=*(const __attribute__((address_space(3))) bf16x8*)(kp+j*2048+512); }
__device__ __forceinline__ s16x4 vtr(lds_cptr p){ return __builtin_bit_cast(s16x4,__builtin_amdgcn_ds_read_tr16_b64_v4i16((__attribute__((address_space(3))) v4i16_t*)p)); }
__device__ __forceinline__ float rowmax(const f32x16&p0,const f32x16&p1){
  float a=max3f(p0[0],p0[1],p1[0]),b=max3f(p0[2],p0[3],p1[1]);a=max3f(a,p1[2],p1[3]);
  #pragma unroll
  for(int r=4;r<16;r+=4){a=max3f(a,p0[r],p0[r+1]);b=max3f(b,p0[r+2],p0[r+3]);a=max3f(a,p1[r],p1[r+1]);b=max3f(b,p1[r+2],p1[r+3]);}
  const float m=max2f(a,b);
  auto rr=__builtin_amdgcn_permlane32_swap(__float_as_uint(m),__float_as_uint(m),false,false);
  return max2f(__uint_as_float(rr[0]),__uint_as_float(rr[1]));
}
__device__ __forceinline__ void pv(f32x16*o,int vb,bf16x8 pa0,bf16x8 pa1,bf16x8 pa2,bf16x8 pa3){
  #pragma unroll
  for(int d0=0;d0<2;++d0){s16x4 lo[4],hi[4];
    #pragma unroll
    for(int ks=0;ks<4;++ks){
      asm volatile("ds_read_b64_tr_b16 %0,%1 offset:%c2":"=&v"(lo[ks]):"v"(vb),"i"(d0*4096+ks*1024):"memory");
      asm volatile("ds_read_b64_tr_b16 %0,%1 offset:%c2":"=&v"(hi[ks]):"v"(vb),"i"(d0*4096+ks*1024+512):"memory");}
    asm volatile("s_waitcnt lgkmcnt(0)":::"memory");SBAR();
    #define PK(k) (bf16x8){lo[k][0],lo[k][1],lo[k][2],lo[k][3],hi[k][0],hi[k][1],hi[k][2],hi[k][3]}
    o[d0]=__builtin_amdgcn_mfma_f32_32x32x16_bf16(pa0,PK(0),o[d0],0,0,0);
    o[d0]=__builtin_amdgcn_mfma_f32_32x32x16_bf16(pa1,PK(1),o[d0],0,0,0);
    o[d0]=__builtin_amdgcn_mfma_f32_32x32x16_bf16(pa2,PK(2),o[d0],0,0,0);
    o[d0]=__builtin_amdgcn_mfma_f32_32x32x16_bf16(pa3,PK(3),o[d0],0,0,0);
    #undef PK
  }
}

#ifndef ATTN_STORE16
#define ATTN_STORE16(p,v) (*(u32x4*)(p)=(v))
#endif
template<int THRL> __device__ __forceinline__ void attn_unit(int b,int h,int qb,const bf16*Q,const bf16*__restrict__ K,const bf16*__restrict__ V,bf16*O,char*shm,const float*Gl,int j0){
  int tid_=threadIdx.x; asm volatile("":"+v"(tid_));
  const int tid=tid_,lane=tid&63,r32=lane&31,hi=lane>>5; const int wid=__builtin_amdgcn_readfirstlane(tid>>6);
  const long rowbase=(long)b*SEQ; const int q0=qb*QB;
  const bf16*Qw=Q+(rowbase+q0+wid*QBLK)*DM+h*D;
  const bf16*Kh=K+(rowbase+(long)j0*KVBLK)*DM+h*D,*Vh=V+(rowbase+(long)j0*KVBLK)*DM+h*D; const float*Glt=Gl+j0*KVBLK;
  const unsigned lds0=(unsigned)(uintptr_t)shm;
  float*wsf=(float*)(shm+LDS_WS)+wid*64;
  const bf16*ksrc=Kh+(long)lane*DM+wid*8;
  const bf16*vsrc=Vh+(long)(16*(wid&3)+(lane>>2))*DM+(wid>>2)*32+(lane&3)*8;
  const unsigned kdst=lds0+LDS_K+wid*1024, vdst=lds0+LDS_V+wid*1024;
  #define DMA_K(t,slot) glds16(ksrc+(long)(t)*KVBLK*DM,(unsigned)__builtin_amdgcn_readfirstlane(kdst+(slot)))
  #define DMA_V(t,slot) glds16(vsrc+(long)(t)*KVBLK*DM,(unsigned)__builtin_amdgcn_readfirstlane(vdst+(slot)))
  const int vb0=(int)(lds0+LDS_V)+((lane>>4)&1)*32+(lane&3)*8+(4*hi+((lane&15)>>2))*64;
  const char*Kbase=shm+LDS_K; bf16x8 kf[8];
  const lds_cptr shm3=(lds_cptr)shm; const lds_cptr kp0=shm3+LDS_K+hi*1024+r32*16; const lds_cptr vp0=shm3+LDS_V+((lane>>4)&1)*32+(lane&3)*8+(4*hi+((lane&15)>>2))*64;
  const int NT=(q0+QB)/KVBLK-j0;
  DMA_K(0,0);DMA_V(0,0);DMA_K(1,SLOTB);
  bf16x8 qr[4];
  #pragma unroll
  for(int d0=0;d0<4;++d0)qr[d0]=*reinterpret_cast<const bf16x8*>(&Qw[(long)r32*DM+d0*16+hi*8]);
  typedef __attribute__((address_space(3))) bf16x8* qst_ptr; const qst_ptr qst=(qst_ptr)(((__attribute__((address_space(3))) char*)shm)+LDS_OST+wid*4096)+lane;
  #pragma unroll
  for(int d0=0;d0<4;++d0)qst[d0*64]=qr[d0];
  const int qrel=wid*QBLK+r32; const float Gq=Gl[q0+qrel];
  float mhat=0.f,l_reg=0.f;f32x16 o[2];o[0]=f32x16{};o[1]=f32x16{};const f32x16 negm=f32x16{}; float base=Gq;
  #define BIAS(C0,C1,t) do{ const float*gk_=Glt+(t)*64+4*hi; _Pragma("unroll") for(int g_=0;g_<4;++g_){ SBAR(); const f32x4_t a_=*(const f32x4_t*)(gk_+8*g_), b_=*(const f32x4_t*)(gk_+32+8*g_); \
    _Pragma("unroll") for(int e_=0;e_<4;++e_){ C0[4*g_+e_]+=base-a_[e_]; C1[4*g_+e_]+=base-b_[e_]; } } SBAR(); }while(0)
  #define CMASK(P0,P1,t) do{int jb_=(t)-(NT-4); if(jb_>=0)cmask(P0,P1,jb_,qrel,hi);}while(0)
  bool resc=false;
  #define START(P0,P1) do{ const float rm=rowmax(P0,P1); resc=false; \
    { const float dl=rm; mhat=fadd_s(mhat,dl); \
      _Pragma("unroll") for(int r=0;r<16;++r){P0[r]=fsub_s(P0[r],dl);P1[r]=fsub_s(P1[r],dl);} \
      base=Gq-mhat; } \
    _Pragma("unroll") for(int r=0;r<16;++r)P0[r]=__builtin_amdgcn_exp2f(P0[r]); }while(0)
  #define RESC() do{ if(resc){ asm volatile("s_waitcnt lgkmcnt(0)":::"memory"); \
      _Pragma("unroll") for(int d_=0;d_<2;++d_) _Pragma("unroll") for(int r=0;r<16;++r)o[d_][r]*=wsf[crow(r,hi)]; } }while(0)
  f32x16 pA0,pA1,pB0,pB1;
  int sl_prev=0,sl_cur=0,sl_next=SLOTB;
  #define ROT() do{sl_prev=sl_cur;sl_cur=sl_next;sl_next=(sl_next==(NSLOT-1)*SLOTB)?0:sl_next+SLOTB;}while(0)
  DMA_K(2,2*SLOTB);
  WAIT_BAR(3);
  qkt(pA0,pA1,Kbase,qr,negm,r32,hi);BIAS(pA0,pA1,0);asm volatile("s_nop 15\n\ts_nop 7":"+v"(pA0),"+v"(pA1));CMASK(pA0,pA1,0);
  START(pA0,pA1);
  _Pragma("unroll") for(int r=0;r<16;++r)pA1[r]=__builtin_amdgcn_exp2f(pA1[r]);
  WAIT_BAR(0);
  DMA_K(3,0);DMA_V(1,SLOTB);
  ROT();
  kload8(kf,kp0+sl_cur);
  WAIT_BAR(2);
  s16x4 vlo[8],vhi[8]; u32x4 pw0,pw1,pw2,pw3;
  #define PKW(P,B) cvtpk_s(P[B],P[B+1])
  #define PAF(k) __builtin_bit_cast(bf16x8,pw##k)
  #define VFR(i) (bf16x8){vlo[i][0],vlo[i][1],vlo[i][2],vlo[i][3],vhi[i][0],vhi[i][1],vhi[i][2],vhi[i][3]}
  #define PIN(x) asm volatile("":"+v"(x))
  #define MX3(a,b,c) __builtin_fmaxf(__builtin_fmaxf((a),(b)),(c))
  #define GAPA(MF,A0,A1,A2,A3,W0,W1,PW) do{ MF; sacc+=A0; sacc+=A1; sacc+=A2; sacc+=A3; PIN(sacc); W0; W1; PIN(PW); SBAR(); }while(0)
  #define EX(v) __builtin_amdgcn_exp2f(v)
  #define GAPB(MF,X,B) do{ MF; X[B]=EX(X[B]); X[B+1]=EX(X[B+1]); X[B+2]=EX(X[B+2]); X[B+3]=EX(X[B+3]); PIN(X); SBAR(); }while(0)
  #define VRD(i) do{ vlo[i]=vtr(vp_+(((i)>>2)*4096+((i)&3)*1024)); vhi[i]=vtr(vp_+(((i)>>2)*4096+((i)&3)*1024+512)); }while(0)
  #define KRD(G,j) do{ if(G){ kload2(kf,kp0+sl_next,j); SBAR(); } }while(0)
  #define STEP(C0,C1,P0,P1,t,GK,GV,GL) do{ SBAR(); \
    const lds_cptr vp_=vp0+sl_prev; const bf16x8 q0_=qst[0],q1_=qst[64],q2_=qst[128],q3_=qst[192]; \
    VRD(0); SBAR(); float sacc=(P0[0]+P0[1]); \
    GAPA(C0=__builtin_amdgcn_mfma_f32_32x32x16_bf16(kf[0],q0_,negm,0,0,0), P0[2],P0[3],P0[4],P0[5],     pw0[0]=PKW(P0,0), pw0[1]=PKW(P0,2), pw0); \
    VRD(4); SBAR(); GAPA(C1=__builtin_amdgcn_mfma_f32_32x32x16_bf16(kf[1],q0_,negm,0,0,0), P0[6],P0[7],P0[8],P0[9],     pw0[2]=PKW(P0,4), pw0[3]=PKW(P0,6), pw0); \
    VRD(1); SBAR(); GAPA(C0=__builtin_amdgcn_mfma_f32_32x32x16_bf16(kf[2],q1_,C0,0,0,0),   P0[10],P0[11],P0[12],P0[13], pw1[0]=PKW(P0,8), pw1[1]=PKW(P0,10), pw1); \
    VRD(5); SBAR(); GAPA(C1=__builtin_amdgcn_mfma_f32_32x32x16_bf16(kf[3],q1_,C1,0,0,0),   P0[14],P0[15],P1[0],P1[1],   pw1[2]=PKW(P0,12),pw1[3]=PKW(P0,14), pw1); \
    VRD(2); SBAR(); GAPA(C0=__builtin_amdgcn_mfma_f32_32x32x16_bf16(kf[4],q2_,C0,0,0,0),   P1[2],P1[3],P1[4],P1[5],     pw2[0]=PKW(P1,0), pw2[1]=PKW(P1,2), pw2); \
    VRD(6); SBAR(); GAPA(C1=__builtin_amdgcn_mfma_f32_32x32x16_bf16(kf[5],q2_,C1,0,0,0),   P1[6],P1[7],P1[8],P1[9],     pw2[2]=PKW(P1,4), pw2[3]=PKW(P1,6), pw2); \
    VRD(3); SBAR(); GAPA(C0=__builtin_amdgcn_mfma_f32_32x32x16_bf16(kf[6],q3_,C0,0,0,0),   P1[10],P1[11],P1[12],P1[13], pw3[0]=PKW(P1,8), pw3[1]=PKW(P1,10), pw3); \
    VRD(7); SBAR(); GAPA(C1=__builtin_amdgcn_mfma_f32_32x32x16_bf16(kf[7],q3_,C1,0,0,0),   P1[14],P1[15],0.f,0.f,       pw3[2]=PKW(P1,12),pw3[3]=PKW(P1,14), pw3); \
    l_reg+=sacc; \
    if(GK){DMA_K((t)+3,sl_cur);} if(GV){DMA_V((t)+1,sl_next);} \
    BIAS(C0,C1,t); CMASK(C0,C1,t); \
    { float a=MX3(C0[0],C0[1],C1[0]),b=MX3(C0[2],C0[3],C1[1]); a=MX3(a,C1[2],C1[3]); \
      _Pragma("unroll") for(int r=4;r<16;r+=4){a=MX3(a,C0[r],C0[r+1]);b=MX3(b,C0[r+2],C0[r+3]);a=MX3(a,C1[r],C1[r+1]);b=MX3(b,C1[r+2],C1[r+3]);} \
      float rm=__builtin_fmaxf(a,b); { auto rr=__builtin_amdgcn_permlane32_swap(__float_as_uint(rm),__float_as_uint(rm),false,false); rm=__builtin_fmaxf(__uint_as_float(rr[0]),__uint_as_float(rr[1])); } \
      resc=false; \
      if(__builtin_expect(__any(rm>(float)THRL),0)){ const float dl=__builtin_fmaxf(rm,0.f); mhat+=dl; \
        _Pragma("unroll") for(int r=0;r<16;++r){C0[r]-=dl;C1[r]-=dl;} \
        base=Gq-mhat; \
        const float f=__builtin_amdgcn_exp2f(-dl); l_reg*=f; if(hi==0)wsf[r32]=f; resc=true; } } \
    SBAR(); \
    GAPB(o[0]=__builtin_amdgcn_mfma_f32_32x32x16_bf16(PAF(0),VFR(0),o[0],0,0,0), C0,0); \
    GAPB(o[1]=__builtin_amdgcn_mfma_f32_32x32x16_bf16(PAF(0),VFR(4),o[1],0,0,0), C0,4); \
    KRD(GL,0); GAPB(o[0]=__builtin_amdgcn_mfma_f32_32x32x16_bf16(PAF(1),VFR(1),o[0],0,0,0), C0,8); \
    KRD(GL,1); GAPB(o[1]=__builtin_amdgcn_mfma_f32_32x32x16_bf16(PAF(1),VFR(5),o[1],0,0,0), C0,12); \
    KRD(GL,2); GAPB(o[0]=__builtin_amdgcn_mfma_f32_32x32x16_bf16(PAF(2),VFR(2),o[0],0,0,0), C1,0); \
    KRD(GL,3); GAPB(o[1]=__builtin_amdgcn_mfma_f32_32x32x16_bf16(PAF(2),VFR(6),o[1],0,0,0), C1,4); \
    GAPB(o[0]=__builtin_amdgcn_mfma_f32_32x32x16_bf16(PAF(3),VFR(3),o[0],0,0,0), C1,8); \
    GAPB(o[1]=__builtin_amdgcn_mfma_f32_32x32x16_bf16(PAF(3),VFR(7),o[1],0,0,0), C1,12); \
    }while(0)
  int t=1;
  #undef CMASK
  #define CMASK(P0,P1,t) do{}while(0)
  for(;t+5<NT;t+=2){
    STEP(pB0,pB1,pA0,pA1,t,true,true,true);     WAIT_BAR(2); RESC(); ROT();
    STEP(pA0,pA1,pB0,pB1,t+1,true,true,true);   WAIT_BAR(2); RESC(); ROT();
  }
  #undef CMASK
  #define CMASK(P0,P1,t) do{int jb_=(t)-(NT-4); if(jb_>=0)cmask(P0,P1,jb_,qrel,hi);}while(0)
  #define ENDW(tt) do{ if((tt)+3<NT){WAIT_BAR(2);} else if((tt)+2<NT){WAIT_BAR(1);} else {WAIT_BAR(0);} }while(0)
  for(;t+1<NT;t+=2){
    STEP(pB0,pB1,pA0,pA1,t,(t+3<NT),(t+1<NT),(t+1<NT));       ENDW(t);   RESC(); ROT();
    STEP(pA0,pA1,pB0,pB1,t+1,(t+4<NT),(t+2<NT),(t+2<NT));     ENDW(t+1); RESC(); ROT();
  }
  STEP(pB0,pB1,pA0,pA1,NT-1,false,false,false); RESC();
  { float sacc=pB0[0]+pB0[1]; _Pragma("unroll") for(int r=2;r<16;++r)sacc+=pB0[r]; _Pragma("unroll") for(int r=0;r<16;++r)sacc+=pB1[r]; l_reg+=sacc;
    pw0=(u32x4){PKW(pB0,0),PKW(pB0,2),PKW(pB0,4),PKW(pB0,6)};pw1=(u32x4){PKW(pB0,8),PKW(pB0,10),PKW(pB0,12),PKW(pB0,14)};pw2=(u32x4){PKW(pB1,0),PKW(pB1,2),PKW(pB1,4),PKW(pB1,6)};pw3=(u32x4){PKW(pB1,8),PKW(pB1,10),PKW(pB1,12),PKW(pB1,14)};
    SBAR(); pv(o,vb0+sl_cur,PAF(0),PAF(1),PAF(2),PAF(3)); }
  #undef PKW
  #undef PAF
  #undef VFR
  #undef PIN
  #undef MX3
  #undef GAPA
  #undef GAPB
  #undef EX
  #undef VRD
  #undef KRD
  #undef STEP
  #undef ENDW
  {auto rr=__builtin_amdgcn_permlane32_swap(__float_as_uint(l_reg),__float_as_uint(l_reg),false,false);l_reg=__uint_as_float(rr[0])+__uint_as_float(rr[1]);}
  if(hi==0)wsf[32+r32]=l_reg;asm volatile("s_waitcnt lgkmcnt(0)":::"memory");
  float rli[16];
  #pragma unroll
  for(int r=0;r<16;++r)rli[r]=__builtin_amdgcn_rcpf(wsf[32+crow(r,hi)]);
  bf16*Ow=O+(rowbase+q0+wid*QBLK)*DM+h*D;
  { bf16*stg=(bf16*)(shm+LDS_OST)+wid*2048;
    #pragma unroll
    for(int r=0;r<16;++r){const int orow=crow(r,hi);
      #pragma unroll
      for(int d0=0;d0<2;++d0)stg[orow*64+d0*32+r32]=__float2bfloat16(o[d0][r]*rli[r]);}
    asm volatile("s_waitcnt lgkmcnt(0)":::"memory");
    #pragma unroll
    for(int i=0;i<4;++i){const int row=i*8+(lane>>3),ch=lane&7; const u32x4 v=*(const u32x4*)(stg+row*64+ch*8); ATTN_STORE16(Ow+(long)row*DM+ch*8,v);} }
  asm volatile("s_waitcnt lgkmcnt(0)\n\ts_barrier":::"memory");
  #undef DMA_K
  #undef DMA_V
  #undef CMASK
  #undef BIAS
  #undef START
  #undef RESC
  #undef ROT
}
constexpr int ATTN_LDS_BYTES=LDS_BYTES;
#undef SBAR
#undef WAIT_BAR
}

namespace sbk {
using bf16x8=__attribute__((ext_vector_type(8)))short;
using s16x4=__attribute__((ext_vector_type(4)))short;
using f32x16=__attribute__((ext_vector_type(16)))float;
constexpr int WLDS=12288;
constexpr float R_STOP=22.0f;
__device__ __forceinline__ int crow(int r,int hi){return (r&3)+8*(r>>2)+4*hi;}
__device__ __forceinline__ unsigned cvtpk(float lo,float hi){typedef float f2 __attribute__((ext_vector_type(2)));typedef __bf16 b2 __attribute__((ext_vector_type(2)));f2 v={lo,hi};b2 b=__builtin_convertvector(v,b2);return __builtin_bit_cast(unsigned,b);}
__device__ __forceinline__ void pv(f32x16*o,int vb,bf16x8 pa0,bf16x8 pa1,bf16x8 pa2,bf16x8 pa3){
  #pragma unroll
  for(int d0=0;d0<2;++d0){s16x4 lo[4],hi[4];
    #pragma unroll
    for(int ks=0;ks<4;++ks){
      asm volatile("ds_read_b64_tr_b16 %0,%1 offset:%c2":"=&v"(lo[ks]):"v"(vb),"i"(d0*4096+ks*1024):"memory");
      asm volatile("ds_read_b64_tr_b16 %0,%1 offset:%c2":"=&v"(hi[ks]):"v"(vb),"i"(d0*4096+ks*1024+512):"memory");}
    asm volatile("s_waitcnt lgkmcnt(0)":::"memory");__builtin_amdgcn_sched_barrier(0);
    #define PK(k) (bf16x8){lo[k][0],lo[k][1],lo[k][2],lo[k][3],hi[k][0],hi[k][1],hi[k][2],hi[k][3]}
    o[d0]=__builtin_amdgcn_mfma_f32_32x32x16_bf16(pa0,PK(0),o[d0],0,0,0);
    o[d0]=__builtin_amdgcn_mfma_f32_32x32x16_bf16(pa1,PK(1),o[d0],0,0,0);
    o[d0]=__builtin_amdgcn_mfma_f32_32x32x16_bf16(pa2,PK(2),o[d0],0,0,0);
    o[d0]=__builtin_amdgcn_mfma_f32_32x32x16_bf16(pa3,PK(3),o[d0],0,0,0);
    #undef PK
  }
}
__device__ __forceinline__ float sp2(float z){ return fmaxf(z,0.f)+__builtin_amdgcn_logf(1.0f+__builtin_amdgcn_exp2f(-fabsf(z))); }
__device__ __forceinline__ void sb_unit(int b,int h,int tb,const bf16_t*Q,const bf16_t*K,const bf16_t*V,bf16_t*O,char*wl,int lane){
  const int r32=lane&31,hi=lane>>5,t0=tb*32; const long rowbase=(long)b*SEQ; const int co=512+h*64;
  const bf16_t*Qw=Q+(rowbase+t0)*DM+co;
  bf16x8 qr[4];
  #pragma unroll
  for(int d0=0;d0<4;++d0)qr[d0]=*reinterpret_cast<const bf16x8*>(Qw+(long)r32*DM+d0*16+hi*8);
  f32x16 o[2];o[0]=f32x16{};o[1]=f32x16{};float R=0.f;
  const int vb=(int)(unsigned)(uintptr_t)wl+((lane>>4)&1)*32+(lane&3)*8+(4*hi+((lane&15)>>2))*64;
  bf16x8 kf[8]; u32x4 vr[8];
  #define SB_LOADK(jj) do{ const int s0_=(jj)*64; const bf16_t*Kp=K+(rowbase+s0_+r32)*DM+co+hi*8; \
    _Pragma("unroll") for(int d0=0;d0<4;++d0){kf[2*d0]=*reinterpret_cast<const bf16x8*>(Kp+d0*16);kf[2*d0+1]=*reinterpret_cast<const bf16x8*>(Kp+(long)32*DM+d0*16);} }while(0)
  #define SB_LOADV(jj) do{ const int s0_=(jj)*64; \
    _Pragma("unroll") for(int p=0;p<8;++p)vr[p]=*reinterpret_cast<const u32x4*>(V+(rowbase+s0_+16*(p&3)+(lane>>2))*DM+co+(p>>2)*32+(lane&3)*8); }while(0)
  SB_LOADK(t0>>6);
  for(int j=t0>>6;j>=0;--j){
    const int s0=j*64;
    SB_LOADV(j);
    f32x16 z0=f32x16{},z1=f32x16{};
    #pragma unroll
    for(int d0=0;d0<4;++d0){z0=__builtin_amdgcn_mfma_f32_32x32x16_bf16(kf[2*d0],qr[d0],z0,0,0,0);z1=__builtin_amdgcn_mfma_f32_32x32x16_bf16(kf[2*d0+1],qr[d0],z1,0,0,0);}
    #pragma unroll
    for(int p=0;p<8;++p)*reinterpret_cast<u32x4*>(wl+p*1024+lane*16)=vr[p];
    int rel=((j==(t0>>6))?(t0-s0+r32):1000)-4*hi; asm volatile("":"+v"(rel));
    f32x16 L0,L1;
    #pragma unroll
    for(int r=0;r<16;++r){const int kv=(r&3)+8*(r>>2); L0[r]=(kv<rel)?sp2(z0[r]):0.f; L1[r]=(kv+32<rel)?sp2(z1[r]):0.f;}
    float T[8]; f32x16 E0,E1;
    #pragma unroll
    for(int i=0;i<4;++i){
      E0[4*i+3]=0.f;E0[4*i+2]=L0[4*i+3];E0[4*i+1]=E0[4*i+2]+L0[4*i+2];E0[4*i]=E0[4*i+1]+L0[4*i+1];T[i]=E0[4*i]+L0[4*i];
      E1[4*i+3]=0.f;E1[4*i+2]=L1[4*i+3];E1[4*i+1]=E1[4*i+2]+L1[4*i+2];E1[4*i]=E1[4*i+1]+L1[4*i+1];T[4+i]=E1[4*i]+L1[4*i];}
    float X[8];
    #pragma unroll
    for(int i=0;i<8;++i)X[i]=__shfl_xor(T[i],32);
    float S[8]; float run=0.f;
    #pragma unroll
    for(int i=7;i>=0;--i){
      const float g_hi=hi?T[i]:X[i];
      const float g_lo=hi?X[i]:T[i];
      S[i]=hi?run:(run+g_hi);
      run+=g_hi+g_lo; }
    const float Ttot=run;
    #pragma unroll
    for(int i=0;i<4;++i){
      #pragma unroll
      for(int e=0;e<4;++e){E0[4*i+e]+=S[i];E1[4*i+e]+=S[4+i];}}
    f32x16 P0,P1;
    #pragma unroll
    for(int r=0;r<16;++r){const int kv=(r&3)+8*(r>>2);
      P0[r]=(kv<rel)?__builtin_amdgcn_exp2f(z0[r]-L0[r]-E0[r]-R):0.f;
      P1[r]=(kv+32<rel)?__builtin_amdgcn_exp2f(z1[r]-L1[r]-E1[r]-R):0.f;}
    R+=Ttot;
    u32x4 pw0,pw1,pw2,pw3;
    pw0=(u32x4){cvtpk(P0[0],P0[1]),cvtpk(P0[2],P0[3]),cvtpk(P0[4],P0[5]),cvtpk(P0[6],P0[7])};
    pw1=(u32x4){cvtpk(P0[8],P0[9]),cvtpk(P0[10],P0[11]),cvtpk(P0[12],P0[13]),cvtpk(P0[14],P0[15])};
    pw2=(u32x4){cvtpk(P1[0],P1[1]),cvtpk(P1[2],P1[3]),cvtpk(P1[4],P1[5]),cvtpk(P1[6],P1[7])};
    pw3=(u32x4){cvtpk(P1[8],P1[9]),cvtpk(P1[10],P1[11]),cvtpk(P1[12],P1[13]),cvtpk(P1[14],P1[15])};
    asm volatile("s_waitcnt lgkmcnt(0)":::"memory");
    if(j>0)SB_LOADK(j-1);
    pv(o,vb,__builtin_bit_cast(bf16x8,pw0),__builtin_bit_cast(bf16x8,pw1),__builtin_bit_cast(bf16x8,pw2),__builtin_bit_cast(bf16x8,pw3));
    if(__all(R>R_STOP))break;
  }
  #undef SB_LOADK
  #undef SB_LOADV
  bf16_t*Ow=O+(rowbase+t0)*DM+co;
  { bf16_t*stg=(bf16_t*)(wl+8192);
    #pragma unroll
    for(int r=0;r<16;++r){const int orow=crow(r,hi);
      #pragma unroll
      for(int d0=0;d0<2;++d0)stg[orow*64+d0*32+r32]=(bf16_t)f2bf(o[d0][r]);}
    asm volatile("s_waitcnt lgkmcnt(0)":::"memory");
    #pragma unroll
    for(int i=0;i<4;++i){const int row=i*8+(lane>>3),ch=lane&7; const u32x4 v=*(const u32x4*)(stg+row*64+ch*8); *(u32x4*)(Ow+(long)row*DM+ch*8)=v;}
    asm volatile("s_waitcnt lgkmcnt(0)":::"memory"); }
}
}

constexpr int ATT_G_OFF = attn_body::ATTN_LDS_BYTES, ATT_RED_OFF = ATT_G_OFF + SEQ * 4;
__device__ __forceinline__ void fox_scan_G(const float* FA, int b, int h, float* Gl, float* red, int tid, int lane, int wave) {
    float v[8]; float run = 0.f;
#pragma unroll
    for (int j = 0; j < 8; ++j) { run += FA[((size_t)b * SEQ + 8 * tid + j) * 8 + h] * LOG2E; v[j] = run; }
    float inc = run;
#pragma unroll
    for (int o = 1; o < 64; o <<= 1) { const float n = __shfl_up(inc, o); if (lane >= o) inc += n; }
    if (lane == 63) red[wave] = inc;
    __syncthreads();
    float off = inc - run;
    for (int w = 0; w < wave; ++w) off += red[w];
#pragma unroll
    for (int j = 0; j < 8; ++j) Gl[8 * tid + j] = off + v[j];
    __syncthreads();
}
template <int PARTS = 3>
__device__ __forceinline__ void ph_attn(const Prm& p, const Ctx& C, int l, unsigned char* lds, size_t o_off = WS_QQ) {
    const int G = gridDim.x, bx = blockIdx.x; const int vcu = (G % 8 == 0) ? (bx % 8) * (G / 8) + bx / 8 : bx;
    const attn_body::bf16* Q = (const attn_body::bf16*)(p.ws + WS_QQ); const attn_body::bf16* K = (const attn_body::bf16*)(p.ws + WS_KK); const attn_body::bf16* V = (const attn_body::bf16*)(p.ws + WS_VV);
    float* Gl = (float*)(lds + ATT_G_OFF); float* red = (float*)(lds + ATT_RED_OFF);
    int cur_bh = -1;
    float Bq;
    { float mq = fabsf(p.gq[l * HD + C.lane]), mk = fabsf(p.gk[l * HD + C.lane]);
#pragma unroll
      for (int o = 1; o < 64; o <<= 1) { mq = fmaxf(mq, __shfl_xor(mq, o)); mk = fmaxf(mk, __shfl_xor(mk, o)); }
      Bq = 1.02f * C2 * 64.0f * mq * mk; }
    unsigned* qcnt = (unsigned*)(p.ws + WS_CTL) + 3584 + l * 8 * 64;
    unsigned* uslot = (unsigned*)(lds + ATT_RED_OFF + 64);
    for (int qi = 0; qi < 8; ++qi) {
        const int qx = (bx + qi) & 7;
        for (;;) {
            __syncthreads();
            if (C.tid == 0) *uslot = __hip_atomic_fetch_add(qcnt + 64 * qx, 1u, __ATOMIC_RELAXED, __HIP_MEMORY_SCOPE_AGENT);
            __syncthreads();
            const unsigned u = *uslot;
            if (u >= 256u) break;
            if (u < 128u) {
                if (!(PARTS & 1)) continue;
                const int qb = 15 - (int)(u >> 3), bh = qx * NH + (int)(u & 7);
                if (bh != cur_bh) { __syncthreads(); fox_scan_G((const float*)(p.ws + WS_FA), bh / NH, bh % NH, Gl, red, C.tid, C.lane, C.wave); cur_bh = bh; }
                const int ntf = 4 * qb + 4; const float thr = Gl[qb * 256] + 2.0f * Bq + 22.0f;
                const bool skp = (C.lane < ntf - 4) && (Gl[64 * C.lane + 63] > thr);
                const int j0 = __builtin_popcountll(__ballot(skp)) & ~1;
                attn_body::attn_unit<8>(bh / NH, bh % NH, qb, Q, K, V, (attn_body::bf16*)(p.ws + o_off), (char*)lds, Gl, j0);
            } else {
                if (!(PARTS & 2)) continue;
                const int v = (int)u - 128, h = v & 7, g = 15 - (v >> 3);
                cur_bh = -1;
                int lane_ = C.lane; asm volatile("" : "+v"(lane_));
                sbk::sb_unit(qx, h, 8 * g + C.wave, (const bf16_t*)(p.ws + WS_QQ), (const bf16_t*)(p.ws + WS_KK), (const bf16_t*)(p.ws + WS_VV), (bf16_t*)(p.ws + o_off), (char*)lds + C.wave * sbk::WLDS, lane_);
            }
        }
    }
    __syncthreads();
}

namespace pgk {
typedef __bf16 bf16x2 __attribute__((ext_vector_type(2)));
__device__ __forceinline__ float dot2(unsigned a, unsigned b, float c) { return __builtin_amdgcn_fdot2_f32_bf16(__builtin_bit_cast(bf16x2, a), __builtin_bit_cast(bf16x2, b), c, false); }
__device__ __forceinline__ unsigned cvtpk(float lo, float hi) { typedef float f2 __attribute__((ext_vector_type(2))); f2 v = {lo, hi}; bf16x2 b = __builtin_convertvector(v, bf16x2); return __builtin_bit_cast(unsigned, b); }
}
namespace tk {
using bf16x8 = __attribute__((ext_vector_type(8))) short;
using f32x16 = __attribute__((ext_vector_type(16))) float;
constexpr int NCAND = 50;
__device__ __forceinline__ unsigned f2key(float f) { const unsigned u = __float_as_uint(f); return u ^ ((unsigned)((int)u >> 31) | 0x80000000u); }
__device__ __forceinline__ float key2f(unsigned k) { return __uint_as_float(k ^ ~((unsigned)((int)k >> 31) >> 1)); }
#define TK_CE(a, b) do { const unsigned mx_ = (a) > (b) ? (a) : (b), mn_ = (a) > (b) ? (b) : (a); (a) = mx_; (b) = mn_; } while (0)
template <int N> __device__ __forceinline__ void sort_desc(unsigned (&k)[N]) {
    if constexpr (N == 16) {
        TK_CE(k[0], k[13]); TK_CE(k[1], k[12]); TK_CE(k[2], k[15]); TK_CE(k[3], k[14]); TK_CE(k[4], k[8]); TK_CE(k[5], k[6]); TK_CE(k[7], k[11]); TK_CE(k[9], k[10]);
        TK_CE(k[0], k[5]); TK_CE(k[1], k[7]); TK_CE(k[2], k[9]); TK_CE(k[3], k[4]); TK_CE(k[6], k[13]); TK_CE(k[8], k[14]); TK_CE(k[10], k[15]); TK_CE(k[11], k[12]);
        TK_CE(k[0], k[1]); TK_CE(k[2], k[3]); TK_CE(k[4], k[5]); TK_CE(k[6], k[8]); TK_CE(k[7], k[9]); TK_CE(k[10], k[11]); TK_CE(k[12], k[13]); TK_CE(k[14], k[15]);
        TK_CE(k[0], k[2]); TK_CE(k[1], k[3]); TK_CE(k[4], k[10]); TK_CE(k[5], k[11]); TK_CE(k[6], k[7]); TK_CE(k[8], k[9]); TK_CE(k[12], k[14]); TK_CE(k[13], k[15]);
        TK_CE(k[1], k[2]); TK_CE(k[3], k[12]); TK_CE(k[4], k[6]); TK_CE(k[5], k[7]); TK_CE(k[8], k[10]); TK_CE(k[9], k[11]); TK_CE(k[13], k[14]);
        TK_CE(k[1], k[4]); TK_CE(k[2], k[6]); TK_CE(k[5], k[8]); TK_CE(k[7], k[10]); TK_CE(k[9], k[13]); TK_CE(k[11], k[14]);
        TK_CE(k[2], k[4]); TK_CE(k[3], k[6]); TK_CE(k[9], k[12]); TK_CE(k[11], k[13]);
        TK_CE(k[3], k[5]); TK_CE(k[6], k[8]); TK_CE(k[7], k[9]); TK_CE(k[10], k[12]);
        TK_CE(k[3], k[4]); TK_CE(k[5], k[6]); TK_CE(k[7], k[8]); TK_CE(k[9], k[10]); TK_CE(k[11], k[12]);
        TK_CE(k[6], k[7]); TK_CE(k[8], k[9]);
        return;
    }
#pragma unroll
    for (int size = 2; size <= N; size <<= 1) {
#pragma unroll
        for (int stride = size >> 1; stride > 0; stride >>= 1) {
#pragma unroll
            for (int i = 0; i < N; ++i) { const int j = i ^ stride; if (j > i) { if ((i & size) == 0 || size == N) TK_CE(k[i], k[j]); else TK_CE(k[j], k[i]); } }
        }
    }
}
__device__ __forceinline__ void merge_desc16(unsigned (&k)[16]) {
#pragma unroll
    for (int stride = 8; stride > 0; stride >>= 1) {
#pragma unroll
        for (int i = 0; i < 16; ++i) { const int j = i ^ stride; if (j > i) TK_CE(k[i], k[j]); }
    }
}
__device__ __forceinline__ void top16_merge(unsigned (&a)[16], const unsigned (&b)[16]) {
#pragma unroll
    for (int i = 0; i < 16; ++i) a[i] = a[i] > b[15 - i] ? a[i] : b[15 - i];
    merge_desc16(a);
}
__device__ __forceinline__ void xlane_merge(unsigned (&a)[16]) {
    unsigned o[16];
#pragma unroll
    for (int i = 0; i < 16; ++i) o[i] = (unsigned)__shfl_xor((int)a[i], 32);
    top16_merge(a, o);
}
__device__ __forceinline__ void half_top16(const f32x16 (&z)[4], int c4, unsigned (&out)[16]) {
    unsigned k[4][16];
#pragma unroll
    for (int blk = 0; blk < 4; ++blk)
#pragma unroll
        for (int r = 0; r < 16; ++r) k[blk][r] = (f2key(z[blk][r]) & ~127u) | (unsigned)((127 - 32 * blk - (r & 3) - 8 * (r >> 2)) - c4);
#pragma unroll
    for (int blk = 0; blk < 4; ++blk) sort_desc<16>(k[blk]);
    top16_merge(k[0], k[1]); top16_merge(k[2], k[3]); top16_merge(k[0], k[2]);
    xlane_merge(k[0]);
#pragma unroll
    for (int i = 0; i < 16; ++i) out[i] = k[0][i];
}
}

__device__ __forceinline__ void ph_topk(const Prm& p, const Ctx& C, int l, unsigned char* lds) {
    constexpr int TA[64] = {0,0,0,0,0,0,0,0,0,0,0,0,0,0,0,0,1,1,1,1,1,1,1,1,2,2,2,2,2,3,3,3,3,4,4,4,5,5,6,6,7,7,8,9,10,11,12,13,14,15,0,0,0,0,0,0,0,0,0,0,0,0,0,0};
    constexpr int TB[64] = {0,1,2,3,4,5,6,7,8,9,10,11,12,13,14,15,0,1,2,3,4,5,6,7,0,1,2,3,4,0,1,2,3,0,1,2,0,1,0,1,0,1,0,0,0,0,0,0,0,0,0,0,0,0,0,0,0,0,0,0,0,0,0,0};
    const bf16_t* QP = (const bf16_t*)(p.ws + WS_KK); unsigned short* IDX = (unsigned short*)(p.ws + WS_VV); float* PW = (float*)(p.ws + WS_VV + 16 * MiB);
    const int lane = C.lane, r32 = lane & 31, hi = lane >> 5;
    int c4 = 4 * hi; asm volatile("" : "+v"(c4));
    unsigned char* wtab = lds + 32768 + C.wave * 1024 + r32 * 32;
    for (int item = blockIdx.x; item < 256; item += gridDim.x) {
        const int h = item & 7, tg = item >> 3;
        __syncthreads();
        for (int c = C.tid; c < 2048; c += NTHREADS) {
            const int tbl = c >> 10, row = (c >> 3) & 127, ch = c & 7;
            const float* src = (tbl ? p.k2 : p.k1) + ((size_t)(l * NH + h) * NKEYS + row) * 64 + ch * 8;
            const f32x4 a = *(const f32x4*)src, b = *(const f32x4*)(src + 4);
            u32x4 o; o.x = pgk::cvtpk(a.x, a.y); o.y = pgk::cvtpk(a.z, a.w); o.z = pgk::cvtpk(b.x, b.y); o.w = pgk::cvtpk(b.z, b.w);
            *(u32x4*)(lds + tbl * 16384 + row * 128 + ((ch ^ (row & 7)) << 4)) = o;
        }
        __syncthreads();
#pragma unroll 1
        for (int i = 0; i < 4; ++i) {
            const int tile = tg * 32 + C.wave * 4 + i, t = tile * 32 + r32;
            const bf16_t* qrow = QP + (size_t)t * DM + h * 128 + 8 * hi;
            unsigned V1[16], V2[16];
#pragma unroll
            for (int half = 0; half < 2; ++half) {
                tk::bf16x8 qf[4];
#pragma unroll
                for (int ks = 0; ks < 4; ++ks) qf[ks] = *(const tk::bf16x8*)(qrow + half * 64 + 16 * ks);
                tk::f32x16 z[4];
#pragma unroll
                for (int blk = 0; blk < 4; ++blk) {
                    z[blk] = tk::f32x16{};
                    const int row = 32 * blk + r32;
#pragma unroll
                    for (int ks = 0; ks < 4; ++ks) {
                        const tk::bf16x8 kfr = *(const tk::bf16x8*)(lds + half * 16384 + row * 128 + (((2 * ks + hi) ^ (row & 7)) << 4));
                        z[blk] = __builtin_amdgcn_mfma_f32_32x32x16_bf16(kfr, qf[ks], z[blk], 0, 0, 0);
                    }
                }
                if (half == 0) tk::half_top16(z, c4, V1); else tk::half_top16(z, c4, V2);
            }
            { u32x4 w;
              unsigned n[16];
#pragma unroll
              for (int q = 0; q < 16; ++q) n[q] = 127u - ((hi ? V2[q] : V1[q]) & 127u);
              w.x = n[0] | (n[1] << 8) | (n[2] << 16) | (n[3] << 24); w.y = n[4] | (n[5] << 8) | (n[6] << 16) | (n[7] << 24);
              w.z = n[8] | (n[9] << 8) | (n[10] << 16) | (n[11] << 24); w.w = n[12] | (n[13] << 8) | (n[14] << 16) | (n[15] << 24);
              *(u32x4*)(wtab + 16 * hi) = w; }
            float f1[16], f2[16];
#pragma unroll
            for (int q = 0; q < 16; ++q) { f1[q] = tk::key2f(V1[q] & ~127u); f2[q] = tk::key2f(V2[q] & ~127u); }
            unsigned ca[16], cb[16];
#pragma unroll
            for (int s = 0; s < 32; ++s) {
                const float v0 = f1[TA[s]] + f2[TB[s]];
                const float v1 = (32 + s < tk::NCAND) ? f1[TA[32 + s]] + f2[TB[32 + s]] : -INFINITY;
                const unsigned j0 = 255u - (unsigned)(TA[s] * 16 + TB[s]), j1 = 255u - (unsigned)(TA[32 + s] * 16 + TB[32 + s]);
                const unsigned key = (tk::f2key(hi ? v1 : v0) & ~255u) | (hi ? j1 : j0);
                if (s < 16) ca[s] = key; else cb[s - 16] = key;
            }
            tk::sort_desc<16>(ca); tk::sort_desc<16>(cb); tk::top16_merge(ca, cb); tk::xlane_merge(ca);
            float e[16]; float sum = 0.f; const float mx = tk::key2f(ca[0] & ~255u);
#pragma unroll
            for (int q = 0; q < 16; ++q) { e[q] = __builtin_amdgcn_exp2f((tk::key2f(ca[q] & ~255u) - mx) * LOG2E); sum += e[q]; }
            const float inv = 1.0f / sum;
            int eo[8]; float go[8];
            asm volatile("s_waitcnt lgkmcnt(0)" ::: "memory");
#pragma unroll
            for (int q = 0; q < 8; ++q) {
                const unsigned kq = hi ? ca[8 + q] : ca[q]; const unsigned j = 255u - (kq & 255u);
                const unsigned n1 = wtab[j >> 4], n2 = wtab[16 + (j & 15)];
                eo[q] = (int)(n1 * NKEYS + n2); go[q] = (hi ? e[8 + q] : e[q]) * inv;
            }
            unsigned short* ip = IDX + (size_t)t * 128 + h * 16 + 8 * hi; bf16_t* gp = (bf16_t*)PW + (size_t)t * 128 + h * 16 + 8 * hi;
            *(u32x4*)ip = (u32x4){(unsigned)eo[0] | ((unsigned)eo[1] << 16), (unsigned)eo[2] | ((unsigned)eo[3] << 16), (unsigned)eo[4] | ((unsigned)eo[5] << 16), (unsigned)eo[6] | ((unsigned)eo[7] << 16)};
            *(u32x4*)gp = (u32x4){pk2(go[0], go[1]), pk2(go[2], go[3]), pk2(go[4], go[5]), pk2(go[6], go[7])};
            asm volatile("s_waitcnt lgkmcnt(0)" ::: "memory");
        }
    }
    __syncthreads();
}


constexpr size_t WS_T8 = WS_UB;
constexpr size_t WS_SC8 = WS_K12;
typedef float f32x2 __attribute__((ext_vector_type(2)));
typedef short s16x4 __attribute__((ext_vector_type(4))); typedef int i32x4 __attribute__((ext_vector_type(4))); typedef int i32x2 __attribute__((ext_vector_type(2)));
#define GAS __attribute__((address_space(1)))
#define LAS __attribute__((address_space(3)))
#define XB_TMO      128
#define XB_XCNT(j)  (256  + 64 * (j))
#define XB_XSUB(j)  (1280 + 64 * (j))
#define XB_XGEN(j)  (2304 + 64 * (j))
#define XB_TOP      3328
#define XB_TOPGEN   3392
#define XCD_BAR_WORDS 3456
#define XB_SPIN_CAP (1u << 18)

__device__ __forceinline__ unsigned xb_ld(unsigned* p)              { return __hip_atomic_load(p, __ATOMIC_RELAXED, __HIP_MEMORY_SCOPE_AGENT); }
__device__ __forceinline__ unsigned xb_add(unsigned* p, unsigned v) { return __hip_atomic_fetch_add(p, v, __ATOMIC_RELAXED, __HIP_MEMORY_SCOPE_AGENT); }
__device__ __forceinline__ unsigned xb_xcc_id() { return (unsigned)__builtin_amdgcn_s_getreg((3 << 11) | 20) & 0xFu; }
#define XB_SPIN(cond, bar) do { unsigned _sp = 0; while (cond) { __builtin_amdgcn_s_sleep(1); \
    if ((++_sp & 255u) == 0u) { if (xb_ld(&(bar)[XB_TMO])) break; if (_sp > XB_SPIN_CAP) { atomicAdd(&(bar)[XB_TMO], 1u); break; } } } } while (0)

struct XcdBarrier {
    unsigned* bar; unsigned x;
    volatile LAS unsigned* st;
};

__device__ __forceinline__ XcdBarrier xcd_barrier_post(unsigned* bar, volatile LAS unsigned* st) {
    XcdBarrier b; b.bar = bar; b.x = xb_xcc_id(); b.st = st;
    if (threadIdx.x == 0) st[2] = xb_add(&bar[XB_XCNT(b.x)], 1u);
    return b;
}
__device__ __forceinline__ void xcd_barrier_complete(unsigned* bar, unsigned x, unsigned& nloc, unsigned& nx) {
    const unsigned G = gridDim.x * gridDim.y * gridDim.z;
    unsigned sum, cnt, mine, sp = 0u;
    for (;;) {
        sum = 0u; cnt = 0u; mine = 0u;
#pragma unroll
        for (unsigned j = 0; j < 16; ++j) { const unsigned c = xb_ld(&bar[XB_XCNT(j)]); sum += c; cnt += (c > 0u) ? 1u : 0u; mine = (j == x) ? c : mine; }
        if (sum == G) break;
        __builtin_amdgcn_s_sleep(1);
        if ((++sp & 255u) == 0u) { if (xb_ld(&bar[XB_TMO])) break; if (sp > XB_SPIN_CAP) { atomicAdd(&bar[XB_TMO], 1u); break; } }
    }
    nloc = mine > 0u ? mine : 1u; nx = cnt > 0u ? cnt : 1u;
}

__device__ __forceinline__ void xcd_barrier(const XcdBarrier& b) {
    asm volatile("s_waitcnt vmcnt(0)" ::: "memory");
    __syncthreads();
    if (threadIdx.x == 0) {
        unsigned* bar = b.bar;
        __builtin_amdgcn_s_waitcnt(0);
        unsigned nloc = b.st[0], nx = b.st[1];
        if (nloc == 0u) { xcd_barrier_complete(bar, b.x, nloc, nx); b.st[0] = nloc; b.st[1] = nx; }
        const unsigned old = xb_add(&bar[XB_XSUB(b.x)], 1u);
        const unsigned gen = old / nloc;
        if (old + 1u == (gen + 1u) * nloc) {
            __builtin_amdgcn_fence(__ATOMIC_RELEASE, "agent");
            asm volatile("s_waitcnt vmcnt(0)" ::: "memory");
            const unsigned og = xb_add(&bar[XB_TOP], 1u);
            const unsigned tg = og / nx;
            if (og + 1u == (tg + 1u) * nx) xb_add(&bar[XB_TOPGEN], 1u);
            else XB_SPIN(xb_ld(&bar[XB_TOPGEN]) == tg, bar);
            __builtin_amdgcn_fence(__ATOMIC_ACQUIRE, "agent");
            xb_add(&bar[XB_XGEN(b.x)], 1u);
            asm volatile("s_waitcnt vmcnt(0)" ::: "memory");
        } else {
            XB_SPIN(xb_ld(&bar[XB_XGEN(b.x)]) == gen, bar);
            __builtin_amdgcn_fence(__ATOMIC_ACQUIRE, "agent");
            asm volatile("s_waitcnt vmcnt(0)" ::: "memory");
        }
    }
    __syncthreads();
}


constexpr size_t WS_PD = WS_GT;
__device__ __forceinline__ void ph_convert_tables8s(const Prm& p, const Ctx& C) {
    unsigned char* T8 = p.ws + WS_T8; float* SC = (float*)(p.ws + WS_SC8);
    constexpr int NR = 2 * 2 * NEXP;
    f32x4 v[2][2][4];
#define CV_LOAD(s_, row0_) do { _Pragma("unroll") for (int r = 0; r < 2; ++r) { const int row = min((row0_) + r * C.ngw, NR - 1); const int lt = row >> 14, e = row & (NEXP - 1), l = lt >> 1, tbl = lt & 1; \
        const float* src = (tbl ? p.pv : p.pu) + ((size_t)l * NEXP + e) * DM + 4 * C.lane; _Pragma("unroll") for (int j = 0; j < 4; ++j) v[s_][r][j] = *(const f32x4*)(src + 256 * j); } } while (0)
#define CV_PROC(s_, row0_) do { _Pragma("unroll") for (int r = 0; r < 2; ++r) { const int row = (row0_) + r * C.ngw; if (row >= NR) break; const int lt = row >> 14, e = row & (NEXP - 1); \
        float am = 0.f; _Pragma("unroll") for (int j = 0; j < 4; ++j) am = fmaxf(am, fmaxf(fmaxf(fabsf(v[s_][r][j].x), fabsf(v[s_][r][j].y)), fmaxf(fabsf(v[s_][r][j].z), fabsf(v[s_][r][j].w)))); \
        am = fmaxf(am, dpp_f<0xB1>(am)); am = fmaxf(am, dpp_f<0x4E>(am)); am = fmaxf(am, dpp_f<0x141>(am)); am = fmaxf(am, dpp_f<0x140>(am)); am = xmax16(am); am = xmax32(am); \
          \
        const float qm = 7.0f / 0.75f, sc = am > 0.f ? am / qm : 1.0f, inv = am > 0.f ? qm / am : 0.f; \
        const int o8 = (lt & 1) ? 8 : 0;     \
        _Pragma("unroll") for (int j = 0; j < 4; ++j) {     \
            const int q0 = (int)fminf(fmaxf(rintf(v[s_][r][j].x * inv), -8.0f), 7.0f), q1 = (int)fminf(fmaxf(rintf(v[s_][r][j].y * inv), -8.0f), 7.0f), q2 = (int)fminf(fmaxf(rintf(v[s_][r][j].z * inv), -8.0f), 7.0f), q3 = (int)fminf(fmaxf(rintf(v[s_][r][j].w * inv), -8.0f), 7.0f); \
            const int o_ = C.lane < 32 ? o8 : 0; const unsigned mine = (unsigned)(((q0 + o_) & 15) | (((q1 + o_) & 15) << 8) | (((q2 + o_) & 15) << 16) | (((q3 + o_) & 15) << 24)); \
            const unsigned other = __builtin_amdgcn_permlane32_swap(mine, mine, false, false)[1];     \
            if (C.lane < 32) *(unsigned*)(T8 + (((size_t)lt * 8 + j) * NEXP + e) * 128 + 4 * C.lane) = mine | (other << 4); } \
        if (C.lane == 0) SC[row] = sc; } } while (0)
    CV_LOAD(0, C.gw);
    __builtin_amdgcn_s_waitcnt(0x0F70);
#pragma unroll 1
    for (int row0 = C.gw; row0 < NR; row0 += 4 * C.ngw) {
        CV_LOAD(1, row0 + 2 * C.ngw); CV_PROC(0, row0);
        CV_LOAD(0, row0 + 4 * C.ngw); CV_PROC(1, row0 + 2 * C.ngw);
    }
#undef CV_LOAD
#undef CV_PROC
}
__device__ __forceinline__ float sum8(float v) { v += dpp_f<0xB1>(v); v += dpp_f<0x4E>(v); v += dpp_f<0x141>(v); return v; }
template <int JS> __device__ __forceinline__ unsigned bcast8(unsigned v, int jq) {
    constexpr int c = JS & 3, ctrl = c | (c << 2) | (c << 4) | (c << 6);
    const unsigned v1 = (unsigned)__builtin_amdgcn_update_dpp(0, (int)v, ctrl, 0xF, 0xF, true);
    const unsigned v2 = (unsigned)__builtin_amdgcn_update_dpp(0, (int)v1, 0x141, 0xF, 0xF, true);
    return (jq == (JS >> 2)) ? v1 : v2;
}
template <int BB> __device__ __forceinline__ unsigned pick_id(unsigned idw, int jq) { const unsigned w = bcast8<(BB >> 1)>(idw, jq); return (BB & 1) ? (w >> 16) : (w & 0xffffu); }
template <int G4> __device__ __forceinline__ int bcast4(unsigned v) { constexpr int ctrl = G4 | (G4 << 2) | (G4 << 4) | (G4 << 6); return __builtin_amdgcn_update_dpp(0, (int)v, ctrl, 0xF, 0xF, true); }
struct SliceCtx { int x, wq, nwq; };
#ifndef SLICE_BY_XCC
#define SLICE_BY_XCC 0
#endif
__device__ __forceinline__ SliceCtx slice_ctx(const Ctx& C, const Prm& p, unsigned char* lds) { SliceCtx s; const int G = gridDim.x;
    if (SLICE_BY_XCC) { const unsigned x = xb_xcc_id() & 7u; const unsigned* bar = (const unsigned*)(p.ws + WS_CTL); const volatile LAS unsigned* st = (const volatile LAS unsigned*)((LAS unsigned char*)lds + (LDS_BYTES - 64));
        s.x = (int)x; s.wq = (int)st[2] * NWAVES + C.wave; s.nwq = (int)xb_ld((unsigned*)&bar[XB_XCNT(x)]) * NWAVES; return s; }
    s.x = blockIdx.x & 7; s.wq = (blockIdx.x >> 3) * NWAVES + C.wave; s.nwq = ((G - s.x + 7) >> 3) * NWAVES; return s; }
__device__ __forceinline__ void ph_peer_u(const Prm& p, const Ctx& C, int l, unsigned char* lds) {
    const SliceCtx S = slice_ctx(C, p, lds);
    const bf16_t* HB = (const bf16_t*)(p.ws + WS_QQ);     const unsigned short* IDX = (const unsigned short*)(p.ws + WS_VV); float* PD = (float*)(p.ws + WS_PD);
    const unsigned char* U8 = p.ws + WS_T8 + ((size_t)(l * 2 + 0) * 8 + S.x) * NEXP * 128;
    const int lane = C.lane, j = lane & 7, k = lane >> 3, jq = (lane >> 2) & 1;
    u32x4 uq[2][16]; unsigned idw[2]; u32x4 hr0[2], hr1[2];
    const int nit = (NT - S.wq + S.nwq - 1) / S.nwq;
#define PU_TOK(i) (S.wq + ((i) < nit ? (i) : nit - 1) * S.nwq)
#define PU_LOADID(s_, i) do { idw[s_] = ((const unsigned*)IDX)[(size_t)PU_TOK(i) * 64 + lane]; } while (0)
#define PU_LOADH(s_, i) do { const bf16_t* hp_ = HB + (size_t)PU_TOK(i) * DM + 128 * S.x + 16 * j; hr0[s_] = *(const u32x4*)hp_; hr1[s_] = *(const u32x4*)(hp_ + 8); } while (0)
#define PU_G1(s_, BB) uq[s_][BB] = *(const u32x4*)(U8 + (size_t)pick_id<BB>(idw[s_], jq) * 128 + 16 * j)
#define PU_GATHER(s_, h_) do { PU_G1(s_, 8 * (h_) + 0); PU_G1(s_, 8 * (h_) + 1); PU_G1(s_, 8 * (h_) + 2); PU_G1(s_, 8 * (h_) + 3); PU_G1(s_, 8 * (h_) + 4); PU_G1(s_, 8 * (h_) + 5); PU_G1(s_, 8 * (h_) + 6); PU_G1(s_, 8 * (h_) + 7); } while (0)
#define PU_MATH(s_, h_, pd_) do { _Pragma("unroll") for (int b_ = 0; b_ < 8; ++b_) { const int bb = 8 * (h_) + b_; int ai = __builtin_amdgcn_sdot4((int)uq[s_][bb].x, hq[0], 0, false); \
        ai = __builtin_amdgcn_sdot4((int)uq[s_][bb].y, hq[1], ai, false); ai = __builtin_amdgcn_sdot4((int)uq[s_][bb].z, hq[2], ai, false); ai = __builtin_amdgcn_sdot4((int)uq[s_][bb].w, hq[3], ai, false); \
        ai += dpp_i<0xB1>(ai); ai += dpp_i<0x4E>(ai); ai += dpp_i<0x141>(ai); if (b_ == j) pd_ = ai; } } while (0)
    PU_LOADID(0, 0); PU_LOADID(1, 1); PU_LOADH(0, 0); PU_LOADH(1, 1);
    PU_GATHER(0, 0); PU_GATHER(0, 1); PU_GATHER(1, 0); PU_GATHER(1, 1);
    PU_LOADID(0, 2);
#pragma unroll 1
    for (int it = 0; it < nit; it += 2) {
#pragma unroll
        for (int a = 0; a < 2; ++a) {
            const int i = it + a, bq = 1 - a;
            int hq[4]; float hsc;
            { const unsigned hw[8] = {hr0[a].x, hr0[a].y, hr0[a].z, hr0[a].w, hr1[a].x, hr1[a].y, hr1[a].z, hr1[a].w};
              float hv[16]; float am = 0.f;
#pragma unroll
              for (int q = 0; q < 8; ++q) { hv[2 * q] = __uint_as_float(hw[q] << 16); hv[2 * q + 1] = __uint_as_float(hw[q] & 0xffff0000u); am = fmaxf(am, fmaxf(fabsf(hv[2 * q]), fabsf(hv[2 * q + 1]))); }
              am = fmaxf(am, dpp_f<0xB1>(am)); am = fmaxf(am, dpp_f<0x4E>(am)); am = fmaxf(am, dpp_f<0x141>(am));
              hsc = am > 0.f ? am * (1.0f / 127.0f) : 1.0f; const float inv = am > 0.f ? 127.0f / am : 0.f;
#pragma unroll
              for (int q = 0; q < 4; ++q) { unsigned u0 = __builtin_amdgcn_cvt_pk_u8_f32(hv[4 * q] * inv + 128.0f, 0, 0u); u0 = __builtin_amdgcn_cvt_pk_u8_f32(hv[4 * q + 1] * inv + 128.0f, 1, u0);
                  u0 = __builtin_amdgcn_cvt_pk_u8_f32(hv[4 * q + 2] * inv + 128.0f, 2, u0); u0 = __builtin_amdgcn_cvt_pk_u8_f32(hv[4 * q + 3] * inv + 128.0f, 3, u0); hq[q] = (int)(u0 ^ 0x80808080u); } }
            PU_LOADH(a, i + 2); PU_LOADID(bq, i + 3);
            int pd0 = 0, pd1 = 0;
            PU_MATH(a, 0, pd0); PU_GATHER(a, 0);
            PU_MATH(a, 1, pd1); PU_GATHER(a, 1);
            if (i < nit) { float* pd = PD + ((size_t)S.x * NT + (S.wq + i * S.nwq)) * 128 + 16 * k + j; pd[0] = (float)pd0 * hsc; pd[8] = (float)pd1 * hsc; }
        }
    }
#undef PU_TOK
#undef PU_LOADID
#undef PU_LOADH
#undef PU_GATHER
#undef PU_G1
#undef PU_MATH
}
__device__ __forceinline__ void ph_peer_pre(const Prm& p, const Ctx& C, int l) {
    const float* MOD = (const float*)(p.ws + WS_MOD) + (size_t)l * NB * MODW + 3 * DM;
    const bf16_t* WQT = (const bf16_t*)(p.ws + WS_WQ) + (size_t)l * DM * DM; float* BQ = (float*)(p.ws + WS_BQ) + (size_t)l * NB * DM;
    { float* GS = (float*)(p.ws + WS_USH) + (size_t)l * NB * DM; bf16_t* WQB = (bf16_t*)((char*)p.out + 64 * MiB) + (size_t)l * NB * DM * DM;
      const int b = C.gw & 7;
      float gsv[16];
#pragma unroll
      for (int q = 0; q < 4; ++q) { const f32x4 g = *(const f32x4*)(p.ffn_norm + l * DM + 16 * C.lane + 4 * q), sc = *(const f32x4*)(MOD + (size_t)b * MODW + DM + 16 * C.lane + 4 * q);
          gsv[4 * q] = g.x * (1.0f + sc.x); gsv[4 * q + 1] = g.y * (1.0f + sc.y); gsv[4 * q + 2] = g.z * (1.0f + sc.z); gsv[4 * q + 3] = g.w * (1.0f + sc.w); }
      if (C.gw < 8) {
#pragma unroll
          for (int q = 0; q < 4; ++q) *(f32x4*)(GS + (size_t)b * DM + 16 * C.lane + 4 * q) = (f32x4){gsv[4 * q], gsv[4 * q + 1], gsv[4 * q + 2], gsv[4 * q + 3]}; }
      for (int item = C.gw; item < DM * NB; item += C.ngw) { const int n = item >> 3;
          const u32x4 w0 = *(const u32x4*)(WQT + (size_t)n * DM + 16 * C.lane), w1 = *(const u32x4*)(WQT + (size_t)n * DM + 16 * C.lane + 8);
          const unsigned ww[8] = {w0.x, w0.y, w0.z, w0.w, w1.x, w1.y, w1.z, w1.w}; unsigned o[8];
#pragma unroll
          for (int q = 0; q < 8; ++q) o[q] = pk2(__uint_as_float(ww[q] << 16) * gsv[2 * q], __uint_as_float(ww[q] & 0xffff0000u) * gsv[2 * q + 1]);
          bf16_t* op = WQB + ((size_t)b * DM + n) * DM + 16 * C.lane;
          *(u32x4*)op = (u32x4){o[0], o[1], o[2], o[3]}; *(u32x4*)(op + 8) = (u32x4){o[4], o[5], o[6], o[7]}; } }
    for (int item = C.gw; item < (DM / 8) * NB; item += C.ngw) {
        const int b = item & 7, c0 = (item >> 3) * 8;
        float sh[16];
#pragma unroll
        for (int q = 0; q < 4; ++q) { const f32x4 v = *(const f32x4*)(MOD + (size_t)b * MODW + 16 * C.lane + 4 * q); sh[4 * q] = v.x; sh[4 * q + 1] = v.y; sh[4 * q + 2] = v.z; sh[4 * q + 3] = v.w; }
        float res = 0.f;
#pragma unroll
        for (int c = 0; c < 8; ++c) { const u32x4 w0 = *(const u32x4*)(WQT + (size_t)(c0 + c) * DM + 16 * C.lane), w1 = *(const u32x4*)(WQT + (size_t)(c0 + c) * DM + 16 * C.lane + 8);
            const unsigned ww[8] = {w0.x, w0.y, w0.z, w0.w, w1.x, w1.y, w1.z, w1.w}; float a = 0.f;
#pragma unroll
            for (int q = 0; q < 8; ++q) a += __uint_as_float(ww[q] << 16) * sh[2 * q] + __uint_as_float(ww[q] & 0xffff0000u) * sh[2 * q + 1];
            a = wave_sum(a); if (C.lane == c) res = a; }
        if (C.lane < 8) BQ[(size_t)b * DM + c0 + C.lane] = res;
    }
    const unsigned char* U8 = p.ws + WS_T8 + (size_t)(l * 2 + 0) * 8 * NEXP * 128; const float* SU = (const float*)(p.ws + WS_SC8) + (size_t)(l * 2) * NEXP; float* USH = (float*)(p.ws + WS_USH) + (size_t)l * NB * NEXP;
    float shb[8][16];
    const int cl = 256 * (C.lane >> 4) + 8 * (C.lane & 15);
#pragma unroll
    for (int b = 0; b < 8; ++b)
#pragma unroll
        for (int q = 0; q < 4; ++q) { const f32x4 v = *(const f32x4*)(MOD + (size_t)b * MODW + cl + 128 * (q >> 1) + 4 * (q & 1)); shb[b][4 * q] = v.x; shb[b][4 * q + 1] = v.y; shb[b][4 * q + 2] = v.z; shb[b][4 * q + 3] = v.w; }
    const int hi5 = C.lane >> 5, b4 = (C.lane >> 4) & 1;
    for (int e0 = C.gw; e0 < NEXP; e0 += 2 * C.ngw) {
        u32x2 uq[2];
#pragma unroll
        for (int r = 0; r < 2; ++r) uq[r] = *(const u32x2*)(U8 + ((size_t)(C.lane >> 4) * NEXP + min(e0 + r * C.ngw, NEXP - 1)) * 128 + 8 * (C.lane & 15));
#pragma unroll
        for (int r = 0; r < 2; ++r) { const int e = e0 + r * C.ngw; if (e >= NEXP) break;
            const unsigned w[2] = {uq[r].x, uq[r].y}; float uf[16];
#pragma unroll
            for (int q = 0; q < 8; ++q) { uf[q] = (float)(((int)(w[q >> 2] << (28 - 8 * (q & 3)))) >> 28); uf[8 + q] = (float)(((int)(w[q >> 2] << (24 - 8 * (q & 3)))) >> 28); }
            float a[8];
#pragma unroll
            for (int b = 0; b < 8; ++b) { float t = 0.f;
#pragma unroll
                for (int q = 0; q < 16; ++q) t += uf[q] * shb[b][q];
                a[b] = t; }
            float r4[4], r2[2];
#pragma unroll
            for (int q = 0; q < 4; ++q) r4[q] = xsum32(a[q], a[4 + q]);
#pragma unroll
            for (int q = 0; q < 2; ++q) r2[q] = xsum16(r4[q], r4[2 + q]);
#pragma unroll
            for (int q = 0; q < 2; ++q) { float v = r2[q]; v += dpp_f<0xB1>(v); v += dpp_f<0x4E>(v); v += dpp_f<0x141>(v); v += dpp_f<0x128>(v); r2[q] = v; }
            if ((C.lane & 15) == 0) { const float su = SU[e], sv = SU[NEXP + e]; const int b0 = 4 * hi5 + 2 * b4;
                f32x4* REC = (f32x4*)(p.ws + WS_T8 + ((size_t)(l * 2 + 0) * 8 + 4) * NEXP * 128); REC[(size_t)b0 * NEXP + e] = (f32x4){r2[0] * su, su, sv, 0.f}; REC[(size_t)(b0 + 1) * NEXP + e] = (f32x4){r2[1] * su, su, sv, 0.f}; }
        }
    }
}
__device__ __forceinline__ void ph_peer_r(const Prm& p, const Ctx& C, int l) {
    const unsigned short* IDX = (const unsigned short*)(p.ws + WS_VV); float* PW = (float*)(p.ws + WS_VV + 16 * MiB); const float* PD = (const float*)(p.ws + WS_PD);
    const float* SU = (const float*)(p.ws + WS_SC8) + (size_t)(l * 2) * NEXP; const float* SV = SU + NEXP;
    const size_t n = (size_t)NT * 128, stride = (size_t)gridDim.x * NTHREADS;
    for (size_t i = (size_t)blockIdx.x * NTHREADS + C.tid; i < n; i += stride) {
        float s = 0.f;
#pragma unroll
        for (int x = 0; x < 8; ++x) s += PD[(size_t)x * n + i];
        const size_t t = i >> 7; const float r = ((const float*)(p.ws + WS_FC))[t];
        const int id = IDX[i]; const float d = s * r * SU[id] + ((const float*)(p.ws + WS_USH))[((size_t)l * NB + t / SEQ) * NEXP + id];
        const float cf = PW[i] * (0.5f * d * (1.0f + erff(d * 0.70710678118654752f))) * SV[id];
        float cmx = fabsf(cf); cmx = fmaxf(cmx, dpp_f<0xB1>(cmx)); cmx = fmaxf(cmx, dpp_f<0x4E>(cmx)); cmx = fmaxf(cmx, dpp_f<0x141>(cmx)); cmx = fmaxf(cmx, dpp_f<0x128>(cmx));
        const float inv = cmx > 0.f ? 127.0f / cmx : 0.f;
        ((unsigned char*)(p.ws + WS_VV + 32 * MiB))[i] = (unsigned char)((__builtin_amdgcn_cvt_pk_u8_f32(cf * inv + 128.0f, 0, 0u) ^ 0x80u) & 0xffu);
        if ((C.lane & 15) == 0) ((float*)(p.ws + WS_VV + 40 * MiB))[i >> 4] = cmx * (1.0f / 127.0f);
    }
}
__device__ __forceinline__ void ph_peer_v(const Prm& p, const Ctx& C, int l, unsigned char* lds) {
    const SliceCtx S = slice_ctx(C, p, lds);
    const unsigned short* IDX = (const unsigned short*)(p.ws + WS_VV); const unsigned char* CQ = p.ws + WS_VV + 32 * MiB; const float* CSC = (const float*)(p.ws + WS_VV + 40 * MiB);
    const float* MOD = (const float*)(p.ws + WS_MOD) + (size_t)l * NB * MODW;
    const unsigned char* V8 = p.ws + WS_T8 + ((size_t)(l * 2 + 1) * 8 + S.x) * NEXP * 128;
    const int lane = C.lane, j = lane & 7, k = lane >> 3, b3 = (lane >> 3) & 1, jq = (lane >> 2) & 1;
    u32x4 vq[2][16]; unsigned idw[2]; unsigned cqw[2]; float csv[2]; f32x2 xvv[2], gvv[2];
    const int ocol = 128 * S.x + 16 * j + 2 * k;
    const int nit = (NT - S.wq + S.nwq - 1) / S.nwq;
#define PV_TOK(i) (S.wq + ((i) < nit ? (i) : nit - 1) * S.nwq)
#define PV_LOADID(s_, i) do { idw[s_] = ((const unsigned*)IDX)[(size_t)PV_TOK(i) * 64 + lane]; } while (0)
#define PV_LOADC(s_, i) do { const int t_ = PV_TOK(i); cqw[s_] = ((const unsigned*)CQ)[(size_t)t_ * 32 + 4 * k + (j & 3)]; csv[s_] = CSC[(size_t)t_ * 8 + k]; \
        xvv[s_] = *(const f32x2*)(p.out + (size_t)t_ * DM + ocol); gvv[s_] = *(const f32x2*)(MOD + (size_t)(t_ / SEQ) * MODW + 5 * DM + ocol); } while (0)
#define PV_G1(s_, BB) vq[s_][BB] = *(const u32x4*)(V8 + (size_t)pick_id<BB>(idw[s_], jq) * 128 + 16 * j)
#define PV_GATHER(s_, h_) do { PV_G1(s_, 8 * (h_) + 0); PV_G1(s_, 8 * (h_) + 1); PV_G1(s_, 8 * (h_) + 2); PV_G1(s_, 8 * (h_) + 3); PV_G1(s_, 8 * (h_) + 4); PV_G1(s_, 8 * (h_) + 5); PV_G1(s_, 8 * (h_) + 6); PV_G1(s_, 8 * (h_) + 7); } while (0)
#define PV_MATH(s_, h_) do { _Pragma("unroll") for (int g_ = 2 * (h_); g_ < 2 * (h_) + 2; ++g_) { const unsigned r0_[4] = {vq[s_][4 * g_].x, vq[s_][4 * g_].y, vq[s_][4 * g_].z, vq[s_][4 * g_].w}, r1_[4] = {vq[s_][4 * g_ + 1].x, vq[s_][4 * g_ + 1].y, vq[s_][4 * g_ + 1].z, vq[s_][4 * g_ + 1].w}, \
        r2_[4] = {vq[s_][4 * g_ + 2].x, vq[s_][4 * g_ + 2].y, vq[s_][4 * g_ + 2].z, vq[s_][4 * g_ + 2].w}, r3_[4] = {vq[s_][4 * g_ + 3].x, vq[s_][4 * g_ + 3].y, vq[s_][4 * g_ + 3].z, vq[s_][4 * g_ + 3].w}; \
        _Pragma("unroll") for (int w = 0; w < 4; ++w) { const unsigned p01l = __builtin_amdgcn_perm(r1_[w], r0_[w], 0x05010400u), p01h = __builtin_amdgcn_perm(r1_[w], r0_[w], 0x07030602u), p23l = __builtin_amdgcn_perm(r3_[w], r2_[w], 0x05010400u), p23h = __builtin_amdgcn_perm(r3_[w], r2_[w], 0x07030602u); \
            yi[4 * w + 0] = __builtin_amdgcn_sdot4((int)__builtin_amdgcn_perm(p23l, p01l, 0x05040100u), cq[g_], yi[4 * w + 0], false); yi[4 * w + 1] = __builtin_amdgcn_sdot4((int)__builtin_amdgcn_perm(p23l, p01l, 0x07060302u), cq[g_], yi[4 * w + 1], false); \
            yi[4 * w + 2] = __builtin_amdgcn_sdot4((int)__builtin_amdgcn_perm(p23h, p01h, 0x05040100u), cq[g_], yi[4 * w + 2], false); yi[4 * w + 3] = __builtin_amdgcn_sdot4((int)__builtin_amdgcn_perm(p23h, p01h, 0x07060302u), cq[g_], yi[4 * w + 3], false); } } } while (0)
    PV_LOADID(0, 0); PV_LOADID(1, 1); PV_LOADC(0, 0); PV_LOADC(1, 1);
    PV_GATHER(0, 0); PV_GATHER(0, 1); PV_GATHER(1, 0); PV_GATHER(1, 1);
    PV_LOADID(0, 2);
#pragma unroll 1
    for (int it = 0; it < nit; it += 2) {
#pragma unroll
        for (int a = 0; a < 2; ++a) {
            const int i = it + a, bq = 1 - a;
            const int cq[4] = {bcast4<0>(cqw[a]), bcast4<1>(cqw[a]), bcast4<2>(cqw[a]), bcast4<3>(cqw[a])}; const float cback = csv[a]; const f32x2 xv = xvv[a], gv = gvv[a];
            PV_LOADC(a, i + 2); PV_LOADID(bq, i + 3);
            int yi[16];
#pragma unroll
            for (int q = 0; q < 16; ++q) yi[q] = 0;
            PV_MATH(a, 0); PV_GATHER(a, 0);
            PV_MATH(a, 1); PV_GATHER(a, 1);
            f32x2 y[8];
#pragma unroll
            for (int q = 0; q < 8; ++q) y[q] = (f32x2){(float)yi[2 * q] * cback, (float)yi[2 * q + 1] * cback};
            f32x2 r4[4], r2[2], r1;
#pragma unroll
            for (int q = 0; q < 4; ++q) r4[q] = (f32x2){xsum32(y[q].x, y[4 + q].x), xsum32(y[q].y, y[4 + q].y)};
#pragma unroll
            for (int q = 0; q < 2; ++q) r2[q] = (f32x2){xsum16(r4[q].x, r4[2 + q].x), xsum16(r4[q].y, r4[2 + q].y)};
            { const f32x2 snd = b3 ? r2[0] : r2[1], kp = b3 ? r2[1] : r2[0]; r1 = (f32x2){kp.x + dpp_f<0x128>(snd.x), kp.y + dpp_f<0x128>(snd.y)}; }
            if (i < nit) {
                const int t = S.wq + i * S.nwq;
                *(f32x2*)(p.out + (size_t)t * DM + ocol) = xv + gv * r1;
            }
        }
    }
#undef PV_TOK
#undef PV_LOADID
#undef PV_LOADC
#undef PV_GATHER
#undef PV_G1
#undef PV_MATH
}

template <int MODE = 0> __device__ __forceinline__ void ph_peer_u4(const Prm& p, const Ctx& C, int l, unsigned char* lds) {
    SliceCtx S; S.x = blockIdx.x & 3; S.wq = (blockIdx.x >> 2) * NWAVES + C.wave; S.nwq = (((int)gridDim.x - S.x + 3) >> 2) * NWAVES;
    const bf16_t* HB = (const bf16_t*)(p.ws + WS_XR1); float* PD = (float*)(p.ws + WS_PD);
    const float* GS = (const float*)(p.ws + WS_USH) + (size_t)l * NB * DM + 256 * S.x + 4 * C.lane;
    const unsigned short* IDX = (const unsigned short*)(p.ws + WS_VV);
    const unsigned char* U8 = p.ws + WS_T8 + ((size_t)(l * 2 + 0) * 8 + S.x) * NEXP * 128;
    const int lane = C.lane, j = lane & 7, k = lane >> 3, jq = (lane >> 2) & 1;
    u32x4 uq[2][16]; unsigned idw[2]; u32x2 hr[2]; f32x4 gsr[2];
    LAS unsigned* il = (LAS unsigned*)((LAS unsigned char*)lds + 131072 + C.wave * 256);
    unsigned idr[8];
    LAS unsigned* hl = (LAS unsigned*)((LAS unsigned char*)lds + C.wave * 256);
    const int nit = (NT - S.wq + S.nwq - 1) / S.nwq;
#define PU_TOK(i) (S.wq + ((i) < nit ? (i) : nit - 1) * S.nwq)
#define PU_LOADID(s_, i) do { idw[s_] = ((const unsigned*)IDX)[(size_t)PU_TOK(i) * 64 + lane]; } while (0)
#define PU_LOADH(s_, i) do { const int t_ = PU_TOK(i); hr[s_] = *(const u32x2*)(HB + (size_t)t_ * DM + 256 * S.x + 4 * lane); gsr[s_] = *(const f32x4*)(GS + (size_t)(t_ / SEQ) * DM); } while (0)
#define PU_IDS(s_) do { il[lane] = idw[s_]; const u32x4 i0_ = *(LAS u32x4*)(il + 8 * k), i1_ = *(LAS u32x4*)(il + 8 * k + 4); idr[0] = i0_.x; idr[1] = i0_.y; idr[2] = i0_.z; idr[3] = i0_.w; idr[4] = i1_.x; idr[5] = i1_.y; idr[6] = i1_.z; idr[7] = i1_.w; } while (0)
#define PU_G1(s_, BB) uq[s_][BB] = *(const u32x4*)(U8 + (size_t)((((BB) & 1) ? (idr[(BB) >> 1] >> 16) : (idr[(BB) >> 1] & 0xffffu)) * 128u + 16u * (unsigned)j))
#define PU_GATHER(s_, h_) do { PU_G1(s_, 8 * (h_) + 0); PU_G1(s_, 8 * (h_) + 1); PU_G1(s_, 8 * (h_) + 2); PU_G1(s_, 8 * (h_) + 3); PU_G1(s_, 8 * (h_) + 4); PU_G1(s_, 8 * (h_) + 5); PU_G1(s_, 8 * (h_) + 6); PU_G1(s_, 8 * (h_) + 7); } while (0)
#define PU_MATH(s_, h_, pd_) do { _Pragma("unroll") for (int b_ = 0; b_ < 8; ++b_) { const int bb = 8 * (h_) + b_; const unsigned x_[4] = {uq[s_][bb].x, uq[s_][bb].y, uq[s_][bb].z, uq[s_][bb].w}; int a1_ = 0; \
        _Pragma("unroll") for (int w_ = 0; w_ < 4; ++w_) a1_ = __builtin_amdgcn_sdot8((int)x_[w_], hp1[w_], a1_, false); \
        int a0_ = a1_ * 16;     \
        _Pragma("unroll") for (int w_ = 0; w_ < 4; ++w_) a0_ = __builtin_amdgcn_sdot8((int)x_[w_], hp0[w_], a0_, false); \
        pd_[bb] = a0_; } } while (0)
    PU_LOADID(0, 0); PU_LOADID(1, 1); PU_LOADH(0, 0); PU_LOADH(1, 1);
    PU_IDS(0); PU_GATHER(0, 0); PU_GATHER(0, 1); PU_IDS(1); PU_GATHER(1, 0); PU_GATHER(1, 1);
    PU_LOADID(0, 2);
    __builtin_amdgcn_s_waitcnt(0x0F70);
#pragma unroll 1
    for (int it = 0; it < nit; it += 2) {
#pragma unroll
        for (int a = 0; a < 2; ++a) {
            const int i = it + a, bq = 1 - a;
            int hp0[4], hp1[4]; float hsc;
            { const float h0_ = __uint_as_float(hr[a].x << 16) * gsr[a].x, h1_ = __uint_as_float(hr[a].x & 0xffff0000u) * gsr[a].y, h2_ = __uint_as_float(hr[a].y << 16) * gsr[a].z, h3_ = __uint_as_float(hr[a].y & 0xffff0000u) * gsr[a].w;
              float am = fmaxf(fmaxf(fabsf(h0_), fabsf(h1_)), fmaxf(fabsf(h2_), fabsf(h3_)));
              am = fmaxf(am, dpp_f<0xB1>(am)); am = fmaxf(am, dpp_f<0x4E>(am)); am = fmaxf(am, dpp_f<0x141>(am)); am = fmaxf(am, dpp_f<0x140>(am)); am = xmax16(am); am = xmax32(am);
              hsc = am > 0.f ? am * (1.0f / 119.0f) : 1.0f; const float inv = am > 0.f ? 119.0f * __builtin_amdgcn_rcpf(am) : 0.f;
              unsigned u0 = __builtin_amdgcn_cvt_pk_u8_f32(h0_ * inv + 136.0f, 0, 0u); u0 = __builtin_amdgcn_cvt_pk_u8_f32(h1_ * inv + 136.0f, 1, u0); u0 = __builtin_amdgcn_cvt_pk_u8_f32(h2_ * inv + 136.0f, 2, u0); u0 = __builtin_amdgcn_cvt_pk_u8_f32(h3_ * inv + 136.0f, 3, u0);
              hl[lane] = u0;
              const u32x4 lo4 = *(LAS u32x4*)(hl + 4 * j), hi4 = *(LAS u32x4*)(hl + 32 + 4 * j);
              const unsigned L8_[4] = {lo4.x, lo4.y, lo4.z, lo4.w}, H8_[4] = {hi4.x, hi4.y, hi4.z, hi4.w};
#pragma unroll
              for (int w = 0; w < 4; ++w) { const unsigned L8 = L8_[w], H8 = H8_[w];
                  hp0[w] = (int)(((L8 & 0x0f0f0f0fu) | ((H8 & 0x0f0f0f0fu) << 4)) ^ 0x88888888u);
                  hp1[w] = (int)((((L8 >> 4) & 0x0f0f0f0fu) | (H8 & 0xf0f0f0f0u)) ^ 0x88888888u); } }
            PU_LOADH(a, i + 2); PU_LOADID(bq, i + 3);
            int v16[16];
            PU_IDS(a); PU_MATH(a, 0, v16); PU_GATHER(a, 0);
            PU_MATH(a, 1, v16); PU_GATHER(a, 1);
            int v8[8], v4[4], v2[2];
#pragma unroll
            for (int m = 0; m < 8; ++m) { const int kp = (j & 4) ? v16[8 + m] : v16[m], sd = (j & 4) ? v16[m] : v16[8 + m]; v8[m] = kp + dpp_i<0x141>(sd); }
#pragma unroll
            for (int m = 0; m < 4; ++m) { const int kp = (j & 2) ? v8[4 + m] : v8[m], sd = (j & 2) ? v8[m] : v8[4 + m]; v4[m] = kp + dpp_i<0x4E>(sd); }
#pragma unroll
            for (int m = 0; m < 2; ++m) { const int kp = (j & 1) ? v4[2 + m] : v4[m], sd = (j & 1) ? v4[m] : v4[2 + m]; v2[m] = kp + dpp_i<0xB1>(sd); }
            if (i < nit) { unsigned* pd = (unsigned*)(MODE == 1 ? (float*)(p.ws + WS_HB) : PD) + ((size_t)S.x * NT + (S.wq + i * S.nwq)) * 64 + lane; *pd = pk2((float)v2[0] * hsc, (float)v2[1] * hsc); }
        }
    }
#undef PU_TOK
#undef PU_LOADID
#undef PU_LOADH
#undef PU_GATHER
#undef PU_G1
#undef PU_MATH
}

__device__ __forceinline__ float erf_bl(float x) {
    const float ax = fabsf(x), t = __builtin_amdgcn_rcpf(1.0f + 0.3275911f * ax);
    const float pl = ((((1.061405429f * t - 1.453152027f) * t + 1.421413741f) * t - 0.284496736f) * t + 0.254829592f) * t;
    const float y = 1.0f - pl * __builtin_amdgcn_exp2f(-ax * ax * 1.4426950408889634f);
    return copysignf(y, x);
}
__device__ __forceinline__ void ph_peer_r2(const Prm& p, const Ctx& C, int l, unsigned char* lds) {
    const unsigned* IDX = (const unsigned*)(p.ws + WS_VV); const unsigned* PW = (const unsigned*)(p.ws + WS_VV + 16 * MiB)  ; const unsigned* PD = (const unsigned*)(p.ws + WS_PD);
    unsigned char* CQ2 = p.ws + WS_VV + 32 * MiB; float* CSC = (float*)(p.ws + WS_VV + 40 * MiB);
    const float* SU = (const float*)(p.ws + WS_SC8) + (size_t)(l * 2) * NEXP; const float* SV = SU + NEXP;
    const size_t n2 = (size_t)NT * 64; const int lane = C.lane;
    const int bidx = 64 * (lane & 1) + 8 * ((lane >> 1) & 3) + (lane >> 3);
    LAS unsigned char* wl = (LAS unsigned char*)lds + C.wave * 256;
    for (int t = C.gw; t < NT; t += C.ngw) {
        unsigned pd0 = PD[(size_t)t * 64 + lane], pd1 = PD[n2 + (size_t)t * 64 + lane], pd2 = PD[2 * n2 + (size_t)t * 64 + lane], pd3 = PD[3 * n2 + (size_t)t * 64 + lane];
        float r = ((const float*)(p.ws + WS_FC))[t];
        unsigned idw = IDX[(size_t)t * 64 + lane];
        unsigned pwb = PW[(size_t)t * 64 + lane];
        asm volatile("" : "+v"(pd0), "+v"(pd1), "+v"(pd2), "+v"(pd3), "+v"(r), "+v"(idw), "+v"(pwb));
        const f32x2 pw = {__uint_as_float(pwb << 16), __uint_as_float(pwb & 0xffff0000u)};
        const f32x2 sa = {(__uint_as_float(pd0 << 16) + __uint_as_float(pd1 << 16)) + (__uint_as_float(pd2 << 16) + __uint_as_float(pd3 << 16)), (__uint_as_float(pd0 & 0xffff0000u) + __uint_as_float(pd1 & 0xffff0000u)) + (__uint_as_float(pd2 & 0xffff0000u) + __uint_as_float(pd3 & 0xffff0000u))};
        const int id0 = (int)(idw & 0xffffu), id1 = (int)(idw >> 16);
        const f32x4* REC = (const f32x4*)(p.ws + WS_T8 + ((size_t)(l * 2 + 0) * 8 + 4) * NEXP * 128) + (size_t)(t / SEQ) * NEXP;
        f32x4 rc0 = REC[id0], rc1 = REC[id1];
        asm volatile("" : "+v"(rc0), "+v"(rc1));
        const float us0 = rc0.x, su0 = rc0.y, sv0 = rc0.z, us1 = rc1.x, su1 = rc1.y, sv1 = rc1.z;
        const float d0 = sa.x * r * su0 + us0, d1 = sa.y * r * su1 + us1;
        const float cf0 = pw.x * (0.5f * d0 * (1.0f + erf_bl(d0 * 0.70710678118654752f))) * sv0;
        const float cf1 = pw.y * (0.5f * d1 * (1.0f + erf_bl(d1 * 0.70710678118654752f))) * sv1;
        float cmx = fmaxf(fabsf(cf0), fabsf(cf1));
        cmx = fmaxf(cmx, dpp_f<0xB1>(cmx)); cmx = fmaxf(cmx, dpp_f<0x4E>(cmx)); cmx = fmaxf(cmx, dpp_f<0x141>(cmx)); cmx = fmaxf(cmx, dpp_f<0x140>(cmx));
        cmx = xmax16(cmx); cmx = xmax32(cmx);
        const float inv = cmx > 0.f ? 16383.0f / cmx : 0.f;
        const int q0 = (int)rintf(cf0 * inv), q1 = (int)rintf(cf1 * inv);
        wl[bidx] = (unsigned char)(q0 >> 7); wl[bidx + 128] = (unsigned char)(q0 & 127); wl[bidx + 32] = (unsigned char)(q1 >> 7); wl[bidx + 160] = (unsigned char)(q1 & 127);
        int qs = q0 + q1;
        qs += dpp_i<0xB1>(qs); qs += dpp_i<0x4E>(qs); qs += dpp_i<0x141>(qs); qs += dpp_i<0x140>(qs); qs = xsumi16(qs); qs = xsumi32(qs);
        ((unsigned*)(CQ2 + (size_t)t * 256))[lane] = ((LAS unsigned*)wl)[lane];
        if (lane == 0) { const float sc = cmx * (1.0f / 16383.0f); *(f32x2*)(CSC + 2 * (size_t)t) = (f32x2){sc, 8.0f * sc * (float)qs}; }
    }
}
__device__ __forceinline__ void ph_peer_v2(const Prm& p, const Ctx& C, int l, unsigned char* lds) {
    SliceCtx S; S.x = blockIdx.x & 3; S.wq = (blockIdx.x >> 2) * NWAVES + C.wave; S.nwq = (((int)gridDim.x - S.x + 3) >> 2) * NWAVES;
    const unsigned short* IDX = (const unsigned short*)(p.ws + WS_VV); const unsigned char* CQ2 = p.ws + WS_VV + 32 * MiB; const f32x2* CSC = (const f32x2*)(p.ws + WS_VV + 40 * MiB);
    const float* MOD = (const float*)(p.ws + WS_MOD) + (size_t)l * NB * MODW;
    const unsigned char* V8 = p.ws + WS_T8 + ((size_t)(l * 2 + 1) * 8 + S.x) * NEXP * 128;
    const int lane = C.lane, j = lane & 7, k = lane >> 3, jq = (lane >> 2) & 1, n16 = lane & 15, q4 = lane >> 4;
    LAS unsigned* il = (LAS unsigned*)((LAS unsigned char*)lds + 131072 + C.wave * 256); unsigned idr[8];
    LAS unsigned char* wl = (LAS unsigned char*)lds + C.wave * 16384;
    const int wb_e = 128 * k + 32 * ((j >> 1) ^ ((k >> 1) & 1)) + 16 * (j & 1), wb_o = 128 * k + 32 * ((j >> 1) ^ ((k >> 1) & 1) ^ 2) + 16 * (j & 1);
    const int rr = (lane >> 2) & 3, pp = lane & 3, fr = ((rr >> 1) & 1) | ((q4 & 1) << 1);
    int rb[4];
#pragma unroll
    for (int nt = 0; nt < 4; ++nt) rb[nt] = 128 * (8 * q4 + rr) + 32 * (nt ^ fr) + 8 * pp;
    const unsigned selA0 = (lane & 1) ? 0x010c000cu : 0x0c010c00u, selB0 = (lane & 1) ? 0x030c020cu : 0x0c030c02u;
    const unsigned selAL = (lane & 4) ? 0x0c0c0c0cu : selA0, selBL = (lane & 4) ? 0x0c0c0c0cu : selB0, selAH = (lane & 4) ? selA0 : 0x0c0c0c0cu, selBH = (lane & 4) ? selB0 : 0x0c0c0c0cu;
    const int cqo = 128 * ((lane >> 1) & 1) + 32 * q4;
    const int ocol = 256 * S.x + 128 * (q4 & 1) + 64 * (q4 >> 1) + 2 * n16;
    u32x4 vq[2][16]; unsigned idw[2]; u32x4 cqa[2][2]; f32x2 csv[2]; unsigned xvb[2][2]; f32x2 gvv[2][2];
    const bf16_t* XR1 = (const bf16_t*)(p.ws + WS_XR1); bf16_t* XR2 = (bf16_t*)p.out;
    const int nit = (NT - S.wq + S.nwq - 1) / S.nwq;
#define PV_TOK(i) (S.wq + ((i) < nit ? (i) : nit - 1) * S.nwq)
#define PV_LOADID(s_, i) do { idw[s_] = ((const unsigned*)IDX)[(size_t)PV_TOK(i) * 64 + lane]; } while (0)
#define PV_LOADC(s_, i) do { const int t_ = PV_TOK(i); const unsigned char* cp_ = CQ2 + (size_t)t_ * 256 + cqo; cqa[s_][0] = *(const u32x4*)cp_; cqa[s_][1] = *(const u32x4*)(cp_ + 16); csv[s_] = CSC[t_]; \
        xvb[s_][0] = *(const unsigned*)(XR1 + (size_t)t_ * DM + ocol); xvb[s_][1] = *(const unsigned*)(XR1 + (size_t)t_ * DM + ocol + 32); gvv[s_][0] = *(const f32x2*)(MOD + (size_t)(t_ / SEQ) * MODW + 5 * DM + ocol); gvv[s_][1] = *(const f32x2*)(MOD + (size_t)(t_ / SEQ) * MODW + 5 * DM + ocol + 32); } while (0)
#define PV_IDS(s_) do { il[lane] = idw[s_]; const u32x4 i0_ = *(LAS u32x4*)(il + 8 * k), i1_ = *(LAS u32x4*)(il + 8 * k + 4); idr[0] = i0_.x; idr[1] = i0_.y; idr[2] = i0_.z; idr[3] = i0_.w; idr[4] = i1_.x; idr[5] = i1_.y; idr[6] = i1_.z; idr[7] = i1_.w; } while (0)
#define PV_G1(s_, BB) vq[s_][BB] = *(const u32x4*)(V8 + (size_t)((((BB) & 1) ? (idr[(BB) >> 1] >> 16) : (idr[(BB) >> 1] & 0xffffu)) * 128u + 16u * (unsigned)j))
#define PV_GATHER(s_, h_) do { PV_G1(s_, 8 * (h_) + 0); PV_G1(s_, 8 * (h_) + 1); PV_G1(s_, 8 * (h_) + 2); PV_G1(s_, 8 * (h_) + 3); PV_G1(s_, 8 * (h_) + 4); PV_G1(s_, 8 * (h_) + 5); PV_G1(s_, 8 * (h_) + 6); PV_G1(s_, 8 * (h_) + 7); } while (0)
#define PV_W1(s_, h_, B_) *(LAS u32x4*)(wl + 8192 * (h_) + 1024 * (B_) + (((B_) & 1) ? wb_o : wb_e)) = vq[s_][8 * (h_) + (B_)]
#define PV_WRITE(s_, h_) do { PV_W1(s_, h_, 0); PV_W1(s_, h_, 1); PV_W1(s_, h_, 2); PV_W1(s_, h_, 3); PV_W1(s_, h_, 4); PV_W1(s_, h_, 5); PV_W1(s_, h_, 6); PV_W1(s_, h_, 7); } while (0)
#define PV_TR(h_, ksl_, nt_, rd_) __builtin_amdgcn_ds_read_tr16_b64_v4i16((LAS s16x4*)(wl + 8192 * (h_) + 4096 * (ksl_) + 512 * (rd_) + rb[nt_]))
#define PV_MMA(h_) do { _Pragma("unroll") for (int ksl_ = 0; ksl_ < 2; ++ksl_) { const int ks_ = 2 * (h_) + ksl_; const unsigned w0_ = cw[2 * ks_], w1_ = cw[2 * ks_ + 1]; \
        const i32x4 AL_ = {(int)__builtin_amdgcn_perm(w0_, w0_, selAL), (int)__builtin_amdgcn_perm(w0_, w0_, selBL), (int)__builtin_amdgcn_perm(w1_, w1_, selAL), (int)__builtin_amdgcn_perm(w1_, w1_, selBL)}; \
        const i32x4 AH_ = {(int)__builtin_amdgcn_perm(w0_, w0_, selAH), (int)__builtin_amdgcn_perm(w0_, w0_, selBH), (int)__builtin_amdgcn_perm(w1_, w1_, selAH), (int)__builtin_amdgcn_perm(w1_, w1_, selBH)}; \
        _Pragma("unroll") for (int nt_ = 0; nt_ < 4; ++nt_) { const s16x4 b0_ = PV_TR(h_, ksl_, nt_, 0), b1_ = PV_TR(h_, ksl_, nt_, 1); const i32x2 c0_ = __builtin_bit_cast(i32x2, b0_), c1_ = __builtin_bit_cast(i32x2, b1_); \
            const i32x4 BL_ = {c0_.x & 0x0f0f0f0f, c0_.y & 0x0f0f0f0f, c1_.x & 0x0f0f0f0f, c1_.y & 0x0f0f0f0f}, BH_ = {c0_.x, c0_.y, c1_.x, c1_.y};     \
            acc[nt_] = __builtin_amdgcn_mfma_i32_16x16x64_i8(AL_, BL_, acc[nt_], 0, 0, 0); acc[nt_] = __builtin_amdgcn_mfma_i32_16x16x64_i8(AH_, BH_, acc[nt_], 0, 0, 0); } } } while (0)
    PV_LOADID(0, 0); PV_LOADID(1, 1); PV_LOADC(0, 0);
    PV_IDS(0); PV_GATHER(0, 0); PV_GATHER(0, 1); PV_IDS(1); PV_GATHER(1, 0); PV_GATHER(1, 1);
    PV_LOADID(0, 2);
    __builtin_amdgcn_s_waitcnt(0x0F70);
#pragma unroll 1
    for (int it = 0; it < nit; it += 2) {
#pragma unroll
        for (int a = 0; a < 2; ++a) {
            const int i = it + a, bq = 1 - a;
            const unsigned cw[8] = {cqa[a][0].x, cqa[a][0].y, cqa[a][0].z, cqa[a][0].w, cqa[a][1].x, cqa[a][1].y, cqa[a][1].z, cqa[a][1].w}; const f32x2 cback = csv[a]; const f32x2 xv0 = {__uint_as_float(xvb[a][0] << 16), __uint_as_float(xvb[a][0] & 0xffff0000u)}, xv1 = {__uint_as_float(xvb[a][1] << 16), __uint_as_float(xvb[a][1] & 0xffff0000u)}, gv0 = gvv[a][0], gv1 = gvv[a][1];
            PV_LOADC(bq, i + 1); PV_LOADID(bq, i + 3);
            i32x4 acc[4];
#pragma unroll
            for (int nt = 0; nt < 4; ++nt) acc[nt] = (i32x4){0, 0, 0, 0};
            PV_IDS(a); PV_WRITE(a, 0); PV_GATHER(a, 0); PV_MMA(0);
            PV_WRITE(a, 1); PV_GATHER(a, 1); PV_MMA(1);
            const i32x4 a0 = (q4 >> 1) ? acc[2] : acc[0], a1 = (q4 >> 1) ? acc[3] : acc[1];
            const float mf = (q4 & 1) ? cback.x * 0.0625f : cback.x, sb = (q4 & 1) ? 0.f : cback.y;
            int v00 = a0.x * 128 + a0.z, v01 = a0.y * 128 + a0.w, v10 = a1.x * 128 + a1.z, v11 = a1.y * 128 + a1.w;
            { const int p00 = (int)__builtin_amdgcn_permlane16_swap((unsigned)v00, (unsigned)v00, false, false)[0], p01 = (int)__builtin_amdgcn_permlane16_swap((unsigned)v01, (unsigned)v01, false, false)[0], p10 = (int)__builtin_amdgcn_permlane16_swap((unsigned)v10, (unsigned)v10, false, false)[0], p11 = (int)__builtin_amdgcn_permlane16_swap((unsigned)v11, (unsigned)v11, false, false)[0];
              if (q4 & 1) { v00 -= p00; v01 -= p01; v10 -= p10; v11 -= p11; } }
            const f32x2 y0 = {(float)v00 * mf - sb, (float)v01 * mf - sb}, y1 = {(float)v10 * mf - sb, (float)v11 * mf - sb};
            if (i < nit) {
                const int t = S.wq + i * S.nwq;
                const f32x2 o0 = xv0 + gv0 * y0, o1 = xv1 + gv1 * y1;
                if (l == 0) { *(unsigned*)(XR2 + (size_t)t * DM + ocol) = pg8::cvt_pk_bf16(o0.x, o0.y); *(unsigned*)(XR2 + (size_t)t * DM + ocol + 32) = pg8::cvt_pk_bf16(o1.x, o1.y); }
                else { *(f32x2*)(p.out + (size_t)t * DM + ocol) = o0; *(f32x2*)(p.out + (size_t)t * DM + ocol + 32) = o1; }
            }
        }
    }
#undef PV_TOK
#undef PV_LOADID
#undef PV_LOADC
#undef PV_GATHER
#undef PV_G1
#undef PV_W1
#undef PV_WRITE
#undef PV_TR
#undef PV_MMA
}

constexpr int PH_PER_LAYER = 11, NPH = 1 + 2 * PH_PER_LAYER;

__global__ void __launch_bounds__(NTHREADS, 2) mega(Prm p0) {
    extern __shared__ __attribute__((aligned(16))) unsigned char lds[];
    const int ph_lo = p0.ph_lo, ph_hi = p0.ph_hi;
    volatile LAS unsigned* bst = (volatile LAS unsigned*)((LAS unsigned char*)lds + (LDS_BYTES - 64));
    if (threadIdx.x < 16) bst[threadIdx.x] = 0u;
    __syncthreads();
    XcdBarrier bar = xcd_barrier_post((unsigned*)(p0.ws + WS_CTL), bst);
#define PHASE_BEGIN(k) if (ph_lo <= (k) && (k) < ph_hi) { Prm p = p0; Ctx C; \
        { size_t z_ = 0; asm volatile("" : "+s"(z_));     \
          p.x = (const float*)((const char*)p0.x + z_); p.c = (const float*)((const char*)p0.c + z_); p.ada_w = (const float*)((const char*)p0.ada_w + z_); p.ada_b = (const float*)((const char*)p0.ada_b + z_); \
          p.attn_norm = (const float*)((const char*)p0.attn_norm + z_); p.ffn_norm = (const float*)((const char*)p0.ffn_norm + z_); p.w_in = (const float*)((const char*)p0.w_in + z_); p.fox_bf = (const float*)((const char*)p0.fox_bf + z_); \
          p.gq = (const float*)((const char*)p0.gq + z_); p.gk = (const float*)((const char*)p0.gk + z_); p.w_branch = (const float*)((const char*)p0.w_branch + z_); p.w_out = (const float*)((const char*)p0.w_out + z_); \
          p.wq = (const float*)((const char*)p0.wq + z_); p.k1 = (const float*)((const char*)p0.k1 + z_); p.k2 = (const float*)((const char*)p0.k2 + z_); p.pu = (const float*)((const char*)p0.pu + z_); p.pv = (const float*)((const char*)p0.pv + z_); \
          p.out = (float*)((char*)p0.out + z_); p.ws = p0.ws + z_; } \
        C.tid = threadIdx.x; asm volatile("" : "+v"(C.tid)); C.lane = C.tid & 63; C.wave = __builtin_amdgcn_readfirstlane(C.tid >> 6); \
        C.gw = blockIdx.x * NWAVES + C.wave; C.ngw = gridDim.x * NWAVES;
#define PHASE_END(k) if ((k) + 1 < ph_hi) { xcd_barrier(bar); } }
    PHASE_BEGIN(0) ph_mod(p, C); ph_weights(p, C, lds); ph_convert_tables8s(p, C); PHASE_END(0)
#pragma unroll 1
    for (int l = 0; l < 2; ++l) {
        const int k0 = 1 + l * PH_PER_LAYER;
        PHASE_BEGIN(k0 + 0) ph_norm<true>(p, C, l, p.x, l == 0 ? (const bf16_t*)nullptr : (const bf16_t*)p.out, p.attn_norm + l * DM, 0, 1, lds); ph_peer_pre(p, C, l); PHASE_END(k0 + 0)
        PHASE_BEGIN(k0 + 1) ph_gemm1(p, l, lds); PHASE_END(k0 + 1)
        PHASE_BEGIN(k0 + 2) ph_attn<3>(p, C, l, lds); PHASE_END(k0 + 2)
        PHASE_BEGIN(k0 + 3) ph_merge(p, l, lds); PHASE_END(k0 + 3)
        PHASE_BEGIN(k0 + 4) ph_out(p, l, lds); PHASE_END(k0 + 4)
        PHASE_BEGIN(k0 + 6) ph_q(p, l, lds); PHASE_END(k0 + 6)
        PHASE_BEGIN(k0 + 7) ph_topk(p, C, l, lds); PHASE_END(k0 + 7)
        PHASE_BEGIN(k0 + 8) ph_peer_u4(p, C, l, lds); PHASE_END(k0 + 8)
        PHASE_BEGIN(k0 + 9) ph_peer_r2(p, C, l, lds); PHASE_END(k0 + 9)
        PHASE_BEGIN(k0 + 10) ph_peer_v2(p, C, l, lds); PHASE_END(k0 + 10)
    }
}

extern "C" void kernel_launch(void* const* d_in, const int* in_sizes, int n_in, void* d_out, int out_size, void* d_ws, size_t ws_size, hipStream_t stream) {
    static int grid = 0;
    if (grid == 0) {
        if (n_in != 17 || out_size != NT * DM || ws_size < WS_END) { fprintf(stderr, "kernel_launch: unexpected shapes (n_in %d out %d ws %zu)\n", n_in, out_size, ws_size); grid = -1; return; }
        int dev = 0, cus = 0, per_cu = 0;
        hipGetDevice(&dev); hipDeviceGetAttribute(&cus, hipDeviceAttributeMultiprocessorCount, dev);
        hipFuncSetAttribute((const void*)mega, hipFuncAttributeMaxDynamicSharedMemorySize, LDS_BYTES);
        hipOccupancyMaxActiveBlocksPerMultiprocessor(&per_cu, (const void*)mega, NTHREADS, LDS_BYTES);
        if (per_cu < 1) { fprintf(stderr, "kernel_launch: occupancy query says %d blocks per CU\n", per_cu); per_cu = 1; }
        (void)hipGetLastError();
        grid = cus;
    }
    if (grid < 0) return;
    if (hipMemsetAsync((char*)d_ws + WS_CTL, 0, 32768, stream) != hipSuccess) { fprintf(stderr, "kernel_launch: memset of the barrier words failed\n"); return; }
    Prm p{};
    const float** pp = (const float**)&p;
    for (int i = 0; i < 17; ++i) pp[i] = (const float*)d_in[i];
    p.out = (float*)d_out; p.ws = (unsigned char*)d_ws;
#if MK_MULTI
    for (int ph = 0; ph < NPH; ++ph) { p.ph_lo = ph; p.ph_hi = ph + 1; hipLaunchKernelGGL(mega, dim3(grid), dim3(NTHREADS), LDS_BYTES, stream, p); }
#else
    p.ph_lo = 0; p.ph_hi = NPH;
    void* args[] = {&p};
    hipError_t e = hipLaunchCooperativeKernel((const void*)mega, dim3(grid), dim3(NTHREADS), args, LDS_BYTES, stream);
    if (e != hipSuccess) fprintf(stderr, "cooperative launch failed: %s (grid %d)\n", hipGetErrorString(e), grid);
#endif
}
```
